# Optimizing an MI355X kernel written in HIP

```python
import jax, jax.numpy as jnp
from jax import lax
import numpy as np

D_MODEL = 1024
BATCH = 2
SEQ = 8192
DEPTH = 1

RET_HEADS = 4
RET_DK = 128
RET_DV = 256
RET_CHUNK = 128
ROPE_THETA = 10000.0
CONV_WIDTH = 1024
CONV_K = 3
N_EXPERTS = 256
TOP_K = 8
N_GROUPS = 8
TOPK_GROUPS = 4
EXPERT_HIDDEN = 256
SHARED_HIDDEN = 256
ROUTED_SCALE = 2.5
EXPERT_BLOCK = 128
NORM_EPS = 1e-6

Q_W = RET_HEADS * RET_DK
V_W = RET_HEADS * RET_DV
IN_SIZES = (Q_W, Q_W, V_W, V_W, CONV_WIDTH, CONV_WIDTH, CONV_WIDTH, D_MODEL, D_MODEL)
IN_WIDTH = Q_W * 2 + V_W * 2 + CONV_WIDTH * 3 + D_MODEL * 2
IN_OFFSETS = (Q_W, 2 * Q_W, 2 * Q_W + V_W, 2 * Q_W + 2 * V_W, 2 * Q_W + 2 * V_W + CONV_WIDTH,
              2 * Q_W + 2 * V_W + 2 * CONV_WIDTH, 2 * Q_W + 2 * V_W + 3 * CONV_WIDTH,
              2 * Q_W + 2 * V_W + 3 * CONV_WIDTH + D_MODEL)

kernel_name = 'hybrid_retention_shortconv_moe_block'


def rmsnorm(x, g):
    xf = x.astype(jnp.float32)
    y = xf * lax.rsqrt(jnp.mean(xf * xf, axis=-1, keepdims=True) + NORM_EPS)
    return (y * g.astype(jnp.float32)).astype(x.dtype)


def rope(t, positions):
    inv_freq = ROPE_THETA ** (-jnp.arange(0, RET_DK, 2, dtype=jnp.float32) / RET_DK)
    ang = positions.astype(jnp.float32)[..., None] * inv_freq
    cos = jnp.cos(ang)[:, :, None, :]
    sin = jnp.sin(ang)[:, :, None, :]
    tf = t.astype(jnp.float32)
    t1, t2 = tf[..., :RET_DK // 2], tf[..., RET_DK // 2:]
    return jnp.concatenate([t1 * cos - t2 * sin, t2 * cos + t1 * sin], axis=-1).astype(t.dtype)


def retention_chunkwise(q, k, v):
    B, S = q.shape[0], q.shape[1]
    C = RET_CHUNK
    N = S // C
    dt = q.dtype

    def chunks(t):
        return t.reshape(B, N, C, RET_HEADS, -1).transpose(0, 3, 1, 2, 4)

    q, k, v = chunks(q), chunks(k), chunks(v)
    log_g = jnp.log1p(-(2.0 ** (-5.0 - jnp.arange(RET_HEADS, dtype=jnp.float32))))
    idx = jnp.arange(C, dtype=jnp.float32)
    diff = idx[:, None] - idx[None, :]
    intra = jnp.where(diff >= 0, jnp.exp(log_g[:, None, None] * jnp.maximum(diff, 0.0)), 0.0)
    k_decay = jnp.exp(log_g[:, None] * (C - 1 - idx))
    q_decay = jnp.exp(log_g[:, None] * (idx + 1.0))
    chunk_decay = jnp.exp(log_g * C)

    scores = jnp.einsum('bhnid,bhnjd->bhnij', q, k) * intra[None, :, None].astype(dt)
    inner = jnp.einsum('bhnij,bhnjv->bhniv', scores, v)
    kv = jnp.einsum('bhncd,bhncv->nbhdv', k * k_decay[None, :, None, :, None].astype(dt), v)

    def step(state, kv_n):
        return state * chunk_decay[None, :, None, None].astype(dt) + kv_n, state

    _, s_prev = lax.scan(step, jnp.zeros((B, RET_HEADS, RET_DK, RET_DV), dt), kv)
    cross = jnp.einsum('bhncd,nbhdv->bhncv', q * q_decay[None, :, None, :, None].astype(dt), s_prev)
    return (inner + cross).transpose(0, 2, 3, 1, 4).reshape(B, S, RET_HEADS, RET_DV)


def causal_dwconv(z, w):
    return lax.conv_general_dilated(z, w[:, None, :].astype(z.dtype), window_strides=(1,),
                                    padding=[(CONV_K - 1, 0)], dimension_numbers=('NWC', 'WIO', 'NWC'),
                                    feature_group_count=z.shape[-1])


def token_mixer(h, positions, w_in, ret_norm_g, conv_w, w_br_ret, w_br_conv, w_out):
    B, S, _ = h.shape
    q, k, v, g_ret, u, gate_c, gate_b, m_ret, m_conv = jnp.split(h @ w_in, IN_OFFSETS, axis=-1)
    q = rope(q.reshape(B, S, RET_HEADS, RET_DK), positions) * (RET_DK ** -0.5)
    k = rope(k.reshape(B, S, RET_HEADS, RET_DK), positions)
    ret = retention_chunkwise(q, k, v.reshape(B, S, RET_HEADS, RET_DV))
    ret = rmsnorm(ret, ret_norm_g.reshape(RET_HEADS, RET_DV)).reshape(B, S, V_W)
    y_ret = (jax.nn.silu(g_ret) * ret) @ w_br_ret
    y_conv = (gate_b * causal_dwconv(gate_c * u, conv_w)) @ w_br_conv
    mix = jax.nn.sigmoid(m_ret) * y_ret + jax.nn.sigmoid(m_conv) * y_conv
    return mix @ w_out


def swiglu(x, wg, wu, wd):
    return (jax.nn.silu(x @ wg) * (x @ wu)) @ wd


def moe(h, w_router, router_bias, w_exp_gate, w_exp_up, w_exp_down, w_sh_gate, w_sh_up, w_sh_down):
    T, D = h.shape
    dt = h.dtype
    scores = jax.nn.sigmoid(h.astype(jnp.float32) @ w_router.astype(jnp.float32))
    choice = scores + router_bias.astype(jnp.float32)
    grp_score = lax.top_k(choice.reshape(T, N_GROUPS, N_EXPERTS // N_GROUPS), 2)[0].sum(-1)
    _, gidx = lax.top_k(grp_score, TOPK_GROUPS)
    gmask = jax.nn.one_hot(gidx, N_GROUPS, dtype=jnp.float32).sum(1) > 0
    masked = jnp.where(jnp.repeat(gmask, N_EXPERTS // N_GROUPS, axis=-1), choice, -jnp.inf)
    _, eidx = lax.top_k(masked, TOP_K)
    wts = jnp.take_along_axis(scores, eidx, axis=-1)
    wts = wts / jnp.sum(wts, axis=-1, keepdims=True) * ROUTED_SCALE

    A = T * TOP_K
    flat_e = eidx.reshape(-1)
    flat_tok = jnp.repeat(jnp.arange(T, dtype=jnp.int32), TOP_K)
    flat_w = wts.reshape(-1)
    order = jnp.argsort(flat_e)
    se, stok, sw = flat_e[order], flat_tok[order], flat_w[order]
    counts = jnp.bincount(flat_e, length=N_EXPERTS)
    start = jnp.cumsum(counts) - counts
    pcounts = (counts + EXPERT_BLOCK - 1) // EXPERT_BLOCK * EXPERT_BLOCK
    pend = jnp.cumsum(pcounts)
    pstart = pend - pcounts
    dest = pstart[se] + (jnp.arange(A, dtype=jnp.int32) - start[se])
    n_blocks = -(-A // EXPERT_BLOCK) + N_EXPERTS
    P = n_blocks * EXPERT_BLOCK
    buf_tok = jnp.full((P,), T, jnp.int32).at[dest].set(stok)
    buf_w = jnp.zeros((P,), jnp.float32).at[dest].set(sw)
    block_e = jnp.minimum(jnp.searchsorted(pend, jnp.arange(n_blocks) * EXPERT_BLOCK, side='right'),
                          N_EXPERTS - 1)
    h_pad = jnp.concatenate([h, jnp.zeros((1, D), dt)], axis=0)

    def expert_block(args):
        tok, w_rows, e = args
        out = swiglu(h_pad[tok], w_exp_gate[e], w_exp_up[e], w_exp_down[e])
        return out * w_rows[:, None].astype(dt)

    out_buf = lax.map(expert_block, (buf_tok.reshape(n_blocks, EXPERT_BLOCK),
                                     buf_w.reshape(n_blocks, EXPERT_BLOCK), block_e))
    routed = jnp.zeros((T + 1, D), dt).at[buf_tok].add(out_buf.reshape(P, D))[:T]
    return routed + swiglu(h, w_sh_gate, w_sh_up, w_sh_down)


def setup_inputs(seed: int = 0) -> dict:
    key = jax.random.key(seed)
    ks = jax.random.split(key, 24)
    L, D, E, F = DEPTH, D_MODEL, N_EXPERTS, EXPERT_HIDDEN

    def nrm(k, shape, fan_in, scale=1.0):
        return jax.random.normal(k, shape, jnp.float32) * (scale * fan_in ** -0.5)

    def gain(k, shape):
        return 1.0 + 0.05 * jax.random.normal(k, shape, jnp.float32)

    return {
        'x': jax.random.normal(ks[0], (BATCH, SEQ, D), jnp.float32),
        'c': jax.random.normal(ks[1], (BATCH, D), jnp.float32),
        'positions': jnp.broadcast_to(jnp.arange(SEQ, dtype=jnp.int32), (BATCH, SEQ)),
        'w_ada': nrm(ks[2], (L, D, 6 * D), D, 0.5),
        'b_ada': 0.02 * jax.random.normal(ks[3], (L, 6 * D), jnp.float32),
        'norm_mix_g': gain(ks[4], (L, D)),
        'w_in': nrm(ks[5], (L, D, IN_WIDTH), D),
        'ret_norm_g': gain(ks[6], (L, V_W)),
        'conv_w': nrm(ks[7], (L, CONV_K, CONV_WIDTH), CONV_K),
        'w_br_ret': nrm(ks[8], (L, V_W, D), V_W),
        'w_br_conv': nrm(ks[9], (L, CONV_WIDTH, D), CONV_WIDTH),
        'w_out': nrm(ks[10], (L, D, D), D),
        'norm_ffn_g': gain(ks[11], (L, D)),
        'w_router': nrm(ks[12], (L, D, E), D),
        'router_bias': 0.01 * jax.random.normal(ks[13], (L, E), jnp.float32),
        'w_exp_gate': nrm(ks[14], (L, E, D, F), D),
        'w_exp_up': nrm(ks[15], (L, E, D, F), D),
        'w_exp_down': nrm(ks[16], (L, E, F, D), F),
        'w_sh_gate': nrm(ks[17], (L, D, SHARED_HIDDEN), D),
        'w_sh_up': nrm(ks[18], (L, D, SHARED_HIDDEN), D),
        'w_sh_down': nrm(ks[19], (L, SHARED_HIDDEN, D), SHARED_HIDDEN),
        'norm_final_g': gain(ks[20], (D,)),
    }


def reference(x, c, positions, w_ada, b_ada, norm_mix_g, w_in, ret_norm_g, conv_w, w_br_ret, w_br_conv,
              w_out, norm_ffn_g, w_router, router_bias, w_exp_gate, w_exp_up, w_exp_down,
              w_sh_gate, w_sh_up, w_sh_down, norm_final_g):
    B, S, D = x.shape
    for l in range(DEPTH):
        mod = jax.nn.silu(c) @ w_ada[l] + b_ada[l]
        sh1, sc1, g1, sh2, sc2, g2 = [m[:, None, :] for m in jnp.split(mod, 6, axis=-1)]
        h = rmsnorm(x, norm_mix_g[l]) * (1.0 + sc1) + sh1
        x = x + g1 * token_mixer(h, positions, w_in[l], ret_norm_g[l], conv_w[l],
                                 w_br_ret[l], w_br_conv[l], w_out[l])
        h = rmsnorm(x, norm_ffn_g[l]) * (1.0 + sc2) + sh2
        y = moe(h.reshape(B * S, D), w_router[l], router_bias[l], w_exp_gate[l], w_exp_up[l],
                w_exp_down[l], w_sh_gate[l], w_sh_up[l], w_sh_down[l])
        x = x + g2 * y.reshape(B, S, D)
    return rmsnorm(x, norm_final_g)
```

```cpp
#include <hip/hip_runtime.h>
#include <cstdio>
#include <cstdint>
namespace pg8 {
#define PG8_LAS __attribute__((address_space(3)))
typedef unsigned short bf16_t;
typedef short bf16x8 __attribute__((ext_vector_type(8)));
typedef float f32x4 __attribute__((ext_vector_type(4)));
typedef unsigned u32x4 __attribute__((ext_vector_type(4)));
constexpr int BM = 256, BK = 64, HALF = 128, HTB = HALF * BK * 2  , STAGE_BYTES = 8 * HTB, NXCD = 8, WGM = 8;

__host__ __device__ __forceinline__ int lds_byte(int r, int c) { const int st = (r >> 4) * 2 + (c >> 5), rr = r & 15, cc = c & 31, ob = rr * 64 + cc * 2; return st * 1024 + (ob ^ (((ob >> 9) & 1) << 5)); }
__host__ __device__ __forceinline__ void stage_rc(int b, int& R, int& C) { const int st = b / 1024, sb = b % 1024, swz = sb ^ (((sb >> 9) & 1) << 5); R = (st >> 1) * 16 + swz / 64; C = (st & 1) * 32 + (swz % 64) / 2; }
__host__ __device__ __forceinline__ int perm32(int rho) { const int n = rho >> 4, i = rho & 15; return 8 * (i >> 2) + 4 * n + (i & 3); }

struct Unit { int pm, pn; };
struct Gemm { const bf16_t* A; const bf16_t* Bt; int M, N, K; };

struct StaticOrder {
    int nM, nN, nwg, G, c;
    __host__ __device__ void init(int M, int N, int G_, int c_) { nM = M / BM; nN = N / BM; nwg = nM * nN; G = G_; c = c_; }
    __host__ __device__ bool next(int i, Unit& u) const {
        const long L = (long)i * G + c; if (L >= nwg) return false;
        int wgid = (int)L; { const int q = nwg / NXCD, r = nwg % NXCD, xcd = wgid % NXCD, off = wgid / NXCD; wgid = (xcd < r ? xcd * (q + 1) : r * (q + 1) + (xcd - r) * q) + off; }
        const int nig = WGM * nN, gid = wgid / nig, fm = gid * WGM, gsz = (nM - fm) < WGM ? (nM - fm) : WGM;
        u.pm = fm + ((wgid % nig) % gsz); u.pn = (wgid % nig) / gsz; return true;
    }
    __device__ __forceinline__ void a_ready(const Unit&) const {}
    __device__ __forceinline__ void done(const Unit&) const {}
};

__device__ __forceinline__ unsigned cvt_pk_bf16(float lo, float hi) { unsigned r; asm volatile("v_cvt_pk_bf16_f32 %0, %1, %2" : "=v"(r) : "v"(lo), "v"(hi)); return r; }
typedef float f32x2 __attribute__((ext_vector_type(2)));
typedef unsigned u32x2 __attribute__((ext_vector_type(2)));
__device__ __forceinline__ float bf_lo(unsigned w) { return __uint_as_float(w << 16); }
__device__ __forceinline__ float bf_hi(unsigned w) { return __uint_as_float(w & 0xffff0000u); }
__device__ __forceinline__ float sigm(float x) { return 1.0f / (1.0f + __expf(-x)); }
__device__ __forceinline__ float silu_f(float x) { return x / (1.0f + __expf(-x)); }

struct EpiBf16 {
    static constexpr bool PERM = true, AFTER_DRAIN = false;
    bf16_t* O; int ldc;
    __device__ __forceinline__ void operator()(const f32x4 (&acc)[2][2][4][2], const Unit& u, int wr, int wc, int fr, int fq) const {
        const int row0 = u.pm * BM + wr * 64 + fr; const int col0 = u.pn * BM + wc * 32 + 8 * fq;
#pragma unroll
        for (int ai = 0; ai < 2; ++ai)
#pragma unroll
            for (int m = 0; m < 4; ++m) { bf16_t* rowp = O + (size_t)(row0 + ai * HALF + m * 16) * ldc + col0;
#pragma unroll
                for (int bj = 0; bj < 2; ++bj) { const f32x4 v0 = acc[ai][bj][m][0], v1 = acc[ai][bj][m][1];
                    u32x4 w; w.x = cvt_pk_bf16(v0[0], v0[1]); w.y = cvt_pk_bf16(v0[2], v0[3]); w.z = cvt_pk_bf16(v1[0], v1[1]); w.w = cvt_pk_bf16(v1[2], v1[3]);
                    *(u32x4*)(rowp + bj * HALF) = w; } }
    }
};
struct EpiF32 {
    static constexpr bool PERM = false, AFTER_DRAIN = false;
    float* C; int ldc;
    __device__ __forceinline__ void operator()(const f32x4 (&acc)[2][2][4][2], const Unit& u, int wr, int wc, int fr, int fq) const {
        const int row0 = u.pm * BM + wr * 64 + fr, col0 = u.pn * BM + wc * 32 + 4 * fq;
#pragma unroll
        for (int ai = 0; ai < 2; ++ai)
#pragma unroll
            for (int m = 0; m < 4; ++m) { float* rowp = C + (size_t)(row0 + ai * HALF + m * 16) * ldc + col0;
#pragma unroll
                for (int bj = 0; bj < 2; ++bj)
#pragma unroll
                    for (int n = 0; n < 2; ++n) *(f32x4*)(rowp + bj * HALF + n * 16) = acc[ai][bj][m][n]; }
    }
};
struct EpiGateF32 {
    static constexpr bool PERM = false, AFTER_DRAIN = false;
    float* C; int ldc; const bf16_t* gate; int ldg;
    __device__ __forceinline__ void operator()(const f32x4 (&acc)[2][2][4][2], const Unit& u, int wr, int wc, int fr, int fq) const {
        const int row0 = u.pm * BM + wr * 64 + fr, col0 = u.pn * BM + wc * 32 + 4 * fq;
#pragma unroll
        for (int ai = 0; ai < 2; ++ai)
#pragma unroll
            for (int m = 0; m < 4; ++m) { const size_t r = (size_t)(row0 + ai * HALF + m * 16); float* rowp = C + r * ldc + col0; const bf16_t* gp = gate + r * ldg + col0;
#pragma unroll
                for (int bj = 0; bj < 2; ++bj)
#pragma unroll
                    for (int n = 0; n < 2; ++n) { const u32x2 g = *(const u32x2*)(gp + bj * HALF + n * 16); const f32x4 a = acc[ai][bj][m][n];
                        f32x4 o; o[0] = sigm(bf_lo(g.x)) * a[0]; o[1] = sigm(bf_hi(g.x)) * a[1]; o[2] = sigm(bf_lo(g.y)) * a[2]; o[3] = sigm(bf_hi(g.y)) * a[3];
                        *(f32x4*)(rowp + bj * HALF + n * 16) = o; } }
    }
};
struct EpiMixBf16 {
    static constexpr bool PERM = true, AFTER_DRAIN = false;
    bf16_t* O; int ldc; const float* P; const bf16_t* gate; int ldg;
    __device__ __forceinline__ void operator()(const f32x4 (&acc)[2][2][4][2], const Unit& u, int wr, int wc, int fr, int fq) const {
        const int row0 = u.pm * BM + wr * 64 + fr; const int col0 = u.pn * BM + wc * 32 + 8 * fq;
#pragma unroll
        for (int ai = 0; ai < 2; ++ai)
#pragma unroll
            for (int m = 0; m < 4; ++m) { const size_t r = (size_t)(row0 + ai * HALF + m * 16); bf16_t* rowp = O + r * ldc + col0; const float* pp = P + r * ldc + col0; const bf16_t* gp = gate + r * ldg + col0;
#pragma unroll
                for (int bj = 0; bj < 2; ++bj) { const f32x4 v0 = acc[ai][bj][m][0], v1 = acc[ai][bj][m][1];
                    const u32x4 g = *(const u32x4*)(gp + bj * HALF); const f32x4 p0 = *(const f32x4*)(pp + bj * HALF), p1 = *(const f32x4*)(pp + bj * HALF + 4);
                    const float o0 = p0[0] + sigm(bf_lo(g.x)) * v0[0], o1 = p0[1] + sigm(bf_hi(g.x)) * v0[1], o2 = p0[2] + sigm(bf_lo(g.y)) * v0[2], o3 = p0[3] + sigm(bf_hi(g.y)) * v0[3];
                    const float o4 = p1[0] + sigm(bf_lo(g.z)) * v1[0], o5 = p1[1] + sigm(bf_hi(g.z)) * v1[1], o6 = p1[2] + sigm(bf_lo(g.w)) * v1[2], o7 = p1[3] + sigm(bf_hi(g.w)) * v1[3];
                    u32x4 w; w.x = cvt_pk_bf16(o0, o1); w.y = cvt_pk_bf16(o2, o3); w.z = cvt_pk_bf16(o4, o5); w.w = cvt_pk_bf16(o6, o7);
                    *(u32x4*)(rowp + bj * HALF) = w; } }
    }
};
struct EpiResid {
    static constexpr bool PERM = false, AFTER_DRAIN = false;
    float* C; const float* base; int ldc; const float* gvec; int gstride; int rows_per_b_shift;
    __device__ __forceinline__ void operator()(const f32x4 (&acc)[2][2][4][2], const Unit& u, int wr, int wc, int fr, int fq) const {
        const int row0 = u.pm * BM + wr * 64 + fr, col0 = u.pn * BM + wc * 32 + 4 * fq;
        const float* gp = gvec + (size_t)((u.pm * BM) >> rows_per_b_shift) * gstride + col0;
        f32x4 gv[2][2];
#pragma unroll
        for (int bj = 0; bj < 2; ++bj)
#pragma unroll
            for (int n = 0; n < 2; ++n) gv[bj][n] = *(const f32x4*)(gp + bj * HALF + n * 16);
#pragma unroll
        for (int ai = 0; ai < 2; ++ai)
#pragma unroll
            for (int m = 0; m < 4; ++m) { const size_t off = (size_t)(row0 + ai * HALF + m * 16) * ldc + col0;
#pragma unroll
                for (int bj = 0; bj < 2; ++bj)
#pragma unroll
                    for (int n = 0; n < 2; ++n) { const f32x4 b = *(const f32x4*)(base + off + bj * HALF + n * 16);
                        *(f32x4*)(C + off + bj * HALF + n * 16) = b + gv[bj][n] * acc[ai][bj][m][n]; } }
    }
};
struct EpiSwiglu {
    static constexpr bool PERM = true, AFTER_DRAIN = false;
    bf16_t* O; int ldo;
    __device__ __forceinline__ void operator()(const f32x4 (&acc)[2][2][4][2], const Unit& u, int wr, int wc, int fr, int fq) const {
        const int row0 = u.pm * BM + wr * 64 + fr; const int col0 = u.pn * BM + wc * 32 + 8 * fq;
#pragma unroll
        for (int ai = 0; ai < 2; ++ai)
#pragma unroll
            for (int m = 0; m < 4; ++m) { bf16_t* rowp = O + (size_t)(row0 + ai * HALF + m * 16) * ldo + (col0 >> 1);
#pragma unroll
                for (int bj = 0; bj < 2; ++bj) { const f32x4 v0 = acc[ai][bj][m][0], v1 = acc[ai][bj][m][1];
                    const float g0 = silu_f(v0[0]) * v0[1], g1 = silu_f(v0[2]) * v0[3], g2 = silu_f(v1[0]) * v1[1], g3 = silu_f(v1[2]) * v1[3];
                    u32x2 w; w.x = cvt_pk_bf16(g0, g1); w.y = cvt_pk_bf16(g2, g3);
                    *(u32x2*)(rowp + bj * (HALF / 2)) = w; } }
    }
};
template <class Epi, class Sched, bool ALIGN_EPI = false, bool SP2 = false>
__device__ __forceinline__ void gemm_phase(PG8_LAS unsigned char* lds, const Gemm g, const Sched& S, const Epi& E) {
    const int tid = threadIdx.x, wid = __builtin_amdgcn_readfirstlane(tid >> 6), lane = tid & 63, wr = wid >> 2, wc = wid & 3, fr = lane & 15, fq = lane >> 4;
    const int K = g.K, nt = K / BK;
    unsigned voffA[2], voffB[2];
#pragma unroll
    for (int i = 0; i < 2; ++i) { int R, C; stage_rc(tid * 16 + i * 8192, R, C); const int Rb = Epi::PERM ? ((R & ~31) + perm32(R & 31)) : R;
        voffA[i] = (unsigned)(R * K + C) * 2u; voffB[i] = (unsigned)(Rb * K + C) * 2u; }
    const size_t kstep = (size_t)(BK * 2);
    const size_t hstep = (size_t)HALF * K * 2;
    const size_t tstep = 2 * hstep;
    const unsigned ldsw = (unsigned)wid * 1024u;
    const int aoff = lds_byte(wr * 64 + fr, fq * 8), boff = lds_byte(wc * 32 + fr, fq * 8);
#define PG8_SA(b, h) (((b) * 2 + (h)) * HTB)
#define PG8_SB(b, h) ((4 + (b) * 2 + (h)) * HTB)
#define PG8_STAGE(bufoff, gbase, voff) do { _Pragma("unroll") for (int _i = 0; _i < 2; ++_i) \
        __builtin_amdgcn_global_load_lds((const unsigned*)((const char*)(gbase) + (voff)[_i]), (PG8_LAS unsigned*)(lds + (bufoff) + ldsw + _i * 8192), 16, 0, 0); } while (0)
#define PG8_LDA(dst, b, h) do { _Pragma("unroll") for (int m = 0; m < 4; ++m) _Pragma("unroll") for (int k = 0; k < 2; ++k) dst[m][k] = *(const PG8_LAS bf16x8*)(lds + PG8_SA(b, h) + aoff + m * 2048 + k * 1024); } while (0)
#define PG8_LDB(dst, b, h) do { _Pragma("unroll") for (int n = 0; n < 2; ++n) _Pragma("unroll") for (int k = 0; k < 2; ++k) dst[n][k] = *(const PG8_LAS bf16x8*)(lds + PG8_SB(b, h) + boff + n * 2048 + k * 1024); } while (0)
#define PG8_MMA(ai, bj, At, Bt) do { __builtin_amdgcn_s_setprio(1); _Pragma("unroll") for (int m = 0; m < 4; ++m) _Pragma("unroll") for (int n = 0; n < 2; ++n) _Pragma("unroll") for (int k = 0; k < 2; ++k) \
        acc[ai][bj][m][n] = __builtin_amdgcn_mfma_f32_16x16x32_bf16(Bt[n][k], At[m][k], acc[ai][bj][m][n], 0, 0, 0); __builtin_amdgcn_s_setprio(0); } while (0)
#define PG8_WAIT_V(n) asm volatile("s_waitcnt vmcnt(" #n ")" ::: "memory")
#define PG8_WAIT_L(n) asm volatile("s_waitcnt lgkmcnt(" #n ")" ::: "memory")
#define PG8_BAR __builtin_amdgcn_s_barrier()
#define PG8_SCHED __builtin_amdgcn_sched_barrier(0)
    Unit cur, nxt; int ui = 0;
    if (!S.next(0, cur)) return;
    f32x4 acc[2][2][4][2];
#pragma unroll
    for (int a = 0; a < 2; ++a)
#pragma unroll
        for (int b = 0; b < 2; ++b)
#pragma unroll
            for (int m = 0; m < 4; ++m)
#pragma unroll
                for (int n = 0; n < 2; ++n) acc[a][b][m][n] = (f32x4){0.f, 0.f, 0.f, 0.f};
    bf16x8 At[4][2], B0[2][2], B1[2][2];
    const char* cA = (const char*)g.A + (size_t)cur.pm * tstep; const char* cB = (const char*)g.Bt + (size_t)cur.pn * tstep;
    S.a_ready(cur);
    if constexpr (SP2) {
        PG8_STAGE(PG8_SB(0, 0), cB, voffB); PG8_STAGE(PG8_SB(0, 1), cB + hstep, voffB); PG8_STAGE(PG8_SA(0, 0), cA, voffA); PG8_STAGE(PG8_SA(0, 1), cA + hstep, voffA);
        if (wr == 1) PG8_BAR;
        PG8_WAIT_V(2); PG8_BAR;
        PG8_STAGE(PG8_SB(1, 0), cB + kstep, voffB); PG8_STAGE(PG8_SA(1, 0), cA + kstep, voffA); PG8_STAGE(PG8_SB(1, 1), cB + hstep + kstep, voffB);
        PG8_WAIT_V(6); PG8_BAR;
    } else {
        PG8_STAGE(PG8_SB(0, 0), cB, voffB); PG8_STAGE(PG8_SA(0, 0), cA, voffA); PG8_STAGE(PG8_SB(0, 1), cB + hstep, voffB); PG8_STAGE(PG8_SA(0, 1), cA + hstep, voffA);
        if (wr == 1) PG8_BAR;
        PG8_WAIT_V(4); PG8_BAR;
        PG8_STAGE(PG8_SB(1, 0), cB + kstep, voffB); PG8_STAGE(PG8_SA(1, 0), cA + kstep, voffA); PG8_STAGE(PG8_SB(1, 1), cB + hstep + kstep, voffB);
        PG8_WAIT_V(6); PG8_BAR;
    }
    for (;;) {
        const bool has_next = S.next(ui + 1, nxt);
        const char* nA = has_next ? (const char*)g.A + (size_t)nxt.pm * tstep : cA; const char* nB = has_next ? (const char*)g.Bt + (size_t)nxt.pn * tstep : cB;
        for (int t = 0; t < nt; t += 2) {
            const bool last = (t == nt - 2);
            const char* a1 = cA + (size_t)(t + 1) * kstep;
            const char* a2 = last ? nA : cA + (size_t)(t + 2) * kstep; const char* b2 = last ? nB : cB + (size_t)(t + 2) * kstep;
            const char* a3 = a2 + kstep; const char* b3 = b2 + kstep;
            if (last && has_next) S.a_ready(nxt);
            if constexpr (SP2) {
            PG8_LDB(B0, 0, 0); PG8_LDB(B1, 0, 1); PG8_SCHED; PG8_LDA(At, 0, 0); PG8_STAGE(PG8_SA(1, 1), a1 + hstep, voffA);
            PG8_WAIT_V(8); PG8_WAIT_L(0); PG8_BAR; PG8_MMA(0, 0, At, B0); PG8_MMA(0, 1, At, B1); PG8_BAR; PG8_SCHED;
            PG8_LDA(At, 0, 1); PG8_STAGE(PG8_SB(0, 0), b2, voffB); PG8_STAGE(PG8_SB(0, 1), b2 + hstep, voffB); PG8_STAGE(PG8_SA(0, 0), a2, voffA);
            PG8_WAIT_V(8); PG8_WAIT_L(0); PG8_BAR; PG8_MMA(1, 0, At, B0); PG8_MMA(1, 1, At, B1); PG8_BAR; PG8_SCHED;
            PG8_LDB(B0, 1, 0); PG8_LDB(B1, 1, 1); PG8_SCHED; PG8_LDA(At, 1, 0); PG8_STAGE(PG8_SA(0, 1), a2 + hstep, voffA);
            PG8_WAIT_V(8); PG8_WAIT_L(0); PG8_BAR; PG8_MMA(0, 0, At, B0); PG8_MMA(0, 1, At, B1); PG8_BAR; PG8_SCHED;
            PG8_LDA(At, 1, 1); PG8_STAGE(PG8_SB(1, 0), b3, voffB); PG8_STAGE(PG8_SB(1, 1), b3 + hstep, voffB); PG8_STAGE(PG8_SA(1, 0), a3, voffA);
            PG8_WAIT_V(8); PG8_WAIT_L(0); PG8_BAR; PG8_MMA(1, 0, At, B0); PG8_MMA(1, 1, At, B1); PG8_BAR; PG8_SCHED;
            } else {
            PG8_LDB(B0, 0, 0); PG8_SCHED; PG8_LDA(At, 0, 0); PG8_STAGE(PG8_SA(1, 1), a1 + hstep, voffA);
            PG8_WAIT_L(8); PG8_BAR; PG8_WAIT_L(0); PG8_MMA(0, 0, At, B0); PG8_BAR; PG8_SCHED;
            PG8_LDB(B1, 0, 1); PG8_STAGE(PG8_SB(0, 0), b2, voffB);
            PG8_BAR; PG8_WAIT_L(0); PG8_MMA(0, 1, At, B1); PG8_BAR;
            PG8_LDA(At, 0, 1); PG8_STAGE(PG8_SA(0, 0), a2, voffA);
            PG8_BAR; PG8_WAIT_L(0); PG8_MMA(1, 0, At, B0); PG8_BAR; PG8_SCHED;
            PG8_STAGE(PG8_SB(0, 1), b2 + hstep, voffB);
            PG8_WAIT_V(6); PG8_BAR; PG8_MMA(1, 1, At, B1); PG8_BAR;
            PG8_LDB(B0, 1, 0); PG8_SCHED; PG8_LDA(At, 1, 0); PG8_STAGE(PG8_SA(0, 1), a2 + hstep, voffA);
            PG8_WAIT_L(8); PG8_BAR; PG8_WAIT_L(0); PG8_MMA(0, 0, At, B0); PG8_BAR; PG8_SCHED;
            PG8_LDB(B1, 1, 1); PG8_STAGE(PG8_SB(1, 0), b3, voffB);
            PG8_BAR; PG8_WAIT_L(0); PG8_MMA(0, 1, At, B1); PG8_BAR;
            PG8_LDA(At, 1, 1); PG8_STAGE(PG8_SA(1, 0), a3, voffA);
            PG8_BAR; PG8_WAIT_L(0); PG8_MMA(1, 0, At, B0); PG8_BAR; PG8_SCHED;
            PG8_STAGE(PG8_SB(1, 1), b3 + hstep, voffB);
            PG8_WAIT_V(6); PG8_BAR; PG8_MMA(1, 1, At, B1); PG8_BAR;
            }
        }
        if constexpr (ALIGN_EPI) { if (wr == 0) PG8_BAR; }
        if constexpr (!Epi::AFTER_DRAIN) { E(acc, cur, wr, wc, fr, fq); S.done(cur); }
        if (!has_next) break;
#pragma unroll
        for (int a = 0; a < 2; ++a)
#pragma unroll
            for (int b = 0; b < 2; ++b)
#pragma unroll
                for (int m = 0; m < 4; ++m)
#pragma unroll
                    for (int n = 0; n < 2; ++n) acc[a][b][m][n] = (f32x4){0.f, 0.f, 0.f, 0.f};
        cur = nxt; cA = nA; cB = nB; ++ui;
        if constexpr (ALIGN_EPI) { if (wr == 1) PG8_BAR; }
    }
    PG8_WAIT_V(0);
    if constexpr (!ALIGN_EPI) { if (wr == 0) PG8_BAR; }
    PG8_BAR;
    if constexpr (Epi::AFTER_DRAIN) { E.fused(acc, cur, wr, wc, fr, fq, lds, wid, lane); S.done(cur); }
#undef PG8_SA
#undef PG8_SB
#undef PG8_STAGE
#undef PG8_LDA
#undef PG8_LDB
#undef PG8_MMA
#undef PG8_WAIT_V
#undef PG8_WAIT_L
#undef PG8_BAR
#undef PG8_SCHED
}
}

constexpr int NWAVES = 8, NT = 512;
#ifndef MK_PER_PHASE
#define MK_PER_PHASE 0
#endif
#ifndef MK_SKIP_MIXER
#define MK_SKIP_MIXER 0
#endif
#ifndef MK_SKIP_SHARED
#define MK_SKIP_SHARED 0
#endif
#ifndef MK_SKIP_ROUTED
#define MK_SKIP_ROUTED 0
#endif
constexpr int NPHASE = 13;
constexpr int BATCH = 2, SEQ = 8192, D = 1024, M = BATCH * SEQ, NIN = 8192, NMOD = 6144;
constexpr int OFF_Q = 0, OFF_K = 512, OFF_V = 1024, OFF_GR = 2048, OFF_U = 3072, OFF_GC = 4096, OFF_GB = 5120, OFF_MR = 6144, OFF_MC = 7168;
constexpr int NE = 256, TOPK = 8, EH = 256, CAP = 16384, NCH = 64, CH = 128, NH = 4, DK = 128, DV = 256;
constexpr float EPS = 1e-6f;

constexpr size_t MiB = (size_t)1 << 20;
constexpr size_t WS_CTL = 0, CTL_ZERO_BYTES = 1 * MiB;
constexpr size_t WS_MOD = 1 * MiB;
constexpr size_t WS_ROPE = 2 * MiB;
constexpr size_t WS_WR = 10 * MiB;
constexpr size_t WS_WSGU = 11 * MiB;
constexpr size_t WS_WSD = 12 * MiB;
constexpr size_t WS_WBR = 13 * MiB, WS_WBC = 15 * MiB, WS_WO = 17 * MiB;
constexpr size_t WS_WIN = 20 * MiB;
constexpr size_t WS_HB = 36 * MiB;
constexpr size_t WS_PROJ = 68 * MiB;
constexpr size_t WS_KV = 324 * MiB;
constexpr size_t WS_SP = 388 * MiB;
constexpr size_t WS_RETG = 420 * MiB;
constexpr size_t WS_CONVG = 452 * MiB;
constexpr size_t WS_MIXP = 484 * MiB;
constexpr size_t WS_MIX = 548 * MiB;
constexpr size_t WS_X1 = 580 * MiB;
constexpr size_t WS_LOGITS = 644 * MiB;
constexpr size_t WS_SHG = 660 * MiB;
constexpr size_t WS_EIDX = 668 * MiB, WS_POS = 669 * MiB;
constexpr size_t WS_LTOK = 670 * MiB, WS_LW = 686 * MiB;
constexpr size_t WS_YP = 702 * MiB;
constexpr size_t WS_END = 958 * MiB;
constexpr int CW_TMO = 0, CW_CODE = 1, CW_BAR = 4096, CW_CNT = 8192;

constexpr int LDSCTL_OFF = 143360, MISC_OFF = LDSCTL_OFF + 320, LDS_BYTES = 147456;

#define GAS __attribute__((address_space(1)))
#define LAS __attribute__((address_space(3)))
typedef unsigned short bf16;
typedef unsigned v4u __attribute__((ext_vector_type(4)));
typedef unsigned v2u __attribute__((ext_vector_type(2)));
typedef float f32x4 __attribute__((ext_vector_type(4)));
typedef float f32x2 __attribute__((ext_vector_type(2)));
typedef short bf16x8 __attribute__((ext_vector_type(8)));
typedef short s16x4 __attribute__((ext_vector_type(4)));
typedef GAS unsigned gu32;
#define RLX_AGENT __ATOMIC_RELAXED, __HIP_MEMORY_SCOPE_AGENT
__device__ __forceinline__ unsigned f2bf(float f) { unsigned u = __builtin_bit_cast(unsigned, f); return (u + 0x7fffu + ((u >> 16) & 1u)) >> 16; }
__device__ __forceinline__ unsigned pk2(float lo, float hi) { return f2bf(lo) | (f2bf(hi) << 16); }
__device__ __forceinline__ float bflo(unsigned w) { return __uint_as_float(w << 16); }
__device__ __forceinline__ float bfhi(unsigned w) { return __uint_as_float(w & 0xffff0000u); }
__device__ __forceinline__ float sigmoidf_(float x) { return 1.0f / (1.0f + __expf(-x)); }
__device__ __forceinline__ float siluf_(float x) { return x / (1.0f + __expf(-x)); }

#define XB_TMO      128
#define XB_XCNT(j)  (256  + 64 * (j))
#define XB_XSUB(j)  (1280 + 64 * (j))
#define XB_XGEN(j)  (2304 + 64 * (j))
#define XB_TOP      3328
#define XB_TOPGEN   3392
#define XCD_BAR_WORDS 3456
#define XB_SPIN_CAP (1u << 18)

__device__ __forceinline__ unsigned xb_ld(unsigned* p)              { return __hip_atomic_load(p, __ATOMIC_RELAXED, __HIP_MEMORY_SCOPE_AGENT); }
__device__ __forceinline__ unsigned xb_add(unsigned* p, unsigned v) { return __hip_atomic_fetch_add(p, v, __ATOMIC_RELAXED, __HIP_MEMORY_SCOPE_AGENT); }
__device__ __forceinline__ unsigned xb_xcc_id() { return (unsigned)__builtin_amdgcn_s_getreg((3 << 11) | 20) & 0xFu; }
#define XB_SPIN(cond, bar) do { unsigned _sp = 0; while (cond) { __builtin_amdgcn_s_sleep(1); \
    if ((++_sp & 255u) == 0u) { if (xb_ld(&(bar)[XB_TMO])) break; if (_sp > XB_SPIN_CAP) { atomicAdd(&(bar)[XB_TMO], 1u); break; } } } } while (0)

struct XcdBarrier {
    unsigned* bar; unsigned x;
    volatile LAS unsigned* st;
};

__device__ __forceinline__ XcdBarrier xcd_barrier_post(unsigned* bar, volatile LAS unsigned* st) {
    XcdBarrier b; b.bar = bar; b.x = xb_xcc_id(); b.st = st;
    if (threadIdx.x == 0) (void)xb_add(&bar[XB_XCNT(b.x)], 1u);
    return b;
}
__device__ __forceinline__ void xcd_barrier_complete(unsigned* bar, unsigned x, unsigned& nloc, unsigned& nx) {
    const unsigned G = gridDim.x * gridDim.y * gridDim.z;
    unsigned sum, cnt, mine, sp = 0u;
    for (;;) {
        sum = 0u; cnt = 0u; mine = 0u;
#pragma unroll
        for (unsigned j = 0; j < 16; ++j) { const unsigned c = xb_ld(&bar[XB_XCNT(j)]); sum += c; cnt += (c > 0u) ? 1u : 0u; mine = (j == x) ? c : mine; }
        if (sum == G) break;
        __builtin_amdgcn_s_sleep(1);
        if ((++sp & 255u) == 0u) { if (xb_ld(&bar[XB_TMO])) break; if (sp > XB_SPIN_CAP) { atomicAdd(&bar[XB_TMO], 1u); break; } }
    }
    nloc = mine > 0u ? mine : 1u; nx = cnt > 0u ? cnt : 1u;
}

__device__ __forceinline__ void xcd_barrier(const XcdBarrier& b) {
    asm volatile("s_waitcnt vmcnt(0)" ::: "memory");
    __syncthreads();
    if (threadIdx.x == 0) {
        unsigned* bar = b.bar;
        __builtin_amdgcn_s_waitcnt(0);
        unsigned nloc = b.st[0], nx = b.st[1];
        if (nloc == 0u) { xcd_barrier_complete(bar, b.x, nloc, nx); b.st[0] = nloc; b.st[1] = nx; }
        const unsigned old = xb_add(&bar[XB_XSUB(b.x)], 1u);
        const unsigned gen = old / nloc;
        if (old + 1u == (gen + 1u) * nloc) {
            __builtin_amdgcn_fence(__ATOMIC_RELEASE, "agent");
            asm volatile("s_waitcnt vmcnt(0)" ::: "memory");
            const unsigned og = xb_add(&bar[XB_TOP], 1u);
            const unsigned tg = og / nx;
            if (og + 1u == (tg + 1u) * nx) xb_add(&bar[XB_TOPGEN], 1u);
            else XB_SPIN(xb_ld(&bar[XB_TOPGEN]) == tg, bar);
            __builtin_amdgcn_fence(__ATOMIC_ACQUIRE, "agent");
            xb_add(&bar[XB_XGEN(b.x)], 1u);
            asm volatile("s_waitcnt vmcnt(0)" ::: "memory");
        } else {
            XB_SPIN(xb_ld(&bar[XB_XGEN(b.x)]) == gen, bar);
            __builtin_amdgcn_fence(__ATOMIC_ACQUIRE, "agent");
            asm volatile("s_waitcnt vmcnt(0)" ::: "memory");
        }
    }
    __syncthreads();
}

struct Frame {
    LAS unsigned char* lds; unsigned ldsb;
    volatile LAS unsigned* MISC; gu32* ctl;
    int tid, lane, wave, vcu, G;
    const float *x, *c; const int* pos; const float *w_ada, *b_ada, *norm_mix_g, *w_in, *ret_norm_g, *conv_w, *w_br_ret, *w_br_conv, *w_out, *norm_ffn_g, *w_router, *router_bias,
        *w_eg, *w_eu, *w_ed, *w_sg, *w_su, *w_sd, *norm_final_g;
    float* out; unsigned char* ws;
};
__device__ __forceinline__ float wave_sum(float v) {
#pragma unroll
    for (int o = 1; o < 64; o <<= 1) v += __shfl_xor(v, o);
    return v;
}

__device__ __forceinline__ void p0_mod_task(Frame& F, int j) {
    const int cq = F.tid & 15, kq = F.tid >> 4;
    f32x4 a0 = {0.f, 0.f, 0.f, 0.f}, a1 = {0.f, 0.f, 0.f, 0.f};
    const float* W = F.w_ada + 64 * j + 4 * cq;
#pragma unroll 8
    for (int i = 0; i < 32; ++i) { const int k = kq + 32 * i; const float c0 = F.c[k], c1 = F.c[1024 + k];
        const float s0 = c0 / (1.0f + expf(-c0)), s1 = c1 / (1.0f + expf(-c1));
        const f32x4 w = *(const f32x4*)(W + (size_t)k * NMOD); a0 += s0 * w; a1 += s1 * w; }
    LAS f32x4* red = (LAS f32x4*)F.lds;
    red[(kq * 2 + 0) * 16 + cq] = a0; red[(kq * 2 + 1) * 16 + cq] = a1;
    __syncthreads();
    if (F.tid < 32) { const int b = F.tid >> 4, c2 = F.tid & 15; f32x4 s = *(const f32x4*)(F.b_ada + 64 * j + 4 * c2);
        for (int k2 = 0; k2 < 32; ++k2) s += red[(k2 * 2 + b) * 16 + c2];
        *(f32x4*)((float*)(F.ws + WS_MOD) + b * NMOD + 64 * j + 4 * c2) = s; }
    __syncthreads();
}
__device__ __forceinline__ void p0_transpose_item(const float* W, int K, int N, bf16* WT, int row_off, int row_mul, LAS float* scr, int item, int lane) {
    const int nblk = N / 32, kb = item / nblk, nb = item % nblk, k0 = 64 * kb, n0 = 32 * nb;
#pragma unroll 8
    for (int i = 0; i < 32; ++i) { const int kk = 2 * i + (lane >> 5); scr[kk * 33 + (lane & 31)] = W[(size_t)(k0 + kk) * N + n0 + (lane & 31)]; }
    asm volatile("s_waitcnt lgkmcnt(0)" ::: "memory");
    const int c = lane & 7;
#pragma unroll
    for (int j = 0; j < 4; ++j) { const int n = (lane >> 3) + 8 * j; const LAS float* s = scr + (8 * c) * 33 + n;
        v4u o; o.x = pk2(s[0 * 33], s[1 * 33]); o.y = pk2(s[2 * 33], s[3 * 33]); o.z = pk2(s[4 * 33], s[5 * 33]); o.w = pk2(s[6 * 33], s[7 * 33]);
        *(v4u*)(WT + (size_t)(row_off + row_mul * (n0 + n)) * K + k0 + 8 * c) = o; }
    asm volatile("s_waitcnt lgkmcnt(0)" ::: "memory");
}
__device__ __forceinline__ void p0_prologue(Frame& F) {
    if ((int)blockIdx.x < NMOD / 64) p0_mod_task(F, (int)blockIdx.x);
    LAS float* scr = (LAS float*)(F.lds + F.wave * 16384);
    const int gw = F.vcu * NWAVES + F.wave, NGW = F.G * NWAVES;
    constexpr int I_IN = (D / 64) * (NIN / 32), I_SQ = (D / 64) * (D / 32), I_R = (D / 64) * (256 / 32), I_SD = (256 / 64) * (D / 32);
    constexpr int NITEMS = I_IN + 3 * I_SQ + 3 * I_R + I_SD;
    unsigned char* ws = F.ws;
    for (int it = gw; it < NITEMS; it += NGW) {
        int r = it;
        if (r < I_IN) { p0_transpose_item(F.w_in, D, NIN, (bf16*)(ws + WS_WIN), 0, 1, scr, r, F.lane); continue; } r -= I_IN;
        if (r < I_SQ) { p0_transpose_item(F.w_br_ret, D, D, (bf16*)(ws + WS_WBR), 0, 1, scr, r, F.lane); continue; } r -= I_SQ;
        if (r < I_SQ) { p0_transpose_item(F.w_br_conv, D, D, (bf16*)(ws + WS_WBC), 0, 1, scr, r, F.lane); continue; } r -= I_SQ;
        if (r < I_SQ) { p0_transpose_item(F.w_out, D, D, (bf16*)(ws + WS_WO), 0, 1, scr, r, F.lane); continue; } r -= I_SQ;
        if (r < I_R) { p0_transpose_item(F.w_router, D, NE, (bf16*)(ws + WS_WR), 0, 1, scr, r, F.lane); continue; } r -= I_R;
        if (r < I_R) { p0_transpose_item(F.w_sg, D, EH, (bf16*)(ws + WS_WSGU), 0, 2, scr, r, F.lane); continue; } r -= I_R;
        if (r < I_R) { p0_transpose_item(F.w_su, D, EH, (bf16*)(ws + WS_WSGU), 1, 2, scr, r, F.lane); continue; } r -= I_R;
        p0_transpose_item(F.w_sd, EH, D, (bf16*)(ws + WS_WSD), 0, 1, scr, r, F.lane);
    }
    f32x2* rope = (f32x2*)(ws + WS_ROPE);
    for (int idx = F.vcu * NT + F.tid; idx < M * 64; idx += F.G * NT) { const int t = idx >> 6, i = idx & 63;
        const float invf = powf(10000.0f, -(float)i * (1.0f / 64.0f)); const float ang = (float)F.pos[t] * invf;
        const double ad = (double)ang; const double rr = ad - 6.283185307179586 * rint(ad * 0.15915494309189535); const float rf = (float)rr;
        rope[idx] = (f32x2){cosf(rf), sinf(rf)}; }
}

__device__ __forceinline__ void norm_mod_rows(Frame& F, const float* X, const float* gain, int sc_off, int sh_off, bf16* O) {
    const int gw = F.vcu * NWAVES + F.wave, NGW = F.G * NWAVES;
    const float* mod = (const float*)(F.ws + WS_MOD);
    f32x4 g[4];
#pragma unroll
    for (int j = 0; j < 4; ++j) g[j] = *(const f32x4*)(gain + 4 * F.lane + 256 * j);
    for (int m = gw; m < M; m += NGW) {
        const int b = m >> 13; const f32x4* xr = (const f32x4*)(X + (size_t)m * D) + F.lane;
        f32x4 v[4]; float ss = 0.f;
#pragma unroll
        for (int j = 0; j < 4; ++j) { v[j] = xr[64 * j]; ss += (v[j].x * v[j].x + v[j].y * v[j].y) + (v[j].z * v[j].z + v[j].w * v[j].w); }
        const float rstd = 1.0f / sqrtf(wave_sum(ss) * (1.0f / D) + EPS);
        v2u* o8 = (v2u*)(O + (size_t)m * D) + F.lane;
#pragma unroll
        for (int j = 0; j < 4; ++j) { const f32x4 sc = *(const f32x4*)(mod + b * NMOD + sc_off + 4 * F.lane + 256 * j), sh = *(const f32x4*)(mod + b * NMOD + sh_off + 4 * F.lane + 256 * j);
            const f32x4 h = (v[j] * rstd * g[j]) * (1.0f + sc) + sh; v2u w; w.x = pk2(h.x, h.y); w.y = pk2(h.z, h.w); o8[64 * j] = w; }
    }
}

constexpr int KS = 136, KSB = KS * 2;
constexpr int VS = 264, VSB = VS * 2;
__device__ __forceinline__ float log_gamma(int h) { return log1pf(-exp2f(-5.0f - (float)h)); }
__device__ __forceinline__ bf16x8 ldfrag(const LAS unsigned char* img, int row, int rsb, int k) { return *(const LAS bf16x8*)(img + row * rsb + k * 2); }
template <int RS4> __device__ __forceinline__ bf16x8 tr_frag(unsigned addr) {
    s16x4 lo, hi;
    asm volatile("ds_read_b64_tr_b16 %0, %2\n\tds_read_b64_tr_b16 %1, %2 offset:%3\n\ts_waitcnt lgkmcnt(0)" : "=&v"(lo), "=&v"(hi) : "v"(addr), "i"(RS4) : "memory");
    return __builtin_shufflevector(lo, hi, 0, 1, 2, 3, 4, 5, 6, 7);
}
template <int RS4, int STEP> __device__ __forceinline__ void tr_frag4(unsigned addr, bf16x8& f0, bf16x8& f1, bf16x8& f2, bf16x8& f3) {
    s16x4 l0, h0, l1, h1, l2, h2, l3, h3;
    asm volatile("ds_read_b64_tr_b16 %0, %8\n\tds_read_b64_tr_b16 %1, %8 offset:%9\n\t"
                 "ds_read_b64_tr_b16 %2, %8 offset:%10\n\tds_read_b64_tr_b16 %3, %8 offset:%11\n\t"
                 "ds_read_b64_tr_b16 %4, %8 offset:%12\n\tds_read_b64_tr_b16 %5, %8 offset:%13\n\t"
                 "ds_read_b64_tr_b16 %6, %8 offset:%14\n\tds_read_b64_tr_b16 %7, %8 offset:%15\n\ts_waitcnt lgkmcnt(0)"
                 : "=&v"(l0), "=&v"(h0), "=&v"(l1), "=&v"(h1), "=&v"(l2), "=&v"(h2), "=&v"(l3), "=&v"(h3)
                 : "v"(addr), "i"(RS4), "i"(STEP), "i"(STEP + RS4), "i"(2 * STEP), "i"(2 * STEP + RS4), "i"(3 * STEP), "i"(3 * STEP + RS4) : "memory");
    f0 = __builtin_shufflevector(l0, h0, 0, 1, 2, 3, 4, 5, 6, 7); f1 = __builtin_shufflevector(l1, h1, 0, 1, 2, 3, 4, 5, 6, 7);
    f2 = __builtin_shufflevector(l2, h2, 0, 1, 2, 3, 4, 5, 6, 7); f3 = __builtin_shufflevector(l3, h3, 0, 1, 2, 3, 4, 5, 6, 7);
}
#define MFMA16(a, b, c) __builtin_amdgcn_mfma_f32_16x16x32_bf16((a), (b), (c), 0, 0, 0)

template <bool DECAY> __device__ __forceinline__ void stage_rope(Frame& F, LAS unsigned char* img, const bf16* src, const f32x2* rope, float s_const, float lg) {
#pragma unroll
    for (int i = 0; i < 4; ++i) { const int task = F.tid + NT * i, c = task >> 4, g = task & 15;
        const v2u lo = *(const v2u*)(src + (size_t)c * NIN + 4 * g), hi = *(const v2u*)(src + (size_t)c * NIN + 64 + 4 * g);
        const f32x4 r01 = *(const f32x4*)(rope + c * 64 + 4 * g), r23 = *(const f32x4*)(rope + c * 64 + 4 * g + 2);
        const float sc = DECAY ? s_const * __expf(lg * (float)(127 - c)) : s_const;
        const float x1[4] = {bflo(lo.x), bfhi(lo.x), bflo(lo.y), bfhi(lo.y)}, x2[4] = {bflo(hi.x), bfhi(hi.x), bflo(hi.y), bfhi(hi.y)};
        const float cs[4] = {r01.x, r01.z, r23.x, r23.z}, sn[4] = {r01.y, r01.w, r23.y, r23.w};
        float y1[4], y2[4];
#pragma unroll
        for (int j = 0; j < 4; ++j) { y1[j] = (x1[j] * cs[j] - x2[j] * sn[j]) * sc; y2[j] = (x2[j] * cs[j] + x1[j] * sn[j]) * sc; }
        v2u w1, w2; w1.x = pk2(y1[0], y1[1]); w1.y = pk2(y1[2], y1[3]); w2.x = pk2(y2[0], y2[1]); w2.y = pk2(y2[2], y2[3]);
        *(LAS v2u*)(img + c * KSB + 8 * g) = w1; *(LAS v2u*)(img + c * KSB + 128 + 8 * g) = w2; }
}
__device__ __forceinline__ void stage_v(Frame& F, LAS unsigned char* img, const bf16* src) {
#pragma unroll
    for (int i = 0; i < 8; ++i) { const int task = F.tid + NT * i, c = task >> 5, g = task & 31;
        *(LAS v4u*)(img + c * VSB + 16 * g) = *(const v4u*)(src + (size_t)c * NIN + 8 * g); }
}

__device__ __forceinline__ void p3_kv_conv(Frame& F) {
    unsigned char* ws = F.ws; const bf16* PROJ = (const bf16*)(ws + WS_PROJ); const f32x2* ROPE = (const f32x2*)(ws + WS_ROPE); float* KV = (float*)(ws + WS_KV);
    LAS unsigned char* Kimg = F.lds; LAS unsigned char* Vimg = F.lds + 34816;
    const int w = F.wave, lane = F.lane, g = lane >> 4, q = (lane & 15) >> 2, p = lane & 3;
    for (int it = (int)blockIdx.x; it < BATCH * NH * NCH; it += F.G) {
        const int n = it & 63, h = (it >> 6) & 3, b = it >> 8; const int t0 = b * SEQ + n * CH; const float lg = log_gamma(h);
        stage_rope<true>(F, Kimg, PROJ + (size_t)t0 * NIN + OFF_K + h * DK, ROPE + (size_t)t0 * 64, 1.0f, lg);
        stage_v(F, Vimg, PROJ + (size_t)t0 * NIN + OFF_V + h * DV);
        __syncthreads();
        f32x4 acc[16];
#pragma unroll
        for (int i = 0; i < 16; ++i) acc[i] = (f32x4){0.f, 0.f, 0.f, 0.f};
        const unsigned ka = F.ldsb + (unsigned)((8 * g + q) * KSB + (16 * w + 4 * p) * 2);
        const unsigned va = F.ldsb + 34816u + (unsigned)((8 * g + q) * VSB + (4 * p) * 2);
#pragma unroll
        for (int ks = 0; ks < 4; ++ks) {
            const bf16x8 a = tr_frag<4 * KSB>(ka + ks * 32 * KSB);
#pragma unroll
            for (int nt = 0; nt < 16; nt += 4) { bf16x8 b0, b1, b2, b3; tr_frag4<4 * VSB, 32>(va + ks * 32 * VSB + nt * 32, b0, b1, b2, b3);
                acc[nt] = MFMA16(a, b0, acc[nt]); acc[nt + 1] = MFMA16(a, b1, acc[nt + 1]); acc[nt + 2] = MFMA16(a, b2, acc[nt + 2]); acc[nt + 3] = MFMA16(a, b3, acc[nt + 3]); }
        }
        float* kvp = KV + (size_t)it * (DV * DK) + (size_t)(lane & 15) * DK + 16 * w + 4 * g;
#pragma unroll
        for (int nt = 0; nt < 16; ++nt) *(f32x4*)(kvp + (size_t)(16 * nt) * DK) = acc[nt];
        __syncthreads();
    }
    bf16* CONVG = (bf16*)(ws + WS_CONVG);
    const int gw = F.vcu * NWAVES + F.wave, NGW = F.G * NWAVES;
    for (int m = gw; m < M; m += NGW) { const int s = m & (SEQ - 1);
#pragma unroll
        for (int j = 0; j < 4; ++j) { const int ch = 4 * lane + 256 * j; const bf16* rp = PROJ + (size_t)m * NIN + ch;
            const f32x4 w0 = *(const f32x4*)(F.conv_w + ch), w1 = *(const f32x4*)(F.conv_w + D + ch), w2 = *(const f32x4*)(F.conv_w + 2 * D + ch);
            const v2u u0 = *(const v2u*)(rp + OFF_U), c0 = *(const v2u*)(rp + OFF_GC), gb = *(const v2u*)(rp + OFF_GB);
            v2u u1 = {0u, 0u}, c1 = {0u, 0u}, u2 = {0u, 0u}, c2 = {0u, 0u};
            if (s >= 1) { u1 = *(const v2u*)(rp - NIN + OFF_U); c1 = *(const v2u*)(rp - NIN + OFF_GC); }
            if (s >= 2) { u2 = *(const v2u*)(rp - 2 * NIN + OFF_U); c2 = *(const v2u*)(rp - 2 * NIN + OFF_GC); }
            f32x4 cu0 = {bflo(u0.x) * bflo(c0.x), bfhi(u0.x) * bfhi(c0.x), bflo(u0.y) * bflo(c0.y), bfhi(u0.y) * bfhi(c0.y)};
            f32x4 cu1 = {bflo(u1.x) * bflo(c1.x), bfhi(u1.x) * bfhi(c1.x), bflo(u1.y) * bflo(c1.y), bfhi(u1.y) * bfhi(c1.y)};
            f32x4 cu2 = {bflo(u2.x) * bflo(c2.x), bfhi(u2.x) * bfhi(c2.x), bflo(u2.y) * bflo(c2.y), bfhi(u2.y) * bfhi(c2.y)};
            const f32x4 gbf = {bflo(gb.x), bfhi(gb.x), bflo(gb.y), bfhi(gb.y)};
            const f32x4 o = gbf * (w0 * cu2 + w1 * cu1 + w2 * cu0);
            v2u wv; wv.x = pk2(o.x, o.y); wv.y = pk2(o.z, o.w); *(v2u*)(CONVG + (size_t)m * D + ch) = wv; }
    }
}

__device__ __forceinline__ void p4_scan(Frame& F) {
    const float* KV = (const float*)(F.ws + WS_KV); unsigned* SP = (unsigned*)(F.ws + WS_SP);
    for (int gid = F.vcu * NT + F.tid; gid < BATCH * NH * (DV * DK / 2); gid += F.G * NT) {
        const int bh = gid >> 14, e2 = gid & 16383, h = bh & 3; const float dec = __expf(log_gamma(h) * 128.0f);
        f32x2 S = {0.f, 0.f};
        const f32x2* kp = (const f32x2*)KV + (size_t)bh * NCH * 16384 + e2; unsigned* sp = SP + (size_t)bh * NCH * 16384 + e2;
#pragma unroll 8
        for (int n = 0; n < NCH; ++n) { const f32x2 kv = kp[(size_t)n * 16384]; sp[(size_t)n * 16384] = pk2(S.x, S.y); S = S * dec + kv; }
    }
}

__device__ __forceinline__ void p5_retention(Frame& F) {
    unsigned char* ws = F.ws; const bf16* PROJ = (const bf16*)(ws + WS_PROJ); const f32x2* ROPE = (const f32x2*)(ws + WS_ROPE); const bf16* SP = (const bf16*)(ws + WS_SP);
    bf16* RETG = (bf16*)(ws + WS_RETG);
    LAS unsigned char* Qimg = F.lds; LAS unsigned char* Kimg = F.lds + 34816; LAS unsigned char* Bimg = F.lds + 69632;
    const int w = F.wave, lane = F.lane, g = lane >> 4, q = (lane & 15) >> 2, p = lane & 3, fr = lane & 15;
    for (int it = (int)blockIdx.x; it < BATCH * NH * NCH; it += F.G) {
        const int n = it & 63, h = (it >> 6) & 3, b = it >> 8; const int t0 = b * SEQ + n * CH; const float lg = log_gamma(h);
        stage_rope<false>(F, Qimg, PROJ + (size_t)t0 * NIN + OFF_Q + h * DK, ROPE + (size_t)t0 * 64, 0.08838834764831845f, 0.f);
        stage_rope<false>(F, Kimg, PROJ + (size_t)t0 * NIN + OFF_K + h * DK, ROPE + (size_t)t0 * 64, 1.0f, 0.f);
        { const bf16* sp = SP + (size_t)it * (DV * DK);
#pragma unroll
          for (int i = 0; i < 8; ++i) { const int task = F.tid + NT * i, r = task >> 4, c16 = task & 15; *(LAS v4u*)(Bimg + r * KSB + 16 * c16) = *(const v4u*)(sp + r * DK + 8 * c16); } }
        __syncthreads();
        f32x4 acc[16];
#pragma unroll
        for (int i = 0; i < 16; ++i) acc[i] = (f32x4){0.f, 0.f, 0.f, 0.f};
        f32x4 sc[8];
#pragma unroll
        for (int i = 0; i < 8; ++i) sc[i] = (f32x4){0.f, 0.f, 0.f, 0.f};
#pragma unroll 1
        for (int ks = 0; ks < 4; ++ks) {
            const bf16x8 qf = ldfrag(Qimg, 16 * w + fr, KSB, 32 * ks + 8 * g);
#pragma unroll
            for (int nt = 0; nt < 16; ++nt) { const bf16x8 sf = ldfrag(Bimg, 16 * nt + fr, KSB, 32 * ks + 8 * g); acc[nt] = MFMA16(sf, qf, acc[nt]); }
#pragma unroll
            for (int jt = 0; jt < 8; ++jt) { const bf16x8 kf = ldfrag(Kimg, 16 * jt + fr, KSB, 32 * ks + 8 * g); sc[jt] = MFMA16(kf, qf, sc[jt]); }
        }
        const int irow = 16 * w + fr;
        { const float cd = __expf(lg * (float)(irow + 1));
#pragma unroll
          for (int nt = 0; nt < 16; ++nt) acc[nt] = acc[nt] * cd; }
        __syncthreads();
#pragma unroll
        for (int jt = 0; jt < 8; ++jt) { float pv[4];
#pragma unroll
            for (int r = 0; r < 4; ++r) { const int j = 16 * jt + 4 * g + r; pv[r] = (irow >= j) ? sc[jt][r] * __expf(lg * (float)(irow - j)) : 0.f; }
            v2u wv; wv.x = pk2(pv[0], pv[1]); wv.y = pk2(pv[2], pv[3]); *(LAS v2u*)(Kimg + irow * KSB + (16 * jt + 4 * g) * 2) = wv; }
        stage_v(F, Bimg, PROJ + (size_t)t0 * NIN + OFF_V + h * DV);
        __syncthreads();
        const unsigned va = F.ldsb + 69632u + (unsigned)((8 * g + q) * VSB + (4 * p) * 2);
#pragma unroll 1
        for (int ks = 0; ks < 4; ++ks) {
            const bf16x8 pf = ldfrag(Kimg, 16 * w + fr, KSB, 32 * ks + 8 * g);
#pragma unroll
            for (int nt = 0; nt < 16; nt += 4) { bf16x8 v0, v1, v2, v3; tr_frag4<4 * VSB, 32>(va + ks * 32 * VSB + nt * 32, v0, v1, v2, v3);
                acc[nt] = MFMA16(v0, pf, acc[nt]); acc[nt + 1] = MFMA16(v1, pf, acc[nt + 1]); acc[nt + 2] = MFMA16(v2, pf, acc[nt + 2]); acc[nt + 3] = MFMA16(v3, pf, acc[nt + 3]); }
        }
        float ss = 0.f;
#pragma unroll
        for (int nt = 0; nt < 16; ++nt) ss += (acc[nt][0] * acc[nt][0] + acc[nt][1] * acc[nt][1]) + (acc[nt][2] * acc[nt][2] + acc[nt][3] * acc[nt][3]);
        ss += __shfl_xor(ss, 16); ss += __shfl_xor(ss, 32);
        const float rstd = 1.0f / sqrtf(ss * (1.0f / DV) + EPS);
        const size_t trow = (size_t)(t0 + irow);
#pragma unroll
        for (int nt = 0; nt < 16; ++nt) { const int dv = 16 * nt + 4 * g; const f32x4 gn = *(const f32x4*)(F.ret_norm_g + h * DV + dv);
            const v2u gr = *(const v2u*)(PROJ + trow * NIN + OFF_GR + h * DV + dv);
            const f32x4 o = acc[nt] * rstd * gn * (f32x4){siluf_(bflo(gr.x)), siluf_(bfhi(gr.x)), siluf_(bflo(gr.y)), siluf_(bfhi(gr.y))};
            v2u wv; wv.x = pk2(o[0], o[1]); wv.y = pk2(o[2], o[3]); *(v2u*)(RETG + trow * D + h * DV + dv) = wv; }
        __syncthreads();
    }
}

__device__ __forceinline__ void route_tokens(Frame& F) {
    unsigned char* ws = F.ws; const float* LOGITS = (const float*)(ws + WS_LOGITS);
    int* EIDX = (int*)(ws + WS_EIDX); int* POS = (int*)(ws + WS_POS); int* LTOK = (int*)(ws + WS_LTOK); float* LW = (float*)(ws + WS_LW);
    unsigned* cnt = (unsigned*)(F.ctl + CW_CNT);
    const int gw = F.vcu * NWAVES + F.wave, NGW = F.G * NWAVES, lane = F.lane;
    const f32x4 bias = *(const f32x4*)(F.router_bias + 4 * lane);
    const float NEG = -__builtin_inff();
    for (int t = gw; t < M; t += NGW) {
        const f32x4 lgv = *(const f32x4*)(LOGITS + (size_t)t * NE + 4 * lane);
        float s0 = 1.0f / (1.0f + expf(-lgv.x)), s1 = 1.0f / (1.0f + expf(-lgv.y)), s2 = 1.0f / (1.0f + expf(-lgv.z)), s3 = 1.0f / (1.0f + expf(-lgv.w));
        float c0 = s0 + bias.x, c1 = s1 + bias.y, c2 = s2 + bias.z, c3 = s3 + bias.w;
        float a = fmaxf(c0, c1), bq = fminf(c0, c1), cc = fmaxf(c2, c3), dd = fminf(c2, c3);
        float m1 = fmaxf(a, cc), m2 = fmaxf(fminf(a, cc), fmaxf(bq, dd));
#pragma unroll
        for (int o = 1; o < 8; o <<= 1) { const float o1 = __shfl_xor(m1, o), o2 = __shfl_xor(m2, o); const float n1 = fmaxf(m1, o1), n2 = fmaxf(fminf(m1, o1), fmaxf(m2, o2)); m1 = n1; m2 = n2; }
        const float gs = m1 + m2; const int myg = lane >> 3; int rank = 0;
#pragma unroll
        for (int g2 = 0; g2 < 8; ++g2) { const float sg = __shfl(gs, g2 * 8); rank += (sg > gs || (sg == gs && g2 < myg)) ? 1 : 0; }
        if (rank >= 4) { c0 = NEG; c1 = NEG; c2 = NEG; c3 = NEG; }
        int ek[8]; float wk[8]; float wsum = 0.f;
#pragma unroll
        for (int k = 0; k < 8; ++k) {
            float bv = c0; int bi = 0;
            if (c1 > bv) { bv = c1; bi = 1; } if (c2 > bv) { bv = c2; bi = 2; } if (c3 > bv) { bv = c3; bi = 3; }
            int be = 4 * lane + bi;
#pragma unroll
            for (int o = 32; o >= 1; o >>= 1) { const float ov = __shfl_xor(bv, o); const int oe = __shfl_xor(be, o); if (ov > bv || (ov == bv && oe < be)) { bv = ov; be = oe; } }
            const int sl = be >> 2, sj = be & 3;
            const float myv = sj == 0 ? s0 : (sj == 1 ? s1 : (sj == 2 ? s2 : s3));
            const float wv = __shfl(myv, sl);
            if (lane == sl) { if (sj == 0) c0 = NEG; else if (sj == 1) c1 = NEG; else if (sj == 2) c2 = NEG; else c3 = NEG; }
            ek[k] = be; wk[k] = wv; wsum += wv;
        }
        const float inv = 2.5f / wsum;
        int my_e = ek[0]; float my_w = wk[0];
#pragma unroll
        for (int k = 1; k < 8; ++k) if (lane == k) { my_e = ek[k]; my_w = wk[k]; }
        if (lane < 8) { const unsigned ps = __hip_atomic_fetch_add(cnt + my_e, 1u, RLX_AGENT);
            LTOK[(size_t)my_e * CAP + ps] = t; LW[(size_t)my_e * CAP + ps] = my_w * inv; EIDX[t * 8 + lane] = my_e; POS[t * 8 + lane] = (int)ps; }
    }
}

__device__ __forceinline__ void expert_prefix(Frame& F, LAS int* pref, LAS int* off) {
    if (F.wave == 0) { const unsigned* cnt = (const unsigned*)(F.ctl + CW_CNT); const int lane = F.lane;
        int c[4], nb[4]; int tc = 0, tb = 0;
#pragma unroll
        for (int j = 0; j < 4; ++j) { c[j] = (int)__hip_atomic_load(cnt + 4 * lane + j, RLX_AGENT); nb[j] = (c[j] + 127) >> 7; tc += c[j]; tb += nb[j]; }
        int xc = tc, xb = tb;
#pragma unroll
        for (int o = 1; o < 64; o <<= 1) { const int vc = __shfl_up(xc, o), vb = __shfl_up(xb, o); if (lane >= o) { xc += vc; xb += vb; } }
        int ec = xc - tc, eb = xb - tb;
#pragma unroll
        for (int j = 0; j < 4; ++j) { off[4 * lane + j] = ec; pref[4 * lane + j] = eb; ec += c[j]; eb += nb[j]; }
        if (lane == 63) { off[256] = ec; pref[256] = eb; } }
}

constexpr int EX_PREF = 0, EX_OFF = 1040, EX_TOK = 2176, EX_W = 2688, EX_A = 3200, EX_BG = 21632, EX_BU = 39040, EX_G = 56448;
constexpr int ASB = 144;
template <int RS4, int STEP> __device__ __forceinline__ void tr_frag2(unsigned addr, bf16x8& f0, bf16x8& f1) {
    s16x4 l0, h0, l1, h1;
    asm volatile("ds_read_b64_tr_b16 %0, %4\n\tds_read_b64_tr_b16 %1, %4 offset:%5\n\tds_read_b64_tr_b16 %2, %4 offset:%6\n\tds_read_b64_tr_b16 %3, %4 offset:%7\n\ts_waitcnt lgkmcnt(0)"
                 : "=&v"(l0), "=&v"(h0), "=&v"(l1), "=&v"(h1) : "v"(addr), "i"(RS4), "i"(STEP), "i"(STEP + RS4) : "memory");
    f0 = __builtin_shufflevector(l0, h0, 0, 1, 2, 3, 4, 5, 6, 7); f1 = __builtin_shufflevector(l1, h1, 0, 1, 2, 3, 4, 5, 6, 7);
}
__device__ __forceinline__ void p11_experts(Frame& F) {
    unsigned char* ws = F.ws; const bf16* H2 = (const bf16*)(ws + WS_HB); const int* LTOK = (const int*)(ws + WS_LTOK); const float* LW = (const float*)(ws + WS_LW); bf16* YP = (bf16*)(ws + WS_YP);
    LAS int* pref = (LAS int*)(F.lds + EX_PREF); LAS int* off = (LAS int*)(F.lds + EX_OFF); LAS int* tokl = (LAS int*)(F.lds + EX_TOK); LAS float* wl = (LAS float*)(F.lds + EX_W);
    LAS unsigned char* Aimg = F.lds + EX_A; LAS unsigned char* Gimg = F.lds + EX_G;
    const int tid = F.tid, w = F.wave, lane = F.lane, g = lane >> 4, q = (lane & 15) >> 2, p = lane & 3, fr = lane & 15, wr = w >> 2, wc = w & 3;
    expert_prefix(F, pref, off);
    __syncthreads();
    const int nitems = pref[256];
    for (int it = (int)blockIdx.x; it < nitems; it += F.G) {
        int e = 0;
#pragma unroll
        for (int s = 128; s >= 1; s >>= 1) if (pref[e + s] <= it) e += s;
        const int rb = it - pref[e], cnt_e = off[e + 1] - off[e], r0 = rb * 128, slot0 = off[e] + r0;
        if (tid < 128) { const int idx = r0 + tid; const bool ok = idx < cnt_e; tokl[tid] = LTOK[(size_t)e * CAP + (ok ? idx : r0)]; wl[tid] = ok ? LW[(size_t)e * CAP + idx] : 0.f; }
        __syncthreads();
        const float* Wg = F.w_eg + (size_t)e * D * EH; const float* Wu = F.w_eu + (size_t)e * D * EH; const float* Wd = F.w_ed + (size_t)e * EH * D;
        const bf16* asrc = H2 + (size_t)tokl[tid >> 2] * D + (tid & 3) * 16;
        const int bkk = tid >> 5, bn4 = tid & 31;
        for (int hp = 0; hp < 2; ++hp) {
            f32x4 acc[4][4];
#pragma unroll
            for (int i = 0; i < 4; ++i)
#pragma unroll
                for (int j = 0; j < 4; ++j) acc[i][j] = (f32x4){0.f, 0.f, 0.f, 0.f};
            v4u pa0, pa1; f32x4 pg[4], pu[4];
            pa0 = *(const v4u*)asrc; pa1 = *(const v4u*)(asrc + 8);
#pragma unroll
            for (int i = 0; i < 4; ++i) { const size_t o = (size_t)(bkk + 16 * i) * EH + 128 * hp + 4 * bn4; pg[i] = *(const f32x4*)(Wg + o); pu[i] = *(const f32x4*)(Wu + o); }
            const unsigned bga = F.ldsb + EX_BG + (unsigned)((8 * g + q) * KSB + (32 * wc + 4 * p) * 2);
            const unsigned bua = F.ldsb + EX_BU + (unsigned)((8 * g + q) * KSB + (32 * wc + 4 * p) * 2);
#pragma unroll 1
            for (int kc = 0; kc < D / 64; ++kc) {
                __syncthreads();
                *(LAS v4u*)(Aimg + (tid >> 2) * ASB + (tid & 3) * 32) = pa0; *(LAS v4u*)(Aimg + (tid >> 2) * ASB + (tid & 3) * 32 + 16) = pa1;
#pragma unroll
                for (int i = 0; i < 4; ++i) { v2u wg, wu; wg.x = pk2(pg[i].x, pg[i].y); wg.y = pk2(pg[i].z, pg[i].w); wu.x = pk2(pu[i].x, pu[i].y); wu.y = pk2(pu[i].z, pu[i].w);
                    *(LAS v2u*)(F.lds + EX_BG + (bkk + 16 * i) * KSB + 8 * bn4) = wg; *(LAS v2u*)(F.lds + EX_BU + (bkk + 16 * i) * KSB + 8 * bn4) = wu; }
                __syncthreads();
                if (kc + 1 < D / 64) { const int k0 = 64 * (kc + 1); pa0 = *(const v4u*)(asrc + k0); pa1 = *(const v4u*)(asrc + k0 + 8);
#pragma unroll
                    for (int i = 0; i < 4; ++i) { const size_t o = (size_t)(k0 + bkk + 16 * i) * EH + 128 * hp + 4 * bn4; pg[i] = *(const f32x4*)(Wg + o); pu[i] = *(const f32x4*)(Wu + o); } }
#pragma unroll
                for (int s = 0; s < 2; ++s) {
                    bf16x8 af[4];
#pragma unroll
                    for (int rt = 0; rt < 4; ++rt) af[rt] = ldfrag(Aimg, 64 * wr + 16 * rt + fr, ASB, 32 * s + 8 * g);
                    bf16x8 b0, b1, b2, b3; tr_frag2<4 * KSB, 32>(bga + s * 32 * KSB, b0, b1); tr_frag2<4 * KSB, 32>(bua + s * 32 * KSB, b2, b3);
#pragma unroll
                    for (int rt = 0; rt < 4; ++rt) { acc[rt][0] = MFMA16(b0, af[rt], acc[rt][0]); acc[rt][1] = MFMA16(b1, af[rt], acc[rt][1]); acc[rt][2] = MFMA16(b2, af[rt], acc[rt][2]); acc[rt][3] = MFMA16(b3, af[rt], acc[rt][3]); }
                }
            }
#pragma unroll
            for (int rt = 0; rt < 4; ++rt)
#pragma unroll
                for (int ct = 0; ct < 2; ++ct) { const f32x4 ga = acc[rt][ct], ua = acc[rt][ct + 2];
                    v2u wv; wv.x = pk2(siluf_(ga[0]) * ua[0], siluf_(ga[1]) * ua[1]); wv.y = pk2(siluf_(ga[2]) * ua[2], siluf_(ga[3]) * ua[3]);
                    *(LAS v2u*)(Gimg + (64 * wr + 16 * rt + fr) * VSB + (128 * hp + 32 * wc + 16 * ct + 4 * g) * 2) = wv; }
        }
        const int dkk = tid >> 6, dn4 = tid & 63;
        f32x4 pd[8];
#pragma unroll
        for (int i = 0; i < 8; ++i) pd[i] = *(const f32x4*)(Wd + (size_t)(dkk + 8 * i) * D + 4 * dn4);
        const unsigned bda = F.ldsb + EX_BG + (unsigned)((8 * g + q) * VSB + (64 * wc + 4 * p) * 2);
#pragma unroll 1
        for (int np = 0; np < 4; ++np) {
            f32x4 ac2[4][4];
#pragma unroll
            for (int i = 0; i < 4; ++i)
#pragma unroll
                for (int j = 0; j < 4; ++j) ac2[i][j] = (f32x4){0.f, 0.f, 0.f, 0.f};
#pragma unroll 1
            for (int kc = 0; kc < EH / 64; ++kc) {
                __syncthreads();
#pragma unroll
                for (int i = 0; i < 8; ++i) { v2u wd; wd.x = pk2(pd[i].x, pd[i].y); wd.y = pk2(pd[i].z, pd[i].w); *(LAS v2u*)(F.lds + EX_BG + (dkk + 8 * i) * VSB + 8 * dn4) = wd; }
                __syncthreads();
                { int kn = kc + 1, npn = np; if (kn == EH / 64) { kn = 0; npn = np + 1; }
                  if (npn < 4) {
#pragma unroll
                    for (int i = 0; i < 8; ++i) pd[i] = *(const f32x4*)(Wd + (size_t)(64 * kn + dkk + 8 * i) * D + 256 * npn + 4 * dn4); } }
#pragma unroll
                for (int s = 0; s < 2; ++s) {
                    bf16x8 gf[4];
#pragma unroll
                    for (int rt = 0; rt < 4; ++rt) gf[rt] = ldfrag(Gimg, 64 * wr + 16 * rt + fr, VSB, 64 * kc + 32 * s + 8 * g);
                    bf16x8 b0, b1, b2, b3; tr_frag4<4 * VSB, 32>(bda + s * 32 * VSB, b0, b1, b2, b3);
#pragma unroll
                    for (int rt = 0; rt < 4; ++rt) { ac2[rt][0] = MFMA16(b0, gf[rt], ac2[rt][0]); ac2[rt][1] = MFMA16(b1, gf[rt], ac2[rt][1]); ac2[rt][2] = MFMA16(b2, gf[rt], ac2[rt][2]); ac2[rt][3] = MFMA16(b3, gf[rt], ac2[rt][3]); }
                }
            }
#pragma unroll
            for (int rt = 0; rt < 4; ++rt) { const int row = 64 * wr + 16 * rt + fr; const float rw = wl[row];
                if (r0 + row < cnt_e) { bf16* yp = YP + (size_t)(slot0 + row) * D + 256 * np + 64 * wc + 4 * g;
#pragma unroll
                    for (int ct = 0; ct < 4; ++ct) { const f32x4 o = ac2[rt][ct] * rw; v2u wv; wv.x = pk2(o[0], o[1]); wv.y = pk2(o[2], o[3]); *(v2u*)(yp + 16 * ct) = wv; } } }
        }
        __syncthreads();
    }
}

__device__ __forceinline__ void p12_final(Frame& F) {
    unsigned char* ws = F.ws; const float* X1 = (const float*)(ws + WS_X1); const bf16* YP = (const bf16*)(ws + WS_YP); const int* EIDX = (const int*)(ws + WS_EIDX); const int* POS = (const int*)(ws + WS_POS);
    const float* mod = (const float*)(ws + WS_MOD);
    LAS int* pref = (LAS int*)(F.lds + EX_PREF); LAS int* off = (LAS int*)(F.lds + EX_OFF);
    expert_prefix(F, pref, off);
    __syncthreads();
    const int gw = F.vcu * NWAVES + F.wave, NGW = F.G * NWAVES, lane = F.lane;
    f32x4 gn[4];
#pragma unroll
    for (int j = 0; j < 4; ++j) gn[j] = *(const f32x4*)(F.norm_final_g + 4 * lane + 256 * j);
    for (int t = gw; t < M; t += NGW) {
        const int b = t >> 13;
        f32x4 y[4];
#pragma unroll
        for (int j = 0; j < 4; ++j) y[j] = (f32x4){0.f, 0.f, 0.f, 0.f};
#if !MK_SKIP_ROUTED
        int myslot = 0;
        if (lane < 8) myslot = off[EIDX[t * 8 + lane]] + POS[t * 8 + lane];
#pragma unroll
        for (int k = 0; k < 8; ++k) { const int slot = __shfl(myslot, k); const v2u* yp = (const v2u*)(YP + (size_t)slot * D) + lane;
#pragma unroll
            for (int j = 0; j < 4; ++j) { const v2u v = yp[64 * j]; y[j] += (f32x4){bflo(v.x), bfhi(v.x), bflo(v.y), bfhi(v.y)}; } }
#endif
        const f32x4* xr = (const f32x4*)(X1 + (size_t)t * D) + lane; f32x4 v[4]; float ss = 0.f;
#pragma unroll
        for (int j = 0; j < 4; ++j) { const f32x4 g2 = *(const f32x4*)(mod + b * NMOD + 5 * D + 4 * lane + 256 * j); v[j] = xr[64 * j] + g2 * y[j];
            ss += (v[j].x * v[j].x + v[j].y * v[j].y) + (v[j].z * v[j].z + v[j].w * v[j].w); }
        const float rstd = 1.0f / sqrtf(wave_sum(ss) * (1.0f / D) + EPS);
        f32x4* op = (f32x4*)(F.out + (size_t)t * D) + lane;
#pragma unroll
        for (int j = 0; j < 4; ++j) op[64 * j] = v[j] * rstd * gn[j];
    }
}

struct Args { const void* in[22]; float* out; unsigned char* ws; int ph_lo, ph_hi; };
__global__ void __launch_bounds__(NT, 2) mk_fwd(Args args) {
    extern __shared__ __attribute__((aligned(16))) unsigned char lds[];
    Frame F;
    F.lds = (LAS unsigned char*)lds; F.ldsb = (unsigned)(size_t)F.lds;
    F.MISC = (volatile LAS unsigned*)(F.lds + MISC_OFF);
    F.tid = threadIdx.x; F.lane = F.tid & 63; F.wave = __builtin_amdgcn_readfirstlane(F.tid >> 6);
    F.G = gridDim.x; { const int bx = blockIdx.x; F.vcu = (F.G % 8 == 0) ? (bx % 8) * (F.G / 8) + bx / 8 : bx; }
    unsigned char* ws = args.ws; F.ws = ws; F.ctl = (gu32*)(ws + WS_CTL); F.out = args.out;
    F.x = (const float*)args.in[0]; F.c = (const float*)args.in[1]; F.pos = (const int*)args.in[2]; F.w_ada = (const float*)args.in[3]; F.b_ada = (const float*)args.in[4];
    F.norm_mix_g = (const float*)args.in[5]; F.w_in = (const float*)args.in[6]; F.ret_norm_g = (const float*)args.in[7]; F.conv_w = (const float*)args.in[8];
    F.w_br_ret = (const float*)args.in[9]; F.w_br_conv = (const float*)args.in[10]; F.w_out = (const float*)args.in[11]; F.norm_ffn_g = (const float*)args.in[12];
    F.w_router = (const float*)args.in[13]; F.router_bias = (const float*)args.in[14]; F.w_eg = (const float*)args.in[15]; F.w_eu = (const float*)args.in[16]; F.w_ed = (const float*)args.in[17];
    F.w_sg = (const float*)args.in[18]; F.w_su = (const float*)args.in[19]; F.w_sd = (const float*)args.in[20]; F.norm_final_g = (const float*)args.in[21];
    for (int u = F.tid; u < (LDS_BYTES - LDSCTL_OFF) / 4; u += NT) ((LAS unsigned*)(F.lds + LDSCTL_OFF))[u] = 0u;
    __syncthreads();
    XcdBarrier bar; bar.bar = (unsigned*)(F.ctl + CW_BAR); bar.x = 0; bar.st = nullptr;
    if (!MK_PER_PHASE) bar = xcd_barrier_post((unsigned*)(F.ctl + CW_BAR), F.MISC + 8);
    const int lo = args.ph_lo, hi = args.ph_hi;
#ifndef MK_PHASE_MASK
#define MK_PHASE_MASK 0x1fff
#endif
#define IN(k) (((MK_PHASE_MASK >> (k)) & 1) && lo <= (k) && (k) < hi)
#define SEAM(k) do { if (IN(k) && IN((k) + 1)) xcd_barrier(bar); } while (0)
    bf16* HB = (bf16*)(ws + WS_HB); bf16* PROJ = (bf16*)(ws + WS_PROJ); const float* mod = (const float*)(ws + WS_MOD);

    if (IN(0)) { p0_prologue(F); } SEAM(0);
    if (IN(1)) { norm_mod_rows(F, F.x, F.norm_mix_g, 1 * D, 0 * D, HB); } SEAM(1);
    if (IN(2)) {
        pg8::Gemm g{HB, (const bf16*)(ws + WS_WIN), M, NIN, D}; pg8::StaticOrder S; S.init(M, NIN, F.G, (int)blockIdx.x);
        pg8::EpiBf16 E{PROJ, NIN};
        pg8::gemm_phase<pg8::EpiBf16, pg8::StaticOrder, true, true>(F.lds, g, S, E);
    } SEAM(2);
    if (IN(3)) { p3_kv_conv(F); } SEAM(3);
    if (IN(4)) { p4_scan(F); } SEAM(4);
    if (IN(5)) { p5_retention(F); } SEAM(5);
    if (IN(6)) {
        { pg8::Gemm g{(const bf16*)(ws + WS_RETG), (const bf16*)(ws + WS_WBR), M, D, D}; pg8::StaticOrder S; S.init(M, D, F.G, (int)blockIdx.x);
          pg8::EpiGateF32 E{(float*)(ws + WS_MIXP), D, PROJ + OFF_MR, NIN};
          pg8::gemm_phase<pg8::EpiGateF32, pg8::StaticOrder, true, true>(F.lds, g, S, E); }
        asm volatile("s_waitcnt vmcnt(0)" ::: "memory"); __syncthreads();
        { pg8::Gemm g{(const bf16*)(ws + WS_CONVG), (const bf16*)(ws + WS_WBC), M, D, D}; pg8::StaticOrder S; S.init(M, D, F.G, (int)blockIdx.x);
          pg8::EpiMixBf16 E{(bf16*)(ws + WS_MIX), D, (const float*)(ws + WS_MIXP), PROJ + OFF_MC, NIN};
          pg8::gemm_phase<pg8::EpiMixBf16, pg8::StaticOrder, true, true>(F.lds, g, S, E); }
    } SEAM(6);
    if (IN(7)) {
#if MK_SKIP_MIXER
        for (size_t i = (size_t)F.vcu * NT + F.tid; i < (size_t)M * D / 4; i += (size_t)F.G * NT) ((f32x4*)(ws + WS_X1))[i] = ((const f32x4*)F.x)[i];
#else
        pg8::Gemm g{(const bf16*)(ws + WS_MIX), (const bf16*)(ws + WS_WO), M, D, D}; pg8::StaticOrder S; S.init(M, D, F.G, (int)blockIdx.x);
        pg8::EpiResid E{(float*)(ws + WS_X1), F.x, D, mod + 2 * D, NMOD, 13};
        pg8::gemm_phase<pg8::EpiResid, pg8::StaticOrder, true, true>(F.lds, g, S, E);
#endif
    } SEAM(7);
    if (IN(8)) { norm_mod_rows(F, (const float*)(ws + WS_X1), F.norm_ffn_g, 4 * D, 3 * D, HB); } SEAM(8);
    if (IN(9)) {
        { pg8::Gemm g{HB, (const bf16*)(ws + WS_WR), M, NE, D}; pg8::StaticOrder S; S.init(M, NE, F.G, (int)blockIdx.x);
          pg8::EpiF32 E{(float*)(ws + WS_LOGITS), NE};
          pg8::gemm_phase<pg8::EpiF32, pg8::StaticOrder, true, true>(F.lds, g, S, E); }
        { pg8::Gemm g{HB, (const bf16*)(ws + WS_WSGU), M, 2 * EH, D}; pg8::StaticOrder S; S.init(M, 2 * EH, F.G, (int)((blockIdx.x + F.G / 2) % F.G));
          pg8::EpiSwiglu E{(bf16*)(ws + WS_SHG), EH};
          pg8::gemm_phase<pg8::EpiSwiglu, pg8::StaticOrder, true, true>(F.lds, g, S, E); }
    } SEAM(9);
    if (IN(10)) {
#if !MK_SKIP_SHARED
        { pg8::Gemm g{(const bf16*)(ws + WS_SHG), (const bf16*)(ws + WS_WSD), M, D, EH}; pg8::StaticOrder S; S.init(M, D, F.G, (int)blockIdx.x);
          pg8::EpiResid E{(float*)(ws + WS_X1), (const float*)(ws + WS_X1), D, mod + 5 * D, NMOD, 13};
          pg8::gemm_phase<pg8::EpiResid, pg8::StaticOrder, true, true>(F.lds, g, S, E); }
#endif
        route_tokens(F);
    } SEAM(10);
    if (IN(11)) {
#if !MK_SKIP_ROUTED
        p11_experts(F);
#endif
    } SEAM(11);
    if (IN(12)) { p12_final(F); }
#undef IN
#undef SEAM
}

extern "C" void kernel_launch(void* const* d_in, const int* in_sizes, int n_in, void* d_out, int out_size, void* d_ws, size_t ws_size, hipStream_t stream) {
    static int grid = 0;
    if (grid == 0) {
        if (n_in != 22 || in_sizes[0] != M * D || out_size != M * D || ws_size < WS_END) { fprintf(stderr, "kernel_launch: unexpected shapes (n_in %d, in0 %d, out %d, ws %zu, need %zu); nothing launched\n", n_in, n_in > 0 ? in_sizes[0] : -1, out_size, ws_size, (size_t)WS_END); grid = -1; return; }
        int dev = 0, cus = 0, per_cu = 0;
        if (hipGetDevice(&dev) != hipSuccess || hipDeviceGetAttribute(&cus, hipDeviceAttributeMultiprocessorCount, dev) != hipSuccess) { fprintf(stderr, "kernel_launch: device query failed\n"); grid = -1; return; }
        if (hipFuncSetAttribute((const void*)mk_fwd, hipFuncAttributeMaxDynamicSharedMemorySize, LDS_BYTES) != hipSuccess) { fprintf(stderr, "kernel_launch: hipFuncSetAttribute failed\n"); grid = -1; return; }
        if (hipOccupancyMaxActiveBlocksPerMultiprocessor(&per_cu, (const void*)mk_fwd, NT, LDS_BYTES) != hipSuccess || per_cu < 1) { fprintf(stderr, "kernel_launch: occupancy query reports %d workgroups per CU\n", per_cu); (void)hipGetLastError(); grid = -1; return; }
        grid = cus;
    }
    if (grid < 0) return;
    if (hipMemsetAsync((char*)d_ws + WS_CTL, 0, CTL_ZERO_BYTES, stream) != hipSuccess) { fprintf(stderr, "kernel_launch: hipMemsetAsync failed\n"); return; }
    Args a{};
    for (int i = 0; i < 22; ++i) a.in[i] = d_in[i];
    a.out = (float*)d_out; a.ws = (unsigned char*)d_ws;
#if MK_PER_PHASE
    for (int p = 0; p < NPHASE; ++p) { a.ph_lo = p; a.ph_hi = p + 1; hipLaunchKernelGGL(mk_fwd, dim3(grid), dim3(NT), LDS_BYTES, stream, a); }
#else
    a.ph_lo = 0; a.ph_hi = NPHASE;
    hipLaunchKernelGGL(mk_fwd, dim3(grid), dim3(NT), LDS_BYTES, stream, a);
#endif
    const hipError_t le = hipPeekAtLastError();
    if (le != hipSuccess) fprintf(stderr, "kernel_launch: launch failed: %s\n", hipGetErrorName(le));
}
```

```cpp
#include <hip/hip_runtime.h>
#include <cstdio>
#include <cstdint>
namespace pg8 {
#define PG8_LAS __attribute__((address_space(3)))
typedef unsigned short bf16_t;
typedef short bf16x8 __attribute__((ext_vector_type(8)));
typedef float f32x4 __attribute__((ext_vector_type(4)));
typedef unsigned u32x4 __attribute__((ext_vector_type(4)));
constexpr int BM = 256, BK = 64, HALF = 128, HTB = HALF * BK * 2  , STAGE_BYTES = 8 * HTB, NXCD = 8, WGM = 8;

__host__ __device__ __forceinline__ int lds_byte(int r, int c) { const int st = (r >> 4) * 2 + (c >> 5), rr = r & 15, cc = c & 31, ob = rr * 64 + cc * 2; return st * 1024 + (ob ^ (((ob >> 9) & 1) << 5)); }
__host__ __device__ __forceinline__ void stage_rc(int b, int& R, int& C) { const int st = b / 1024, sb = b % 1024, swz = sb ^ (((sb >> 9) & 1) << 5); R = (st >> 1) * 16 + swz / 64; C = (st & 1) * 32 + (swz % 64) / 2; }
__host__ __device__ __forceinline__ int perm32(int rho) { const int n = rho >> 4, i = rho & 15; return 8 * (i >> 2) + 4 * n + (i & 3); }

struct Unit { int pm, pn; };
struct Gemm { const bf16_t* A; const bf16_t* Bt; int M, N, K; };

struct StaticOrder {
    int nM, nN, nwg, G, c;
    __host__ __device__ void init(int M, int N, int G_, int c_) { nM = M / BM; nN = N / BM; nwg = nM * nN; G = G_; c = c_; }
    __host__ __device__ bool next(int i, Unit& u) const {
        const long L = (long)i * G + c; if (L >= nwg) return false;
        int wgid = (int)L; { const int q = nwg / NXCD, r = nwg % NXCD, xcd = wgid % NXCD, off = wgid / NXCD; wgid = (xcd < r ? xcd * (q + 1) : r * (q + 1) + (xcd - r) * q) + off; }
        const int nig = WGM * nN, gid = wgid / nig, fm = gid * WGM, gsz = (nM - fm) < WGM ? (nM - fm) : WGM;
        u.pm = fm + ((wgid % nig) % gsz); u.pn = (wgid % nig) / gsz; return true;
    }
    __device__ __forceinline__ void a_ready(const Unit&) const {}
    __device__ __forceinline__ void done(const Unit&) const {}
};

__device__ __forceinline__ unsigned cvt_pk_bf16(float lo, float hi) { unsigned r; asm volatile("v_cvt_pk_bf16_f32 %0, %1, %2" : "=v"(r) : "v"(lo), "v"(hi)); return r; }
typedef float f32x2 __attribute__((ext_vector_type(2)));
typedef unsigned u32x2 __attribute__((ext_vector_type(2)));
__device__ __forceinline__ float bf_lo(unsigned w) { return __uint_as_float(w << 16); }
__device__ __forceinline__ float bf_hi(unsigned w) { return __uint_as_float(w & 0xffff0000u); }
__device__ __forceinline__ float sigm(float x) { return 1.0f / (1.0f + __expf(-x)); }
__device__ __forceinline__ float silu_f(float x) { return x / (1.0f + __expf(-x)); }

struct EpiBf16 {
    static constexpr bool PERM = true, AFTER_DRAIN = false;
    bf16_t* O; int ldc;
    __device__ __forceinline__ void operator()(const f32x4 (&acc)[2][2][4][2], const Unit& u, int wr, int wc, int fr, int fq) const {
        const int row0 = u.pm * BM + wr * 64 + fr; const int col0 = u.pn * BM + wc * 32 + 8 * fq;
#pragma unroll
        for (int ai = 0; ai < 2; ++ai)
#pragma unroll
            for (int m = 0; m < 4; ++m) { bf16_t* rowp = O + (size_t)(row0 + ai * HALF + m * 16) * ldc + col0;
#pragma unroll
                for (int bj = 0; bj < 2; ++bj) { const f32x4 v0 = acc[ai][bj][m][0], v1 = acc[ai][bj][m][1];
                    u32x4 w; w.x = cvt_pk_bf16(v0[0], v0[1]); w.y = cvt_pk_bf16(v0[2], v0[3]); w.z = cvt_pk_bf16(v1[0], v1[1]); w.w = cvt_pk_bf16(v1[2], v1[3]);
                    *(u32x4*)(rowp + bj * HALF) = w; } }
    }
};
struct EpiF32 {
    static constexpr bool PERM = false, AFTER_DRAIN = false;
    float* C; int ldc;
    __device__ __forceinline__ void operator()(const f32x4 (&acc)[2][2][4][2], const Unit& u, int wr, int wc, int fr, int fq) const {
        const int row0 = u.pm * BM + wr * 64 + fr, col0 = u.pn * BM + wc * 32 + 4 * fq;
#pragma unroll
        for (int ai = 0; ai < 2; ++ai)
#pragma unroll
            for (int m = 0; m < 4; ++m) { float* rowp = C + (size_t)(row0 + ai * HALF + m * 16) * ldc + col0;
#pragma unroll
                for (int bj = 0; bj < 2; ++bj)
#pragma unroll
                    for (int n = 0; n < 2; ++n) *(f32x4*)(rowp + bj * HALF + n * 16) = acc[ai][bj][m][n]; }
    }
};
struct EpiGateF32 {
    static constexpr bool PERM = false, AFTER_DRAIN = false;
    float* C; int ldc; const bf16_t* gate; int ldg;
    __device__ __forceinline__ void operator()(const f32x4 (&acc)[2][2][4][2], const Unit& u, int wr, int wc, int fr, int fq) const {
        const int row0 = u.pm * BM + wr * 64 + fr, col0 = u.pn * BM + wc * 32 + 4 * fq;
#pragma unroll
        for (int ai = 0; ai < 2; ++ai)
#pragma unroll
            for (int m = 0; m < 4; ++m) { const size_t r = (size_t)(row0 + ai * HALF + m * 16); float* rowp = C + r * ldc + col0; const bf16_t* gp = gate + r * ldg + col0;
#pragma unroll
                for (int bj = 0; bj < 2; ++bj)
#pragma unroll
                    for (int n = 0; n < 2; ++n) { const u32x2 g = *(const u32x2*)(gp + bj * HALF + n * 16); const f32x4 a = acc[ai][bj][m][n];
                        f32x4 o; o[0] = sigm(bf_lo(g.x)) * a[0]; o[1] = sigm(bf_hi(g.x)) * a[1]; o[2] = sigm(bf_lo(g.y)) * a[2]; o[3] = sigm(bf_hi(g.y)) * a[3];
                        *(f32x4*)(rowp + bj * HALF + n * 16) = o; } }
    }
};
struct EpiMixBf16 {
    static constexpr bool PERM = true, AFTER_DRAIN = false;
    bf16_t* O; int ldc; const float* P; const bf16_t* gate; int ldg;
    __device__ __forceinline__ void operator()(const f32x4 (&acc)[2][2][4][2], const Unit& u, int wr, int wc, int fr, int fq) const {
        const int row0 = u.pm * BM + wr * 64 + fr; const int col0 = u.pn * BM + wc * 32 + 8 * fq;
#pragma unroll
        for (int ai = 0; ai < 2; ++ai)
#pragma unroll
            for (int m = 0; m < 4; ++m) { const size_t r = (size_t)(row0 + ai * HALF + m * 16); bf16_t* rowp = O + r * ldc + col0; const float* pp = P + r * ldc + col0; const bf16_t* gp = gate + r * ldg + col0;
#pragma unroll
                for (int bj = 0; bj < 2; ++bj) { const f32x4 v0 = acc[ai][bj][m][0], v1 = acc[ai][bj][m][1];
                    const u32x4 g = *(const u32x4*)(gp + bj * HALF); const f32x4 p0 = *(const f32x4*)(pp + bj * HALF), p1 = *(const f32x4*)(pp + bj * HALF + 4);
                    const float o0 = p0[0] + sigm(bf_lo(g.x)) * v0[0], o1 = p0[1] + sigm(bf_hi(g.x)) * v0[1], o2 = p0[2] + sigm(bf_lo(g.y)) * v0[2], o3 = p0[3] + sigm(bf_hi(g.y)) * v0[3];
                    const float o4 = p1[0] + sigm(bf_lo(g.z)) * v1[0], o5 = p1[1] + sigm(bf_hi(g.z)) * v1[1], o6 = p1[2] + sigm(bf_lo(g.w)) * v1[2], o7 = p1[3] + sigm(bf_hi(g.w)) * v1[3];
                    u32x4 w; w.x = cvt_pk_bf16(o0, o1); w.y = cvt_pk_bf16(o2, o3); w.z = cvt_pk_bf16(o4, o5); w.w = cvt_pk_bf16(o6, o7);
                    *(u32x4*)(rowp + bj * HALF) = w; } }
    }
};
struct EpiResid {
    static constexpr bool PERM = false, AFTER_DRAIN = false;
    float* C; const float* base; int ldc; const float* gvec; int gstride; int rows_per_b_shift;
    __device__ __forceinline__ void operator()(const f32x4 (&acc)[2][2][4][2], const Unit& u, int wr, int wc, int fr, int fq) const {
        const int row0 = u.pm * BM + wr * 64 + fr, col0 = u.pn * BM + wc * 32 + 4 * fq;
        const float* gp = gvec + (size_t)((u.pm * BM) >> rows_per_b_shift) * gstride + col0;
        f32x4 gv[2][2];
#pragma unroll
        for (int bj = 0; bj < 2; ++bj)
#pragma unroll
            for (int n = 0; n < 2; ++n) gv[bj][n] = *(const f32x4*)(gp + bj * HALF + n * 16);
#pragma unroll
        for (int ai = 0; ai < 2; ++ai)
#pragma unroll
            for (int m = 0; m < 4; ++m) { const size_t off = (size_t)(row0 + ai * HALF + m * 16) * ldc + col0;
#pragma unroll
                for (int bj = 0; bj < 2; ++bj)
#pragma unroll
                    for (int n = 0; n < 2; ++n) { const f32x4 b = *(const f32x4*)(base + off + bj * HALF + n * 16);
                        *(f32x4*)(C + off + bj * HALF + n * 16) = b + gv[bj][n] * acc[ai][bj][m][n]; } }
    }
};
struct EpiSwiglu {
    static constexpr bool PERM = true, AFTER_DRAIN = false;
    bf16_t* O; int ldo;
    __device__ __forceinline__ void operator()(const f32x4 (&acc)[2][2][4][2], const Unit& u, int wr, int wc, int fr, int fq) const {
        const int row0 = u.pm * BM + wr * 64 + fr; const int col0 = u.pn * BM + wc * 32 + 8 * fq;
#pragma unroll
        for (int ai = 0; ai < 2; ++ai)
#pragma unroll
            for (int m = 0; m < 4; ++m) { bf16_t* rowp = O + (size_t)(row0 + ai * HALF + m * 16) * ldo + (col0 >> 1);
#pragma unroll
                for (int bj = 0; bj < 2; ++bj) { const f32x4 v0 = acc[ai][bj][m][0], v1 = acc[ai][bj][m][1];
                    const float g0 = silu_f(v0[0]) * v0[1], g1 = silu_f(v0[2]) * v0[3], g2 = silu_f(v1[0]) * v1[1], g3 = silu_f(v1[2]) * v1[3];
                    u32x2 w; w.x = cvt_pk_bf16(g0, g1); w.y = cvt_pk_bf16(g2, g3);
                    *(u32x2*)(rowp + bj * (HALF / 2)) = w; } }
    }
};
template <class Epi, class Sched, bool ALIGN_EPI = false, bool SP2 = false>
__device__ __forceinline__ void gemm_phase(PG8_LAS unsigned char* lds, const Gemm g, const Sched& S, const Epi& E) {
    const int tid = threadIdx.x, wid = __builtin_amdgcn_readfirstlane(tid >> 6), lane = tid & 63, wr = wid >> 2, wc = wid & 3, fr = lane & 15, fq = lane >> 4;
    const int K = g.K, nt = K / BK;
    unsigned voffA[2], voffB[2];
#pragma unroll
    for (int i = 0; i < 2; ++i) { int R, C; stage_rc(tid * 16 + i * 8192, R, C); const int Rb = Epi::PERM ? ((R & ~31) + perm32(R & 31)) : R;
        voffA[i] = (unsigned)(R * K + C) * 2u; voffB[i] = (unsigned)(Rb * K + C) * 2u; }
    const size_t kstep = (size_t)(BK * 2);
    const size_t hstep = (size_t)HALF * K * 2;
    const size_t tstep = 2 * hstep;
    const unsigned ldsw = (unsigned)wid * 1024u;
    const int aoff = lds_byte(wr * 64 + fr, fq * 8), boff = lds_byte(wc * 32 + fr, fq * 8);
#define PG8_SA(b, h) (((b) * 2 + (h)) * HTB)
#define PG8_SB(b, h) ((4 + (b) * 2 + (h)) * HTB)
#define PG8_STAGE(bufoff, gbase, voff) do { _Pragma("unroll") for (int _i = 0; _i < 2; ++_i) \
        __builtin_amdgcn_global_load_lds((const unsigned*)((const char*)(gbase) + (voff)[_i]), (PG8_LAS unsigned*)(lds + (bufoff) + ldsw + _i * 8192), 16, 0, 0); } while (0)
#define PG8_LDA(dst, b, h) do { _Pragma("unroll") for (int m = 0; m < 4; ++m) _Pragma("unroll") for (int k = 0; k < 2; ++k) dst[m][k] = *(const PG8_LAS bf16x8*)(lds + PG8_SA(b, h) + aoff + m * 2048 + k * 1024); } while (0)
#define PG8_LDB(dst, b, h) do { _Pragma("unroll") for (int n = 0; n < 2; ++n) _Pragma("unroll") for (int k = 0; k < 2; ++k) dst[n][k] = *(const PG8_LAS bf16x8*)(lds + PG8_SB(b, h) + boff + n * 2048 + k * 1024); } while (0)
#define PG8_MMA(ai, bj, At, Bt) do { __builtin_amdgcn_s_setprio(1); _Pragma("unroll") for (int m = 0; m < 4; ++m) _Pragma("unroll") for (int n = 0; n < 2; ++n) _Pragma("unroll") for (int k = 0; k < 2; ++k) \
        acc[ai][bj][m][n] = __builtin_amdgcn_mfma_f32_16x16x32_bf16(Bt[n][k], At[m][k], acc[ai][bj][m][n], 0, 0, 0); __builtin_amdgcn_s_setprio(0); } while (0)
#define PG8_WAIT_V(n) asm volatile("s_waitcnt vmcnt(" #n ")" ::: "memory")
#define PG8_WAIT_L(n) asm volatile("s_waitcnt lgkmcnt(" #n ")" ::: "memory")
#define PG8_BAR __builtin_amdgcn_s_barrier()
#define PG8_SCHED __builtin_amdgcn_sched_barrier(0)
    Unit cur, nxt; int ui = 0;
    if (!S.next(0, cur)) return;
    f32x4 acc[2][2][4][2];
#pragma unroll
    for (int a = 0; a < 2; ++a)
#pragma unroll
        for (int b = 0; b < 2; ++b)
#pragma unroll
            for (int m = 0; m < 4; ++m)
#pragma unroll
                for (int n = 0; n < 2; ++n) acc[a][b][m][n] = (f32x4){0.f, 0.f, 0.f, 0.f};
    bf16x8 At[4][2], B0[2][2], B1[2][2];
    const char* cA = (const char*)g.A + (size_t)cur.pm * tstep; const char* cB = (const char*)g.Bt + (size_t)cur.pn * tstep;
    S.a_ready(cur);
    if constexpr (SP2) {
        PG8_STAGE(PG8_SB(0, 0), cB, voffB); PG8_STAGE(PG8_SB(0, 1), cB + hstep, voffB); PG8_STAGE(PG8_SA(0, 0), cA, voffA); PG8_STAGE(PG8_SA(0, 1), cA + hstep, voffA);
        if (wr == 1) PG8_BAR;
        PG8_WAIT_V(2); PG8_BAR;
        PG8_STAGE(PG8_SB(1, 0), cB + kstep, voffB); PG8_STAGE(PG8_SA(1, 0), cA + kstep, voffA); PG8_STAGE(PG8_SB(1, 1), cB + hstep + kstep, voffB);
        PG8_WAIT_V(6); PG8_BAR;
    } else {
        PG8_STAGE(PG8_SB(0, 0), cB, voffB); PG8_STAGE(PG8_SA(0, 0), cA, voffA); PG8_STAGE(PG8_SB(0, 1), cB + hstep, voffB); PG8_STAGE(PG8_SA(0, 1), cA + hstep, voffA);
        if (wr == 1) PG8_BAR;
        PG8_WAIT_V(4); PG8_BAR;
        PG8_STAGE(PG8_SB(1, 0), cB + kstep, voffB); PG8_STAGE(PG8_SA(1, 0), cA + kstep, voffA); PG8_STAGE(PG8_SB(1, 1), cB + hstep + kstep, voffB);
        PG8_WAIT_V(6); PG8_BAR;
    }
    for (;;) {
        const bool has_next = S.next(ui + 1, nxt);
        const char* nA = has_next ? (const char*)g.A + (size_t)nxt.pm * tstep : cA; const char* nB = has_next ? (const char*)g.Bt + (size_t)nxt.pn * tstep : cB;
        for (int t = 0; t < nt; t += 2) {
            const bool last = (t == nt - 2);
            const char* a1 = cA + (size_t)(t + 1) * kstep;
            const char* a2 = last ? nA : cA + (size_t)(t + 2) * kstep; const char* b2 = last ? nB : cB + (size_t)(t + 2) * kstep;
            const char* a3 = a2 + kstep; const char* b3 = b2 + kstep;
            if (last && has_next) S.a_ready(nxt);
            if constexpr (SP2) {
            PG8_LDB(B0, 0, 0); PG8_LDB(B1, 0, 1); PG8_SCHED; PG8_LDA(At, 0, 0); PG8_STAGE(PG8_SA(1, 1), a1 + hstep, voffA);
            PG8_WAIT_V(8); PG8_WAIT_L(0); PG8_BAR; PG8_MMA(0, 0, At, B0); PG8_MMA(0, 1, At, B1); PG8_BAR; PG8_SCHED;
            PG8_LDA(At, 0, 1); PG8_STAGE(PG8_SB(0, 0), b2, voffB); PG8_STAGE(PG8_SB(0, 1), b2 + hstep, voffB); PG8_STAGE(PG8_SA(0, 0), a2, voffA);
            PG8_WAIT_V(8); PG8_WAIT_L(0); PG8_BAR; PG8_MMA(1, 0, At, B0); PG8_MMA(1, 1, At, B1); PG8_BAR; PG8_SCHED;
            PG8_LDB(B0, 1, 0); PG8_LDB(B1, 1, 1); PG8_SCHED; PG8_LDA(At, 1, 0); PG8_STAGE(PG8_SA(0, 1), a2 + hstep, voffA);
            PG8_WAIT_V(8); PG8_WAIT_L(0); PG8_BAR; PG8_MMA(0, 0, At, B0); PG8_MMA(0, 1, At, B1); PG8_BAR; PG8_SCHED;
            PG8_LDA(At, 1, 1); PG8_STAGE(PG8_SB(1, 0), b3, voffB); PG8_STAGE(PG8_SB(1, 1), b3 + hstep, voffB); PG8_STAGE(PG8_SA(1, 0), a3, voffA);
            PG8_WAIT_V(8); PG8_WAIT_L(0); PG8_BAR; PG8_MMA(1, 0, At, B0); PG8_MMA(1, 1, At, B1); PG8_BAR; PG8_SCHED;
            } else {
            PG8_LDB(B0, 0, 0); PG8_SCHED; PG8_LDA(At, 0, 0); PG8_STAGE(PG8_SA(1, 1), a1 + hstep, voffA);
            PG8_WAIT_L(8); PG8_BAR; PG8_WAIT_L(0); PG8_MMA(0, 0, At, B0); PG8_BAR; PG8_SCHED;
            PG8_LDB(B1, 0, 1); PG8_STAGE(PG8_SB(0, 0), b2, voffB);
            PG8_BAR; PG8_WAIT_L(0); PG8_MMA(0, 1, At, B1); PG8_BAR;
            PG8_LDA(At, 0, 1); PG8_STAGE(PG8_SA(0, 0), a2, voffA);
            PG8_BAR; PG8_WAIT_L(0); PG8_MMA(1, 0, At, B0); PG8_BAR; PG8_SCHED;
            PG8_STAGE(PG8_SB(0, 1), b2 + hstep, voffB);
            PG8_WAIT_V(6); PG8_BAR; PG8_MMA(1, 1, At, B1); PG8_BAR;
            PG8_LDB(B0, 1, 0); PG8_SCHED; PG8_LDA(At, 1, 0); PG8_STAGE(PG8_SA(0, 1), a2 + hstep, voffA);
            PG8_WAIT_L(8); PG8_BAR; PG8_WAIT_L(0); PG8_MMA(0, 0, At, B0); PG8_BAR; PG8_SCHED;
            PG8_LDB(B1, 1, 1); PG8_STAGE(PG8_SB(1, 0), b3, voffB);
            PG8_BAR; PG8_WAIT_L(0); PG8_MMA(0, 1, At, B1); PG8_BAR;
            PG8_LDA(At, 1, 1); PG8_STAGE(PG8_SA(1, 0), a3, voffA);
            PG8_BAR; PG8_WAIT_L(0); PG8_MMA(1, 0, At, B0); PG8_BAR; PG8_SCHED;
            PG8_STAGE(PG8_SB(1, 1), b3 + hstep, voffB);
            PG8_WAIT_V(6); PG8_BAR; PG8_MMA(1, 1, At, B1); PG8_BAR;
            }
        }
        if constexpr (ALIGN_EPI) { if (wr == 0) PG8_BAR; }
        if constexpr (!Epi::AFTER_DRAIN) { E(acc, cur, wr, wc, fr, fq); S.done(cur); }
        if (!has_next) break;
#pragma unroll
        for (int a = 0; a < 2; ++a)
#pragma unroll
            for (int b = 0; b < 2; ++b)
#pragma unroll
                for (int m = 0; m < 4; ++m)
#pragma unroll
                    for (int n = 0; n < 2; ++n) acc[a][b][m][n] = (f32x4){0.f, 0.f, 0.f, 0.f};
        cur = nxt; cA = nA; cB = nB; ++ui;
        if constexpr (ALIGN_EPI) { if (wr == 1) PG8_BAR; }
    }
    PG8_WAIT_V(0);
    if constexpr (!ALIGN_EPI) { if (wr == 0) PG8_BAR; }
    PG8_BAR;
    if constexpr (Epi::AFTER_DRAIN) { E.fused(acc, cur, wr, wc, fr, fq, lds, wid, lane); S.done(cur); }
#undef PG8_SA
#undef PG8_SB
#undef PG8_STAGE
#undef PG8_LDA
#undef PG8_LDB
#undef PG8_MMA
#undef PG8_WAIT_V
#undef PG8_WAIT_L
#undef PG8_BAR
#undef PG8_SCHED
}
}

constexpr int NWAVES = 8, NT = 512;
#ifndef MK_PER_PHASE
#define MK_PER_PHASE 0
#endif
#ifndef MK_SKIP_MIXER
#define MK_SKIP_MIXER 0
#endif
#ifndef MK_SKIP_SHARED
#define MK_SKIP_SHARED 0
#endif
#ifndef MK_SKIP_ROUTED
#define MK_SKIP_ROUTED 0
#endif
constexpr int NPHASE = 13;
constexpr int BATCH = 2, SEQ = 8192, D = 1024, M = BATCH * SEQ, NIN = 8192, NMOD = 6144;
constexpr int OFF_Q = 0, OFF_K = 512, OFF_V = 1024, OFF_GR = 2048, OFF_U = 3072, OFF_GC = 4096, OFF_GB = 5120, OFF_MR = 6144, OFF_MC = 7168;
constexpr int NE = 256, TOPK = 8, EH = 256, CAP = 16384, NCH = 64, CH = 128, NH = 4, DK = 128, DV = 256;
constexpr float EPS = 1e-6f;

constexpr size_t MiB = (size_t)1 << 20;
constexpr size_t WS_CTL = 0, CTL_ZERO_BYTES = 1 * MiB;
constexpr size_t WS_MOD = 1 * MiB;
constexpr size_t WS_ROPE = 2 * MiB;
constexpr size_t WS_WR = 10 * MiB;
constexpr size_t WS_WSGU = 11 * MiB;
constexpr size_t WS_WSD = 12 * MiB;
constexpr size_t WS_WBR = 13 * MiB, WS_WBC = 15 * MiB, WS_WO = 17 * MiB;
constexpr size_t WS_WIN = 20 * MiB;
constexpr size_t WS_HB = 36 * MiB;
constexpr size_t WS_PROJ = 68 * MiB;
constexpr size_t WS_KV = 324 * MiB;
constexpr size_t WS_SP = 388 * MiB;
constexpr size_t WS_RETG = 420 * MiB;
constexpr size_t WS_CONVG = 452 * MiB;
constexpr size_t WS_MIXP = 484 * MiB;
constexpr size_t WS_MIX = 548 * MiB;
constexpr size_t WS_X1 = 580 * MiB;
constexpr size_t WS_LOGITS = 644 * MiB;
constexpr size_t WS_SHG = 660 * MiB;
constexpr size_t WS_EIDX = 668 * MiB, WS_POS = 669 * MiB;
constexpr size_t WS_LTOK = 670 * MiB, WS_LW = 686 * MiB;
constexpr size_t WS_YP = 702 * MiB;
constexpr size_t WS_END = 958 * MiB;
constexpr int CW_TMO = 0, CW_CODE = 1, CW_BAR = 4096, CW_CNT = 16384;

constexpr int LDSCTL_OFF = 143360, MISC_OFF = LDSCTL_OFF + 320, LDS_BYTES = 147456;

#define GAS __attribute__((address_space(1)))
#define LAS __attribute__((address_space(3)))
typedef unsigned short bf16;
typedef unsigned v4u __attribute__((ext_vector_type(4)));
typedef unsigned v2u __attribute__((ext_vector_type(2)));
typedef float f32x4 __attribute__((ext_vector_type(4)));
typedef float f32x2 __attribute__((ext_vector_type(2)));
typedef short bf16x8 __attribute__((ext_vector_type(8)));
typedef short s16x4 __attribute__((ext_vector_type(4)));
typedef GAS unsigned gu32;
#define RLX_AGENT __ATOMIC_RELAXED, __HIP_MEMORY_SCOPE_AGENT
__device__ __forceinline__ unsigned f2bf(float f) { unsigned u = __builtin_bit_cast(unsigned, f); return (u + 0x7fffu + ((u >> 16) & 1u)) >> 16; }
__device__ __forceinline__ unsigned pk2(float lo, float hi) { unsigned r; asm volatile("v_cvt_pk_bf16_f32 %0, %1, %2" : "=v"(r) : "v"(lo), "v"(hi)); return r; }
__device__ __forceinline__ float bflo(unsigned w) { return __uint_as_float(w << 16); }
__device__ __forceinline__ float bfhi(unsigned w) { return __uint_as_float(w & 0xffff0000u); }
__device__ __forceinline__ float sigmoidf_(float x) { return 1.0f / (1.0f + __expf(-x)); }
__device__ __forceinline__ float siluf_(float x) { return x / (1.0f + __expf(-x)); }

#define XB_TMO      128
#define XB_XCNT(j)  (256  + 64 * (j))
#define XB_XSUB(j)  (1280 + 64 * (j))
#define XB_XGEN(j)  (2304 + 64 * (j))
#define XB_TOP      3328
#define XB_TOPGEN   3392
#define XCD_BAR_WORDS 3456
#define XB_SPIN_CAP (1u << 18)

__device__ __forceinline__ unsigned xb_ld(unsigned* p)              { return __hip_atomic_load(p, __ATOMIC_RELAXED, __HIP_MEMORY_SCOPE_AGENT); }
__device__ __forceinline__ unsigned xb_add(unsigned* p, unsigned v) { return __hip_atomic_fetch_add(p, v, __ATOMIC_RELAXED, __HIP_MEMORY_SCOPE_AGENT); }
__device__ __forceinline__ unsigned xb_xcc_id() { return (unsigned)__builtin_amdgcn_s_getreg((3 << 11) | 20) & 0xFu; }
#define XB_SPIN(cond, bar) do { unsigned _sp = 0; while (cond) { __builtin_amdgcn_s_sleep(1); \
    if ((++_sp & 255u) == 0u) { if (xb_ld(&(bar)[XB_TMO])) break; if (_sp > XB_SPIN_CAP) { atomicAdd(&(bar)[XB_TMO], 1u); break; } } } } while (0)

struct XcdBarrier {
    unsigned* bar; unsigned x;
    volatile LAS unsigned* st;
};

__device__ __forceinline__ XcdBarrier xcd_barrier_post(unsigned* bar, volatile LAS unsigned* st) {
    XcdBarrier b; b.bar = bar; b.x = xb_xcc_id(); b.st = st;
    if (threadIdx.x == 0) (void)xb_add(&bar[XB_XCNT(b.x)], 1u);
    return b;
}
__device__ __forceinline__ void xcd_barrier_complete(unsigned* bar, unsigned x, unsigned& nloc, unsigned& nx) {
    const unsigned G = gridDim.x * gridDim.y * gridDim.z;
    unsigned sum, cnt, mine, sp = 0u;
    for (;;) {
        sum = 0u; cnt = 0u; mine = 0u;
#pragma unroll
        for (unsigned j = 0; j < 16; ++j) { const unsigned c = xb_ld(&bar[XB_XCNT(j)]); sum += c; cnt += (c > 0u) ? 1u : 0u; mine = (j == x) ? c : mine; }
        if (sum == G) break;
        __builtin_amdgcn_s_sleep(1);
        if ((++sp & 255u) == 0u) { if (xb_ld(&bar[XB_TMO])) break; if (sp > XB_SPIN_CAP) { atomicAdd(&bar[XB_TMO], 1u); break; } }
    }
    nloc = mine > 0u ? mine : 1u; nx = cnt > 0u ? cnt : 1u;
}

__device__ __forceinline__ void xcd_barrier(const XcdBarrier& b) {
    asm volatile("s_waitcnt vmcnt(0)" ::: "memory");
    __syncthreads();
    if (threadIdx.x == 0) {
        unsigned* bar = b.bar;
        __builtin_amdgcn_s_waitcnt(0);
        unsigned nloc = b.st[0], nx = b.st[1];
        if (nloc == 0u) { xcd_barrier_complete(bar, b.x, nloc, nx); b.st[0] = nloc; b.st[1] = nx; }
        const unsigned old = xb_add(&bar[XB_XSUB(b.x)], 1u);
        const unsigned gen = old / nloc;
        if (old + 1u == (gen + 1u) * nloc) {
            __builtin_amdgcn_fence(__ATOMIC_RELEASE, "agent");
            asm volatile("s_waitcnt vmcnt(0)" ::: "memory");
            const unsigned og = xb_add(&bar[XB_TOP], 1u);
            const unsigned tg = og / nx;
            if (og + 1u == (tg + 1u) * nx) xb_add(&bar[XB_TOPGEN], 1u);
            else XB_SPIN(xb_ld(&bar[XB_TOPGEN]) == tg, bar);
            __builtin_amdgcn_fence(__ATOMIC_ACQUIRE, "agent");
            xb_add(&bar[XB_XGEN(b.x)], 1u);
            asm volatile("s_waitcnt vmcnt(0)" ::: "memory");
        } else {
            XB_SPIN(xb_ld(&bar[XB_XGEN(b.x)]) == gen, bar);
            __builtin_amdgcn_fence(__ATOMIC_ACQUIRE, "agent");
            asm volatile("s_waitcnt vmcnt(0)" ::: "memory");
        }
    }
    __syncthreads();
}

struct Frame {
    LAS unsigned char* lds; unsigned ldsb;
    volatile LAS unsigned* MISC; gu32* ctl;
    int tid, lane, wave, vcu, G;
    const float *x, *c; const int* pos; const float *w_ada, *b_ada, *norm_mix_g, *w_in, *ret_norm_g, *conv_w, *w_br_ret, *w_br_conv, *w_out, *norm_ffn_g, *w_router, *router_bias,
        *w_eg, *w_eu, *w_ed, *w_sg, *w_su, *w_sd, *norm_final_g;
    float* out; unsigned char* ws;
};
__device__ __forceinline__ float wave_sum(float v) {
#pragma unroll
    for (int o = 1; o < 64; o <<= 1) v += __shfl_xor(v, o);
    return v;
}

__device__ __forceinline__ void p0_mod_task(Frame& F, int j) {
    const int cq = F.tid & 15, kq = F.tid >> 4;
    f32x4 a0 = {0.f, 0.f, 0.f, 0.f}, a1 = {0.f, 0.f, 0.f, 0.f};
    const float* W = F.w_ada + 64 * j + 4 * cq;
#pragma unroll 8
    for (int i = 0; i < 32; ++i) { const int k = kq + 32 * i; const float c0 = F.c[k], c1 = F.c[1024 + k];
        const float s0 = c0 / (1.0f + expf(-c0)), s1 = c1 / (1.0f + expf(-c1));
        const f32x4 w = *(const f32x4*)(W + (size_t)k * NMOD); a0 += s0 * w; a1 += s1 * w; }
    LAS f32x4* red = (LAS f32x4*)F.lds;
    red[(kq * 2 + 0) * 16 + cq] = a0; red[(kq * 2 + 1) * 16 + cq] = a1;
    __syncthreads();
    if (F.tid < 32) { const int b = F.tid >> 4, c2 = F.tid & 15; f32x4 s = *(const f32x4*)(F.b_ada + 64 * j + 4 * c2);
        for (int k2 = 0; k2 < 32; ++k2) s += red[(k2 * 2 + b) * 16 + c2];
        *(f32x4*)((float*)(F.ws + WS_MOD) + b * NMOD + 64 * j + 4 * c2) = s; }
    __syncthreads();
}
__device__ __forceinline__ void p0_transpose_item(const float* W, int K, int N, bf16* WT, int row_off, int row_mul, LAS float* scr, int item, int lane) {
    const int nblk = N / 32, kb = item / nblk, nb = item % nblk, k0 = 64 * kb, n0 = 32 * nb;
#pragma unroll 8
    for (int i = 0; i < 32; ++i) { const int kk = 2 * i + (lane >> 5); scr[kk * 33 + (lane & 31)] = W[(size_t)(k0 + kk) * N + n0 + (lane & 31)]; }
    asm volatile("s_waitcnt lgkmcnt(0)" ::: "memory");
    const int c = lane & 7;
#pragma unroll
    for (int j = 0; j < 4; ++j) { const int n = (lane >> 3) + 8 * j; const LAS float* s = scr + (8 * c) * 33 + n;
        v4u o; o.x = pk2(s[0 * 33], s[1 * 33]); o.y = pk2(s[2 * 33], s[3 * 33]); o.z = pk2(s[4 * 33], s[5 * 33]); o.w = pk2(s[6 * 33], s[7 * 33]);
        *(v4u*)(WT + (size_t)(row_off + row_mul * (n0 + n)) * K + k0 + 8 * c) = o; }
    asm volatile("s_waitcnt lgkmcnt(0)" ::: "memory");
}
__device__ __forceinline__ void p0_prologue(Frame& F) {
    if ((int)blockIdx.x < NMOD / 64) p0_mod_task(F, (int)blockIdx.x);
    LAS float* scr = (LAS float*)(F.lds + F.wave * 16384);
    const int gw = F.vcu * NWAVES + F.wave, NGW = F.G * NWAVES;
    constexpr int I_IN = (D / 64) * (NIN / 32), I_SQ = (D / 64) * (D / 32), I_R = (D / 64) * (256 / 32), I_SD = (256 / 64) * (D / 32);
    constexpr int NITEMS = I_IN + 3 * I_SQ + 3 * I_R + I_SD;
    unsigned char* ws = F.ws;
    for (int it = gw; it < NITEMS; it += NGW) {
        int r = it;
        if (r < I_IN) { p0_transpose_item(F.w_in, D, NIN, (bf16*)(ws + WS_WIN), 0, 1, scr, r, F.lane); continue; } r -= I_IN;
        if (r < I_SQ) { p0_transpose_item(F.w_br_ret, D, D, (bf16*)(ws + WS_WBR), 0, 1, scr, r, F.lane); continue; } r -= I_SQ;
        if (r < I_SQ) { p0_transpose_item(F.w_br_conv, D, D, (bf16*)(ws + WS_WBC), 0, 1, scr, r, F.lane); continue; } r -= I_SQ;
        if (r < I_SQ) { p0_transpose_item(F.w_out, D, D, (bf16*)(ws + WS_WO), 0, 1, scr, r, F.lane); continue; } r -= I_SQ;
        if (r < I_R) { p0_transpose_item(F.w_router, D, NE, (bf16*)(ws + WS_WR), 0, 1, scr, r, F.lane); continue; } r -= I_R;
        if (r < I_R) { p0_transpose_item(F.w_sg, D, EH, (bf16*)(ws + WS_WSGU), 0, 2, scr, r, F.lane); continue; } r -= I_R;
        if (r < I_R) { p0_transpose_item(F.w_su, D, EH, (bf16*)(ws + WS_WSGU), 1, 2, scr, r, F.lane); continue; } r -= I_R;
        p0_transpose_item(F.w_sd, EH, D, (bf16*)(ws + WS_WSD), 0, 1, scr, r, F.lane);
    }
    f32x2* rope = (f32x2*)(ws + WS_ROPE);
    for (int idx = F.vcu * NT + F.tid; idx < M * 64; idx += F.G * NT) { const int t = idx >> 6, i = idx & 63;
        const float invf = powf(10000.0f, -(float)i * (1.0f / 64.0f)); const float ang = (float)F.pos[t] * invf;
        const double ad = (double)ang; const double rr = ad - 6.283185307179586 * rint(ad * 0.15915494309189535); const float rf = (float)rr;
        rope[idx] = (f32x2){cosf(rf), sinf(rf)}; }
}

__device__ __forceinline__ void norm_mod_rows(Frame& F, const float* X, const float* gain, int sc_off, int sh_off, bf16* O) {
    const int gw = F.vcu * NWAVES + F.wave, NGW = F.G * NWAVES;
    const float* mod = (const float*)(F.ws + WS_MOD);
    f32x4 g[4];
#pragma unroll
    for (int j = 0; j < 4; ++j) g[j] = *(const f32x4*)(gain + 4 * F.lane + 256 * j);
    for (int m = gw; m < M; m += NGW) {
        const int b = m >> 13; const f32x4* xr = (const f32x4*)(X + (size_t)m * D) + F.lane;
        f32x4 v[4]; float ss = 0.f;
#pragma unroll
        for (int j = 0; j < 4; ++j) { v[j] = xr[64 * j]; ss += (v[j].x * v[j].x + v[j].y * v[j].y) + (v[j].z * v[j].z + v[j].w * v[j].w); }
        const float rstd = 1.0f / sqrtf(wave_sum(ss) * (1.0f / D) + EPS);
        v2u* o8 = (v2u*)(O + (size_t)m * D) + F.lane;
#pragma unroll
        for (int j = 0; j < 4; ++j) { const f32x4 sc = *(const f32x4*)(mod + b * NMOD + sc_off + 4 * F.lane + 256 * j), sh = *(const f32x4*)(mod + b * NMOD + sh_off + 4 * F.lane + 256 * j);
            const f32x4 h = (v[j] * rstd * g[j]) * (1.0f + sc) + sh; v2u w; w.x = pk2(h.x, h.y); w.y = pk2(h.z, h.w); o8[64 * j] = w; }
    }
}

constexpr int KS = 136, KSB = KS * 2;
constexpr int VS = 264, VSB = VS * 2;
__device__ __forceinline__ float log_gamma(int h) { return log1pf(-exp2f(-5.0f - (float)h)); }
__device__ __forceinline__ bf16x8 ldfrag(const LAS unsigned char* img, int row, int rsb, int k) { return *(const LAS bf16x8*)(img + row * rsb + k * 2); }
template <int RS4> __device__ __forceinline__ bf16x8 tr_frag(unsigned addr) {
    s16x4 lo, hi;
    asm volatile("ds_read_b64_tr_b16 %0, %2\n\tds_read_b64_tr_b16 %1, %2 offset:%3\n\ts_waitcnt lgkmcnt(0)" : "=&v"(lo), "=&v"(hi) : "v"(addr), "i"(RS4) : "memory");
    return __builtin_shufflevector(lo, hi, 0, 1, 2, 3, 4, 5, 6, 7);
}
template <int RS4, int STEP> __device__ __forceinline__ void tr_frag4(unsigned addr, bf16x8& f0, bf16x8& f1, bf16x8& f2, bf16x8& f3) {
    s16x4 l0, h0, l1, h1, l2, h2, l3, h3;
    asm volatile("ds_read_b64_tr_b16 %0, %8\n\tds_read_b64_tr_b16 %1, %8 offset:%9\n\t"
                 "ds_read_b64_tr_b16 %2, %8 offset:%10\n\tds_read_b64_tr_b16 %3, %8 offset:%11\n\t"
                 "ds_read_b64_tr_b16 %4, %8 offset:%12\n\tds_read_b64_tr_b16 %5, %8 offset:%13\n\t"
                 "ds_read_b64_tr_b16 %6, %8 offset:%14\n\tds_read_b64_tr_b16 %7, %8 offset:%15\n\ts_waitcnt lgkmcnt(0)"
                 : "=&v"(l0), "=&v"(h0), "=&v"(l1), "=&v"(h1), "=&v"(l2), "=&v"(h2), "=&v"(l3), "=&v"(h3)
                 : "v"(addr), "i"(RS4), "i"(STEP), "i"(STEP + RS4), "i"(2 * STEP), "i"(2 * STEP + RS4), "i"(3 * STEP), "i"(3 * STEP + RS4) : "memory");
    f0 = __builtin_shufflevector(l0, h0, 0, 1, 2, 3, 4, 5, 6, 7); f1 = __builtin_shufflevector(l1, h1, 0, 1, 2, 3, 4, 5, 6, 7);
    f2 = __builtin_shufflevector(l2, h2, 0, 1, 2, 3, 4, 5, 6, 7); f3 = __builtin_shufflevector(l3, h3, 0, 1, 2, 3, 4, 5, 6, 7);
}
#define MFMA16(a, b, c) __builtin_amdgcn_mfma_f32_16x16x32_bf16((a), (b), (c), 0, 0, 0)

template <bool DECAY> __device__ __forceinline__ void stage_rope(Frame& F, LAS unsigned char* img, const bf16* src, const f32x2* rope, float s_const, float lg) {
#pragma unroll
    for (int i = 0; i < 4; ++i) { const int task = F.tid + NT * i, c = task >> 4, g = task & 15;
        const v2u lo = *(const v2u*)(src + (size_t)c * NIN + 4 * g), hi = *(const v2u*)(src + (size_t)c * NIN + 64 + 4 * g);
        const f32x4 r01 = *(const f32x4*)(rope + c * 64 + 4 * g), r23 = *(const f32x4*)(rope + c * 64 + 4 * g + 2);
        const float sc = DECAY ? s_const * __expf(lg * (float)(127 - c)) : s_const;
        const float x1[4] = {bflo(lo.x), bfhi(lo.x), bflo(lo.y), bfhi(lo.y)}, x2[4] = {bflo(hi.x), bfhi(hi.x), bflo(hi.y), bfhi(hi.y)};
        const float cs[4] = {r01.x, r01.z, r23.x, r23.z}, sn[4] = {r01.y, r01.w, r23.y, r23.w};
        float y1[4], y2[4];
#pragma unroll
        for (int j = 0; j < 4; ++j) { y1[j] = (x1[j] * cs[j] - x2[j] * sn[j]) * sc; y2[j] = (x2[j] * cs[j] + x1[j] * sn[j]) * sc; }
        v2u w1, w2; w1.x = pk2(y1[0], y1[1]); w1.y = pk2(y1[2], y1[3]); w2.x = pk2(y2[0], y2[1]); w2.y = pk2(y2[2], y2[3]);
        *(LAS v2u*)(img + c * KSB + 8 * g) = w1; *(LAS v2u*)(img + c * KSB + 128 + 8 * g) = w2; }
}
__device__ __forceinline__ void stage_v(Frame& F, LAS unsigned char* img, const bf16* src) {
#pragma unroll
    for (int i = 0; i < 8; ++i) { const int task = F.tid + NT * i, c = task >> 5, g = task & 31;
        *(LAS v4u*)(img + c * VSB + 16 * g) = *(const v4u*)(src + (size_t)c * NIN + 8 * g); }
}

__device__ __forceinline__ void p3_kv_conv(Frame& F) {
    unsigned char* ws = F.ws; const bf16* PROJ = (const bf16*)(ws + WS_PROJ); const f32x2* ROPE = (const f32x2*)(ws + WS_ROPE); float* KV = (float*)(ws + WS_KV);
    LAS unsigned char* Kimg = F.lds; LAS unsigned char* Vimg = F.lds + 34816;
    const int w = F.wave, lane = F.lane, g = lane >> 4, q = (lane & 15) >> 2, p = lane & 3;
    for (int it = (int)blockIdx.x; it < BATCH * NH * NCH; it += F.G) {
        const int n = it & 63, h = (it >> 6) & 3, b = it >> 8; const int t0 = b * SEQ + n * CH; const float lg = log_gamma(h);
        stage_rope<true>(F, Kimg, PROJ + (size_t)t0 * NIN + OFF_K + h * DK, ROPE + (size_t)t0 * 64, 1.0f, lg);
        stage_v(F, Vimg, PROJ + (size_t)t0 * NIN + OFF_V + h * DV);
        __syncthreads();
        f32x4 acc[16];
#pragma unroll
        for (int i = 0; i < 16; ++i) acc[i] = (f32x4){0.f, 0.f, 0.f, 0.f};
        const unsigned ka = F.ldsb + (unsigned)((8 * g + q) * KSB + (16 * w + 4 * p) * 2);
        const unsigned va = F.ldsb + 34816u + (unsigned)((8 * g + q) * VSB + (4 * p) * 2);
#pragma unroll
        for (int ks = 0; ks < 4; ++ks) {
            const bf16x8 a = tr_frag<4 * KSB>(ka + ks * 32 * KSB);
#pragma unroll
            for (int nt = 0; nt < 16; nt += 4) { bf16x8 b0, b1, b2, b3; tr_frag4<4 * VSB, 32>(va + ks * 32 * VSB + nt * 32, b0, b1, b2, b3);
                acc[nt] = MFMA16(a, b0, acc[nt]); acc[nt + 1] = MFMA16(a, b1, acc[nt + 1]); acc[nt + 2] = MFMA16(a, b2, acc[nt + 2]); acc[nt + 3] = MFMA16(a, b3, acc[nt + 3]); }
        }
        float* kvp = KV + (size_t)it * (DV * DK) + (size_t)(lane & 15) * DK + 16 * w + 4 * g;
#pragma unroll
        for (int nt = 0; nt < 16; ++nt) *(f32x4*)(kvp + (size_t)(16 * nt) * DK) = acc[nt];
        __syncthreads();
    }
    bf16* CONVG = (bf16*)(ws + WS_CONVG);
    const int gw = F.vcu * NWAVES + F.wave, NGW = F.G * NWAVES;
    for (int m = gw; m < M; m += NGW) { const int s = m & (SEQ - 1);
#pragma unroll
        for (int j = 0; j < 4; ++j) { const int ch = 4 * lane + 256 * j; const bf16* rp = PROJ + (size_t)m * NIN + ch;
            const f32x4 w0 = *(const f32x4*)(F.conv_w + ch), w1 = *(const f32x4*)(F.conv_w + D + ch), w2 = *(const f32x4*)(F.conv_w + 2 * D + ch);
            const v2u u0 = *(const v2u*)(rp + OFF_U), c0 = *(const v2u*)(rp + OFF_GC), gb = *(const v2u*)(rp + OFF_GB);
            v2u u1 = {0u, 0u}, c1 = {0u, 0u}, u2 = {0u, 0u}, c2 = {0u, 0u};
            if (s >= 1) { u1 = *(const v2u*)(rp - NIN + OFF_U); c1 = *(const v2u*)(rp - NIN + OFF_GC); }
            if (s >= 2) { u2 = *(const v2u*)(rp - 2 * NIN + OFF_U); c2 = *(const v2u*)(rp - 2 * NIN + OFF_GC); }
            f32x4 cu0 = {bflo(u0.x) * bflo(c0.x), bfhi(u0.x) * bfhi(c0.x), bflo(u0.y) * bflo(c0.y), bfhi(u0.y) * bfhi(c0.y)};
            f32x4 cu1 = {bflo(u1.x) * bflo(c1.x), bfhi(u1.x) * bfhi(c1.x), bflo(u1.y) * bflo(c1.y), bfhi(u1.y) * bfhi(c1.y)};
            f32x4 cu2 = {bflo(u2.x) * bflo(c2.x), bfhi(u2.x) * bfhi(c2.x), bflo(u2.y) * bflo(c2.y), bfhi(u2.y) * bfhi(c2.y)};
            const f32x4 gbf = {bflo(gb.x), bfhi(gb.x), bflo(gb.y), bfhi(gb.y)};
            const f32x4 o = gbf * (w0 * cu2 + w1 * cu1 + w2 * cu0);
            v2u wv; wv.x = pk2(o.x, o.y); wv.y = pk2(o.z, o.w); *(v2u*)(CONVG + (size_t)m * D + ch) = wv; }
    }
}

__device__ __forceinline__ void p4_scan(Frame& F) {
    const float* KV = (const float*)(F.ws + WS_KV); unsigned* SP = (unsigned*)(F.ws + WS_SP);
    for (int gid = F.vcu * NT + F.tid; gid < BATCH * NH * (DV * DK / 2); gid += F.G * NT) {
        const int bh = gid >> 14, e2 = gid & 16383, h = bh & 3; const float dec = __expf(log_gamma(h) * 128.0f);
        f32x2 S = {0.f, 0.f};
        const f32x2* kp = (const f32x2*)KV + (size_t)bh * NCH * 16384 + e2; unsigned* sp = SP + (size_t)bh * NCH * 16384 + e2;
#pragma unroll 8
        for (int n = 0; n < NCH; ++n) { const f32x2 kv = kp[(size_t)n * 16384]; sp[(size_t)n * 16384] = pk2(S.x, S.y); S = S * dec + kv; }
    }
}

__device__ __forceinline__ void p5_retention(Frame& F) {
    unsigned char* ws = F.ws; const bf16* PROJ = (const bf16*)(ws + WS_PROJ); const f32x2* ROPE = (const f32x2*)(ws + WS_ROPE); const bf16* SP = (const bf16*)(ws + WS_SP);
    bf16* RETG = (bf16*)(ws + WS_RETG);
    LAS unsigned char* Qimg = F.lds; LAS unsigned char* Kimg = F.lds + 34816; LAS unsigned char* Bimg = F.lds + 69632;
    const int w = F.wave, lane = F.lane, g = lane >> 4, q = (lane & 15) >> 2, p = lane & 3, fr = lane & 15;
    for (int it = (int)blockIdx.x; it < BATCH * NH * NCH; it += F.G) {
        const int n = it & 63, h = (it >> 6) & 3, b = it >> 8; const int t0 = b * SEQ + n * CH; const float lg = log_gamma(h);
        stage_rope<false>(F, Qimg, PROJ + (size_t)t0 * NIN + OFF_Q + h * DK, ROPE + (size_t)t0 * 64, 0.08838834764831845f, 0.f);
        stage_rope<false>(F, Kimg, PROJ + (size_t)t0 * NIN + OFF_K + h * DK, ROPE + (size_t)t0 * 64, 1.0f, 0.f);
        { const bf16* sp = SP + (size_t)it * (DV * DK);
#pragma unroll
          for (int i = 0; i < 8; ++i) { const int task = F.tid + NT * i, r = task >> 4, c16 = task & 15; *(LAS v4u*)(Bimg + r * KSB + 16 * c16) = *(const v4u*)(sp + r * DK + 8 * c16); } }
        __syncthreads();
        f32x4 acc[16];
#pragma unroll
        for (int i = 0; i < 16; ++i) acc[i] = (f32x4){0.f, 0.f, 0.f, 0.f};
        f32x4 sc[8];
#pragma unroll
        for (int i = 0; i < 8; ++i) sc[i] = (f32x4){0.f, 0.f, 0.f, 0.f};
#pragma unroll 1
        for (int ks = 0; ks < 4; ++ks) {
            const bf16x8 qf = ldfrag(Qimg, 16 * w + fr, KSB, 32 * ks + 8 * g);
#pragma unroll
            for (int nt = 0; nt < 16; ++nt) { const bf16x8 sf = ldfrag(Bimg, 16 * nt + fr, KSB, 32 * ks + 8 * g); acc[nt] = MFMA16(sf, qf, acc[nt]); }
#pragma unroll
            for (int jt = 0; jt < 8; ++jt) { const bf16x8 kf = ldfrag(Kimg, 16 * jt + fr, KSB, 32 * ks + 8 * g); sc[jt] = MFMA16(kf, qf, sc[jt]); }
        }
        const int irow = 16 * w + fr;
        { const float cd = __expf(lg * (float)(irow + 1));
#pragma unroll
          for (int nt = 0; nt < 16; ++nt) acc[nt] = acc[nt] * cd; }
        __syncthreads();
#pragma unroll
        for (int jt = 0; jt < 8; ++jt) { float pv[4];
#pragma unroll
            for (int r = 0; r < 4; ++r) { const int j = 16 * jt + 4 * g + r; pv[r] = (irow >= j) ? sc[jt][r] * __expf(lg * (float)(irow - j)) : 0.f; }
            v2u wv; wv.x = pk2(pv[0], pv[1]); wv.y = pk2(pv[2], pv[3]); *(LAS v2u*)(Kimg + irow * KSB + (16 * jt + 4 * g) * 2) = wv; }
        stage_v(F, Bimg, PROJ + (size_t)t0 * NIN + OFF_V + h * DV);
        __syncthreads();
        const unsigned va = F.ldsb + 69632u + (unsigned)((8 * g + q) * VSB + (4 * p) * 2);
#pragma unroll 1
        for (int ks = 0; ks < 4; ++ks) {
            const bf16x8 pf = ldfrag(Kimg, 16 * w + fr, KSB, 32 * ks + 8 * g);
#pragma unroll
            for (int nt = 0; nt < 16; nt += 4) { bf16x8 v0, v1, v2, v3; tr_frag4<4 * VSB, 32>(va + ks * 32 * VSB + nt * 32, v0, v1, v2, v3);
                acc[nt] = MFMA16(v0, pf, acc[nt]); acc[nt + 1] = MFMA16(v1, pf, acc[nt + 1]); acc[nt + 2] = MFMA16(v2, pf, acc[nt + 2]); acc[nt + 3] = MFMA16(v3, pf, acc[nt + 3]); }
        }
        float ss = 0.f;
#pragma unroll
        for (int nt = 0; nt < 16; ++nt) ss += (acc[nt][0] * acc[nt][0] + acc[nt][1] * acc[nt][1]) + (acc[nt][2] * acc[nt][2] + acc[nt][3] * acc[nt][3]);
        ss += __shfl_xor(ss, 16); ss += __shfl_xor(ss, 32);
        const float rstd = 1.0f / sqrtf(ss * (1.0f / DV) + EPS);
        const size_t trow = (size_t)(t0 + irow);
#pragma unroll
        for (int nt = 0; nt < 16; ++nt) { const int dv = 16 * nt + 4 * g; const f32x4 gn = *(const f32x4*)(F.ret_norm_g + h * DV + dv);
            const v2u gr = *(const v2u*)(PROJ + trow * NIN + OFF_GR + h * DV + dv);
            const f32x4 o = acc[nt] * rstd * gn * (f32x4){siluf_(bflo(gr.x)), siluf_(bfhi(gr.x)), siluf_(bflo(gr.y)), siluf_(bfhi(gr.y))};
            v2u wv; wv.x = pk2(o[0], o[1]); wv.y = pk2(o[2], o[3]); *(v2u*)(RETG + trow * D + h * DV + dv) = wv; }
        __syncthreads();
    }
}

__device__ __forceinline__ void route_tokens(Frame& F) {
    unsigned char* ws = F.ws; const float* LOGITS = (const float*)(ws + WS_LOGITS);
    int* EIDX = (int*)(ws + WS_EIDX); int* POS = (int*)(ws + WS_POS); int* LTOK = (int*)(ws + WS_LTOK); float* LW = (float*)(ws + WS_LW);
    unsigned* cnt = (unsigned*)(F.ctl + CW_CNT);
    const int gw = F.vcu * NWAVES + F.wave, NGW = F.G * NWAVES, lane = F.lane;
    const f32x4 bias = *(const f32x4*)(F.router_bias + 4 * lane);
    const float NEG = -__builtin_inff();
    for (int t = gw; t < M; t += NGW) {
        const f32x4 lgv = *(const f32x4*)(LOGITS + (size_t)t * NE + 4 * lane);
        float s0 = 1.0f / (1.0f + expf(-lgv.x)), s1 = 1.0f / (1.0f + expf(-lgv.y)), s2 = 1.0f / (1.0f + expf(-lgv.z)), s3 = 1.0f / (1.0f + expf(-lgv.w));
        float c0 = s0 + bias.x, c1 = s1 + bias.y, c2 = s2 + bias.z, c3 = s3 + bias.w;
        float a = fmaxf(c0, c1), bq = fminf(c0, c1), cc = fmaxf(c2, c3), dd = fminf(c2, c3);
        float m1 = fmaxf(a, cc), m2 = fmaxf(fminf(a, cc), fmaxf(bq, dd));
#pragma unroll
        for (int o = 1; o < 8; o <<= 1) { const float o1 = __shfl_xor(m1, o), o2 = __shfl_xor(m2, o); const float n1 = fmaxf(m1, o1), n2 = fmaxf(fminf(m1, o1), fmaxf(m2, o2)); m1 = n1; m2 = n2; }
        const float gs = m1 + m2; const int myg = lane >> 3; int rank = 0;
#pragma unroll
        for (int g2 = 0; g2 < 8; ++g2) { const float sg = __shfl(gs, g2 * 8); rank += (sg > gs || (sg == gs && g2 < myg)) ? 1 : 0; }
        if (rank >= 4) { c0 = NEG; c1 = NEG; c2 = NEG; c3 = NEG; }
        int ek[8]; float wk[8]; float wsum = 0.f;
#pragma unroll
        for (int k = 0; k < 8; ++k) {
            float bv = c0; int bi = 0;
            if (c1 > bv) { bv = c1; bi = 1; } if (c2 > bv) { bv = c2; bi = 2; } if (c3 > bv) { bv = c3; bi = 3; }
            int be = 4 * lane + bi;
#pragma unroll
            for (int o = 32; o >= 1; o >>= 1) { const float ov = __shfl_xor(bv, o); const int oe = __shfl_xor(be, o); if (ov > bv || (ov == bv && oe < be)) { bv = ov; be = oe; } }
            const int sl = be >> 2, sj = be & 3;
            const float myv = sj == 0 ? s0 : (sj == 1 ? s1 : (sj == 2 ? s2 : s3));
            const float wv = __shfl(myv, sl);
            if (lane == sl) { if (sj == 0) c0 = NEG; else if (sj == 1) c1 = NEG; else if (sj == 2) c2 = NEG; else c3 = NEG; }
            ek[k] = be; wk[k] = wv; wsum += wv;
        }
        const float inv = 2.5f / wsum;
        int my_e = ek[0]; float my_w = wk[0];
#pragma unroll
        for (int k = 1; k < 8; ++k) if (lane == k) { my_e = ek[k]; my_w = wk[k]; }
        if (lane < 8) { const unsigned ps = __hip_atomic_fetch_add(cnt + my_e, 1u, RLX_AGENT);
            LTOK[(size_t)my_e * CAP + ps] = t; LW[(size_t)my_e * CAP + ps] = my_w * inv; EIDX[t * 8 + lane] = my_e; POS[t * 8 + lane] = (int)ps; }
    }
}

__device__ __forceinline__ void expert_prefix(Frame& F, LAS int* pref, LAS int* off) {
    if (F.wave == 0) { const unsigned* cnt = (const unsigned*)(F.ctl + CW_CNT); const int lane = F.lane;
        int c[4], nb[4]; int tc = 0, tb = 0;
#pragma unroll
        for (int j = 0; j < 4; ++j) { c[j] = (int)__hip_atomic_load(cnt + 4 * lane + j, RLX_AGENT); nb[j] = (c[j] + 127) >> 7; tc += c[j]; tb += nb[j]; }
        int xc = tc, xb = tb;
#pragma unroll
        for (int o = 1; o < 64; o <<= 1) { const int vc = __shfl_up(xc, o), vb = __shfl_up(xb, o); if (lane >= o) { xc += vc; xb += vb; } }
        int ec = xc - tc, eb = xb - tb;
#pragma unroll
        for (int j = 0; j < 4; ++j) { off[4 * lane + j] = ec; pref[4 * lane + j] = eb; ec += c[j]; eb += nb[j]; }
        if (lane == 63) { off[256] = ec; pref[256] = eb; } }
}

constexpr int EX_PREF = 0, EX_OFF = 1040, EX_TOK = 2176, EX_W = 2688, EX_A = 3200, EX_BG = 21632, EX_BU = 39040, EX_G = 56448;
constexpr int ASB = 144;
template <int RS4, int STEP> __device__ __forceinline__ void tr_frag2(unsigned addr, bf16x8& f0, bf16x8& f1) {
    s16x4 l0, h0, l1, h1;
    asm volatile("ds_read_b64_tr_b16 %0, %4\n\tds_read_b64_tr_b16 %1, %4 offset:%5\n\tds_read_b64_tr_b16 %2, %4 offset:%6\n\tds_read_b64_tr_b16 %3, %4 offset:%7\n\ts_waitcnt lgkmcnt(0)"
                 : "=&v"(l0), "=&v"(h0), "=&v"(l1), "=&v"(h1) : "v"(addr), "i"(RS4), "i"(STEP), "i"(STEP + RS4) : "memory");
    f0 = __builtin_shufflevector(l0, h0, 0, 1, 2, 3, 4, 5, 6, 7); f1 = __builtin_shufflevector(l1, h1, 0, 1, 2, 3, 4, 5, 6, 7);
}
__device__ __forceinline__ void p11_experts(Frame& F) {
    unsigned char* ws = F.ws; const bf16* H2 = (const bf16*)(ws + WS_HB); const int* LTOK = (const int*)(ws + WS_LTOK); const float* LW = (const float*)(ws + WS_LW); bf16* YP = (bf16*)(ws + WS_YP);
    LAS int* pref = (LAS int*)(F.lds + EX_PREF); LAS int* off = (LAS int*)(F.lds + EX_OFF); LAS int* tokl = (LAS int*)(F.lds + EX_TOK); LAS float* wl = (LAS float*)(F.lds + EX_W);
    LAS unsigned char* Aimg = F.lds + EX_A; LAS unsigned char* Gimg = F.lds + EX_G;
    const int tid = F.tid, w = F.wave, lane = F.lane, g = lane >> 4, q = (lane & 15) >> 2, p = lane & 3, fr = lane & 15, wr = w >> 2, wc = w & 3;
    expert_prefix(F, pref, off);
    __syncthreads();
    const int nitems = pref[256];
    for (int it = F.vcu; it < nitems; it += F.G) {
        int e = 0;
#pragma unroll
        for (int s = 128; s >= 1; s >>= 1) if (pref[e + s] <= it) e += s;
        const int rb = it - pref[e], cnt_e = off[e + 1] - off[e], r0 = rb * 128, slot0 = off[e] + r0;
        if (tid < 128) { const int idx = r0 + tid; const bool ok = idx < cnt_e; tokl[tid] = LTOK[(size_t)e * CAP + (ok ? idx : r0)]; wl[tid] = ok ? LW[(size_t)e * CAP + idx] : 0.f; }
        __syncthreads();
        const float* Wg = F.w_eg + (size_t)e * D * EH; const float* Wu = F.w_eu + (size_t)e * D * EH; const float* Wd = F.w_ed + (size_t)e * EH * D;
        const bf16* asrc = H2 + (size_t)tokl[tid >> 2] * D + (tid & 3) * 16;
        const int bkk = tid >> 5, bn4 = tid & 31;
        for (int hp = 0; hp < 2; ++hp) {
            f32x4 acc[4][4];
#pragma unroll
            for (int i = 0; i < 4; ++i)
#pragma unroll
                for (int j = 0; j < 4; ++j) acc[i][j] = (f32x4){0.f, 0.f, 0.f, 0.f};
            v4u pa0, pa1; f32x4 pg[4], pu[4];
            pa0 = *(const v4u*)asrc; pa1 = *(const v4u*)(asrc + 8);
#pragma unroll
            for (int i = 0; i < 4; ++i) { const size_t o = (size_t)(bkk + 16 * i) * EH + 128 * hp + 4 * bn4; pg[i] = *(const f32x4*)(Wg + o); pu[i] = *(const f32x4*)(Wu + o); }
            const unsigned bga = F.ldsb + EX_BG + (unsigned)((8 * g + q) * KSB + (32 * wc + 4 * p) * 2);
            const unsigned bua = F.ldsb + EX_BU + (unsigned)((8 * g + q) * KSB + (32 * wc + 4 * p) * 2);
#pragma unroll 1
            for (int kc = 0; kc < D / 64; ++kc) {
                __syncthreads();
                *(LAS v4u*)(Aimg + (tid >> 2) * ASB + (tid & 3) * 32) = pa0; *(LAS v4u*)(Aimg + (tid >> 2) * ASB + (tid & 3) * 32 + 16) = pa1;
#pragma unroll
                for (int i = 0; i < 4; ++i) { v2u wg, wu; wg.x = pk2(pg[i].x, pg[i].y); wg.y = pk2(pg[i].z, pg[i].w); wu.x = pk2(pu[i].x, pu[i].y); wu.y = pk2(pu[i].z, pu[i].w);
                    *(LAS v2u*)(F.lds + EX_BG + (bkk + 16 * i) * KSB + 8 * bn4) = wg; *(LAS v2u*)(F.lds + EX_BU + (bkk + 16 * i) * KSB + 8 * bn4) = wu; }
                __syncthreads();
                if (kc + 1 < D / 64) { const int k0 = 64 * (kc + 1); pa0 = *(const v4u*)(asrc + k0); pa1 = *(const v4u*)(asrc + k0 + 8);
#pragma unroll
                    for (int i = 0; i < 4; ++i) { const size_t o = (size_t)(k0 + bkk + 16 * i) * EH + 128 * hp + 4 * bn4; pg[i] = *(const f32x4*)(Wg + o); pu[i] = *(const f32x4*)(Wu + o); } }
#pragma unroll
                for (int s = 0; s < 2; ++s) {
                    bf16x8 af[4];
#pragma unroll
                    for (int rt = 0; rt < 4; ++rt) af[rt] = ldfrag(Aimg, 64 * wr + 16 * rt + fr, ASB, 32 * s + 8 * g);
                    bf16x8 b0, b1, b2, b3; tr_frag2<4 * KSB, 32>(bga + s * 32 * KSB, b0, b1); tr_frag2<4 * KSB, 32>(bua + s * 32 * KSB, b2, b3);
#pragma unroll
                    for (int rt = 0; rt < 4; ++rt) { acc[rt][0] = MFMA16(b0, af[rt], acc[rt][0]); acc[rt][1] = MFMA16(b1, af[rt], acc[rt][1]); acc[rt][2] = MFMA16(b2, af[rt], acc[rt][2]); acc[rt][3] = MFMA16(b3, af[rt], acc[rt][3]); }
                }
            }
#pragma unroll
            for (int rt = 0; rt < 4; ++rt)
#pragma unroll
                for (int ct = 0; ct < 2; ++ct) { const f32x4 ga = acc[rt][ct], ua = acc[rt][ct + 2];
                    v2u wv; wv.x = pk2(siluf_(ga[0]) * ua[0], siluf_(ga[1]) * ua[1]); wv.y = pk2(siluf_(ga[2]) * ua[2], siluf_(ga[3]) * ua[3]);
                    *(LAS v2u*)(Gimg + (64 * wr + 16 * rt + fr) * VSB + (128 * hp + 32 * wc + 16 * ct + 4 * g) * 2) = wv; }
        }
        const int dkk = tid >> 6, dn4 = tid & 63;
        f32x4 pd[8];
#pragma unroll
        for (int i = 0; i < 8; ++i) pd[i] = *(const f32x4*)(Wd + (size_t)(dkk + 8 * i) * D + 4 * dn4);
        const unsigned bda = F.ldsb + EX_BG + (unsigned)((8 * g + q) * VSB + (64 * wc + 4 * p) * 2);
#pragma unroll 1
        for (int np = 0; np < 4; ++np) {
            f32x4 ac2[4][4];
#pragma unroll
            for (int i = 0; i < 4; ++i)
#pragma unroll
                for (int j = 0; j < 4; ++j) ac2[i][j] = (f32x4){0.f, 0.f, 0.f, 0.f};
#pragma unroll 1
            for (int kc = 0; kc < EH / 64; ++kc) {
                __syncthreads();
#pragma unroll
                for (int i = 0; i < 8; ++i) { v2u wd; wd.x = pk2(pd[i].x, pd[i].y); wd.y = pk2(pd[i].z, pd[i].w); *(LAS v2u*)(F.lds + EX_BG + (dkk + 8 * i) * VSB + 8 * dn4) = wd; }
                __syncthreads();
                { int kn = kc + 1, npn = np; if (kn == EH / 64) { kn = 0; npn = np + 1; }
                  if (npn < 4) {
#pragma unroll
                    for (int i = 0; i < 8; ++i) pd[i] = *(const f32x4*)(Wd + (size_t)(64 * kn + dkk + 8 * i) * D + 256 * npn + 4 * dn4); } }
#pragma unroll
                for (int s = 0; s < 2; ++s) {
                    bf16x8 gf[4];
#pragma unroll
                    for (int rt = 0; rt < 4; ++rt) gf[rt] = ldfrag(Gimg, 64 * wr + 16 * rt + fr, VSB, 64 * kc + 32 * s + 8 * g);
                    bf16x8 b0, b1, b2, b3; tr_frag4<4 * VSB, 32>(bda + s * 32 * VSB, b0, b1, b2, b3);
#pragma unroll
                    for (int rt = 0; rt < 4; ++rt) { ac2[rt][0] = MFMA16(b0, gf[rt], ac2[rt][0]); ac2[rt][1] = MFMA16(b1, gf[rt], ac2[rt][1]); ac2[rt][2] = MFMA16(b2, gf[rt], ac2[rt][2]); ac2[rt][3] = MFMA16(b3, gf[rt], ac2[rt][3]); }
                }
            }
#pragma unroll
            for (int rt = 0; rt < 4; ++rt) { const int row = 64 * wr + 16 * rt + fr; const float rw = wl[row];
                if (r0 + row < cnt_e) { bf16* yp = YP + (size_t)(slot0 + row) * D + 256 * np + 64 * wc + 4 * g;
#pragma unroll
                    for (int ct = 0; ct < 4; ++ct) { const f32x4 o = ac2[rt][ct] * rw; v2u wv; wv.x = pk2(o[0], o[1]); wv.y = pk2(o[2], o[3]); *(v2u*)(yp + 16 * ct) = wv; } } }
        }
        __syncthreads();
    }
}

__device__ __forceinline__ void p12_final(Frame& F) {
    unsigned char* ws = F.ws; const float* X1 = (const float*)(ws + WS_X1); const bf16* YP = (const bf16*)(ws + WS_YP); const int* EIDX = (const int*)(ws + WS_EIDX); const int* POS = (const int*)(ws + WS_POS);
    const float* mod = (const float*)(ws + WS_MOD);
    LAS int* pref = (LAS int*)(F.lds + EX_PREF); LAS int* off = (LAS int*)(F.lds + EX_OFF);
    expert_prefix(F, pref, off);
    __syncthreads();
    const int gw = F.vcu * NWAVES + F.wave, NGW = F.G * NWAVES, lane = F.lane;
    f32x4 gn[4];
#pragma unroll
    for (int j = 0; j < 4; ++j) gn[j] = *(const f32x4*)(F.norm_final_g + 4 * lane + 256 * j);
    for (int t = gw; t < M; t += NGW) {
        const int b = t >> 13;
        f32x4 y[4];
#pragma unroll
        for (int j = 0; j < 4; ++j) y[j] = (f32x4){0.f, 0.f, 0.f, 0.f};
#if !MK_SKIP_ROUTED
        int myslot = 0;
        if (lane < 8) myslot = off[EIDX[t * 8 + lane]] + POS[t * 8 + lane];
#pragma unroll
        for (int k = 0; k < 8; ++k) { const int slot = __shfl(myslot, k); const v2u* yp = (const v2u*)(YP + (size_t)slot * D) + lane;
#pragma unroll
            for (int j = 0; j < 4; ++j) { const v2u v = yp[64 * j]; y[j] += (f32x4){bflo(v.x), bfhi(v.x), bflo(v.y), bfhi(v.y)}; } }
#endif
        const f32x4* xr = (const f32x4*)(X1 + (size_t)t * D) + lane; f32x4 v[4]; float ss = 0.f;
#pragma unroll
        for (int j = 0; j < 4; ++j) { const f32x4 g2 = *(const f32x4*)(mod + b * NMOD + 5 * D + 4 * lane + 256 * j); v[j] = xr[64 * j] + g2 * y[j];
            ss += (v[j].x * v[j].x + v[j].y * v[j].y) + (v[j].z * v[j].z + v[j].w * v[j].w); }
        const float rstd = 1.0f / sqrtf(wave_sum(ss) * (1.0f / D) + EPS);
        f32x4* op = (f32x4*)(F.out + (size_t)t * D) + lane;
#pragma unroll
        for (int j = 0; j < 4; ++j) op[64 * j] = v[j] * rstd * gn[j];
    }
}

struct Args { const void* in[22]; float* out; unsigned char* ws; int ph_lo, ph_hi, li, pad; };
__global__ void __launch_bounds__(NT, 2) mk_fwd(Args args) {
    extern __shared__ __attribute__((aligned(16))) unsigned char lds[];
    Frame F;
    F.lds = (LAS unsigned char*)lds; F.ldsb = (unsigned)(size_t)F.lds;
    F.MISC = (volatile LAS unsigned*)(F.lds + MISC_OFF);
    F.tid = threadIdx.x; F.lane = F.tid & 63; F.wave = __builtin_amdgcn_readfirstlane(F.tid >> 6);
    F.G = gridDim.x; { const int bx = blockIdx.x; F.vcu = (F.G % 8 == 0) ? (bx % 8) * (F.G / 8) + bx / 8 : bx; }
    unsigned char* ws = args.ws; F.ws = ws; F.ctl = (gu32*)(ws + WS_CTL); F.out = args.out;
    F.x = (const float*)args.in[0]; F.c = (const float*)args.in[1]; F.pos = (const int*)args.in[2]; F.w_ada = (const float*)args.in[3]; F.b_ada = (const float*)args.in[4];
    F.norm_mix_g = (const float*)args.in[5]; F.w_in = (const float*)args.in[6]; F.ret_norm_g = (const float*)args.in[7]; F.conv_w = (const float*)args.in[8];
    F.w_br_ret = (const float*)args.in[9]; F.w_br_conv = (const float*)args.in[10]; F.w_out = (const float*)args.in[11]; F.norm_ffn_g = (const float*)args.in[12];
    F.w_router = (const float*)args.in[13]; F.router_bias = (const float*)args.in[14]; F.w_eg = (const float*)args.in[15]; F.w_eu = (const float*)args.in[16]; F.w_ed = (const float*)args.in[17];
    F.w_sg = (const float*)args.in[18]; F.w_su = (const float*)args.in[19]; F.w_sd = (const float*)args.in[20]; F.norm_final_g = (const float*)args.in[21];
    for (int u = F.tid; u < (LDS_BYTES - LDSCTL_OFF) / 4; u += NT) ((LAS unsigned*)(F.lds + LDSCTL_OFF))[u] = 0u;
    __syncthreads();
    XcdBarrier bar; bar.bar = (unsigned*)(F.ctl + CW_BAR) + args.li * XCD_BAR_WORDS; bar.x = 0; bar.st = nullptr;
    if (!MK_PER_PHASE) bar = xcd_barrier_post((unsigned*)(F.ctl + CW_BAR) + args.li * XCD_BAR_WORDS, F.MISC + 8);
    const int lo = args.ph_lo, hi = args.ph_hi;
#ifndef MK_PHASE_MASK
#define MK_PHASE_MASK 0x1fff
#endif
#define IN(k) (((MK_PHASE_MASK >> (k)) & 1) && lo <= (k) && (k) < hi)
#define SEAM(k) do { if (IN(k) && IN((k) + 1)) xcd_barrier(bar); } while (0)
#ifndef MK_DOUBLE_MASK
#define MK_DOUBLE_MASK 0
#endif
#define REP(k) for (int rep_ = 0; rep_ < (((MK_DOUBLE_MASK >> (k)) & 1) ? 2 : 1); ++rep_, (((MK_DOUBLE_MASK >> (k)) & 1) && rep_ == 1 ? xcd_barrier(bar) : (void)0))
    bf16* HB = (bf16*)(ws + WS_HB); bf16* PROJ = (bf16*)(ws + WS_PROJ); const float* mod = (const float*)(ws + WS_MOD);

    if (IN(0)) { p0_prologue(F); } SEAM(0);
    if (IN(1)) { norm_mod_rows(F, F.x, F.norm_mix_g, 1 * D, 0 * D, HB); } SEAM(1);
    if (IN(2)) {
        pg8::Gemm g{HB, (const bf16*)(ws + WS_WIN), M, NIN, D}; pg8::StaticOrder S; S.init(M, NIN, F.G, (int)blockIdx.x);
        pg8::EpiBf16 E{PROJ, NIN};
        pg8::gemm_phase<pg8::EpiBf16, pg8::StaticOrder, true, true>(F.lds, g, S, E);
    } SEAM(2);
    if (IN(3)) { p3_kv_conv(F); } SEAM(3);
    if (IN(4)) { p4_scan(F); } SEAM(4);
    if (IN(5)) { p5_retention(F); } SEAM(5);
    if (IN(6)) {
        { pg8::Gemm g{(const bf16*)(ws + WS_RETG), (const bf16*)(ws + WS_WBR), M, D, D}; pg8::StaticOrder S; S.init(M, D, F.G, (int)blockIdx.x);
          pg8::EpiGateF32 E{(float*)(ws + WS_MIXP), D, PROJ + OFF_MR, NIN};
          pg8::gemm_phase<pg8::EpiGateF32, pg8::StaticOrder, true, true>(F.lds, g, S, E); }
        asm volatile("s_waitcnt vmcnt(0)" ::: "memory"); __syncthreads();
        { pg8::Gemm g{(const bf16*)(ws + WS_CONVG), (const bf16*)(ws + WS_WBC), M, D, D}; pg8::StaticOrder S; S.init(M, D, F.G, (int)blockIdx.x);
          pg8::EpiMixBf16 E{(bf16*)(ws + WS_MIX), D, (const float*)(ws + WS_MIXP), PROJ + OFF_MC, NIN};
          pg8::gemm_phase<pg8::EpiMixBf16, pg8::StaticOrder, true, true>(F.lds, g, S, E); }
    } SEAM(6);
    if (IN(7)) {
#if MK_SKIP_MIXER
        for (size_t i = (size_t)F.vcu * NT + F.tid; i < (size_t)M * D / 4; i += (size_t)F.G * NT) ((f32x4*)(ws + WS_X1))[i] = ((const f32x4*)F.x)[i];
#else
        pg8::Gemm g{(const bf16*)(ws + WS_MIX), (const bf16*)(ws + WS_WO), M, D, D}; pg8::StaticOrder S; S.init(M, D, F.G, (int)blockIdx.x);
        pg8::EpiResid E{(float*)(ws + WS_X1), F.x, D, mod + 2 * D, NMOD, 13};
        pg8::gemm_phase<pg8::EpiResid, pg8::StaticOrder, true, true>(F.lds, g, S, E);
#endif
    } SEAM(7);
    if (IN(8)) { norm_mod_rows(F, (const float*)(ws + WS_X1), F.norm_ffn_g, 4 * D, 3 * D, HB); } SEAM(8);
    if (IN(9)) {
        { pg8::Gemm g{HB, (const bf16*)(ws + WS_WR), M, NE, D}; pg8::StaticOrder S; S.init(M, NE, F.G, (int)blockIdx.x);
          pg8::EpiF32 E{(float*)(ws + WS_LOGITS), NE};
          pg8::gemm_phase<pg8::EpiF32, pg8::StaticOrder, true, true>(F.lds, g, S, E); }
        { pg8::Gemm g{HB, (const bf16*)(ws + WS_WSGU), M, 2 * EH, D}; pg8::StaticOrder S; S.init(M, 2 * EH, F.G, (int)((blockIdx.x + F.G / 2) % F.G));
          pg8::EpiSwiglu E{(bf16*)(ws + WS_SHG), EH};
          pg8::gemm_phase<pg8::EpiSwiglu, pg8::StaticOrder, true, true>(F.lds, g, S, E); }
    } SEAM(9);
    if (IN(10)) {
#if !MK_SKIP_SHARED
        { pg8::Gemm g{(const bf16*)(ws + WS_SHG), (const bf16*)(ws + WS_WSD), M, D, EH}; pg8::StaticOrder S; S.init(M, D, F.G, (int)blockIdx.x);
          pg8::EpiResid E{(float*)(ws + WS_X1), (const float*)(ws + WS_X1), D, mod + 5 * D, NMOD, 13};
          pg8::gemm_phase<pg8::EpiResid, pg8::StaticOrder, true, true>(F.lds, g, S, E); }
#endif
        route_tokens(F);
    } SEAM(10);
    if (IN(11)) {
#if !MK_SKIP_ROUTED
        p11_experts(F);
#endif
    } SEAM(11);
    if (IN(12)) { p12_final(F); }
#undef IN
#undef SEAM
}

extern "C" void kernel_launch(void* const* d_in, const int* in_sizes, int n_in, void* d_out, int out_size, void* d_ws, size_t ws_size, hipStream_t stream) {
    static int grid = 0;
    if (grid == 0) {
        if (n_in != 22 || in_sizes[0] != M * D || out_size != M * D || ws_size < WS_END) { fprintf(stderr, "kernel_launch: unexpected shapes (n_in %d, in0 %d, out %d, ws %zu, need %zu); nothing launched\n", n_in, n_in > 0 ? in_sizes[0] : -1, out_size, ws_size, (size_t)WS_END); grid = -1; return; }
        int dev = 0, cus = 0, per_cu = 0;
        if (hipGetDevice(&dev) != hipSuccess || hipDeviceGetAttribute(&cus, hipDeviceAttributeMultiprocessorCount, dev) != hipSuccess) { fprintf(stderr, "kernel_launch: device query failed\n"); grid = -1; return; }
        if (hipFuncSetAttribute((const void*)mk_fwd, hipFuncAttributeMaxDynamicSharedMemorySize, LDS_BYTES) != hipSuccess) { fprintf(stderr, "kernel_launch: hipFuncSetAttribute failed\n"); grid = -1; return; }
        if (hipOccupancyMaxActiveBlocksPerMultiprocessor(&per_cu, (const void*)mk_fwd, NT, LDS_BYTES) != hipSuccess || per_cu < 1) { fprintf(stderr, "kernel_launch: occupancy query reports %d workgroups per CU\n", per_cu); (void)hipGetLastError(); grid = -1; return; }
        grid = cus;
    }
    if (grid < 0) return;
    if (hipMemsetAsync((char*)d_ws + WS_CTL, 0, CTL_ZERO_BYTES, stream) != hipSuccess) { fprintf(stderr, "kernel_launch: hipMemsetAsync failed\n"); return; }
    Args a{};
    for (int i = 0; i < 22; ++i) a.in[i] = d_in[i];
    a.out = (float*)d_out; a.ws = (unsigned char*)d_ws;
#if MK_PER_PHASE
    for (int p = 0; p < NPHASE; ++p) { a.ph_lo = p; a.ph_hi = p + 1; hipLaunchKernelGGL(mk_fwd, dim3(grid), dim3(NT), LDS_BYTES, stream, a); }
#elif defined(MK_PROBE_LO)
    a.ph_lo = 0; a.ph_hi = MK_PROBE_HI; a.li = 0; hipLaunchKernelGGL(mk_fwd, dim3(grid), dim3(NT), LDS_BYTES, stream, a);
    a.ph_lo = MK_PROBE_LO; a.ph_hi = NPHASE; a.li = 1; hipLaunchKernelGGL(mk_fwd, dim3(grid), dim3(NT), LDS_BYTES, stream, a);
#else
    a.ph_lo = 0; a.ph_hi = NPHASE;
    hipLaunchKernelGGL(mk_fwd, dim3(grid), dim3(NT), LDS_BYTES, stream, a);
#endif
    const hipError_t le = hipPeekAtLastError();
    if (le != hipSuccess) fprintf(stderr, "kernel_launch: launch failed: %s\n", hipGetErrorName(le));
}
```

```cpp
#include <hip/hip_runtime.h>
#include <cstdio>
#include <cstdint>
#define MK_EXP_V 2
namespace pg8 {
#define PG8_LAS __attribute__((address_space(3)))
typedef unsigned short bf16_t;
typedef short bf16x8 __attribute__((ext_vector_type(8)));
typedef float f32x4 __attribute__((ext_vector_type(4)));
typedef unsigned u32x4 __attribute__((ext_vector_type(4)));
constexpr int BM = 256, BK = 64, HALF = 128, HTB = HALF * BK * 2  , STAGE_BYTES = 8 * HTB, NXCD = 8, WGM = 8;

__host__ __device__ __forceinline__ int lds_byte(int r, int c) { const int st = (r >> 4) * 2 + (c >> 5), rr = r & 15, cc = c & 31, ob = rr * 64 + cc * 2; return st * 1024 + (ob ^ (((ob >> 9) & 1) << 5)); }
__host__ __device__ __forceinline__ void stage_rc(int b, int& R, int& C) { const int st = b / 1024, sb = b % 1024, swz = sb ^ (((sb >> 9) & 1) << 5); R = (st >> 1) * 16 + swz / 64; C = (st & 1) * 32 + (swz % 64) / 2; }
__host__ __device__ __forceinline__ int perm32(int rho) { const int n = rho >> 4, i = rho & 15; return 8 * (i >> 2) + 4 * n + (i & 3); }

struct Unit { int pm, pn; };
struct Gemm { const bf16_t* A; const bf16_t* Bt; int M, N, K; };

struct StaticOrder {
    int nM, nN, nwg, G, c;
    __host__ __device__ void init(int M, int N, int G_, int c_) { nM = M / BM; nN = N / BM; nwg = nM * nN; G = G_; c = c_; }
    __host__ __device__ bool next(int i, Unit& u) const {
        const long L = (long)i * G + c; if (L >= nwg) return false;
        int wgid = (int)L; { const int q = nwg / NXCD, r = nwg % NXCD, xcd = wgid % NXCD, off = wgid / NXCD; wgid = (xcd < r ? xcd * (q + 1) : r * (q + 1) + (xcd - r) * q) + off; }
        const int nig = WGM * nN, gid = wgid / nig, fm = gid * WGM, gsz = (nM - fm) < WGM ? (nM - fm) : WGM;
        u.pm = fm + ((wgid % nig) % gsz); u.pn = (wgid % nig) / gsz; return true;
    }
    __device__ __forceinline__ void a_ready(const Unit&) const {}
    __device__ __forceinline__ void done(const Unit&) const {}
};

__device__ __forceinline__ unsigned cvt_pk_bf16(float lo, float hi) { unsigned r; asm volatile("v_cvt_pk_bf16_f32 %0, %1, %2" : "=v"(r) : "v"(lo), "v"(hi)); return r; }
typedef float f32x2 __attribute__((ext_vector_type(2)));
typedef unsigned u32x2 __attribute__((ext_vector_type(2)));
__device__ __forceinline__ float bf_lo(unsigned w) { return __uint_as_float(w << 16); }
__device__ __forceinline__ float bf_hi(unsigned w) { return __uint_as_float(w & 0xffff0000u); }
__device__ __forceinline__ float sigm(float x) { return 1.0f / (1.0f + __expf(-x)); }
__device__ __forceinline__ float silu_f(float x) { return x / (1.0f + __expf(-x)); }

struct EpiBf16 {
    static constexpr bool PERM = true, AFTER_DRAIN = false;
    bf16_t* O; int ldc;
    __device__ __forceinline__ void operator()(const f32x4 (&acc)[2][2][4][2], const Unit& u, int wr, int wc, int fr, int fq) const {
        const int row0 = u.pm * BM + wr * 64 + fr; const int col0 = u.pn * BM + wc * 32 + 8 * fq;
#pragma unroll
        for (int ai = 0; ai < 2; ++ai)
#pragma unroll
            for (int m = 0; m < 4; ++m) { bf16_t* rowp = O + (size_t)(row0 + ai * HALF + m * 16) * ldc + col0;
#pragma unroll
                for (int bj = 0; bj < 2; ++bj) { const f32x4 v0 = acc[ai][bj][m][0], v1 = acc[ai][bj][m][1];
                    u32x4 w; w.x = cvt_pk_bf16(v0[0], v0[1]); w.y = cvt_pk_bf16(v0[2], v0[3]); w.z = cvt_pk_bf16(v1[0], v1[1]); w.w = cvt_pk_bf16(v1[2], v1[3]);
                    *(u32x4*)(rowp + bj * HALF) = w; } }
    }
};
struct EpiF32 {
    static constexpr bool PERM = false, AFTER_DRAIN = false;
    float* C; int ldc;
    __device__ __forceinline__ void operator()(const f32x4 (&acc)[2][2][4][2], const Unit& u, int wr, int wc, int fr, int fq) const {
        const int row0 = u.pm * BM + wr * 64 + fr, col0 = u.pn * BM + wc * 32 + 4 * fq;
#pragma unroll
        for (int ai = 0; ai < 2; ++ai)
#pragma unroll
            for (int m = 0; m < 4; ++m) { float* rowp = C + (size_t)(row0 + ai * HALF + m * 16) * ldc + col0;
#pragma unroll
                for (int bj = 0; bj < 2; ++bj)
#pragma unroll
                    for (int n = 0; n < 2; ++n) *(f32x4*)(rowp + bj * HALF + n * 16) = acc[ai][bj][m][n]; }
    }
};
struct EpiGateF32 {
    static constexpr bool PERM = false, AFTER_DRAIN = false;
    float* C; int ldc; const bf16_t* gate; int ldg;
    __device__ __forceinline__ void operator()(const f32x4 (&acc)[2][2][4][2], const Unit& u, int wr, int wc, int fr, int fq) const {
        const int row0 = u.pm * BM + wr * 64 + fr, col0 = u.pn * BM + wc * 32 + 4 * fq;
#pragma unroll
        for (int ai = 0; ai < 2; ++ai)
#pragma unroll
            for (int m = 0; m < 4; ++m) { const size_t r = (size_t)(row0 + ai * HALF + m * 16); float* rowp = C + r * ldc + col0; const bf16_t* gp = gate + r * ldg + col0;
#pragma unroll
                for (int bj = 0; bj < 2; ++bj)
#pragma unroll
                    for (int n = 0; n < 2; ++n) { const u32x2 g = *(const u32x2*)(gp + bj * HALF + n * 16); const f32x4 a = acc[ai][bj][m][n];
                        f32x4 o; o[0] = sigm(bf_lo(g.x)) * a[0]; o[1] = sigm(bf_hi(g.x)) * a[1]; o[2] = sigm(bf_lo(g.y)) * a[2]; o[3] = sigm(bf_hi(g.y)) * a[3];
                        *(f32x4*)(rowp + bj * HALF + n * 16) = o; } }
    }
};
struct EpiMixBf16 {
    static constexpr bool PERM = true, AFTER_DRAIN = false;
    bf16_t* O; int ldc; const float* P; const bf16_t* gate; int ldg;
    __device__ __forceinline__ void operator()(const f32x4 (&acc)[2][2][4][2], const Unit& u, int wr, int wc, int fr, int fq) const {
        const int row0 = u.pm * BM + wr * 64 + fr; const int col0 = u.pn * BM + wc * 32 + 8 * fq;
#pragma unroll
        for (int ai = 0; ai < 2; ++ai)
#pragma unroll
            for (int m = 0; m < 4; ++m) { const size_t r = (size_t)(row0 + ai * HALF + m * 16); bf16_t* rowp = O + r * ldc + col0; const float* pp = P + r * ldc + col0; const bf16_t* gp = gate + r * ldg + col0;
#pragma unroll
                for (int bj = 0; bj < 2; ++bj) { const f32x4 v0 = acc[ai][bj][m][0], v1 = acc[ai][bj][m][1];
                    const u32x4 g = *(const u32x4*)(gp + bj * HALF); const f32x4 p0 = *(const f32x4*)(pp + bj * HALF), p1 = *(const f32x4*)(pp + bj * HALF + 4);
                    const float o0 = p0[0] + sigm(bf_lo(g.x)) * v0[0], o1 = p0[1] + sigm(bf_hi(g.x)) * v0[1], o2 = p0[2] + sigm(bf_lo(g.y)) * v0[2], o3 = p0[3] + sigm(bf_hi(g.y)) * v0[3];
                    const float o4 = p1[0] + sigm(bf_lo(g.z)) * v1[0], o5 = p1[1] + sigm(bf_hi(g.z)) * v1[1], o6 = p1[2] + sigm(bf_lo(g.w)) * v1[2], o7 = p1[3] + sigm(bf_hi(g.w)) * v1[3];
                    u32x4 w; w.x = cvt_pk_bf16(o0, o1); w.y = cvt_pk_bf16(o2, o3); w.z = cvt_pk_bf16(o4, o5); w.w = cvt_pk_bf16(o6, o7);
                    *(u32x4*)(rowp + bj * HALF) = w; } }
    }
};
struct EpiResid {
    static constexpr bool PERM = false, AFTER_DRAIN = false;
    float* C; const float* base; int ldc; const float* gvec; int gstride; int rows_per_b_shift;
    __device__ __forceinline__ void operator()(const f32x4 (&acc)[2][2][4][2], const Unit& u, int wr, int wc, int fr, int fq) const {
        const int row0 = u.pm * BM + wr * 64 + fr, col0 = u.pn * BM + wc * 32 + 4 * fq;
        const float* gp = gvec + (size_t)((u.pm * BM) >> rows_per_b_shift) * gstride + col0;
        f32x4 gv[2][2];
#pragma unroll
        for (int bj = 0; bj < 2; ++bj)
#pragma unroll
            for (int n = 0; n < 2; ++n) gv[bj][n] = *(const f32x4*)(gp + bj * HALF + n * 16);
#pragma unroll
        for (int ai = 0; ai < 2; ++ai)
#pragma unroll
            for (int m = 0; m < 4; ++m) { const size_t off = (size_t)(row0 + ai * HALF + m * 16) * ldc + col0;
#pragma unroll
                for (int bj = 0; bj < 2; ++bj)
#pragma unroll
                    for (int n = 0; n < 2; ++n) { const f32x4 b = *(const f32x4*)(base + off + bj * HALF + n * 16);
                        *(f32x4*)(C + off + bj * HALF + n * 16) = b + gv[bj][n] * acc[ai][bj][m][n]; } }
    }
};
struct EpiSwiglu {
    static constexpr bool PERM = true, AFTER_DRAIN = false;
    bf16_t* O; int ldo;
    __device__ __forceinline__ void operator()(const f32x4 (&acc)[2][2][4][2], const Unit& u, int wr, int wc, int fr, int fq) const {
        const int row0 = u.pm * BM + wr * 64 + fr; const int col0 = u.pn * BM + wc * 32 + 8 * fq;
#pragma unroll
        for (int ai = 0; ai < 2; ++ai)
#pragma unroll
            for (int m = 0; m < 4; ++m) { bf16_t* rowp = O + (size_t)(row0 + ai * HALF + m * 16) * ldo + (col0 >> 1);
#pragma unroll
                for (int bj = 0; bj < 2; ++bj) { const f32x4 v0 = acc[ai][bj][m][0], v1 = acc[ai][bj][m][1];
                    const float g0 = silu_f(v0[0]) * v0[1], g1 = silu_f(v0[2]) * v0[3], g2 = silu_f(v1[0]) * v1[1], g3 = silu_f(v1[2]) * v1[3];
                    u32x2 w; w.x = cvt_pk_bf16(g0, g1); w.y = cvt_pk_bf16(g2, g3);
                    *(u32x2*)(rowp + bj * (HALF / 2)) = w; } }
    }
};
template <class Epi, class Sched, bool ALIGN_EPI = false, bool SP2 = false>
__device__ __forceinline__ void gemm_phase(PG8_LAS unsigned char* lds, const Gemm g, const Sched& S, const Epi& E) {
    const int tid = threadIdx.x, wid = __builtin_amdgcn_readfirstlane(tid >> 6), lane = tid & 63, wr = wid >> 2, wc = wid & 3, fr = lane & 15, fq = lane >> 4;
    const int K = g.K, nt = K / BK;
    unsigned voffA[2], voffB[2];
#pragma unroll
    for (int i = 0; i < 2; ++i) { int R, C; stage_rc(tid * 16 + i * 8192, R, C); const int Rb = Epi::PERM ? ((R & ~31) + perm32(R & 31)) : R;
        voffA[i] = (unsigned)(R * K + C) * 2u; voffB[i] = (unsigned)(Rb * K + C) * 2u; }
    const size_t kstep = (size_t)(BK * 2);
    const size_t hstep = (size_t)HALF * K * 2;
    const size_t tstep = 2 * hstep;
    const unsigned ldsw = (unsigned)wid * 1024u;
    const int aoff = lds_byte(wr * 64 + fr, fq * 8), boff = lds_byte(wc * 32 + fr, fq * 8);
#define PG8_SA(b, h) (((b) * 2 + (h)) * HTB)
#define PG8_SB(b, h) ((4 + (b) * 2 + (h)) * HTB)
#define PG8_STAGE(bufoff, gbase, voff) do { _Pragma("unroll") for (int _i = 0; _i < 2; ++_i) \
        __builtin_amdgcn_global_load_lds((const unsigned*)((const char*)(gbase) + (voff)[_i]), (PG8_LAS unsigned*)(lds + (bufoff) + ldsw + _i * 8192), 16, 0, 0); } while (0)
#define PG8_LDA(dst, b, h) do { _Pragma("unroll") for (int m = 0; m < 4; ++m) _Pragma("unroll") for (int k = 0; k < 2; ++k) dst[m][k] = *(const PG8_LAS bf16x8*)(lds + PG8_SA(b, h) + aoff + m * 2048 + k * 1024); } while (0)
#define PG8_LDB(dst, b, h) do { _Pragma("unroll") for (int n = 0; n < 2; ++n) _Pragma("unroll") for (int k = 0; k < 2; ++k) dst[n][k] = *(const PG8_LAS bf16x8*)(lds + PG8_SB(b, h) + boff + n * 2048 + k * 1024); } while (0)
#define PG8_MMA(ai, bj, At, Bt) do { __builtin_amdgcn_s_setprio(1); _Pragma("unroll") for (int m = 0; m < 4; ++m) _Pragma("unroll") for (int n = 0; n < 2; ++n) _Pragma("unroll") for (int k = 0; k < 2; ++k) \
        acc[ai][bj][m][n] = __builtin_amdgcn_mfma_f32_16x16x32_bf16(Bt[n][k], At[m][k], acc[ai][bj][m][n], 0, 0, 0); __builtin_amdgcn_s_setprio(0); } while (0)
#define PG8_WAIT_V(n) asm volatile("s_waitcnt vmcnt(" #n ")" ::: "memory")
#define PG8_WAIT_L(n) asm volatile("s_waitcnt lgkmcnt(" #n ")" ::: "memory")
#define PG8_BAR __builtin_amdgcn_s_barrier()
#define PG8_SCHED __builtin_amdgcn_sched_barrier(0)
    Unit cur, nxt; int ui = 0;
    if (!S.next(0, cur)) return;
    f32x4 acc[2][2][4][2];
#pragma unroll
    for (int a = 0; a < 2; ++a)
#pragma unroll
        for (int b = 0; b < 2; ++b)
#pragma unroll
            for (int m = 0; m < 4; ++m)
#pragma unroll
                for (int n = 0; n < 2; ++n) acc[a][b][m][n] = (f32x4){0.f, 0.f, 0.f, 0.f};
    bf16x8 At[4][2], B0[2][2], B1[2][2];
    const char* cA = (const char*)g.A + (size_t)cur.pm * tstep; const char* cB = (const char*)g.Bt + (size_t)cur.pn * tstep;
    S.a_ready(cur);
    if constexpr (SP2) {
        PG8_STAGE(PG8_SB(0, 0), cB, voffB); PG8_STAGE(PG8_SB(0, 1), cB + hstep, voffB); PG8_STAGE(PG8_SA(0, 0), cA, voffA); PG8_STAGE(PG8_SA(0, 1), cA + hstep, voffA);
        if (wr == 1) PG8_BAR;
        PG8_WAIT_V(2); PG8_BAR;
        PG8_STAGE(PG8_SB(1, 0), cB + kstep, voffB); PG8_STAGE(PG8_SA(1, 0), cA + kstep, voffA); PG8_STAGE(PG8_SB(1, 1), cB + hstep + kstep, voffB);
        PG8_WAIT_V(6); PG8_BAR;
    } else {
        PG8_STAGE(PG8_SB(0, 0), cB, voffB); PG8_STAGE(PG8_SA(0, 0), cA, voffA); PG8_STAGE(PG8_SB(0, 1), cB + hstep, voffB); PG8_STAGE(PG8_SA(0, 1), cA + hstep, voffA);
        if (wr == 1) PG8_BAR;
        PG8_WAIT_V(4); PG8_BAR;
        PG8_STAGE(PG8_SB(1, 0), cB + kstep, voffB); PG8_STAGE(PG8_SA(1, 0), cA + kstep, voffA); PG8_STAGE(PG8_SB(1, 1), cB + hstep + kstep, voffB);
        PG8_WAIT_V(6); PG8_BAR;
    }
    for (;;) {
        const bool has_next = S.next(ui + 1, nxt);
        const char* nA = has_next ? (const char*)g.A + (size_t)nxt.pm * tstep : cA; const char* nB = has_next ? (const char*)g.Bt + (size_t)nxt.pn * tstep : cB;
        for (int t = 0; t < nt; t += 2) {
            const bool last = (t == nt - 2);
            const char* a1 = cA + (size_t)(t + 1) * kstep;
            const char* a2 = last ? nA : cA + (size_t)(t + 2) * kstep; const char* b2 = last ? nB : cB + (size_t)(t + 2) * kstep;
            const char* a3 = a2 + kstep; const char* b3 = b2 + kstep;
            if (last && has_next) S.a_ready(nxt);
            if constexpr (SP2) {
            PG8_LDB(B0, 0, 0); PG8_LDB(B1, 0, 1); PG8_SCHED; PG8_LDA(At, 0, 0); PG8_STAGE(PG8_SA(1, 1), a1 + hstep, voffA);
            PG8_WAIT_V(8); PG8_WAIT_L(0); PG8_BAR; PG8_MMA(0, 0, At, B0); PG8_MMA(0, 1, At, B1); PG8_BAR; PG8_SCHED;
            PG8_LDA(At, 0, 1); PG8_STAGE(PG8_SB(0, 0), b2, voffB); PG8_STAGE(PG8_SB(0, 1), b2 + hstep, voffB); PG8_STAGE(PG8_SA(0, 0), a2, voffA);
            PG8_WAIT_V(8); PG8_WAIT_L(0); PG8_BAR; PG8_MMA(1, 0, At, B0); PG8_MMA(1, 1, At, B1); PG8_BAR; PG8_SCHED;
            PG8_LDB(B0, 1, 0); PG8_LDB(B1, 1, 1); PG8_SCHED; PG8_LDA(At, 1, 0); PG8_STAGE(PG8_SA(0, 1), a2 + hstep, voffA);
            PG8_WAIT_V(8); PG8_WAIT_L(0); PG8_BAR; PG8_MMA(0, 0, At, B0); PG8_MMA(0, 1, At, B1); PG8_BAR; PG8_SCHED;
            PG8_LDA(At, 1, 1); PG8_STAGE(PG8_SB(1, 0), b3, voffB); PG8_STAGE(PG8_SB(1, 1), b3 + hstep, voffB); PG8_STAGE(PG8_SA(1, 0), a3, voffA);
            PG8_WAIT_V(8); PG8_WAIT_L(0); PG8_BAR; PG8_MMA(1, 0, At, B0); PG8_MMA(1, 1, At, B1); PG8_BAR; PG8_SCHED;
            } else {
            PG8_LDB(B0, 0, 0); PG8_SCHED; PG8_LDA(At, 0, 0); PG8_STAGE(PG8_SA(1, 1), a1 + hstep, voffA);
            PG8_WAIT_L(8); PG8_BAR; PG8_WAIT_L(0); PG8_MMA(0, 0, At, B0); PG8_BAR; PG8_SCHED;
            PG8_LDB(B1, 0, 1); PG8_STAGE(PG8_SB(0, 0), b2, voffB);
            PG8_BAR; PG8_WAIT_L(0); PG8_MMA(0, 1, At, B1); PG8_BAR;
            PG8_LDA(At, 0, 1); PG8_STAGE(PG8_SA(0, 0), a2, voffA);
            PG8_BAR; PG8_WAIT_L(0); PG8_MMA(1, 0, At, B0); PG8_BAR; PG8_SCHED;
            PG8_STAGE(PG8_SB(0, 1), b2 + hstep, voffB);
            PG8_WAIT_V(6); PG8_BAR; PG8_MMA(1, 1, At, B1); PG8_BAR;
            PG8_LDB(B0, 1, 0); PG8_SCHED; PG8_LDA(At, 1, 0); PG8_STAGE(PG8_SA(0, 1), a2 + hstep, voffA);
            PG8_WAIT_L(8); PG8_BAR; PG8_WAIT_L(0); PG8_MMA(0, 0, At, B0); PG8_BAR; PG8_SCHED;
            PG8_LDB(B1, 1, 1); PG8_STAGE(PG8_SB(1, 0), b3, voffB);
            PG8_BAR; PG8_WAIT_L(0); PG8_MMA(0, 1, At, B1); PG8_BAR;
            PG8_LDA(At, 1, 1); PG8_STAGE(PG8_SA(1, 0), a3, voffA);
            PG8_BAR; PG8_WAIT_L(0); PG8_MMA(1, 0, At, B0); PG8_BAR; PG8_SCHED;
            PG8_STAGE(PG8_SB(1, 1), b3 + hstep, voffB);
            PG8_WAIT_V(6); PG8_BAR; PG8_MMA(1, 1, At, B1); PG8_BAR;
            }
        }
        if constexpr (ALIGN_EPI) { if (wr == 0) PG8_BAR; }
        if constexpr (!Epi::AFTER_DRAIN) { E(acc, cur, wr, wc, fr, fq); S.done(cur); }
        if (!has_next) break;
#pragma unroll
        for (int a = 0; a < 2; ++a)
#pragma unroll
            for (int b = 0; b < 2; ++b)
#pragma unroll
                for (int m = 0; m < 4; ++m)
#pragma unroll
                    for (int n = 0; n < 2; ++n) acc[a][b][m][n] = (f32x4){0.f, 0.f, 0.f, 0.f};
        cur = nxt; cA = nA; cB = nB; ++ui;
        if constexpr (ALIGN_EPI) { if (wr == 1) PG8_BAR; }
    }
    PG8_WAIT_V(0);
    if constexpr (!ALIGN_EPI) { if (wr == 0) PG8_BAR; }
    PG8_BAR;
    if constexpr (Epi::AFTER_DRAIN) { E.fused(acc, cur, wr, wc, fr, fq, lds, wid, lane); S.done(cur); }
#undef PG8_SA
#undef PG8_SB
#undef PG8_STAGE
#undef PG8_LDA
#undef PG8_LDB
#undef PG8_MMA
#undef PG8_WAIT_V
#undef PG8_WAIT_L
#undef PG8_BAR
#undef PG8_SCHED
}
}

constexpr int NWAVES = 8, NT = 512;
#ifndef MK_PER_PHASE
#define MK_PER_PHASE 0
#endif
#ifndef MK_EXP_V
#define MK_EXP_V 1
#endif
#ifndef MK_TIMER_PHASE
#define MK_TIMER_PHASE -1
#endif
#ifndef MK_ABL_RT
#define MK_ABL_RT 0
#endif
#ifndef MK_P10_GEMM_REP
#define MK_P10_GEMM_REP 1
#endif
#ifndef MK_SKIP_MIXER
#define MK_SKIP_MIXER 0
#endif
#ifndef MK_SKIP_SHARED
#define MK_SKIP_SHARED 0
#endif
#ifndef MK_SKIP_ROUTED
#define MK_SKIP_ROUTED 0
#endif
constexpr int NPHASE = 13;
constexpr int BATCH = 2, SEQ = 8192, D = 1024, M = BATCH * SEQ, NIN = 8192, NMOD = 6144;
constexpr int OFF_Q = 0, OFF_K = 512, OFF_V = 1024, OFF_GR = 2048, OFF_U = 3072, OFF_GC = 4096, OFF_GB = 5120, OFF_MR = 6144, OFF_MC = 7168;
constexpr int NE = 256, TOPK = 8, EH = 256, CAP = 16384, NCH = 64, CH = 128, NH = 4, DK = 128, DV = 256;
constexpr float EPS = 1e-6f;

constexpr size_t MiB = (size_t)1 << 20;
constexpr size_t WS_CTL = 0, CTL_ZERO_BYTES = 1 * MiB;
constexpr size_t WS_MOD = 1 * MiB;
constexpr size_t WS_ROPE = 2 * MiB;
constexpr size_t WS_WR = 10 * MiB;
constexpr size_t WS_WSGU = 11 * MiB;
constexpr size_t WS_WSD = 12 * MiB;
constexpr size_t WS_WBR = 13 * MiB, WS_WBC = 15 * MiB, WS_WO = 17 * MiB;
constexpr size_t WS_WIN = 20 * MiB;
constexpr size_t WS_HB = 36 * MiB;
constexpr size_t WS_PROJ = 68 * MiB;
constexpr size_t WS_KV = 324 * MiB;
constexpr size_t WS_SP = 388 * MiB;
constexpr size_t WS_RETG = 420 * MiB;
constexpr size_t WS_CONVG = 452 * MiB;
constexpr size_t WS_MIXP = 484 * MiB;
constexpr size_t WS_MIX = 548 * MiB;
constexpr size_t WS_X1 = 580 * MiB;
constexpr size_t WS_LOGITS = 644 * MiB;
constexpr size_t WS_SHG = 660 * MiB;
constexpr size_t WS_EIDX = 668 * MiB, WS_POS = 669 * MiB;
constexpr size_t WS_LTOK = 670 * MiB, WS_LW = 686 * MiB;
constexpr size_t WS_YP = 702 * MiB;
constexpr size_t WS_END = 958 * MiB;
constexpr int CW_TMO = 0, CW_CODE = 1, CW_BAR = 4096, CW_CNT = 16384;

constexpr int LDSCTL_OFF = 143360, MISC_OFF = LDSCTL_OFF + 320, LDS_BYTES = 147456;

#define GAS __attribute__((address_space(1)))
#define LAS __attribute__((address_space(3)))
typedef unsigned short bf16;
typedef unsigned v4u __attribute__((ext_vector_type(4)));
typedef unsigned v2u __attribute__((ext_vector_type(2)));
typedef float f32x4 __attribute__((ext_vector_type(4)));
typedef float f32x2 __attribute__((ext_vector_type(2)));
typedef short bf16x8 __attribute__((ext_vector_type(8)));
typedef short s16x4 __attribute__((ext_vector_type(4)));
typedef GAS unsigned gu32;
#define RLX_AGENT __ATOMIC_RELAXED, __HIP_MEMORY_SCOPE_AGENT
__device__ __forceinline__ unsigned f2bf(float f) { unsigned u = __builtin_bit_cast(unsigned, f); return (u + 0x7fffu + ((u >> 16) & 1u)) >> 16; }
__device__ __forceinline__ unsigned pk2(float lo, float hi) { unsigned r; asm volatile("v_cvt_pk_bf16_f32 %0, %1, %2" : "=v"(r) : "v"(lo), "v"(hi)); return r; }
__device__ __forceinline__ float bflo(unsigned w) { return __uint_as_float(w << 16); }
__device__ __forceinline__ float bfhi(unsigned w) { return __uint_as_float(w & 0xffff0000u); }
__device__ __forceinline__ float sigmoidf_(float x) { return 1.0f / (1.0f + __expf(-x)); }
__device__ __forceinline__ float siluf_(float x) { return x / (1.0f + __expf(-x)); }

#define XB_TMO      128
#define XB_XCNT(j)  (256  + 64 * (j))
#define XB_XSUB(j)  (1280 + 64 * (j))
#define XB_XGEN(j)  (2304 + 64 * (j))
#define XB_TOP      3328
#define XB_TOPGEN   3392
#define XCD_BAR_WORDS 3456
#define XB_SPIN_CAP (1u << 18)

__device__ __forceinline__ unsigned xb_ld(unsigned* p)              { return __hip_atomic_load(p, __ATOMIC_RELAXED, __HIP_MEMORY_SCOPE_AGENT); }
__device__ __forceinline__ unsigned xb_add(unsigned* p, unsigned v) { return __hip_atomic_fetch_add(p, v, __ATOMIC_RELAXED, __HIP_MEMORY_SCOPE_AGENT); }
__device__ __forceinline__ unsigned xb_xcc_id() { return (unsigned)__builtin_amdgcn_s_getreg((3 << 11) | 20) & 0xFu; }
#define XB_SPIN(cond, bar) do { unsigned _sp = 0; while (cond) { __builtin_amdgcn_s_sleep(1); \
    if ((++_sp & 255u) == 0u) { if (xb_ld(&(bar)[XB_TMO])) break; if (_sp > XB_SPIN_CAP) { atomicAdd(&(bar)[XB_TMO], 1u); break; } } } } while (0)

struct XcdBarrier {
    unsigned* bar; unsigned x;
    volatile LAS unsigned* st;
};

__device__ __forceinline__ XcdBarrier xcd_barrier_post(unsigned* bar, volatile LAS unsigned* st) {
    XcdBarrier b; b.bar = bar; b.x = xb_xcc_id(); b.st = st;
    if (threadIdx.x == 0) (void)xb_add(&bar[XB_XCNT(b.x)], 1u);
    return b;
}
__device__ __forceinline__ void xcd_barrier_complete(unsigned* bar, unsigned x, unsigned& nloc, unsigned& nx) {
    const unsigned G = gridDim.x * gridDim.y * gridDim.z;
    unsigned sum, cnt, mine, sp = 0u;
    for (;;) {
        sum = 0u; cnt = 0u; mine = 0u;
#pragma unroll
        for (unsigned j = 0; j < 16; ++j) { const unsigned c = xb_ld(&bar[XB_XCNT(j)]); sum += c; cnt += (c > 0u) ? 1u : 0u; mine = (j == x) ? c : mine; }
        if (sum == G) break;
        __builtin_amdgcn_s_sleep(1);
        if ((++sp & 255u) == 0u) { if (xb_ld(&bar[XB_TMO])) break; if (sp > XB_SPIN_CAP) { atomicAdd(&bar[XB_TMO], 1u); break; } }
    }
    nloc = mine > 0u ? mine : 1u; nx = cnt > 0u ? cnt : 1u;
}

__device__ __forceinline__ void xcd_barrier(const XcdBarrier& b) {
    asm volatile("s_waitcnt vmcnt(0)" ::: "memory");
    __syncthreads();
    if (threadIdx.x == 0) {
        unsigned* bar = b.bar;
        __builtin_amdgcn_s_waitcnt(0);
        unsigned nloc = b.st[0], nx = b.st[1];
        if (nloc == 0u) { xcd_barrier_complete(bar, b.x, nloc, nx); b.st[0] = nloc; b.st[1] = nx; }
        const unsigned old = xb_add(&bar[XB_XSUB(b.x)], 1u);
        const unsigned gen = old / nloc;
        if (old + 1u == (gen + 1u) * nloc) {
            __builtin_amdgcn_fence(__ATOMIC_RELEASE, "agent");
            asm volatile("s_waitcnt vmcnt(0)" ::: "memory");
            const unsigned og = xb_add(&bar[XB_TOP], 1u);
            const unsigned tg = og / nx;
            if (og + 1u == (tg + 1u) * nx) xb_add(&bar[XB_TOPGEN], 1u);
            else XB_SPIN(xb_ld(&bar[XB_TOPGEN]) == tg, bar);
            __builtin_amdgcn_fence(__ATOMIC_ACQUIRE, "agent");
            xb_add(&bar[XB_XGEN(b.x)], 1u);
            asm volatile("s_waitcnt vmcnt(0)" ::: "memory");
        } else {
            XB_SPIN(xb_ld(&bar[XB_XGEN(b.x)]) == gen, bar);
            __builtin_amdgcn_fence(__ATOMIC_ACQUIRE, "agent");
            asm volatile("s_waitcnt vmcnt(0)" ::: "memory");
        }
    }
    __syncthreads();
}

struct Frame {
    LAS unsigned char* lds; unsigned ldsb;
    volatile LAS unsigned* MISC; gu32* ctl;
    int tid, lane, wave, vcu, G, abl;
    const float *x, *c; const int* pos; const float *w_ada, *b_ada, *norm_mix_g, *w_in, *ret_norm_g, *conv_w, *w_br_ret, *w_br_conv, *w_out, *norm_ffn_g, *w_router, *router_bias,
        *w_eg, *w_eu, *w_ed, *w_sg, *w_su, *w_sd, *norm_final_g;
    float* out; unsigned char* ws;
};
__device__ __forceinline__ float wave_sum(float v) {
#pragma unroll
    for (int o = 1; o < 64; o <<= 1) v += __shfl_xor(v, o);
    return v;
}

__device__ __forceinline__ void p0_mod_task(Frame& F, int j) {
    const int cq = F.tid & 15, kq = F.tid >> 4;
    f32x4 a0 = {0.f, 0.f, 0.f, 0.f}, a1 = {0.f, 0.f, 0.f, 0.f};
    const float* W = F.w_ada + 64 * j + 4 * cq;
#pragma unroll 8
    for (int i = 0; i < 32; ++i) { const int k = kq + 32 * i; const float c0 = F.c[k], c1 = F.c[1024 + k];
        const float s0 = c0 / (1.0f + expf(-c0)), s1 = c1 / (1.0f + expf(-c1));
        const f32x4 w = *(const f32x4*)(W + (size_t)k * NMOD); a0 += s0 * w; a1 += s1 * w; }
    LAS f32x4* red = (LAS f32x4*)F.lds;
    red[(kq * 2 + 0) * 16 + cq] = a0; red[(kq * 2 + 1) * 16 + cq] = a1;
    __syncthreads();
    if (F.tid < 32) { const int b = F.tid >> 4, c2 = F.tid & 15; f32x4 s = *(const f32x4*)(F.b_ada + 64 * j + 4 * c2);
        for (int k2 = 0; k2 < 32; ++k2) s += red[(k2 * 2 + b) * 16 + c2];
        *(f32x4*)((float*)(F.ws + WS_MOD) + b * NMOD + 64 * j + 4 * c2) = s; }
    __syncthreads();
}
__device__ __forceinline__ void p0_transpose_item(const float* W, int K, int N, bf16* WT, int row_off, int row_mul, LAS float* scr, int item, int lane) {
    const int nblk = N / 32, kb = item / nblk, nb = item % nblk, k0 = 64 * kb, n0 = 32 * nb;
#pragma unroll 8
    for (int i = 0; i < 32; ++i) { const int kk = 2 * i + (lane >> 5); scr[kk * 33 + (lane & 31)] = W[(size_t)(k0 + kk) * N + n0 + (lane & 31)]; }
    asm volatile("s_waitcnt lgkmcnt(0)" ::: "memory");
    const int c = lane & 7;
#pragma unroll
    for (int j = 0; j < 4; ++j) { const int n = (lane >> 3) + 8 * j; const LAS float* s = scr + (8 * c) * 33 + n;
        v4u o; o.x = pk2(s[0 * 33], s[1 * 33]); o.y = pk2(s[2 * 33], s[3 * 33]); o.z = pk2(s[4 * 33], s[5 * 33]); o.w = pk2(s[6 * 33], s[7 * 33]);
        *(v4u*)(WT + (size_t)(row_off + row_mul * (n0 + n)) * K + k0 + 8 * c) = o; }
    asm volatile("s_waitcnt lgkmcnt(0)" ::: "memory");
}
__device__ __forceinline__ void p0_prologue(Frame& F) {
    if ((int)blockIdx.x < NMOD / 64) p0_mod_task(F, (int)blockIdx.x);
    LAS float* scr = (LAS float*)(F.lds + F.wave * 16384);
    const int gw = F.vcu * NWAVES + F.wave, NGW = F.G * NWAVES;
    constexpr int I_IN = (D / 64) * (NIN / 32), I_SQ = (D / 64) * (D / 32), I_R = (D / 64) * (256 / 32), I_SD = (256 / 64) * (D / 32);
    constexpr int NITEMS = I_IN + 3 * I_SQ + 3 * I_R + I_SD;
    unsigned char* ws = F.ws;
    for (int it = gw; it < NITEMS; it += NGW) {
        int r = it;
        if (r < I_IN) { p0_transpose_item(F.w_in, D, NIN, (bf16*)(ws + WS_WIN), 0, 1, scr, r, F.lane); continue; } r -= I_IN;
        if (r < I_SQ) { p0_transpose_item(F.w_br_ret, D, D, (bf16*)(ws + WS_WBR), 0, 1, scr, r, F.lane); continue; } r -= I_SQ;
        if (r < I_SQ) { p0_transpose_item(F.w_br_conv, D, D, (bf16*)(ws + WS_WBC), 0, 1, scr, r, F.lane); continue; } r -= I_SQ;
        if (r < I_SQ) { p0_transpose_item(F.w_out, D, D, (bf16*)(ws + WS_WO), 0, 1, scr, r, F.lane); continue; } r -= I_SQ;
        if (r < I_R) { p0_transpose_item(F.w_router, D, NE, (bf16*)(ws + WS_WR), 0, 1, scr, r, F.lane); continue; } r -= I_R;
        if (r < I_R) { p0_transpose_item(F.w_sg, D, EH, (bf16*)(ws + WS_WSGU), 0, 2, scr, r, F.lane); continue; } r -= I_R;
        if (r < I_R) { p0_transpose_item(F.w_su, D, EH, (bf16*)(ws + WS_WSGU), 1, 2, scr, r, F.lane); continue; } r -= I_R;
        p0_transpose_item(F.w_sd, EH, D, (bf16*)(ws + WS_WSD), 0, 1, scr, r, F.lane);
    }
    f32x2* rope = (f32x2*)(ws + WS_ROPE);
    for (int idx = F.vcu * NT + F.tid; idx < M * 64; idx += F.G * NT) { const int t = idx >> 6, i = idx & 63;
        const float invf = powf(10000.0f, -(float)i * (1.0f / 64.0f)); const float ang = (float)F.pos[t] * invf;
        const double ad = (double)ang; const double rr = ad - 6.283185307179586 * rint(ad * 0.15915494309189535); const float rf = (float)rr;
        rope[idx] = (f32x2){cosf(rf), sinf(rf)}; }
}

__device__ __forceinline__ void norm_mod_rows(Frame& F, const float* X, const float* gain, int sc_off, int sh_off, bf16* O) {
    const int gw = F.vcu * NWAVES + F.wave, NGW = F.G * NWAVES;
    const float* mod = (const float*)(F.ws + WS_MOD);
    f32x4 g[4];
#pragma unroll
    for (int j = 0; j < 4; ++j) g[j] = *(const f32x4*)(gain + 4 * F.lane + 256 * j);
    for (int m = gw; m < M; m += NGW) {
        const int b = m >> 13; const f32x4* xr = (const f32x4*)(X + (size_t)m * D) + F.lane;
        f32x4 v[4]; float ss = 0.f;
#pragma unroll
        for (int j = 0; j < 4; ++j) { v[j] = xr[64 * j]; ss += (v[j].x * v[j].x + v[j].y * v[j].y) + (v[j].z * v[j].z + v[j].w * v[j].w); }
        const float rstd = 1.0f / sqrtf(wave_sum(ss) * (1.0f / D) + EPS);
        v2u* o8 = (v2u*)(O + (size_t)m * D) + F.lane;
#pragma unroll
        for (int j = 0; j < 4; ++j) { const f32x4 sc = *(const f32x4*)(mod + b * NMOD + sc_off + 4 * F.lane + 256 * j), sh = *(const f32x4*)(mod + b * NMOD + sh_off + 4 * F.lane + 256 * j);
            const f32x4 h = (v[j] * rstd * g[j]) * (1.0f + sc) + sh; v2u w; w.x = pk2(h.x, h.y); w.y = pk2(h.z, h.w); o8[64 * j] = w; }
    }
}

constexpr int KS = 136, KSB = KS * 2;
constexpr int VS = 264, VSB = VS * 2;
__device__ __forceinline__ float log_gamma(int h) { return log1pf(-exp2f(-5.0f - (float)h)); }
__device__ __forceinline__ bf16x8 ldfrag(const LAS unsigned char* img, int row, int rsb, int k) { return *(const LAS bf16x8*)(img + row * rsb + k * 2); }
template <int RS4> __device__ __forceinline__ bf16x8 tr_frag(unsigned addr) {
    s16x4 lo, hi;
    asm volatile("ds_read_b64_tr_b16 %0, %2\n\tds_read_b64_tr_b16 %1, %2 offset:%3\n\ts_waitcnt lgkmcnt(0)" : "=&v"(lo), "=&v"(hi) : "v"(addr), "i"(RS4) : "memory");
    return __builtin_shufflevector(lo, hi, 0, 1, 2, 3, 4, 5, 6, 7);
}
template <int RS4, int STEP> __device__ __forceinline__ void tr_frag4(unsigned addr, bf16x8& f0, bf16x8& f1, bf16x8& f2, bf16x8& f3) {
    s16x4 l0, h0, l1, h1, l2, h2, l3, h3;
    asm volatile("ds_read_b64_tr_b16 %0, %8\n\tds_read_b64_tr_b16 %1, %8 offset:%9\n\t"
                 "ds_read_b64_tr_b16 %2, %8 offset:%10\n\tds_read_b64_tr_b16 %3, %8 offset:%11\n\t"
                 "ds_read_b64_tr_b16 %4, %8 offset:%12\n\tds_read_b64_tr_b16 %5, %8 offset:%13\n\t"
                 "ds_read_b64_tr_b16 %6, %8 offset:%14\n\tds_read_b64_tr_b16 %7, %8 offset:%15\n\ts_waitcnt lgkmcnt(0)"
                 : "=&v"(l0), "=&v"(h0), "=&v"(l1), "=&v"(h1), "=&v"(l2), "=&v"(h2), "=&v"(l3), "=&v"(h3)
                 : "v"(addr), "i"(RS4), "i"(STEP), "i"(STEP + RS4), "i"(2 * STEP), "i"(2 * STEP + RS4), "i"(3 * STEP), "i"(3 * STEP + RS4) : "memory");
    f0 = __builtin_shufflevector(l0, h0, 0, 1, 2, 3, 4, 5, 6, 7); f1 = __builtin_shufflevector(l1, h1, 0, 1, 2, 3, 4, 5, 6, 7);
    f2 = __builtin_shufflevector(l2, h2, 0, 1, 2, 3, 4, 5, 6, 7); f3 = __builtin_shufflevector(l3, h3, 0, 1, 2, 3, 4, 5, 6, 7);
}
#define MFMA16(a, b, c) __builtin_amdgcn_mfma_f32_16x16x32_bf16((a), (b), (c), 0, 0, 0)

template <bool DECAY> __device__ __forceinline__ void stage_rope(Frame& F, LAS unsigned char* img, const bf16* src, const f32x2* rope, float s_const, float lg) {
#pragma unroll
    for (int i = 0; i < 4; ++i) { const int task = F.tid + NT * i, c = task >> 4, g = task & 15;
        const v2u lo = *(const v2u*)(src + (size_t)c * NIN + 4 * g), hi = *(const v2u*)(src + (size_t)c * NIN + 64 + 4 * g);
        const f32x4 r01 = *(const f32x4*)(rope + c * 64 + 4 * g), r23 = *(const f32x4*)(rope + c * 64 + 4 * g + 2);
        const float sc = DECAY ? s_const * __expf(lg * (float)(127 - c)) : s_const;
        const float x1[4] = {bflo(lo.x), bfhi(lo.x), bflo(lo.y), bfhi(lo.y)}, x2[4] = {bflo(hi.x), bfhi(hi.x), bflo(hi.y), bfhi(hi.y)};
        const float cs[4] = {r01.x, r01.z, r23.x, r23.z}, sn[4] = {r01.y, r01.w, r23.y, r23.w};
        float y1[4], y2[4];
#pragma unroll
        for (int j = 0; j < 4; ++j) { y1[j] = (x1[j] * cs[j] - x2[j] * sn[j]) * sc; y2[j] = (x2[j] * cs[j] + x1[j] * sn[j]) * sc; }
        v2u w1, w2; w1.x = pk2(y1[0], y1[1]); w1.y = pk2(y1[2], y1[3]); w2.x = pk2(y2[0], y2[1]); w2.y = pk2(y2[2], y2[3]);
        *(LAS v2u*)(img + c * KSB + 8 * g) = w1; *(LAS v2u*)(img + c * KSB + 128 + 8 * g) = w2; }
}
__device__ __forceinline__ void stage_v(Frame& F, LAS unsigned char* img, const bf16* src) {
#pragma unroll
    for (int i = 0; i < 8; ++i) { const int task = F.tid + NT * i, c = task >> 5, g = task & 31;
        *(LAS v4u*)(img + c * VSB + 16 * g) = *(const v4u*)(src + (size_t)c * NIN + 8 * g); }
}

__device__ __forceinline__ void p3_kv_conv(Frame& F) {
    unsigned char* ws = F.ws; const bf16* PROJ = (const bf16*)(ws + WS_PROJ); const f32x2* ROPE = (const f32x2*)(ws + WS_ROPE); float* KV = (float*)(ws + WS_KV);
    LAS unsigned char* Kimg = F.lds; LAS unsigned char* Vimg = F.lds + 34816;
    const int w = F.wave, lane = F.lane, g = lane >> 4, q = (lane & 15) >> 2, p = lane & 3;
    for (int it = (int)blockIdx.x; it < BATCH * NH * NCH; it += F.G) {
        const int n = it & 63, h = (it >> 6) & 3, b = it >> 8; const int t0 = b * SEQ + n * CH; const float lg = log_gamma(h);
        stage_rope<true>(F, Kimg, PROJ + (size_t)t0 * NIN + OFF_K + h * DK, ROPE + (size_t)t0 * 64, 1.0f, lg);
        stage_v(F, Vimg, PROJ + (size_t)t0 * NIN + OFF_V + h * DV);
        __syncthreads();
        f32x4 acc[16];
#pragma unroll
        for (int i = 0; i < 16; ++i) acc[i] = (f32x4){0.f, 0.f, 0.f, 0.f};
        const unsigned ka = F.ldsb + (unsigned)((8 * g + q) * KSB + (16 * w + 4 * p) * 2);
        const unsigned va = F.ldsb + 34816u + (unsigned)((8 * g + q) * VSB + (4 * p) * 2);
#pragma unroll
        for (int ks = 0; ks < 4; ++ks) {
            const bf16x8 a = tr_frag<4 * KSB>(ka + ks * 32 * KSB);
#pragma unroll
            for (int nt = 0; nt < 16; nt += 4) { bf16x8 b0, b1, b2, b3; tr_frag4<4 * VSB, 32>(va + ks * 32 * VSB + nt * 32, b0, b1, b2, b3);
                acc[nt] = MFMA16(a, b0, acc[nt]); acc[nt + 1] = MFMA16(a, b1, acc[nt + 1]); acc[nt + 2] = MFMA16(a, b2, acc[nt + 2]); acc[nt + 3] = MFMA16(a, b3, acc[nt + 3]); }
        }
        float* kvp = KV + (size_t)it * (DV * DK) + (size_t)(lane & 15) * DK + 16 * w + 4 * g;
#pragma unroll
        for (int nt = 0; nt < 16; ++nt) *(f32x4*)(kvp + (size_t)(16 * nt) * DK) = acc[nt];
        __syncthreads();
    }
    bf16* CONVG = (bf16*)(ws + WS_CONVG);
    const int gw = F.vcu * NWAVES + F.wave, NGW = F.G * NWAVES;
    for (int m = gw; m < M; m += NGW) { const int s = m & (SEQ - 1);
#pragma unroll
        for (int j = 0; j < 4; ++j) { const int ch = 4 * lane + 256 * j; const bf16* rp = PROJ + (size_t)m * NIN + ch;
            const f32x4 w0 = *(const f32x4*)(F.conv_w + ch), w1 = *(const f32x4*)(F.conv_w + D + ch), w2 = *(const f32x4*)(F.conv_w + 2 * D + ch);
            const v2u u0 = *(const v2u*)(rp + OFF_U), c0 = *(const v2u*)(rp + OFF_GC), gb = *(const v2u*)(rp + OFF_GB);
            v2u u1 = {0u, 0u}, c1 = {0u, 0u}, u2 = {0u, 0u}, c2 = {0u, 0u};
            if (s >= 1) { u1 = *(const v2u*)(rp - NIN + OFF_U); c1 = *(const v2u*)(rp - NIN + OFF_GC); }
            if (s >= 2) { u2 = *(const v2u*)(rp - 2 * NIN + OFF_U); c2 = *(const v2u*)(rp - 2 * NIN + OFF_GC); }
            f32x4 cu0 = {bflo(u0.x) * bflo(c0.x), bfhi(u0.x) * bfhi(c0.x), bflo(u0.y) * bflo(c0.y), bfhi(u0.y) * bfhi(c0.y)};
            f32x4 cu1 = {bflo(u1.x) * bflo(c1.x), bfhi(u1.x) * bfhi(c1.x), bflo(u1.y) * bflo(c1.y), bfhi(u1.y) * bfhi(c1.y)};
            f32x4 cu2 = {bflo(u2.x) * bflo(c2.x), bfhi(u2.x) * bfhi(c2.x), bflo(u2.y) * bflo(c2.y), bfhi(u2.y) * bfhi(c2.y)};
            const f32x4 gbf = {bflo(gb.x), bfhi(gb.x), bflo(gb.y), bfhi(gb.y)};
            const f32x4 o = gbf * (w0 * cu2 + w1 * cu1 + w2 * cu0);
            v2u wv; wv.x = pk2(o.x, o.y); wv.y = pk2(o.z, o.w); *(v2u*)(CONVG + (size_t)m * D + ch) = wv; }
    }
}

__device__ __forceinline__ void p4_scan(Frame& F) {
    const float* KV = (const float*)(F.ws + WS_KV); unsigned* SP = (unsigned*)(F.ws + WS_SP);
    for (int gid = F.vcu * NT + F.tid; gid < BATCH * NH * (DV * DK / 2); gid += F.G * NT) {
        const int bh = gid >> 14, e2 = gid & 16383, h = bh & 3; const float dec = __expf(log_gamma(h) * 128.0f);
        f32x2 S = {0.f, 0.f};
        const f32x2* kp = (const f32x2*)KV + (size_t)bh * NCH * 16384 + e2; unsigned* sp = SP + (size_t)bh * NCH * 16384 + e2;
#pragma unroll 8
        for (int n = 0; n < NCH; ++n) { const f32x2 kv = kp[(size_t)n * 16384]; sp[(size_t)n * 16384] = pk2(S.x, S.y); S = S * dec + kv; }
    }
}

__device__ __forceinline__ void p5_retention(Frame& F) {
    unsigned char* ws = F.ws; const bf16* PROJ = (const bf16*)(ws + WS_PROJ); const f32x2* ROPE = (const f32x2*)(ws + WS_ROPE); const bf16* SP = (const bf16*)(ws + WS_SP);
    bf16* RETG = (bf16*)(ws + WS_RETG);
    LAS unsigned char* Qimg = F.lds; LAS unsigned char* Kimg = F.lds + 34816; LAS unsigned char* Bimg = F.lds + 69632;
    const int w = F.wave, lane = F.lane, g = lane >> 4, q = (lane & 15) >> 2, p = lane & 3, fr = lane & 15;
    for (int it = (int)blockIdx.x; it < BATCH * NH * NCH; it += F.G) {
        const int n = it & 63, h = (it >> 6) & 3, b = it >> 8; const int t0 = b * SEQ + n * CH; const float lg = log_gamma(h);
        stage_rope<false>(F, Qimg, PROJ + (size_t)t0 * NIN + OFF_Q + h * DK, ROPE + (size_t)t0 * 64, 0.08838834764831845f, 0.f);
        stage_rope<false>(F, Kimg, PROJ + (size_t)t0 * NIN + OFF_K + h * DK, ROPE + (size_t)t0 * 64, 1.0f, 0.f);
        { const bf16* sp = SP + (size_t)it * (DV * DK);
#pragma unroll
          for (int i = 0; i < 8; ++i) { const int task = F.tid + NT * i, r = task >> 4, c16 = task & 15; *(LAS v4u*)(Bimg + r * KSB + 16 * c16) = *(const v4u*)(sp + r * DK + 8 * c16); } }
        __syncthreads();
        f32x4 acc[16];
#pragma unroll
        for (int i = 0; i < 16; ++i) acc[i] = (f32x4){0.f, 0.f, 0.f, 0.f};
        f32x4 sc[8];
#pragma unroll
        for (int i = 0; i < 8; ++i) sc[i] = (f32x4){0.f, 0.f, 0.f, 0.f};
#pragma unroll 1
        for (int ks = 0; ks < 4; ++ks) {
            const bf16x8 qf = ldfrag(Qimg, 16 * w + fr, KSB, 32 * ks + 8 * g);
#pragma unroll
            for (int nt = 0; nt < 16; ++nt) { const bf16x8 sf = ldfrag(Bimg, 16 * nt + fr, KSB, 32 * ks + 8 * g); acc[nt] = MFMA16(sf, qf, acc[nt]); }
#pragma unroll
            for (int jt = 0; jt < 8; ++jt) { const bf16x8 kf = ldfrag(Kimg, 16 * jt + fr, KSB, 32 * ks + 8 * g); sc[jt] = MFMA16(kf, qf, sc[jt]); }
        }
        const int irow = 16 * w + fr;
        { const float cd = __expf(lg * (float)(irow + 1));
#pragma unroll
          for (int nt = 0; nt < 16; ++nt) acc[nt] = acc[nt] * cd; }
        __syncthreads();
#pragma unroll
        for (int jt = 0; jt < 8; ++jt) { float pv[4];
#pragma unroll
            for (int r = 0; r < 4; ++r) { const int j = 16 * jt + 4 * g + r; pv[r] = (irow >= j) ? sc[jt][r] * __expf(lg * (float)(irow - j)) : 0.f; }
            v2u wv; wv.x = pk2(pv[0], pv[1]); wv.y = pk2(pv[2], pv[3]); *(LAS v2u*)(Kimg + irow * KSB + (16 * jt + 4 * g) * 2) = wv; }
        stage_v(F, Bimg, PROJ + (size_t)t0 * NIN + OFF_V + h * DV);
        __syncthreads();
        const unsigned va = F.ldsb + 69632u + (unsigned)((8 * g + q) * VSB + (4 * p) * 2);
#pragma unroll 1
        for (int ks = 0; ks < 4; ++ks) {
            const bf16x8 pf = ldfrag(Kimg, 16 * w + fr, KSB, 32 * ks + 8 * g);
#pragma unroll
            for (int nt = 0; nt < 16; nt += 4) { bf16x8 v0, v1, v2, v3; tr_frag4<4 * VSB, 32>(va + ks * 32 * VSB + nt * 32, v0, v1, v2, v3);
                acc[nt] = MFMA16(v0, pf, acc[nt]); acc[nt + 1] = MFMA16(v1, pf, acc[nt + 1]); acc[nt + 2] = MFMA16(v2, pf, acc[nt + 2]); acc[nt + 3] = MFMA16(v3, pf, acc[nt + 3]); }
        }
        float ss = 0.f;
#pragma unroll
        for (int nt = 0; nt < 16; ++nt) ss += (acc[nt][0] * acc[nt][0] + acc[nt][1] * acc[nt][1]) + (acc[nt][2] * acc[nt][2] + acc[nt][3] * acc[nt][3]);
        ss += __shfl_xor(ss, 16); ss += __shfl_xor(ss, 32);
        const float rstd = 1.0f / sqrtf(ss * (1.0f / DV) + EPS);
        const size_t trow = (size_t)(t0 + irow);
#pragma unroll
        for (int nt = 0; nt < 16; ++nt) { const int dv = 16 * nt + 4 * g; const f32x4 gn = *(const f32x4*)(F.ret_norm_g + h * DV + dv);
            const v2u gr = *(const v2u*)(PROJ + trow * NIN + OFF_GR + h * DV + dv);
            const f32x4 o = acc[nt] * rstd * gn * (f32x4){siluf_(bflo(gr.x)), siluf_(bfhi(gr.x)), siluf_(bflo(gr.y)), siluf_(bfhi(gr.y))};
            v2u wv; wv.x = pk2(o[0], o[1]); wv.y = pk2(o[2], o[3]); *(v2u*)(RETG + trow * D + h * DV + dv) = wv; }
        __syncthreads();
    }
}

__device__ __forceinline__ void route_tokens(Frame& F) {
    unsigned char* ws = F.ws; const float* LOGITS = (const float*)(ws + WS_LOGITS);
    int* EIDX = (int*)(ws + WS_EIDX); int* POS = (int*)(ws + WS_POS); int* LTOK = (int*)(ws + WS_LTOK); float* LW = (float*)(ws + WS_LW);
    unsigned* cnt = (unsigned*)(F.ctl + CW_CNT);
    const int gw = F.vcu * NWAVES + F.wave, NGW = F.G * NWAVES, lane = F.lane;
    const f32x4 bias = *(const f32x4*)(F.router_bias + 4 * lane);
    const float NEG = -__builtin_inff();
    for (int t = gw; t < M; t += NGW) {
        const f32x4 lgv = *(const f32x4*)(LOGITS + (size_t)t * NE + 4 * lane);
        float s0 = 1.0f / (1.0f + expf(-lgv.x)), s1 = 1.0f / (1.0f + expf(-lgv.y)), s2 = 1.0f / (1.0f + expf(-lgv.z)), s3 = 1.0f / (1.0f + expf(-lgv.w));
        float c0 = s0 + bias.x, c1 = s1 + bias.y, c2 = s2 + bias.z, c3 = s3 + bias.w;
        float a = fmaxf(c0, c1), bq = fminf(c0, c1), cc = fmaxf(c2, c3), dd = fminf(c2, c3);
        float m1 = fmaxf(a, cc), m2 = fmaxf(fminf(a, cc), fmaxf(bq, dd));
#pragma unroll
        for (int o = 1; o < 8; o <<= 1) { const float o1 = __shfl_xor(m1, o), o2 = __shfl_xor(m2, o); const float n1 = fmaxf(m1, o1), n2 = fmaxf(fminf(m1, o1), fmaxf(m2, o2)); m1 = n1; m2 = n2; }
        const float gs = m1 + m2; const int myg = lane >> 3; int rank = 0;
#pragma unroll
        for (int g2 = 0; g2 < 8; ++g2) { const float sg = __shfl(gs, g2 * 8); rank += (sg > gs || (sg == gs && g2 < myg)) ? 1 : 0; }
        if (rank >= 4) { c0 = NEG; c1 = NEG; c2 = NEG; c3 = NEG; }
        int ek[8]; float wk[8]; float wsum = 0.f;
#pragma unroll
        for (int k = 0; k < 8; ++k) {
            float bv = c0; int bi = 0;
            if (c1 > bv) { bv = c1; bi = 1; } if (c2 > bv) { bv = c2; bi = 2; } if (c3 > bv) { bv = c3; bi = 3; }
            int be = 4 * lane + bi;
#pragma unroll
            for (int o = 32; o >= 1; o >>= 1) { const float ov = __shfl_xor(bv, o); const int oe = __shfl_xor(be, o); if (ov > bv || (ov == bv && oe < be)) { bv = ov; be = oe; } }
            const int sl = be >> 2, sj = be & 3;
            const float myv = sj == 0 ? s0 : (sj == 1 ? s1 : (sj == 2 ? s2 : s3));
            const float wv = __shfl(myv, sl);
            if (lane == sl) { if (sj == 0) c0 = NEG; else if (sj == 1) c1 = NEG; else if (sj == 2) c2 = NEG; else c3 = NEG; }
            ek[k] = be; wk[k] = wv; wsum += wv;
        }
        const float inv = 2.5f / wsum;
        int my_e = ek[0]; float my_w = wk[0];
#pragma unroll
        for (int k = 1; k < 8; ++k) if (lane == k) { my_e = ek[k]; my_w = wk[k]; }
        if (lane < 8) { const unsigned ps = __hip_atomic_fetch_add(cnt + 64 * my_e, 1u, RLX_AGENT);
            LTOK[(size_t)my_e * CAP + ps] = t; LW[(size_t)my_e * CAP + ps] = my_w * inv; EIDX[t * 8 + lane] = my_e; POS[t * 8 + lane] = (int)ps; }
    }
}

__device__ __forceinline__ void expert_prefix(Frame& F, LAS int* pref, LAS int* off) {
    if (F.wave == 0) { const unsigned* cnt = (const unsigned*)(F.ctl + CW_CNT); const int lane = F.lane;
        int c[4], nb[4]; int tc = 0, tb = 0;
#pragma unroll
        for (int j = 0; j < 4; ++j) { c[j] = (int)__hip_atomic_load(cnt + 64 * (4 * lane + j), RLX_AGENT); nb[j] = (c[j] + 127) >> 7; tc += c[j]; tb += nb[j]; }
        int xc = tc, xb = tb;
#pragma unroll
        for (int o = 1; o < 64; o <<= 1) { const int vc = __shfl_up(xc, o), vb = __shfl_up(xb, o); if (lane >= o) { xc += vc; xb += vb; } }
        int ec = xc - tc, eb = xb - tb;
#pragma unroll
        for (int j = 0; j < 4; ++j) { off[4 * lane + j] = ec; pref[4 * lane + j] = eb; ec += c[j]; eb += nb[j]; }
        if (lane == 63) { off[256] = ec; pref[256] = eb; } }
}

constexpr int EX_PREF = 0, EX_OFF = 1040, EX_TOK = 2176, EX_W = 2688, EX_BUF = 3200, EX_BUFSZ = 27648, EX_BOFF = 10240, EX_G = EX_BUF + 2 * EX_BUFSZ;
constexpr int ASB = 80, EXD = 4, EXNC = 96;
static_assert(EX_G + 128 * VSB <= LDSCTL_OFF, "expert LDS map");
template <int RS4, int STEP> __device__ __forceinline__ void tr_frag2(unsigned addr, bf16x8& f0, bf16x8& f1) {
    s16x4 l0, h0, l1, h1;
    asm volatile("ds_read_b64_tr_b16 %0, %4\n\tds_read_b64_tr_b16 %1, %4 offset:%5\n\tds_read_b64_tr_b16 %2, %4 offset:%6\n\tds_read_b64_tr_b16 %3, %4 offset:%7\n\ts_waitcnt lgkmcnt(0)"
                 : "=&v"(l0), "=&v"(h0), "=&v"(l1), "=&v"(h1) : "v"(addr), "i"(RS4), "i"(STEP), "i"(STEP + RS4) : "memory");
    f0 = __builtin_shufflevector(l0, h0, 0, 1, 2, 3, 4, 5, 6, 7); f1 = __builtin_shufflevector(l1, h1, 0, 1, 2, 3, 4, 5, 6, 7);
}
struct ExSet { f32x4 w[4]; v4u a; };
template <int ABL> __device__ __forceinline__ void p11_experts(Frame& F) {
    unsigned char* ws = F.ws; const bf16* H2 = (const bf16*)(ws + WS_HB); const int* LTOK = (const int*)(ws + WS_LTOK); const float* LW = (const float*)(ws + WS_LW); bf16* YP = (bf16*)(ws + WS_YP);
    LAS int* pref = (LAS int*)(F.lds + EX_PREF); LAS int* off = (LAS int*)(F.lds + EX_OFF); LAS int* tokl = (LAS int*)(F.lds + EX_TOK); LAS float* wl = (LAS float*)(F.lds + EX_W);
    LAS unsigned char* Gimg = F.lds + EX_G;
    const int tid = F.tid, w = F.wave, wr = w >> 2, wc = w & 3;
    expert_prefix(F, pref, off);
    __syncthreads();
    const int nitems = pref[256];
    for (int it = F.vcu; it < nitems; it += F.G) {
        int e = 0;
#pragma unroll
        for (int s = 128; s >= 1; s >>= 1) if (pref[e + s] <= it) e += s;
        e = __builtin_amdgcn_readfirstlane(e);
        const int rb = __builtin_amdgcn_readfirstlane(it - pref[e]), cnt_e = __builtin_amdgcn_readfirstlane(off[e + 1] - off[e]), r0 = rb * 128, slot0 = __builtin_amdgcn_readfirstlane(off[e]) + r0;
        if (tid < 128) { const int idx = r0 + tid; const bool ok = idx < cnt_e; tokl[tid] = LTOK[(size_t)e * CAP + (ok ? idx : r0)]; wl[tid] = ok ? LW[(size_t)e * CAP + idx] : 0.f; }
        __syncthreads();
        const float* Wg = F.w_eg + (size_t)e * D * EH; const float* Wu = F.w_eu + (size_t)e * D * EH; const float* Wd = F.w_ed + (size_t)e * EH * D;
        const bf16* asrc = H2 + (size_t)tokl[tid >> 2] * D + (tid & 3) * 8;
        f32x4 acc[4][4];
#define EX_ZERO() do { _Pragma("unroll") for (int i = 0; i < 4; ++i) _Pragma("unroll") for (int j = 0; j < 4; ++j) acc[i][j] = (f32x4){0.f, 0.f, 0.f, 0.f}; } while (0)
        EX_ZERO();
        ExSet S0, S1, S2, S3;
#define EX_L1(S, CC) do { const int cc_ = (CC) & 63, hp_ = cc_ >> 5, kc_ = cc_ & 31; int tl = tid; asm volatile("" : "+v"(tl));                         \
            unsigned o = (unsigned)((32 * kc_ + (tl >> 5)) * EH + 128 * hp_ + 4 * (tl & 31));                                                            \
            S.w[0] = *(const f32x4*)(Wg + o); S.w[1] = *(const f32x4*)(Wg + o + 16 * EH); S.w[2] = *(const f32x4*)(Wu + o); S.w[3] = *(const f32x4*)(Wu + o + 16 * EH); \
            S.a = *(const v4u*)(asrc + 32 * kc_); } while (0)
#define EX_W1(S, BUF) do { int tl = tid; asm volatile("" : "+v"(tl)); LAS unsigned char* b_ = (BUF) + EX_BOFF + (tl >> 5) * KSB + 8 * (tl & 31); v2u p_[4];  \
            _Pragma("unroll") for (int i = 0; i < 4; ++i) { p_[i].x = pk2(S.w[i].x, S.w[i].y); p_[i].y = pk2(S.w[i].z, S.w[i].w); }                        \
            *(LAS v2u*)b_ = p_[0]; *(LAS v2u*)(b_ + 16 * KSB) = p_[1]; *(LAS v2u*)(b_ + 32 * KSB) = p_[2]; *(LAS v2u*)(b_ + 48 * KSB) = p_[3];             \
            *(LAS v4u*)((BUF) + (tl >> 2) * ASB + (tl & 3) * 16) = S.a; } while (0)
#define EX_C1(C) do { int tl = tid; asm volatile("" : "+v"(tl)); const int g = (tl >> 4) & 3, fr = tl & 15, q = (tl & 15) >> 2, p = tl & 3;              \
            LAS unsigned char* buf = F.lds + EX_BUF + ((C) & 1) * EX_BUFSZ; const unsigned ta = F.ldsb + EX_BUF + (unsigned)(((C) & 1) * EX_BUFSZ + EX_BOFF + (8 * g + q) * KSB + (32 * wc + 4 * p) * 2); \
            bf16x8 af[4]; _Pragma("unroll") for (int rt = 0; rt < 4; ++rt) af[rt] = ldfrag(buf, 64 * wr + 16 * rt + fr, ASB, 8 * g);                     \
            bf16x8 b0, b1, b2, b3; tr_frag2<4 * KSB, 32>(ta, b0, b1); tr_frag2<4 * KSB, 32>(ta + 32 * KSB, b2, b3);                                       \
            _Pragma("unroll") for (int rt = 0; rt < 4; ++rt) { acc[rt][0] = MFMA16(b0, af[rt], acc[rt][0]); acc[rt][1] = MFMA16(b1, af[rt], acc[rt][1]); acc[rt][2] = MFMA16(b2, af[rt], acc[rt][2]); acc[rt][3] = MFMA16(b3, af[rt], acc[rt][3]); } } while (0)
#define EX_STEP1(SL, SW, C) do { EX_L1(SL, (C) + 4); EX_C1(C); EX_W1(SW, F.lds + EX_BUF + (((C) + 1) & 1) * EX_BUFSZ); __syncthreads(); } while (0)
        EX_L1(S0, 0); EX_L1(S1, 1); EX_L1(S2, 2); EX_L1(S3, 3);
        EX_W1(S0, F.lds + EX_BUF);
        __syncthreads();
#pragma unroll 1
        for (int c4 = 0; c4 < 64; c4 += 4) {
            EX_STEP1(S0, S1, c4); EX_STEP1(S1, S2, c4 + 1); EX_STEP1(S2, S3, c4 + 2); EX_STEP1(S3, S0, c4 + 3);
            if ((c4 & 31) == 28) { const int hp = c4 >> 5; int tl = tid; asm volatile("" : "+v"(tl)); const int g = (tl >> 4) & 3, fr = tl & 15;
#pragma unroll
                for (int rt = 0; rt < 4; ++rt)
#pragma unroll
                    for (int ct = 0; ct < 2; ++ct) { const f32x4 ga = acc[rt][ct], ua = acc[rt][ct + 2];
                        v2u wv; wv.x = pk2(siluf_(ga[0]) * ua[0], siluf_(ga[1]) * ua[1]); wv.y = pk2(siluf_(ga[2]) * ua[2], siluf_(ga[3]) * ua[3]);
                        *(LAS v2u*)(Gimg + (64 * wr + 16 * rt + fr) * VSB + (128 * hp + 32 * wc + 16 * ct + 4 * g) * 2) = wv; }
                EX_ZERO(); }
        }
#define EX_L2(S, CC) do { const int cc_ = (CC) & 31, np_ = cc_ >> 3, kc_ = cc_ & 7; int tl = tid; asm volatile("" : "+v"(tl));                           \
            unsigned o = (unsigned)((32 * kc_ + (tl >> 6)) * D + 256 * np_ + 4 * (tl & 63));                                                              \
            _Pragma("unroll") for (int i = 0; i < 4; ++i) S.w[i] = *(const f32x4*)(Wd + o + (unsigned)(8 * i * D)); } while (0)
#define EX_W2(S, BUF) do { int tl = tid; asm volatile("" : "+v"(tl)); LAS unsigned char* b_ = (BUF) + EX_BOFF + (tl >> 6) * VSB + 8 * (tl & 63);          \
            _Pragma("unroll") for (int i = 0; i < 4; ++i) { v2u p_; p_.x = pk2(S.w[i].x, S.w[i].y); p_.y = pk2(S.w[i].z, S.w[i].w); *(LAS v2u*)(b_ + (8 * i) * VSB) = p_; } } while (0)
#define EX_C2(C) do { int tl = tid; asm volatile("" : "+v"(tl)); const int g = (tl >> 4) & 3, fr = tl & 15, q = (tl & 15) >> 2, p = tl & 3;              \
            const unsigned ta = F.ldsb + EX_BUF + (unsigned)(((C) & 1) * EX_BUFSZ + EX_BOFF + (8 * g + q) * VSB + (64 * wc + 4 * p) * 2);                \
            bf16x8 gf[4]; _Pragma("unroll") for (int rt = 0; rt < 4; ++rt) gf[rt] = ldfrag(Gimg, 64 * wr + 16 * rt + fr, VSB, 32 * ((C) & 7) + 8 * g);   \
            bf16x8 b0, b1, b2, b3; tr_frag4<4 * VSB, 32>(ta, b0, b1, b2, b3);                                                                             \
            _Pragma("unroll") for (int rt = 0; rt < 4; ++rt) { acc[rt][0] = MFMA16(b0, gf[rt], acc[rt][0]); acc[rt][1] = MFMA16(b1, gf[rt], acc[rt][1]); acc[rt][2] = MFMA16(b2, gf[rt], acc[rt][2]); acc[rt][3] = MFMA16(b3, gf[rt], acc[rt][3]); } } while (0)
#define EX_STEP2(SL, SW, C) do { EX_L2(SL, (C) + 4); EX_C2(C); EX_W2(SW, F.lds + EX_BUF + (((C) + 1) & 1) * EX_BUFSZ); __syncthreads(); } while (0)
        EX_L2(S0, 0); EX_L2(S1, 1); EX_L2(S2, 2); EX_L2(S3, 3);
        EX_W2(S0, F.lds + EX_BUF);
        __syncthreads();
#pragma unroll 1
        for (int np = 0; np < 4; ++np) {
#pragma unroll 1
            for (int h4 = 0; h4 < 8; h4 += 4) { const int c4 = 8 * np + h4;
                EX_STEP2(S0, S1, c4); EX_STEP2(S1, S2, c4 + 1); EX_STEP2(S2, S3, c4 + 2); EX_STEP2(S3, S0, c4 + 3); }
            int tl = tid; asm volatile("" : "+v"(tl)); const int g = (tl >> 4) & 3, fr = tl & 15;
#pragma unroll
            for (int rt = 0; rt < 4; ++rt) { const int row = 64 * wr + 16 * rt + fr; const float rw = wl[row];
                if (!(ABL & 32) && r0 + row < cnt_e) { bf16* yp = YP + (size_t)(slot0 + row) * D + 256 * np + 64 * wc + 4 * g;
#pragma unroll
                    for (int ct = 0; ct < 4; ++ct) { const f32x4 o = acc[rt][ct] * rw; v2u wv; wv.x = pk2(o[0], o[1]); wv.y = pk2(o[2], o[3]); *(v2u*)(yp + 16 * ct) = wv; } } }
            EX_ZERO();
        }
#undef EX_L1
#undef EX_W1
#undef EX_C1
#undef EX_STEP1
#undef EX_L2
#undef EX_W2
#undef EX_C2
#undef EX_STEP2
#undef EX_ZERO
        __syncthreads();
    }
}

constexpr int K6_A = 3200, K6_BG = 21632, K6_BU = 39040, K6_G = 56448;
constexpr int ASB6 = 144;
#define K6MM(a, b, c) ((ABL & 1) ? k6_keep((a), (b), (c)) : MFMA16((a), (b), (c)))
__device__ __forceinline__ f32x4 k6_keep(bf16x8 a, bf16x8 b, f32x4 c) { asm volatile("" :: "v"(a), "v"(b)); return c; }
struct K6Set { f32x4 w[8]; v4u a0, a1; };
template <int ABL> __device__ __forceinline__ void p11_experts_k64(Frame& F) {
    unsigned char* ws = F.ws; const bf16* H2 = (const bf16*)(ws + WS_HB); const int* LTOK = (const int*)(ws + WS_LTOK); const float* LW = (const float*)(ws + WS_LW); bf16* YP = (bf16*)(ws + WS_YP);
    LAS int* pref = (LAS int*)(F.lds + EX_PREF); LAS int* off = (LAS int*)(F.lds + EX_OFF); LAS int* tokl = (LAS int*)(F.lds + EX_TOK); LAS float* wl = (LAS float*)(F.lds + EX_W);
    LAS unsigned char* Aimg = F.lds + K6_A; LAS unsigned char* Gimg = F.lds + K6_G;
    const int tid = F.tid, w = F.wave, wr = w >> 2, wc = w & 3;
    expert_prefix(F, pref, off);
    __syncthreads();
    const int nitems = pref[256];
    for (int it = F.vcu; it < nitems; it += F.G) {
        int e = 0;
#pragma unroll
        for (int s = 128; s >= 1; s >>= 1) if (pref[e + s] <= it) e += s;
        e = __builtin_amdgcn_readfirstlane(e);
        const int rb = __builtin_amdgcn_readfirstlane(it - pref[e]), cnt_e = __builtin_amdgcn_readfirstlane(off[e + 1] - off[e]), r0 = rb * 128, slot0 = __builtin_amdgcn_readfirstlane(off[e]) + r0;
        if (tid < 128) { const int idx = r0 + tid; const bool ok = idx < cnt_e; tokl[tid] = LTOK[(size_t)e * CAP + (ok ? idx : r0)]; wl[tid] = ok ? LW[(size_t)e * CAP + idx] : 0.f; }
        __syncthreads();
        const int ew = e;
        const float* Wg = F.w_eg + (size_t)ew * D * EH; const float* Wu = F.w_eu + (size_t)ew * D * EH; const float* Wd = F.w_ed + (size_t)ew * EH * D;
        const bf16* asrc = H2 + (size_t)tokl[tid >> 2] * D + (tid & 3) * 16;
        f32x4 acc[4][4];
#pragma unroll
        for (int i = 0; i < 4; ++i)
#pragma unroll
            for (int j = 0; j < 4; ++j) acc[i][j] = (f32x4){0.f, 0.f, 0.f, 0.f};
        K6Set S0, S1;
        if constexpr (ABL & 16) {
#pragma unroll
            for (int i = 0; i < 8; ++i) { S0.w[i] = (f32x4){1.f, 1.f, 1.f, 1.f}; S1.w[i] = (f32x4){1.f, 1.f, 1.f, 1.f}; } S0.a0 = S0.a1 = S1.a0 = S1.a1 = (v4u){0u, 0u, 0u, 0u}; }
#define K6_LOAD1(S, CC) do { const int cc_ = (CC) & 31, hp_ = cc_ >> 4, kc_ = cc_ & 15; int tl = tid; asm volatile("" : "+v"(tl));                      \
            unsigned o = (unsigned)((64 * kc_ + (tl >> 5)) * EH + 128 * hp_ + 4 * (tl & 31));                                                            \
            if constexpr (!(ABL & 16)) { _Pragma("unroll") for (int i = 0; i < 4; ++i) { S.w[i] = *(const f32x4*)(Wg + o + (unsigned)(16 * i * EH)); S.w[4 + i] = *(const f32x4*)(Wu + o + (unsigned)(16 * i * EH)); } \
            S.a0 = *(const v4u*)(asrc + 64 * kc_); S.a1 = *(const v4u*)(asrc + 64 * kc_ + 8); } } while (0)
#define K6_STEP1(S, CC) do { int tl = tid; asm volatile("" : "+v"(tl)); const int g = (tl >> 4) & 3, fr = tl & 15, q = (tl & 15) >> 2, p = tl & 3;    \
            if constexpr (!(ABL & 8)) __syncthreads();                                                                                                       \
            if constexpr (!(ABL & 2)) { *(LAS v4u*)(Aimg + (tl >> 2) * ASB6 + (tl & 3) * 32) = S.a0; *(LAS v4u*)(Aimg + (tl >> 2) * ASB6 + (tl & 3) * 32 + 16) = S.a1; }            \
            if constexpr (!(ABL & 2)) _Pragma("unroll") for (int i = 0; i < 4; ++i) { v2u wg, wu; wg.x = pk2(S.w[i].x, S.w[i].y); wg.y = pk2(S.w[i].z, S.w[i].w); wu.x = pk2(S.w[4 + i].x, S.w[4 + i].y); wu.y = pk2(S.w[4 + i].z, S.w[4 + i].w); \
                *(LAS v2u*)(F.lds + K6_BG + ((tl >> 5) + 16 * i) * KSB + 8 * (tl & 31)) = wg; *(LAS v2u*)(F.lds + K6_BU + ((tl >> 5) + 16 * i) * KSB + 8 * (tl & 31)) = wu; } \
            if constexpr (!(ABL & 8)) __syncthreads();                                                                                                       \
            K6_LOAD1(S, (CC) + 2);                                                                                                                       \
            const unsigned bga = F.ldsb + K6_BG + (unsigned)((8 * g + q) * KSB + (32 * wc + 4 * p) * 2), bua = bga + (K6_BU - K6_BG);                   \
            if constexpr (!(ABL & 4)) _Pragma("unroll") for (int s = 0; s < 2; ++s) { bf16x8 af[4];                                                                                \
                _Pragma("unroll") for (int rt = 0; rt < 4; ++rt) af[rt] = ldfrag(Aimg, 64 * wr + 16 * rt + fr, ASB6, 32 * s + 8 * g);                    \
                bf16x8 b0, b1, b2, b3; tr_frag2<4 * KSB, 32>(bga + s * 32 * KSB, b0, b1); tr_frag2<4 * KSB, 32>(bua + s * 32 * KSB, b2, b3);             \
                _Pragma("unroll") for (int rt = 0; rt < 4; ++rt) { acc[rt][0] = K6MM(b0, af[rt], acc[rt][0]); acc[rt][1] = K6MM(b1, af[rt], acc[rt][1]); acc[rt][2] = K6MM(b2, af[rt], acc[rt][2]); acc[rt][3] = K6MM(b3, af[rt], acc[rt][3]); } } } while (0)
        K6_LOAD1(S0, 0); K6_LOAD1(S1, 1);
#pragma unroll 1
        for (int cc = 0; cc < 32; cc += 2) {
            K6_STEP1(S0, cc); K6_STEP1(S1, cc + 1);
            if ((cc & 15) == 14) { const int hp = cc >> 4; int tl = tid; asm volatile("" : "+v"(tl)); const int g = (tl >> 4) & 3, fr = tl & 15;
#pragma unroll
                for (int rt = 0; rt < 4; ++rt)
#pragma unroll
                    for (int ct = 0; ct < 2; ++ct) { const f32x4 ga = acc[rt][ct], ua = acc[rt][ct + 2];
                        v2u wv; wv.x = pk2(siluf_(ga[0]) * ua[0], siluf_(ga[1]) * ua[1]); wv.y = pk2(siluf_(ga[2]) * ua[2], siluf_(ga[3]) * ua[3]);
                        *(LAS v2u*)(Gimg + (64 * wr + 16 * rt + fr) * VSB + (128 * hp + 32 * wc + 16 * ct + 4 * g) * 2) = wv; }
#pragma unroll
                for (int i = 0; i < 4; ++i)
#pragma unroll
                    for (int j = 0; j < 4; ++j) acc[i][j] = (f32x4){0.f, 0.f, 0.f, 0.f}; }
        }
#undef K6_STEP1
#undef K6_LOAD1
#define K6_LOAD2(S, CC) do { const int cc_ = (CC) & 15, np_ = cc_ >> 2, kc_ = cc_ & 3; int tl = tid; asm volatile("" : "+v"(tl));                       \
            unsigned o = (unsigned)((64 * kc_ + (tl >> 6)) * D + 256 * np_ + 4 * (tl & 63));                                                             \
            if constexpr (!(ABL & 16)) { _Pragma("unroll") for (int i = 0; i < 8; ++i) S.w[i] = *(const f32x4*)(Wd + o + (unsigned)(8 * i * D)); } } while (0)
#define K6_STEP2(S, CC, KC) do { int tl = tid; asm volatile("" : "+v"(tl)); const int g = (tl >> 4) & 3, fr = tl & 15, q = (tl & 15) >> 2, p = tl & 3; \
            if constexpr (!(ABL & 8)) __syncthreads();                                                                                                       \
            if constexpr (!(ABL & 2)) _Pragma("unroll") for (int i = 0; i < 8; ++i) { v2u wd; wd.x = pk2(S.w[i].x, S.w[i].y); wd.y = pk2(S.w[i].z, S.w[i].w); *(LAS v2u*)(F.lds + K6_BG + ((tl >> 6) + 8 * i) * VSB + 8 * (tl & 63)) = wd; } \
            if constexpr (!(ABL & 8)) __syncthreads();                                                                                                       \
            K6_LOAD2(S, (CC) + 2);                                                                                                                       \
            const unsigned bda = F.ldsb + K6_BG + (unsigned)((8 * g + q) * VSB + (64 * wc + 4 * p) * 2);                                                \
            if constexpr (!(ABL & 4)) _Pragma("unroll") for (int s = 0; s < 2; ++s) { bf16x8 gf[4];                                                                                \
                _Pragma("unroll") for (int rt = 0; rt < 4; ++rt) gf[rt] = ldfrag(Gimg, 64 * wr + 16 * rt + fr, VSB, 64 * (KC) + 32 * s + 8 * g);        \
                bf16x8 b0, b1, b2, b3; tr_frag4<4 * VSB, 32>(bda + s * 32 * VSB, b0, b1, b2, b3);                                                        \
                _Pragma("unroll") for (int rt = 0; rt < 4; ++rt) { acc[rt][0] = K6MM(b0, gf[rt], acc[rt][0]); acc[rt][1] = K6MM(b1, gf[rt], acc[rt][1]); acc[rt][2] = K6MM(b2, gf[rt], acc[rt][2]); acc[rt][3] = K6MM(b3, gf[rt], acc[rt][3]); } } } while (0)
        K6_LOAD2(S0, 0); K6_LOAD2(S1, 1);
#pragma unroll 1
        for (int np = 0; np < 4; ++np) {
            K6_STEP2(S0, 4 * np, 0); K6_STEP2(S1, 4 * np + 1, 1); K6_STEP2(S0, 4 * np + 2, 2); K6_STEP2(S1, 4 * np + 3, 3);
            int tl = tid; asm volatile("" : "+v"(tl)); const int g = (tl >> 4) & 3, fr = tl & 15;
#pragma unroll
            for (int rt = 0; rt < 4; ++rt) { const int row = 64 * wr + 16 * rt + fr; const float rw = wl[row];
                if (!(ABL & 32) && r0 + row < cnt_e) { bf16* yp = YP + (size_t)(slot0 + row) * D + 256 * np + 64 * wc + 4 * g;
#pragma unroll
                    for (int ct = 0; ct < 4; ++ct) { const f32x4 o = acc[rt][ct] * rw; v2u wv; wv.x = pk2(o[0], o[1]); wv.y = pk2(o[2], o[3]); *(v2u*)(yp + 16 * ct) = wv; } } }
#pragma unroll
            for (int i = 0; i < 4; ++i)
#pragma unroll
                for (int j = 0; j < 4; ++j) acc[i][j] = (f32x4){0.f, 0.f, 0.f, 0.f};
        }
#undef K6_STEP2
#undef K6_LOAD2
        __syncthreads();
    }
}

#undef K6MM
__device__ __forceinline__ void p12_final(Frame& F) {
    unsigned char* ws = F.ws; const float* X1 = (const float*)(ws + (MK_SKIP_SHARED ? WS_X1 : WS_MIXP)); const bf16* YP = (const bf16*)(ws + WS_YP); const int* EIDX = (const int*)(ws + WS_EIDX); const int* POS = (const int*)(ws + WS_POS);
    const float* mod = (const float*)(ws + WS_MOD);
    LAS int* pref = (LAS int*)(F.lds + EX_PREF); LAS int* off = (LAS int*)(F.lds + EX_OFF);
    expert_prefix(F, pref, off);
    __syncthreads();
    const int gw = F.vcu * NWAVES + F.wave, NGW = F.G * NWAVES, lane = F.lane;
    f32x4 gn[4];
#pragma unroll
    for (int j = 0; j < 4; ++j) gn[j] = *(const f32x4*)(F.norm_final_g + 4 * lane + 256 * j);
    for (int t = gw; t < M; t += NGW) {
        const int b = t >> 13;
        f32x4 y[4];
#pragma unroll
        for (int j = 0; j < 4; ++j) y[j] = (f32x4){0.f, 0.f, 0.f, 0.f};
#if !MK_SKIP_ROUTED
        int myslot = 0;
        if (lane < 8) myslot = off[EIDX[t * 8 + lane]] + POS[t * 8 + lane];
#pragma unroll
        for (int k = 0; k < 8; ++k) { const int slot = __shfl(myslot, k); const v2u* yp = (const v2u*)(YP + (size_t)slot * D) + lane;
#pragma unroll
            for (int j = 0; j < 4; ++j) { const v2u v = yp[64 * j]; y[j] += (f32x4){bflo(v.x), bfhi(v.x), bflo(v.y), bfhi(v.y)}; } }
#endif
        const f32x4* xr = (const f32x4*)(X1 + (size_t)t * D) + lane; f32x4 v[4]; float ss = 0.f;
#pragma unroll
        for (int j = 0; j < 4; ++j) { const f32x4 g2 = *(const f32x4*)(mod + b * NMOD + 5 * D + 4 * lane + 256 * j); v[j] = xr[64 * j] + g2 * y[j];
            ss += (v[j].x * v[j].x + v[j].y * v[j].y) + (v[j].z * v[j].z + v[j].w * v[j].w); }
        const float rstd = 1.0f / sqrtf(wave_sum(ss) * (1.0f / D) + EPS);
        f32x4* op = (f32x4*)(F.out + (size_t)t * D) + lane;
#pragma unroll
        for (int j = 0; j < 4; ++j) op[64 * j] = v[j] * rstd * gn[j];
    }
}

struct Args { const void* in[22]; float* out; unsigned char* ws; int ph_lo, ph_hi, li, abl; };
__global__ void __launch_bounds__(NT, 2) mk_fwd(Args args) {
    extern __shared__ __attribute__((aligned(16))) unsigned char lds[];
    Frame F;
    F.lds = (LAS unsigned char*)lds; F.ldsb = (unsigned)(size_t)F.lds;
    F.MISC = (volatile LAS unsigned*)(F.lds + MISC_OFF);
    F.tid = threadIdx.x; F.lane = F.tid & 63; F.wave = __builtin_amdgcn_readfirstlane(F.tid >> 6);
    F.G = gridDim.x; { const int bx = blockIdx.x; F.vcu = (F.G % 8 == 0) ? (bx % 8) * (F.G / 8) + bx / 8 : bx; }
    F.abl = MK_ABL_RT ? args.abl : 0;
    unsigned char* ws = args.ws; F.ws = ws; F.ctl = (gu32*)(ws + WS_CTL); F.out = args.out;
    F.x = (const float*)args.in[0]; F.c = (const float*)args.in[1]; F.pos = (const int*)args.in[2]; F.w_ada = (const float*)args.in[3]; F.b_ada = (const float*)args.in[4];
    F.norm_mix_g = (const float*)args.in[5]; F.w_in = (const float*)args.in[6]; F.ret_norm_g = (const float*)args.in[7]; F.conv_w = (const float*)args.in[8];
    F.w_br_ret = (const float*)args.in[9]; F.w_br_conv = (const float*)args.in[10]; F.w_out = (const float*)args.in[11]; F.norm_ffn_g = (const float*)args.in[12];
    F.w_router = (const float*)args.in[13]; F.router_bias = (const float*)args.in[14]; F.w_eg = (const float*)args.in[15]; F.w_eu = (const float*)args.in[16]; F.w_ed = (const float*)args.in[17];
    F.w_sg = (const float*)args.in[18]; F.w_su = (const float*)args.in[19]; F.w_sd = (const float*)args.in[20]; F.norm_final_g = (const float*)args.in[21];
    for (int u = F.tid; u < (LDS_BYTES - LDSCTL_OFF) / 4; u += NT) ((LAS unsigned*)(F.lds + LDSCTL_OFF))[u] = 0u;
    __syncthreads();
    XcdBarrier bar; bar.bar = (unsigned*)(F.ctl + CW_BAR) + args.li * XCD_BAR_WORDS; bar.x = 0; bar.st = nullptr;
    if (!MK_PER_PHASE) bar = xcd_barrier_post((unsigned*)(F.ctl + CW_BAR) + args.li * XCD_BAR_WORDS, F.MISC + 8);
    const int lo = args.ph_lo, hi = args.ph_hi;
#ifndef MK_PHASE_MASK
#define MK_PHASE_MASK 0x1fff
#endif
#define IN(k) (((MK_PHASE_MASK >> (k)) & 1) && lo <= (k) && (k) < hi)
#ifndef MK_BAR_REP
#define MK_BAR_REP 1
#endif
#define SEAM(k) do { if (IN(k) && IN((k) + 1)) { for (int br_ = 0; br_ < MK_BAR_REP; ++br_) xcd_barrier(bar); } } while (0)
#ifndef MK_DOUBLE_MASK
#define MK_DOUBLE_MASK 0
#endif
#define REP(k) for (int rep_ = 0; rep_ < (((MK_DOUBLE_MASK >> (k)) & 1) ? 2 : 1); ++rep_, (((MK_DOUBLE_MASK >> (k)) & 1) && rep_ == 1 ? xcd_barrier(bar) : (void)0))
    bf16* HB = (bf16*)(ws + WS_HB); bf16* PROJ = (bf16*)(ws + WS_PROJ); const float* mod = (const float*)(ws + WS_MOD);

    if (IN(0)) { p0_prologue(F); } SEAM(0);
    if (IN(1)) { norm_mod_rows(F, F.x, F.norm_mix_g, 1 * D, 0 * D, HB); } SEAM(1);
    if (IN(2)) {
        pg8::Gemm g{HB, (const bf16*)(ws + WS_WIN), M, NIN, D}; pg8::StaticOrder S; S.init(M, NIN, F.G, (int)blockIdx.x);
        pg8::EpiBf16 E{PROJ, NIN};
        pg8::gemm_phase<pg8::EpiBf16, pg8::StaticOrder, true, true>(F.lds, g, S, E);
    } SEAM(2);
    if (IN(3)) { p3_kv_conv(F); } SEAM(3);
    if (IN(4)) { p4_scan(F); } SEAM(4);
    if (IN(5)) { p5_retention(F); } SEAM(5);
    if (IN(6)) {
        { pg8::Gemm g{(const bf16*)(ws + WS_RETG), (const bf16*)(ws + WS_WBR), M, D, D}; pg8::StaticOrder S; S.init(M, D, F.G, (int)blockIdx.x);
          pg8::EpiGateF32 E{(float*)(ws + WS_MIXP), D, PROJ + OFF_MR, NIN};
          pg8::gemm_phase<pg8::EpiGateF32, pg8::StaticOrder, true, true>(F.lds, g, S, E); }
        asm volatile("s_waitcnt vmcnt(0)" ::: "memory"); __syncthreads();
        { pg8::Gemm g{(const bf16*)(ws + WS_CONVG), (const bf16*)(ws + WS_WBC), M, D, D}; pg8::StaticOrder S; S.init(M, D, F.G, (int)blockIdx.x);
          pg8::EpiMixBf16 E{(bf16*)(ws + WS_MIX), D, (const float*)(ws + WS_MIXP), PROJ + OFF_MC, NIN};
          pg8::gemm_phase<pg8::EpiMixBf16, pg8::StaticOrder, true, true>(F.lds, g, S, E); }
    } SEAM(6);
    if (IN(7)) {
#if MK_SKIP_MIXER
        for (size_t i = (size_t)F.vcu * NT + F.tid; i < (size_t)M * D / 4; i += (size_t)F.G * NT) ((f32x4*)(ws + WS_X1))[i] = ((const f32x4*)F.x)[i];
#else
        pg8::Gemm g{(const bf16*)(ws + WS_MIX), (const bf16*)(ws + WS_WO), M, D, D}; pg8::StaticOrder S; S.init(M, D, F.G, (int)blockIdx.x);
        pg8::EpiResid E{(float*)(ws + WS_X1), F.x, D, mod + 2 * D, NMOD, 13};
        pg8::gemm_phase<pg8::EpiResid, pg8::StaticOrder, true, true>(F.lds, g, S, E);
#endif
    } SEAM(7);
    if (IN(8)) { norm_mod_rows(F, (const float*)(ws + WS_X1), F.norm_ffn_g, 4 * D, 3 * D, HB); } SEAM(8);
    if (IN(9)) {
        { pg8::Gemm g{HB, (const bf16*)(ws + WS_WR), M, NE, D}; pg8::StaticOrder S; S.init(M, NE, F.G, (int)blockIdx.x);
          pg8::EpiF32 E{(float*)(ws + WS_LOGITS), NE};
          pg8::gemm_phase<pg8::EpiF32, pg8::StaticOrder, true, true>(F.lds, g, S, E); }
        { pg8::Gemm g{HB, (const bf16*)(ws + WS_WSGU), M, 2 * EH, D}; pg8::StaticOrder S; S.init(M, 2 * EH, F.G, (int)((blockIdx.x + F.G / 2) % F.G));
          pg8::EpiSwiglu E{(bf16*)(ws + WS_SHG), EH};
          pg8::gemm_phase<pg8::EpiSwiglu, pg8::StaticOrder, true, true>(F.lds, g, S, E); }
    } SEAM(9);
    if (IN(10)) {
#if !MK_SKIP_SHARED
        for (int rp_ = 0; rp_ < MK_P10_GEMM_REP; ++rp_)
        { pg8::Gemm g{(const bf16*)(ws + WS_SHG), (const bf16*)(ws + WS_WSD), M, D, EH}; pg8::StaticOrder S; S.init(M, D, F.G, (int)blockIdx.x);
          pg8::EpiResid E{(float*)(ws + WS_MIXP), (const float*)(ws + WS_X1), D, mod + 5 * D, NMOD, 13};
          pg8::gemm_phase<pg8::EpiResid, pg8::StaticOrder, true, true>(F.lds, g, S, E); }
#endif
        route_tokens(F);
    } SEAM(10);
    if (IN(11)) {
#if !MK_SKIP_ROUTED
#if MK_EXP_V == 1
#if MK_ABL_RT
        if (F.abl) p11_experts_k64<MK_ABL_PROBE>(F); else
#endif
        p11_experts_k64<0>(F);
#else
#if MK_ABL_RT
        if (F.abl) p11_experts<MK_ABL_PROBE>(F); else
#endif
        p11_experts<0>(F);
#endif
#endif
    } SEAM(11);
    if (IN(12)) { p12_final(F); }
#undef IN
#undef SEAM
}

extern "C" void kernel_launch(void* const* d_in, const int* in_sizes, int n_in, void* d_out, int out_size, void* d_ws, size_t ws_size, hipStream_t stream) {
    static int grid = 0;
    if (grid == 0) {
        if (n_in != 22 || in_sizes[0] != M * D || out_size != M * D || ws_size < WS_END) { fprintf(stderr, "kernel_launch: unexpected shapes (n_in %d, in0 %d, out %d, ws %zu, need %zu); nothing launched\n", n_in, n_in > 0 ? in_sizes[0] : -1, out_size, ws_size, (size_t)WS_END); grid = -1; return; }
        int dev = 0, cus = 0, per_cu = 0;
        if (hipGetDevice(&dev) != hipSuccess || hipDeviceGetAttribute(&cus, hipDeviceAttributeMultiprocessorCount, dev) != hipSuccess) { fprintf(stderr, "kernel_launch: device query failed\n"); grid = -1; return; }
        if (hipFuncSetAttribute((const void*)mk_fwd, hipFuncAttributeMaxDynamicSharedMemorySize, LDS_BYTES) != hipSuccess) { fprintf(stderr, "kernel_launch: hipFuncSetAttribute failed\n"); grid = -1; return; }
        if (hipOccupancyMaxActiveBlocksPerMultiprocessor(&per_cu, (const void*)mk_fwd, NT, LDS_BYTES) != hipSuccess || per_cu < 1) { fprintf(stderr, "kernel_launch: occupancy query reports %d workgroups per CU\n", per_cu); (void)hipGetLastError(); grid = -1; return; }
        grid = cus;
    }
    if (grid < 0) return;
    if (hipMemsetAsync((char*)d_ws + WS_CTL, 0, CTL_ZERO_BYTES, stream) != hipSuccess) { fprintf(stderr, "kernel_launch: hipMemsetAsync failed\n"); return; }
    Args a{};
    for (int i = 0; i < 22; ++i) a.in[i] = d_in[i];
    a.out = (float*)d_out; a.ws = (unsigned char*)d_ws;
#if MK_PER_PHASE
    for (int p = 0; p < NPHASE; ++p) { a.ph_lo = p; a.ph_hi = p + 1; hipLaunchKernelGGL(mk_fwd, dim3(grid), dim3(NT), LDS_BYTES, stream, a); }
#elif defined(MK_ABL_PROBE)
    a.ph_lo = 0; a.ph_hi = 12; a.li = 0; a.abl = 1; hipLaunchKernelGGL(mk_fwd, dim3(grid), dim3(NT), LDS_BYTES, stream, a);
    a.ph_lo = 11; a.ph_hi = NPHASE; a.li = 1; a.abl = 0; hipLaunchKernelGGL(mk_fwd, dim3(grid), dim3(NT), LDS_BYTES, stream, a);
#elif defined(MK_PROBE_LO)
    a.ph_lo = 0; a.ph_hi = MK_PROBE_HI; a.li = 0; hipLaunchKernelGGL(mk_fwd, dim3(grid), dim3(NT), LDS_BYTES, stream, a);
    a.ph_lo = MK_PROBE_LO; a.ph_hi = NPHASE; a.li = 1; hipLaunchKernelGGL(mk_fwd, dim3(grid), dim3(NT), LDS_BYTES, stream, a);
#else
    a.ph_lo = 0; a.ph_hi = NPHASE;
    hipLaunchKernelGGL(mk_fwd, dim3(grid), dim3(NT), LDS_BYTES, stream, a);
#endif
    const hipError_t le = hipPeekAtLastError();
    if (le != hipSuccess) fprintf(stderr, "kernel_launch: launch failed: %s\n", hipGetErrorName(le));
}
```

```cpp
#include <hip/hip_runtime.h>
#include <cstdio>
#include <cstdint>
#define MK_EXP_V 2
namespace pg8 {
#define PG8_LAS __attribute__((address_space(3)))
typedef unsigned short bf16_t;
typedef short bf16x8 __attribute__((ext_vector_type(8)));
typedef float f32x4 __attribute__((ext_vector_type(4)));
typedef unsigned u32x4 __attribute__((ext_vector_type(4)));
constexpr int BM = 256, BK = 64, HALF = 128, HTB = HALF * BK * 2  , STAGE_BYTES = 8 * HTB, NXCD = 8, WGM = 8;

__host__ __device__ __forceinline__ int lds_byte(int r, int c) { const int st = (r >> 4) * 2 + (c >> 5), rr = r & 15, cc = c & 31, ob = rr * 64 + cc * 2; return st * 1024 + (ob ^ (((ob >> 9) & 1) << 5)); }
__host__ __device__ __forceinline__ void stage_rc(int b, int& R, int& C) { const int st = b / 1024, sb = b % 1024, swz = sb ^ (((sb >> 9) & 1) << 5); R = (st >> 1) * 16 + swz / 64; C = (st & 1) * 32 + (swz % 64) / 2; }
__host__ __device__ __forceinline__ int perm32(int rho) { const int n = rho >> 4, i = rho & 15; return 8 * (i >> 2) + 4 * n + (i & 3); }

struct Unit { int pm, pn; };
struct Gemm { const bf16_t* A; const bf16_t* Bt; int M, N, K; };

struct StaticOrder {
    int nM, nN, nwg, G, c;
    __host__ __device__ void init(int M, int N, int G_, int c_) { nM = M / BM; nN = N / BM; nwg = nM * nN; G = G_; c = c_; }
    __host__ __device__ bool next(int i, Unit& u) const {
        const long L = (long)i * G + c; if (L >= nwg) return false;
        int wgid = (int)L; { const int q = nwg / NXCD, r = nwg % NXCD, xcd = wgid % NXCD, off = wgid / NXCD; wgid = (xcd < r ? xcd * (q + 1) : r * (q + 1) + (xcd - r) * q) + off; }
        const int nig = WGM * nN, gid = wgid / nig, fm = gid * WGM, gsz = (nM - fm) < WGM ? (nM - fm) : WGM;
        u.pm = fm + ((wgid % nig) % gsz); u.pn = (wgid % nig) / gsz; return true;
    }
    __device__ __forceinline__ void a_ready(const Unit&) const {}
    __device__ __forceinline__ void done(const Unit&) const {}
};

__device__ __forceinline__ unsigned cvt_pk_bf16(float lo, float hi) { unsigned r; asm volatile("v_cvt_pk_bf16_f32 %0, %1, %2" : "=v"(r) : "v"(lo), "v"(hi)); return r; }
typedef float f32x2 __attribute__((ext_vector_type(2)));
typedef unsigned u32x2 __attribute__((ext_vector_type(2)));
__device__ __forceinline__ float bf_lo(unsigned w) { return __uint_as_float(w << 16); }
__device__ __forceinline__ float bf_hi(unsigned w) { return __uint_as_float(w & 0xffff0000u); }
__device__ __forceinline__ float sigm(float x) { return 1.0f / (1.0f + __expf(-x)); }
__device__ __forceinline__ float silu_f(float x) { return x / (1.0f + __expf(-x)); }

struct EpiBf16 {
    static constexpr bool PERM = true, AFTER_DRAIN = false;
    bf16_t* O; int ldc;
    __device__ __forceinline__ void operator()(const f32x4 (&acc)[2][2][4][2], const Unit& u, int wr, int wc, int fr, int fq) const {
        const int row0 = u.pm * BM + wr * 64 + fr; const int col0 = u.pn * BM + wc * 32 + 8 * fq;
#pragma unroll
        for (int ai = 0; ai < 2; ++ai)
#pragma unroll
            for (int m = 0; m < 4; ++m) { bf16_t* rowp = O + (size_t)(row0 + ai * HALF + m * 16) * ldc + col0;
#pragma unroll
                for (int bj = 0; bj < 2; ++bj) { const f32x4 v0 = acc[ai][bj][m][0], v1 = acc[ai][bj][m][1];
                    u32x4 w; w.x = cvt_pk_bf16(v0[0], v0[1]); w.y = cvt_pk_bf16(v0[2], v0[3]); w.z = cvt_pk_bf16(v1[0], v1[1]); w.w = cvt_pk_bf16(v1[2], v1[3]);
                    *(u32x4*)(rowp + bj * HALF) = w; } }
    }
};
struct EpiF32 {
    static constexpr bool PERM = false, AFTER_DRAIN = false;
    float* C; int ldc;
    __device__ __forceinline__ void operator()(const f32x4 (&acc)[2][2][4][2], const Unit& u, int wr, int wc, int fr, int fq) const {
        const int row0 = u.pm * BM + wr * 64 + fr, col0 = u.pn * BM + wc * 32 + 4 * fq;
#pragma unroll
        for (int ai = 0; ai < 2; ++ai)
#pragma unroll
            for (int m = 0; m < 4; ++m) { float* rowp = C + (size_t)(row0 + ai * HALF + m * 16) * ldc + col0;
#pragma unroll
                for (int bj = 0; bj < 2; ++bj)
#pragma unroll
                    for (int n = 0; n < 2; ++n) *(f32x4*)(rowp + bj * HALF + n * 16) = acc[ai][bj][m][n]; }
    }
};
struct EpiGateF32 {
    static constexpr bool PERM = false, AFTER_DRAIN = false;
    float* C; int ldc; const bf16_t* gate; int ldg;
    __device__ __forceinline__ void operator()(const f32x4 (&acc)[2][2][4][2], const Unit& u, int wr, int wc, int fr, int fq) const {
        const int row0 = u.pm * BM + wr * 64 + fr, col0 = u.pn * BM + wc * 32 + 4 * fq;
#pragma unroll
        for (int ai = 0; ai < 2; ++ai)
#pragma unroll
            for (int m = 0; m < 4; ++m) { const size_t r = (size_t)(row0 + ai * HALF + m * 16); float* rowp = C + r * ldc + col0; const bf16_t* gp = gate + r * ldg + col0;
#pragma unroll
                for (int bj = 0; bj < 2; ++bj)
#pragma unroll
                    for (int n = 0; n < 2; ++n) { const u32x2 g = *(const u32x2*)(gp + bj * HALF + n * 16); const f32x4 a = acc[ai][bj][m][n];
                        f32x4 o; o[0] = sigm(bf_lo(g.x)) * a[0]; o[1] = sigm(bf_hi(g.x)) * a[1]; o[2] = sigm(bf_lo(g.y)) * a[2]; o[3] = sigm(bf_hi(g.y)) * a[3];
                        *(f32x4*)(rowp + bj * HALF + n * 16) = o; } }
    }
};
struct EpiMixBf16 {
    static constexpr bool PERM = true, AFTER_DRAIN = false;
    bf16_t* O; int ldc; const float* P; const bf16_t* gate; int ldg;
    __device__ __forceinline__ void operator()(const f32x4 (&acc)[2][2][4][2], const Unit& u, int wr, int wc, int fr, int fq) const {
        const int row0 = u.pm * BM + wr * 64 + fr; const int col0 = u.pn * BM + wc * 32 + 8 * fq;
#pragma unroll
        for (int ai = 0; ai < 2; ++ai)
#pragma unroll
            for (int m = 0; m < 4; ++m) { const size_t r = (size_t)(row0 + ai * HALF + m * 16); bf16_t* rowp = O + r * ldc + col0; const float* pp = P + r * ldc + col0; const bf16_t* gp = gate + r * ldg + col0;
#pragma unroll
                for (int bj = 0; bj < 2; ++bj) { const f32x4 v0 = acc[ai][bj][m][0], v1 = acc[ai][bj][m][1];
                    const u32x4 g = *(const u32x4*)(gp + bj * HALF); const f32x4 p0 = *(const f32x4*)(pp + bj * HALF), p1 = *(const f32x4*)(pp + bj * HALF + 4);
                    const float o0 = p0[0] + sigm(bf_lo(g.x)) * v0[0], o1 = p0[1] + sigm(bf_hi(g.x)) * v0[1], o2 = p0[2] + sigm(bf_lo(g.y)) * v0[2], o3 = p0[3] + sigm(bf_hi(g.y)) * v0[3];
                    const float o4 = p1[0] + sigm(bf_lo(g.z)) * v1[0], o5 = p1[1] + sigm(bf_hi(g.z)) * v1[1], o6 = p1[2] + sigm(bf_lo(g.w)) * v1[2], o7 = p1[3] + sigm(bf_hi(g.w)) * v1[3];
                    u32x4 w; w.x = cvt_pk_bf16(o0, o1); w.y = cvt_pk_bf16(o2, o3); w.z = cvt_pk_bf16(o4, o5); w.w = cvt_pk_bf16(o6, o7);
                    *(u32x4*)(rowp + bj * HALF) = w; } }
    }
};
struct EpiResid {
    static constexpr bool PERM = false, AFTER_DRAIN = false;
    float* C; const float* base; int ldc; const float* gvec; int gstride; int rows_per_b_shift;
    __device__ __forceinline__ void operator()(const f32x4 (&acc)[2][2][4][2], const Unit& u, int wr, int wc, int fr, int fq) const {
        const int row0 = u.pm * BM + wr * 64 + fr, col0 = u.pn * BM + wc * 32 + 4 * fq;
        const float* gp = gvec + (size_t)((u.pm * BM) >> rows_per_b_shift) * gstride + col0;
        f32x4 gv[2][2];
#pragma unroll
        for (int bj = 0; bj < 2; ++bj)
#pragma unroll
            for (int n = 0; n < 2; ++n) gv[bj][n] = *(const f32x4*)(gp + bj * HALF + n * 16);
#pragma unroll
        for (int ai = 0; ai < 2; ++ai)
#pragma unroll
            for (int m = 0; m < 4; ++m) { const size_t off = (size_t)(row0 + ai * HALF + m * 16) * ldc + col0;
#pragma unroll
                for (int bj = 0; bj < 2; ++bj)
#pragma unroll
                    for (int n = 0; n < 2; ++n) { const f32x4 b = *(const f32x4*)(base + off + bj * HALF + n * 16);
                        *(f32x4*)(C + off + bj * HALF + n * 16) = b + gv[bj][n] * acc[ai][bj][m][n]; } }
    }
};
struct EpiSwiglu {
    static constexpr bool PERM = true, AFTER_DRAIN = false;
    bf16_t* O; int ldo;
    __device__ __forceinline__ void operator()(const f32x4 (&acc)[2][2][4][2], const Unit& u, int wr, int wc, int fr, int fq) const {
        const int row0 = u.pm * BM + wr * 64 + fr; const int col0 = u.pn * BM + wc * 32 + 8 * fq;
#pragma unroll
        for (int ai = 0; ai < 2; ++ai)
#pragma unroll
            for (int m = 0; m < 4; ++m) { bf16_t* rowp = O + (size_t)(row0 + ai * HALF + m * 16) * ldo + (col0 >> 1);
#pragma unroll
                for (int bj = 0; bj < 2; ++bj) { const f32x4 v0 = acc[ai][bj][m][0], v1 = acc[ai][bj][m][1];
                    const float g0 = silu_f(v0[0]) * v0[1], g1 = silu_f(v0[2]) * v0[3], g2 = silu_f(v1[0]) * v1[1], g3 = silu_f(v1[2]) * v1[3];
                    u32x2 w; w.x = cvt_pk_bf16(g0, g1); w.y = cvt_pk_bf16(g2, g3);
                    *(u32x2*)(rowp + bj * (HALF / 2)) = w; } }
    }
};
template <class Epi, class Sched, bool ALIGN_EPI = false, bool SP2 = false>
__device__ __forceinline__ void gemm_phase(PG8_LAS unsigned char* lds, const Gemm g, const Sched& S, const Epi& E) {
    const int tid = threadIdx.x, wid = __builtin_amdgcn_readfirstlane(tid >> 6), lane = tid & 63, wr = wid >> 2, wc = wid & 3, fr = lane & 15, fq = lane >> 4;
    const int K = g.K, nt = K / BK;
    unsigned voffA[2], voffB[2];
#pragma unroll
    for (int i = 0; i < 2; ++i) { int R, C; stage_rc(tid * 16 + i * 8192, R, C); const int Rb = Epi::PERM ? ((R & ~31) + perm32(R & 31)) : R;
        voffA[i] = (unsigned)(R * K + C) * 2u; voffB[i] = (unsigned)(Rb * K + C) * 2u; }
    const size_t kstep = (size_t)(BK * 2);
    const size_t hstep = (size_t)HALF * K * 2;
    const size_t tstep = 2 * hstep;
    const unsigned ldsw = (unsigned)wid * 1024u;
    const int aoff = lds_byte(wr * 64 + fr, fq * 8), boff = lds_byte(wc * 32 + fr, fq * 8);
#define PG8_SA(b, h) (((b) * 2 + (h)) * HTB)
#define PG8_SB(b, h) ((4 + (b) * 2 + (h)) * HTB)
#define PG8_STAGE(bufoff, gbase, voff) do { _Pragma("unroll") for (int _i = 0; _i < 2; ++_i) \
        __builtin_amdgcn_global_load_lds((const unsigned*)((const char*)(gbase) + (voff)[_i]), (PG8_LAS unsigned*)(lds + (bufoff) + ldsw + _i * 8192), 16, 0, 0); } while (0)
#define PG8_LDA(dst, b, h) do { _Pragma("unroll") for (int m = 0; m < 4; ++m) _Pragma("unroll") for (int k = 0; k < 2; ++k) dst[m][k] = *(const PG8_LAS bf16x8*)(lds + PG8_SA(b, h) + aoff + m * 2048 + k * 1024); } while (0)
#define PG8_LDB(dst, b, h) do { _Pragma("unroll") for (int n = 0; n < 2; ++n) _Pragma("unroll") for (int k = 0; k < 2; ++k) dst[n][k] = *(const PG8_LAS bf16x8*)(lds + PG8_SB(b, h) + boff + n * 2048 + k * 1024); } while (0)
#define PG8_MMA(ai, bj, At, Bt) do { __builtin_amdgcn_s_setprio(1); _Pragma("unroll") for (int m = 0; m < 4; ++m) _Pragma("unroll") for (int n = 0; n < 2; ++n) _Pragma("unroll") for (int k = 0; k < 2; ++k) \
        acc[ai][bj][m][n] = __builtin_amdgcn_mfma_f32_16x16x32_bf16(Bt[n][k], At[m][k], acc[ai][bj][m][n], 0, 0, 0); __builtin_amdgcn_s_setprio(0); } while (0)
#define PG8_WAIT_V(n) asm volatile("s_waitcnt vmcnt(" #n ")" ::: "memory")
#define PG8_WAIT_L(n) asm volatile("s_waitcnt lgkmcnt(" #n ")" ::: "memory")
#define PG8_BAR __builtin_amdgcn_s_barrier()
#define PG8_SCHED __builtin_amdgcn_sched_barrier(0)
    Unit cur, nxt; int ui = 0;
    if (!S.next(0, cur)) return;
    f32x4 acc[2][2][4][2];
#pragma unroll
    for (int a = 0; a < 2; ++a)
#pragma unroll
        for (int b = 0; b < 2; ++b)
#pragma unroll
            for (int m = 0; m < 4; ++m)
#pragma unroll
                for (int n = 0; n < 2; ++n) acc[a][b][m][n] = (f32x4){0.f, 0.f, 0.f, 0.f};
    bf16x8 At[4][2], B0[2][2], B1[2][2];
    const char* cA = (const char*)g.A + (size_t)cur.pm * tstep; const char* cB = (const char*)g.Bt + (size_t)cur.pn * tstep;
    S.a_ready(cur);
    if constexpr (SP2) {
        PG8_STAGE(PG8_SB(0, 0), cB, voffB); PG8_STAGE(PG8_SB(0, 1), cB + hstep, voffB); PG8_STAGE(PG8_SA(0, 0), cA, voffA); PG8_STAGE(PG8_SA(0, 1), cA + hstep, voffA);
        if (wr == 1) PG8_BAR;
        PG8_WAIT_V(2); PG8_BAR;
        PG8_STAGE(PG8_SB(1, 0), cB + kstep, voffB); PG8_STAGE(PG8_SA(1, 0), cA + kstep, voffA); PG8_STAGE(PG8_SB(1, 1), cB + hstep + kstep, voffB);
        PG8_WAIT_V(6); PG8_BAR;
    } else {
        PG8_STAGE(PG8_SB(0, 0), cB, voffB); PG8_STAGE(PG8_SA(0, 0), cA, voffA); PG8_STAGE(PG8_SB(0, 1), cB + hstep, voffB); PG8_STAGE(PG8_SA(0, 1), cA + hstep, voffA);
        if (wr == 1) PG8_BAR;
        PG8_WAIT_V(4); PG8_BAR;
        PG8_STAGE(PG8_SB(1, 0), cB + kstep, voffB); PG8_STAGE(PG8_SA(1, 0), cA + kstep, voffA); PG8_STAGE(PG8_SB(1, 1), cB + hstep + kstep, voffB);
        PG8_WAIT_V(6); PG8_BAR;
    }
    for (;;) {
        const bool has_next = S.next(ui + 1, nxt);
        const char* nA = has_next ? (const char*)g.A + (size_t)nxt.pm * tstep : cA; const char* nB = has_next ? (const char*)g.Bt + (size_t)nxt.pn * tstep : cB;
        for (int t = 0; t < nt; t += 2) {
            const bool last = (t == nt - 2);
            const char* a1 = cA + (size_t)(t + 1) * kstep;
            const char* a2 = last ? nA : cA + (size_t)(t + 2) * kstep; const char* b2 = last ? nB : cB + (size_t)(t + 2) * kstep;
            const char* a3 = a2 + kstep; const char* b3 = b2 + kstep;
            if (last && has_next) S.a_ready(nxt);
            if constexpr (SP2) {
            PG8_LDB(B0, 0, 0); PG8_LDB(B1, 0, 1); PG8_SCHED; PG8_LDA(At, 0, 0); PG8_STAGE(PG8_SA(1, 1), a1 + hstep, voffA);
            PG8_WAIT_V(8); PG8_WAIT_L(0); PG8_BAR; PG8_MMA(0, 0, At, B0); PG8_MMA(0, 1, At, B1); PG8_BAR; PG8_SCHED;
            PG8_LDA(At, 0, 1); PG8_STAGE(PG8_SB(0, 0), b2, voffB); PG8_STAGE(PG8_SB(0, 1), b2 + hstep, voffB); PG8_STAGE(PG8_SA(0, 0), a2, voffA);
            PG8_WAIT_V(8); PG8_WAIT_L(0); PG8_BAR; PG8_MMA(1, 0, At, B0); PG8_MMA(1, 1, At, B1); PG8_BAR; PG8_SCHED;
            PG8_LDB(B0, 1, 0); PG8_LDB(B1, 1, 1); PG8_SCHED; PG8_LDA(At, 1, 0); PG8_STAGE(PG8_SA(0, 1), a2 + hstep, voffA);
            PG8_WAIT_V(8); PG8_WAIT_L(0); PG8_BAR; PG8_MMA(0, 0, At, B0); PG8_MMA(0, 1, At, B1); PG8_BAR; PG8_SCHED;
            PG8_LDA(At, 1, 1); PG8_STAGE(PG8_SB(1, 0), b3, voffB); PG8_STAGE(PG8_SB(1, 1), b3 + hstep, voffB); PG8_STAGE(PG8_SA(1, 0), a3, voffA);
            PG8_WAIT_V(8); PG8_WAIT_L(0); PG8_BAR; PG8_MMA(1, 0, At, B0); PG8_MMA(1, 1, At, B1); PG8_BAR; PG8_SCHED;
            } else {
            PG8_LDB(B0, 0, 0); PG8_SCHED; PG8_LDA(At, 0, 0); PG8_STAGE(PG8_SA(1, 1), a1 + hstep, voffA);
            PG8_WAIT_L(8); PG8_BAR; PG8_WAIT_L(0); PG8_MMA(0, 0, At, B0); PG8_BAR; PG8_SCHED;
            PG8_LDB(B1, 0, 1); PG8_STAGE(PG8_SB(0, 0), b2, voffB);
            PG8_BAR; PG8_WAIT_L(0); PG8_MMA(0, 1, At, B1); PG8_BAR;
            PG8_LDA(At, 0, 1); PG8_STAGE(PG8_SA(0, 0), a2, voffA);
            PG8_BAR; PG8_WAIT_L(0); PG8_MMA(1, 0, At, B0); PG8_BAR; PG8_SCHED;
            PG8_STAGE(PG8_SB(0, 1), b2 + hstep, voffB);
            PG8_WAIT_V(6); PG8_BAR; PG8_MMA(1, 1, At, B1); PG8_BAR;
            PG8_LDB(B0, 1, 0); PG8_SCHED; PG8_LDA(At, 1, 0); PG8_STAGE(PG8_SA(0, 1), a2 + hstep, voffA);
            PG8_WAIT_L(8); PG8_BAR; PG8_WAIT_L(0); PG8_MMA(0, 0, At, B0); PG8_BAR; PG8_SCHED;
            PG8_LDB(B1, 1, 1); PG8_STAGE(PG8_SB(1, 0), b3, voffB);
            PG8_BAR; PG8_WAIT_L(0); PG8_MMA(0, 1, At, B1); PG8_BAR;
            PG8_LDA(At, 1, 1); PG8_STAGE(PG8_SA(1, 0), a3, voffA);
            PG8_BAR; PG8_WAIT_L(0); PG8_MMA(1, 0, At, B0); PG8_BAR; PG8_SCHED;
            PG8_STAGE(PG8_SB(1, 1), b3 + hstep, voffB);
            PG8_WAIT_V(6); PG8_BAR; PG8_MMA(1, 1, At, B1); PG8_BAR;
            }
        }
        if constexpr (ALIGN_EPI) { if (wr == 0) PG8_BAR; }
        if constexpr (!Epi::AFTER_DRAIN) { E(acc, cur, wr, wc, fr, fq); S.done(cur); }
        if (!has_next) break;
#pragma unroll
        for (int a = 0; a < 2; ++a)
#pragma unroll
            for (int b = 0; b < 2; ++b)
#pragma unroll
                for (int m = 0; m < 4; ++m)
#pragma unroll
                    for (int n = 0; n < 2; ++n) acc[a][b][m][n] = (f32x4){0.f, 0.f, 0.f, 0.f};
        cur = nxt; cA = nA; cB = nB; ++ui;
        if constexpr (ALIGN_EPI) { if (wr == 1) PG8_BAR; }
    }
    PG8_WAIT_V(0);
    if constexpr (!ALIGN_EPI) { if (wr == 0) PG8_BAR; }
    PG8_BAR;
    if constexpr (Epi::AFTER_DRAIN) { E.fused(acc, cur, wr, wc, fr, fq, lds, wid, lane); S.done(cur); }
#undef PG8_SA
#undef PG8_SB
#undef PG8_STAGE
#undef PG8_LDA
#undef PG8_LDB
#undef PG8_MMA
#undef PG8_WAIT_V
#undef PG8_WAIT_L
#undef PG8_BAR
#undef PG8_SCHED
}
}

constexpr int NWAVES = 8, NT = 512;
#ifndef MK_PER_PHASE
#define MK_PER_PHASE 0
#endif
#ifndef MK_EXP_V
#define MK_EXP_V 1
#endif
#ifndef MK_TIMER_PHASE
#define MK_TIMER_PHASE -1
#endif
#ifndef MK_ABL_RT
#define MK_ABL_RT 0
#endif
#ifndef MK_P10_GEMM_REP
#define MK_P10_GEMM_REP 1
#endif
#ifndef MK_SKIP_MIXER
#define MK_SKIP_MIXER 0
#endif
#ifndef MK_SKIP_SHARED
#define MK_SKIP_SHARED 0
#endif
#ifndef MK_SKIP_ROUTED
#define MK_SKIP_ROUTED 0
#endif
constexpr int NPHASE = 13;
constexpr int BATCH = 2, SEQ = 8192, D = 1024, M = BATCH * SEQ, NIN = 8192, NMOD = 6144;
constexpr int OFF_Q = 0, OFF_K = 512, OFF_V = 1024, OFF_GR = 2048, OFF_U = 3072, OFF_GC = 4096, OFF_GB = 5120, OFF_MR = 6144, OFF_MC = 7168;
constexpr int NE = 256, TOPK = 8, EH = 256, CAP = 16384, NCH = 64, CH = 128, NH = 4, DK = 128, DV = 256;
constexpr float EPS = 1e-6f;

constexpr size_t MiB = (size_t)1 << 20;
constexpr size_t WS_CTL = 0, CTL_ZERO_BYTES = 1 * MiB;
constexpr size_t WS_MOD = 1 * MiB;
constexpr size_t WS_ROPE = 2 * MiB;
constexpr size_t WS_WR = 10 * MiB;
constexpr size_t WS_WSGU = 11 * MiB;
constexpr size_t WS_WSD = 12 * MiB;
constexpr size_t WS_WBR = 13 * MiB, WS_WBC = 15 * MiB, WS_WO = 17 * MiB;
constexpr size_t WS_WIN = 20 * MiB;
constexpr size_t WS_HB = 36 * MiB;
constexpr size_t WS_PROJ = 68 * MiB;
constexpr size_t WS_KV = 324 * MiB;
constexpr size_t WS_SP = 388 * MiB;
constexpr size_t WS_RETG = 420 * MiB;
constexpr size_t WS_CONVG = 452 * MiB;
constexpr size_t WS_MIXP = 484 * MiB;
constexpr size_t WS_MIX = 548 * MiB;
constexpr size_t WS_X1 = 580 * MiB;
constexpr size_t WS_LOGITS = 644 * MiB;
constexpr size_t WS_SHG = 660 * MiB;
constexpr size_t WS_EIDX = 668 * MiB, WS_POS = 669 * MiB;
constexpr size_t WS_LTOK = 670 * MiB, WS_LW = 686 * MiB;
constexpr size_t WS_YP = 702 * MiB;
constexpr size_t WS_END = 958 * MiB;
constexpr int CW_TMO = 0, CW_CODE = 1, CW_BAR = 4096, CW_CNT = 16384;

constexpr int LDSCTL_OFF = 143360, MISC_OFF = LDSCTL_OFF + 320, LDS_BYTES = 147456;

#define GAS __attribute__((address_space(1)))
#define LAS __attribute__((address_space(3)))
typedef unsigned short bf16;
typedef unsigned v4u __attribute__((ext_vector_type(4)));
typedef unsigned v2u __attribute__((ext_vector_type(2)));
typedef float f32x4 __attribute__((ext_vector_type(4)));
typedef float f32x2 __attribute__((ext_vector_type(2)));
typedef short bf16x8 __attribute__((ext_vector_type(8)));
typedef short s16x4 __attribute__((ext_vector_type(4)));
typedef GAS unsigned gu32;
#define RLX_AGENT __ATOMIC_RELAXED, __HIP_MEMORY_SCOPE_AGENT
__device__ __forceinline__ unsigned f2bf(float f) { unsigned u = __builtin_bit_cast(unsigned, f); return (u + 0x7fffu + ((u >> 16) & 1u)) >> 16; }
__device__ __forceinline__ unsigned pk2(float lo, float hi) { unsigned r; asm volatile("v_cvt_pk_bf16_f32 %0, %1, %2" : "=v"(r) : "v"(lo), "v"(hi)); return r; }
__device__ __forceinline__ float bflo(unsigned w) { return __uint_as_float(w << 16); }
__device__ __forceinline__ float bfhi(unsigned w) { return __uint_as_float(w & 0xffff0000u); }
__device__ __forceinline__ float sigmoidf_(float x) { return 1.0f / (1.0f + __expf(-x)); }
__device__ __forceinline__ float siluf_(float x) { return x / (1.0f + __expf(-x)); }

#define XB_TMO      128
#define XB_XCNT(j)  (256  + 64 * (j))
#define XB_XSUB(j)  (1280 + 64 * (j))
#define XB_XGEN(j)  (2304 + 64 * (j))
#define XB_TOP      3328
#define XB_TOPGEN   3392
#define XCD_BAR_WORDS 3456
#define XB_SPIN_CAP (1u << 18)

__device__ __forceinline__ unsigned xb_ld(unsigned* p)              { return __hip_atomic_load(p, __ATOMIC_RELAXED, __HIP_MEMORY_SCOPE_AGENT); }
__device__ __forceinline__ unsigned xb_add(unsigned* p, unsigned v) { return __hip_atomic_fetch_add(p, v, __ATOMIC_RELAXED, __HIP_MEMORY_SCOPE_AGENT); }
__device__ __forceinline__ unsigned xb_xcc_id() { return (unsigned)__builtin_amdgcn_s_getreg((3 << 11) | 20) & 0xFu; }
#define XB_SPIN(cond, bar) do { unsigned _sp = 0; while (cond) { __builtin_amdgcn_s_sleep(1); \
    if ((++_sp & 255u) == 0u) { if (xb_ld(&(bar)[XB_TMO])) break; if (_sp > XB_SPIN_CAP) { atomicAdd(&(bar)[XB_TMO], 1u); break; } } } } while (0)

struct XcdBarrier {
    unsigned* bar; unsigned x;
    volatile LAS unsigned* st;
};

__device__ __forceinline__ XcdBarrier xcd_barrier_post(unsigned* bar, volatile LAS unsigned* st) {
    XcdBarrier b; b.bar = bar; b.x = xb_xcc_id(); b.st = st;
    if (threadIdx.x == 0) (void)xb_add(&bar[XB_XCNT(b.x)], 1u);
    return b;
}
__device__ __forceinline__ void xcd_barrier_complete(unsigned* bar, unsigned x, unsigned& nloc, unsigned& nx) {
    const unsigned G = gridDim.x * gridDim.y * gridDim.z;
    unsigned sum, cnt, mine, sp = 0u;
    for (;;) {
        sum = 0u; cnt = 0u; mine = 0u;
#pragma unroll
        for (unsigned j = 0; j < 16; ++j) { const unsigned c = xb_ld(&bar[XB_XCNT(j)]); sum += c; cnt += (c > 0u) ? 1u : 0u; mine = (j == x) ? c : mine; }
        if (sum == G) break;
        __builtin_amdgcn_s_sleep(1);
        if ((++sp & 255u) == 0u) { if (xb_ld(&bar[XB_TMO])) break; if (sp > XB_SPIN_CAP) { atomicAdd(&bar[XB_TMO], 1u); break; } }
    }
    nloc = mine > 0u ? mine : 1u; nx = cnt > 0u ? cnt : 1u;
}

__device__ __forceinline__ void xcd_barrier(const XcdBarrier& b) {
    asm volatile("s_waitcnt vmcnt(0)" ::: "memory");
    __syncthreads();
    if (threadIdx.x == 0) {
        unsigned* bar = b.bar;
        __builtin_amdgcn_s_waitcnt(0);
        unsigned nloc = b.st[0], nx = b.st[1];
        if (nloc == 0u) { xcd_barrier_complete(bar, b.x, nloc, nx); b.st[0] = nloc; b.st[1] = nx; }
        const unsigned old = xb_add(&bar[XB_XSUB(b.x)], 1u);
        const unsigned gen = old / nloc;
        if (old + 1u == (gen + 1u) * nloc) {
            __builtin_amdgcn_fence(__ATOMIC_RELEASE, "agent");
            asm volatile("s_waitcnt vmcnt(0)" ::: "memory");
            const unsigned og = xb_add(&bar[XB_TOP], 1u);
            const unsigned tg = og / nx;
            if (og + 1u == (tg + 1u) * nx) xb_add(&bar[XB_TOPGEN], 1u);
            else XB_SPIN(xb_ld(&bar[XB_TOPGEN]) == tg, bar);
            __builtin_amdgcn_fence(__ATOMIC_ACQUIRE, "agent");
            xb_add(&bar[XB_XGEN(b.x)], 1u);
            asm volatile("s_waitcnt vmcnt(0)" ::: "memory");
        } else {
            XB_SPIN(xb_ld(&bar[XB_XGEN(b.x)]) == gen, bar);
            __builtin_amdgcn_fence(__ATOMIC_ACQUIRE, "agent");
            asm volatile("s_waitcnt vmcnt(0)" ::: "memory");
        }
    }
    __syncthreads();
}

struct Frame {
    LAS unsigned char* lds; unsigned ldsb;
    volatile LAS unsigned* MISC; gu32* ctl;
    int tid, lane, wave, vcu, G, abl;
    const float *x, *c; const int* pos; const float *w_ada, *b_ada, *norm_mix_g, *w_in, *ret_norm_g, *conv_w, *w_br_ret, *w_br_conv, *w_out, *norm_ffn_g, *w_router, *router_bias,
        *w_eg, *w_eu, *w_ed, *w_sg, *w_su, *w_sd, *norm_final_g;
    float* out; unsigned char* ws;
};
__device__ __forceinline__ float wave_sum(float v) {
#pragma unroll
    for (int o = 1; o < 64; o <<= 1) v += __shfl_xor(v, o);
    return v;
}

__device__ __forceinline__ void p0_mod_task(Frame& F, int j) {
    const int cq = F.tid & 15, kq = F.tid >> 4;
    f32x4 a0 = {0.f, 0.f, 0.f, 0.f}, a1 = {0.f, 0.f, 0.f, 0.f};
    const float* W = F.w_ada + 64 * j + 4 * cq;
#pragma unroll 8
    for (int i = 0; i < 32; ++i) { const int k = kq + 32 * i; const float c0 = F.c[k], c1 = F.c[1024 + k];
        const float s0 = c0 / (1.0f + expf(-c0)), s1 = c1 / (1.0f + expf(-c1));
        const f32x4 w = *(const f32x4*)(W + (size_t)k * NMOD); a0 += s0 * w; a1 += s1 * w; }
    LAS f32x4* red = (LAS f32x4*)F.lds;
    red[(kq * 2 + 0) * 16 + cq] = a0; red[(kq * 2 + 1) * 16 + cq] = a1;
    __syncthreads();
    if (F.tid < 32) { const int b = F.tid >> 4, c2 = F.tid & 15; f32x4 s = *(const f32x4*)(F.b_ada + 64 * j + 4 * c2);
        for (int k2 = 0; k2 < 32; ++k2) s += red[(k2 * 2 + b) * 16 + c2];
        *(f32x4*)((float*)(F.ws + WS_MOD) + b * NMOD + 64 * j + 4 * c2) = s; }
    __syncthreads();
}
__device__ __forceinline__ void p0_transpose_item(const float* W, int K, int N, bf16* WT, int row_off, int row_mul, LAS float* scr, int item, int lane) {
    const int nblk = N / 32, kb = item / nblk, nb = item % nblk, k0 = 64 * kb, n0 = 32 * nb;
#pragma unroll 8
    for (int i = 0; i < 32; ++i) { const int kk = 2 * i + (lane >> 5); scr[kk * 33 + (lane & 31)] = W[(size_t)(k0 + kk) * N + n0 + (lane & 31)]; }
    asm volatile("s_waitcnt lgkmcnt(0)" ::: "memory");
    const int c = lane & 7;
#pragma unroll
    for (int j = 0; j < 4; ++j) { const int n = (lane >> 3) + 8 * j; const LAS float* s = scr + (8 * c) * 33 + n;
        v4u o; o.x = pk2(s[0 * 33], s[1 * 33]); o.y = pk2(s[2 * 33], s[3 * 33]); o.z = pk2(s[4 * 33], s[5 * 33]); o.w = pk2(s[6 * 33], s[7 * 33]);
        *(v4u*)(WT + (size_t)(row_off + row_mul * (n0 + n)) * K + k0 + 8 * c) = o; }
    asm volatile("s_waitcnt lgkmcnt(0)" ::: "memory");
}
__device__ __forceinline__ void p0_prologue(Frame& F) {
    if ((int)blockIdx.x < NMOD / 64) p0_mod_task(F, (int)blockIdx.x);
    LAS float* scr = (LAS float*)(F.lds + F.wave * 16384);
    const int gw = F.vcu * NWAVES + F.wave, NGW = F.G * NWAVES;
    constexpr int I_IN = (D / 64) * (NIN / 32), I_SQ = (D / 64) * (D / 32), I_R = (D / 64) * (256 / 32), I_SD = (256 / 64) * (D / 32);
    constexpr int NITEMS = I_IN + 3 * I_SQ + 3 * I_R + I_SD;
    unsigned char* ws = F.ws;
    for (int it = gw; it < NITEMS; it += NGW) {
        int r = it;
        if (r < I_IN) { p0_transpose_item(F.w_in, D, NIN, (bf16*)(ws + WS_WIN), 0, 1, scr, r, F.lane); continue; } r -= I_IN;
        if (r < I_SQ) { p0_transpose_item(F.w_br_ret, D, D, (bf16*)(ws + WS_WBR), 0, 1, scr, r, F.lane); continue; } r -= I_SQ;
        if (r < I_SQ) { p0_transpose_item(F.w_br_conv, D, D, (bf16*)(ws + WS_WBC), 0, 1, scr, r, F.lane); continue; } r -= I_SQ;
        if (r < I_SQ) { p0_transpose_item(F.w_out, D, D, (bf16*)(ws + WS_WO), 0, 1, scr, r, F.lane); continue; } r -= I_SQ;
        if (r < I_R) { p0_transpose_item(F.w_router, D, NE, (bf16*)(ws + WS_WR), 0, 1, scr, r, F.lane); continue; } r -= I_R;
        if (r < I_R) { p0_transpose_item(F.w_sg, D, EH, (bf16*)(ws + WS_WSGU), 0, 2, scr, r, F.lane); continue; } r -= I_R;
        if (r < I_R) { p0_transpose_item(F.w_su, D, EH, (bf16*)(ws + WS_WSGU), 1, 2, scr, r, F.lane); continue; } r -= I_R;
        p0_transpose_item(F.w_sd, EH, D, (bf16*)(ws + WS_WSD), 0, 1, scr, r, F.lane);
    }
    f32x2* rope = (f32x2*)(ws + WS_ROPE);
    for (int idx = F.vcu * NT + F.tid; idx < M * 64; idx += F.G * NT) { const int t = idx >> 6, i = idx & 63;
        const float invf = powf(10000.0f, -(float)i * (1.0f / 64.0f)); const float ang = (float)F.pos[t] * invf;
        const double ad = (double)ang; const double rr = ad - 6.283185307179586 * rint(ad * 0.15915494309189535); const float rf = (float)rr;
        rope[idx] = (f32x2){cosf(rf), sinf(rf)}; }
}

__device__ __forceinline__ void norm_mod_rows(Frame& F, const float* X, const float* gain, int sc_off, int sh_off, bf16* O) {
    const int gw = F.vcu * NWAVES + F.wave, NGW = F.G * NWAVES;
    const float* mod = (const float*)(F.ws + WS_MOD);
    f32x4 g[4];
#pragma unroll
    for (int j = 0; j < 4; ++j) g[j] = *(const f32x4*)(gain + 4 * F.lane + 256 * j);
    for (int m = gw; m < M; m += NGW) {
        const int b = m >> 13; const f32x4* xr = (const f32x4*)(X + (size_t)m * D) + F.lane;
        f32x4 v[4]; float ss = 0.f;
#pragma unroll
        for (int j = 0; j < 4; ++j) { v[j] = xr[64 * j]; ss += (v[j].x * v[j].x + v[j].y * v[j].y) + (v[j].z * v[j].z + v[j].w * v[j].w); }
        const float rstd = 1.0f / sqrtf(wave_sum(ss) * (1.0f / D) + EPS);
        v2u* o8 = (v2u*)(O + (size_t)m * D) + F.lane;
#pragma unroll
        for (int j = 0; j < 4; ++j) { const f32x4 sc = *(const f32x4*)(mod + b * NMOD + sc_off + 4 * F.lane + 256 * j), sh = *(const f32x4*)(mod + b * NMOD + sh_off + 4 * F.lane + 256 * j);
            const f32x4 h = (v[j] * rstd * g[j]) * (1.0f + sc) + sh; v2u w; w.x = pk2(h.x, h.y); w.y = pk2(h.z, h.w); o8[64 * j] = w; }
    }
}

constexpr int KS = 136, KSB = KS * 2;
constexpr int VS = 264, VSB = VS * 2;
__device__ __forceinline__ float log_gamma(int h) { return log1pf(-exp2f(-5.0f - (float)h)); }
__device__ __forceinline__ bf16x8 ldfrag(const LAS unsigned char* img, int row, int rsb, int k) { return *(const LAS bf16x8*)(img + row * rsb + k * 2); }
template <int RS4> __device__ __forceinline__ bf16x8 tr_frag(unsigned addr) {
    s16x4 lo, hi;
    asm volatile("ds_read_b64_tr_b16 %0, %2\n\tds_read_b64_tr_b16 %1, %2 offset:%3\n\ts_waitcnt lgkmcnt(0)" : "=&v"(lo), "=&v"(hi) : "v"(addr), "i"(RS4) : "memory");
    return __builtin_shufflevector(lo, hi, 0, 1, 2, 3, 4, 5, 6, 7);
}
template <int RS4, int STEP> __device__ __forceinline__ void tr_frag4(unsigned addr, bf16x8& f0, bf16x8& f1, bf16x8& f2, bf16x8& f3) {
    s16x4 l0, h0, l1, h1, l2, h2, l3, h3;
    asm volatile("ds_read_b64_tr_b16 %0, %8\n\tds_read_b64_tr_b16 %1, %8 offset:%9\n\t"
                 "ds_read_b64_tr_b16 %2, %8 offset:%10\n\tds_read_b64_tr_b16 %3, %8 offset:%11\n\t"
                 "ds_read_b64_tr_b16 %4, %8 offset:%12\n\tds_read_b64_tr_b16 %5, %8 offset:%13\n\t"
                 "ds_read_b64_tr_b16 %6, %8 offset:%14\n\tds_read_b64_tr_b16 %7, %8 offset:%15\n\ts_waitcnt lgkmcnt(0)"
                 : "=&v"(l0), "=&v"(h0), "=&v"(l1), "=&v"(h1), "=&v"(l2), "=&v"(h2), "=&v"(l3), "=&v"(h3)
                 : "v"(addr), "i"(RS4), "i"(STEP), "i"(STEP + RS4), "i"(2 * STEP), "i"(2 * STEP + RS4), "i"(3 * STEP), "i"(3 * STEP + RS4) : "memory");
    f0 = __builtin_shufflevector(l0, h0, 0, 1, 2, 3, 4, 5, 6, 7); f1 = __builtin_shufflevector(l1, h1, 0, 1, 2, 3, 4, 5, 6, 7);
    f2 = __builtin_shufflevector(l2, h2, 0, 1, 2, 3, 4, 5, 6, 7); f3 = __builtin_shufflevector(l3, h3, 0, 1, 2, 3, 4, 5, 6, 7);
}
#define MFMA16(a, b, c) __builtin_amdgcn_mfma_f32_16x16x32_bf16((a), (b), (c), 0, 0, 0)

template <bool DECAY> __device__ __forceinline__ void stage_rope(Frame& F, LAS unsigned char* img, const bf16* src, const f32x2* rope, float s_const, float lg) {
#pragma unroll
    for (int i = 0; i < 4; ++i) { const int task = F.tid + NT * i, c = task >> 4, g = task & 15;
        const v2u lo = *(const v2u*)(src + (size_t)c * NIN + 4 * g), hi = *(const v2u*)(src + (size_t)c * NIN + 64 + 4 * g);
        const f32x4 r01 = *(const f32x4*)(rope + c * 64 + 4 * g), r23 = *(const f32x4*)(rope + c * 64 + 4 * g + 2);
        const float sc = DECAY ? s_const * __expf(lg * (float)(127 - c)) : s_const;
        const float x1[4] = {bflo(lo.x), bfhi(lo.x), bflo(lo.y), bfhi(lo.y)}, x2[4] = {bflo(hi.x), bfhi(hi.x), bflo(hi.y), bfhi(hi.y)};
        const float cs[4] = {r01.x, r01.z, r23.x, r23.z}, sn[4] = {r01.y, r01.w, r23.y, r23.w};
        float y1[4], y2[4];
#pragma unroll
        for (int j = 0; j < 4; ++j) { y1[j] = (x1[j] * cs[j] - x2[j] * sn[j]) * sc; y2[j] = (x2[j] * cs[j] + x1[j] * sn[j]) * sc; }
        v2u w1, w2; w1.x = pk2(y1[0], y1[1]); w1.y = pk2(y1[2], y1[3]); w2.x = pk2(y2[0], y2[1]); w2.y = pk2(y2[2], y2[3]);
        *(LAS v2u*)(img + c * KSB + 8 * g) = w1; *(LAS v2u*)(img + c * KSB + 128 + 8 * g) = w2; }
}
__device__ __forceinline__ void stage_v(Frame& F, LAS unsigned char* img, const bf16* src) {
#pragma unroll
    for (int i = 0; i < 8; ++i) { const int task = F.tid + NT * i, c = task >> 5, g = task & 31;
        *(LAS v4u*)(img + c * VSB + 16 * g) = *(const v4u*)(src + (size_t)c * NIN + 8 * g); }
}

__device__ __forceinline__ void p3_kv_conv(Frame& F) {
    unsigned char* ws = F.ws; const bf16* PROJ = (const bf16*)(ws + WS_PROJ); const f32x2* ROPE = (const f32x2*)(ws + WS_ROPE); float* KV = (float*)(ws + WS_KV);
    LAS unsigned char* Kimg = F.lds; LAS unsigned char* Vimg = F.lds + 34816;
    const int w = F.wave, lane = F.lane, g = lane >> 4, q = (lane & 15) >> 2, p = lane & 3;
    for (int it = (int)blockIdx.x; it < BATCH * NH * NCH; it += F.G) {
        const int n = it & 63, h = (it >> 6) & 3, b = it >> 8; const int t0 = b * SEQ + n * CH; const float lg = log_gamma(h);
        stage_rope<true>(F, Kimg, PROJ + (size_t)t0 * NIN + OFF_K + h * DK, ROPE + (size_t)t0 * 64, 1.0f, lg);
        stage_v(F, Vimg, PROJ + (size_t)t0 * NIN + OFF_V + h * DV);
        __syncthreads();
        f32x4 acc[16];
#pragma unroll
        for (int i = 0; i < 16; ++i) acc[i] = (f32x4){0.f, 0.f, 0.f, 0.f};
        const unsigned ka = F.ldsb + (unsigned)((8 * g + q) * KSB + (16 * w + 4 * p) * 2);
        const unsigned va = F.ldsb + 34816u + (unsigned)((8 * g + q) * VSB + (4 * p) * 2);
#pragma unroll
        for (int ks = 0; ks < 4; ++ks) {
            const bf16x8 a = tr_frag<4 * KSB>(ka + ks * 32 * KSB);
#pragma unroll
            for (int nt = 0; nt < 16; nt += 4) { bf16x8 b0, b1, b2, b3; tr_frag4<4 * VSB, 32>(va + ks * 32 * VSB + nt * 32, b0, b1, b2, b3);
                acc[nt] = MFMA16(a, b0, acc[nt]); acc[nt + 1] = MFMA16(a, b1, acc[nt + 1]); acc[nt + 2] = MFMA16(a, b2, acc[nt + 2]); acc[nt + 3] = MFMA16(a, b3, acc[nt + 3]); }
        }
        float* kvp = KV + (size_t)it * (DV * DK) + (size_t)(lane & 15) * DK + 16 * w + 4 * g;
#pragma unroll
        for (int nt = 0; nt < 16; ++nt) *(f32x4*)(kvp + (size_t)(16 * nt) * DK) = acc[nt];
        __syncthreads();
    }
    bf16* CONVG = (bf16*)(ws + WS_CONVG);
    const int gw = F.vcu * NWAVES + F.wave, NGW = F.G * NWAVES;
    for (int m = gw; m < M; m += NGW) { const int s = m & (SEQ - 1);
#pragma unroll
        for (int j = 0; j < 4; ++j) { const int ch = 4 * lane + 256 * j; const bf16* rp = PROJ + (size_t)m * NIN + ch;
            const f32x4 w0 = *(const f32x4*)(F.conv_w + ch), w1 = *(const f32x4*)(F.conv_w + D + ch), w2 = *(const f32x4*)(F.conv_w + 2 * D + ch);
            const v2u u0 = *(const v2u*)(rp + OFF_U), c0 = *(const v2u*)(rp + OFF_GC), gb = *(const v2u*)(rp + OFF_GB);
            v2u u1 = {0u, 0u}, c1 = {0u, 0u}, u2 = {0u, 0u}, c2 = {0u, 0u};
            if (s >= 1) { u1 = *(const v2u*)(rp - NIN + OFF_U); c1 = *(const v2u*)(rp - NIN + OFF_GC); }
            if (s >= 2) { u2 = *(const v2u*)(rp - 2 * NIN + OFF_U); c2 = *(const v2u*)(rp - 2 * NIN + OFF_GC); }
            f32x4 cu0 = {bflo(u0.x) * bflo(c0.x), bfhi(u0.x) * bfhi(c0.x), bflo(u0.y) * bflo(c0.y), bfhi(u0.y) * bfhi(c0.y)};
            f32x4 cu1 = {bflo(u1.x) * bflo(c1.x), bfhi(u1.x) * bfhi(c1.x), bflo(u1.y) * bflo(c1.y), bfhi(u1.y) * bfhi(c1.y)};
            f32x4 cu2 = {bflo(u2.x) * bflo(c2.x), bfhi(u2.x) * bfhi(c2.x), bflo(u2.y) * bflo(c2.y), bfhi(u2.y) * bfhi(c2.y)};
            const f32x4 gbf = {bflo(gb.x), bfhi(gb.x), bflo(gb.y), bfhi(gb.y)};
            const f32x4 o = gbf * (w0 * cu2 + w1 * cu1 + w2 * cu0);
            v2u wv; wv.x = pk2(o.x, o.y); wv.y = pk2(o.z, o.w); *(v2u*)(CONVG + (size_t)m * D + ch) = wv; }
    }
}

__device__ __forceinline__ void p4_scan(Frame& F) {
    const float* KV = (const float*)(F.ws + WS_KV); unsigned* SP = (unsigned*)(F.ws + WS_SP);
    for (int gid = F.vcu * NT + F.tid; gid < BATCH * NH * (DV * DK / 2); gid += F.G * NT) {
        const int bh = gid >> 14, e2 = gid & 16383, h = bh & 3; const float dec = __expf(log_gamma(h) * 128.0f);
        f32x2 S = {0.f, 0.f};
        const f32x2* kp = (const f32x2*)KV + (size_t)bh * NCH * 16384 + e2; unsigned* sp = SP + (size_t)bh * NCH * 16384 + e2;
#pragma unroll 8
        for (int n = 0; n < NCH; ++n) { const f32x2 kv = kp[(size_t)n * 16384]; sp[(size_t)n * 16384] = pk2(S.x, S.y); S = S * dec + kv; }
    }
}

__device__ __forceinline__ void p5_retention(Frame& F) {
    unsigned char* ws = F.ws; const bf16* PROJ = (const bf16*)(ws + WS_PROJ); const f32x2* ROPE = (const f32x2*)(ws + WS_ROPE); const bf16* SP = (const bf16*)(ws + WS_SP);
    bf16* RETG = (bf16*)(ws + WS_RETG);
    LAS unsigned char* Qimg = F.lds; LAS unsigned char* Kimg = F.lds + 34816; LAS unsigned char* Bimg = F.lds + 69632;
    const int w = F.wave, lane = F.lane, g = lane >> 4, q = (lane & 15) >> 2, p = lane & 3, fr = lane & 15;
    for (int it = (int)blockIdx.x; it < BATCH * NH * NCH; it += F.G) {
        const int n = it & 63, h = (it >> 6) & 3, b = it >> 8; const int t0 = b * SEQ + n * CH; const float lg = log_gamma(h);
        stage_rope<false>(F, Qimg, PROJ + (size_t)t0 * NIN + OFF_Q + h * DK, ROPE + (size_t)t0 * 64, 0.08838834764831845f, 0.f);
        stage_rope<false>(F, Kimg, PROJ + (size_t)t0 * NIN + OFF_K + h * DK, ROPE + (size_t)t0 * 64, 1.0f, 0.f);
        { const bf16* sp = SP + (size_t)it * (DV * DK);
#pragma unroll
          for (int i = 0; i < 8; ++i) { const int task = F.tid + NT * i, r = task >> 4, c16 = task & 15; *(LAS v4u*)(Bimg + r * KSB + 16 * c16) = *(const v4u*)(sp + r * DK + 8 * c16); } }
        __syncthreads();
        f32x4 acc[16];
#pragma unroll
        for (int i = 0; i < 16; ++i) acc[i] = (f32x4){0.f, 0.f, 0.f, 0.f};
        f32x4 sc[8];
#pragma unroll
        for (int i = 0; i < 8; ++i) sc[i] = (f32x4){0.f, 0.f, 0.f, 0.f};
#pragma unroll 1
        for (int ks = 0; ks < 4; ++ks) {
            const bf16x8 qf = ldfrag(Qimg, 16 * w + fr, KSB, 32 * ks + 8 * g);
#pragma unroll
            for (int nt = 0; nt < 16; ++nt) { const bf16x8 sf = ldfrag(Bimg, 16 * nt + fr, KSB, 32 * ks + 8 * g); acc[nt] = MFMA16(sf, qf, acc[nt]); }
#pragma unroll
            for (int jt = 0; jt < 8; ++jt) { const bf16x8 kf = ldfrag(Kimg, 16 * jt + fr, KSB, 32 * ks + 8 * g); sc[jt] = MFMA16(kf, qf, sc[jt]); }
        }
        const int irow = 16 * w + fr;
        { const float cd = __expf(lg * (float)(irow + 1));
#pragma unroll
          for (int nt = 0; nt < 16; ++nt) acc[nt] = acc[nt] * cd; }
        __syncthreads();
#pragma unroll
        for (int jt = 0; jt < 8; ++jt) { float pv[4];
#pragma unroll
            for (int r = 0; r < 4; ++r) { const int j = 16 * jt + 4 * g + r; pv[r] = (irow >= j) ? sc[jt][r] * __expf(lg * (float)(irow - j)) : 0.f; }
            v2u wv; wv.x = pk2(pv[0], pv[1]); wv.y = pk2(pv[2], pv[3]); *(LAS v2u*)(Kimg + irow * KSB + (16 * jt + 4 * g) * 2) = wv; }
        stage_v(F, Bimg, PROJ + (size_t)t0 * NIN + OFF_V + h * DV);
        __syncthreads();
        const unsigned va = F.ldsb + 69632u + (unsigned)((8 * g + q) * VSB + (4 * p) * 2);
#pragma unroll 1
        for (int ks = 0; ks < 4; ++ks) {
            const bf16x8 pf = ldfrag(Kimg, 16 * w + fr, KSB, 32 * ks + 8 * g);
#pragma unroll
            for (int nt = 0; nt < 16; nt += 4) { bf16x8 v0, v1, v2, v3; tr_frag4<4 * VSB, 32>(va + ks * 32 * VSB + nt * 32, v0, v1, v2, v3);
                acc[nt] = MFMA16(v0, pf, acc[nt]); acc[nt + 1] = MFMA16(v1, pf, acc[nt + 1]); acc[nt + 2] = MFMA16(v2, pf, acc[nt + 2]); acc[nt + 3] = MFMA16(v3, pf, acc[nt + 3]); }
        }
        float ss = 0.f;
#pragma unroll
        for (int nt = 0; nt < 16; ++nt) ss += (acc[nt][0] * acc[nt][0] + acc[nt][1] * acc[nt][1]) + (acc[nt][2] * acc[nt][2] + acc[nt][3] * acc[nt][3]);
        ss += __shfl_xor(ss, 16); ss += __shfl_xor(ss, 32);
        const float rstd = 1.0f / sqrtf(ss * (1.0f / DV) + EPS);
        const size_t trow = (size_t)(t0 + irow);
#pragma unroll
        for (int nt = 0; nt < 16; ++nt) { const int dv = 16 * nt + 4 * g; const f32x4 gn = *(const f32x4*)(F.ret_norm_g + h * DV + dv);
            const v2u gr = *(const v2u*)(PROJ + trow * NIN + OFF_GR + h * DV + dv);
            const f32x4 o = acc[nt] * rstd * gn * (f32x4){siluf_(bflo(gr.x)), siluf_(bfhi(gr.x)), siluf_(bflo(gr.y)), siluf_(bfhi(gr.y))};
            v2u wv; wv.x = pk2(o[0], o[1]); wv.y = pk2(o[2], o[3]); *(v2u*)(RETG + trow * D + h * DV + dv) = wv; }
        __syncthreads();
    }
}

__device__ __forceinline__ unsigned f32_key(float x) { const unsigned u = __float_as_uint(x); return (u & 0x80000000u) ? ~u : (u | 0x80000000u); }
__device__ __forceinline__ void route_tokens(Frame& F) {
    unsigned char* ws = F.ws; const float* LOGITS = (const float*)(ws + WS_LOGITS);
    int* EIDX = (int*)(ws + WS_EIDX); int* POS = (int*)(ws + WS_POS); int* LTOK = (int*)(ws + WS_LTOK); float* LW = (float*)(ws + WS_LW);
    unsigned* cnt = (unsigned*)(F.ctl + CW_CNT);
    const int gw = F.vcu * NWAVES + F.wave, NGW = F.G * NWAVES, lane = F.lane;
    const f32x4 bias = *(const f32x4*)(F.router_bias + 4 * lane);
    for (int t0 = 2 * gw; t0 < M; t0 += 2 * NGW) {
        float sc[2][4]; unsigned key[2][4];
#pragma unroll
        for (int u = 0; u < 2; ++u) {
            const f32x4 lgv = *(const f32x4*)(LOGITS + (size_t)(t0 + u) * NE + 4 * lane);
            sc[u][0] = 1.0f / (1.0f + __expf(-lgv.x)); sc[u][1] = 1.0f / (1.0f + __expf(-lgv.y)); sc[u][2] = 1.0f / (1.0f + __expf(-lgv.z)); sc[u][3] = 1.0f / (1.0f + __expf(-lgv.w));
            const float c0 = sc[u][0] + bias.x, c1 = sc[u][1] + bias.y, c2 = sc[u][2] + bias.z, c3 = sc[u][3] + bias.w;
            const float a = fmaxf(c0, c1), bq = fminf(c0, c1), cc = fmaxf(c2, c3), dd = fminf(c2, c3);
            float m1 = fmaxf(a, cc), m2 = fmaxf(fminf(a, cc), fmaxf(bq, dd));
#pragma unroll
            for (int o = 1; o < 8; o <<= 1) { const float o1 = __shfl_xor(m1, o), o2 = __shfl_xor(m2, o); const float n1 = fmaxf(m1, o1), n2 = fmaxf(fminf(m1, o1), fmaxf(m2, o2)); m1 = n1; m2 = n2; }
            const float gs = m1 + m2; const int myg = lane >> 3; int rank = 0;
#pragma unroll
            for (int g2 = 0; g2 < 8; ++g2) { const float sg = __uint_as_float((unsigned)__builtin_amdgcn_readlane((int)__float_as_uint(gs), g2 * 8)); rank += (sg > gs || (sg == gs && g2 < myg)) ? 1 : 0; }
            const bool gsel = rank < 4;
            key[u][0] = gsel ? f32_key(c0) : 0u; key[u][1] = gsel ? f32_key(c1) : 0u; key[u][2] = gsel ? f32_key(c2) : 0u; key[u][3] = gsel ? f32_key(c3) : 0u;
        }
        unsigned th0 = 0u, th1 = 0u;
#pragma unroll 4
        for (int bit = 31; bit >= 0; --bit) {
            const unsigned ca = th0 | (1u << bit), cb = th1 | (1u << bit);
            const int na = __popcll(__ballot(key[0][0] >= ca)) + __popcll(__ballot(key[0][1] >= ca)) + __popcll(__ballot(key[0][2] >= ca)) + __popcll(__ballot(key[0][3] >= ca));
            const int nb = __popcll(__ballot(key[1][0] >= cb)) + __popcll(__ballot(key[1][1] >= cb)) + __popcll(__ballot(key[1][2] >= cb)) + __popcll(__ballot(key[1][3] >= cb));
            th0 = na >= 8 ? ca : th0; th1 = nb >= 8 ? cb : th1;
        }
#pragma unroll
        for (int u = 0; u < 2; ++u) { const unsigned th = u ? th1 : th0; const int t = t0 + u;
            const bool s0 = key[u][0] >= th, s1 = key[u][1] >= th, s2 = key[u][2] >= th, s3 = key[u][3] >= th;
            const unsigned long long b0 = __ballot(s0), b1 = __ballot(s1), b2 = __ballot(s2), b3 = __ballot(s3);
            const unsigned long long lt = (1ull << lane) - 1ull;
            const int base = __popcll(b0 & lt) + __popcll(b1 & lt) + __popcll(b2 & lt) + __popcll(b3 & lt);
            const int r0 = base, r1 = r0 + (s0 ? 1 : 0), r2 = r1 + (s1 ? 1 : 0), r3 = r2 + (s2 ? 1 : 0);
            const float part = (s0 ? sc[u][0] : 0.f) + (s1 ? sc[u][1] : 0.f) + (s2 ? sc[u][2] : 0.f) + (s3 ? sc[u][3] : 0.f);
            const float inv = 2.5f / wave_sum(part);
            if (s0 && r0 < 8) { const int e = 4 * lane; const unsigned ps = __hip_atomic_fetch_add(cnt + 64 * e, 1u, RLX_AGENT); LTOK[(size_t)e * CAP + ps] = t; LW[(size_t)e * CAP + ps] = sc[u][0] * inv; EIDX[t * 8 + r0] = e; POS[t * 8 + r0] = (int)ps; }
            if (s1 && r1 < 8) { const int e = 4 * lane + 1; const unsigned ps = __hip_atomic_fetch_add(cnt + 64 * e, 1u, RLX_AGENT); LTOK[(size_t)e * CAP + ps] = t; LW[(size_t)e * CAP + ps] = sc[u][1] * inv; EIDX[t * 8 + r1] = e; POS[t * 8 + r1] = (int)ps; }
            if (s2 && r2 < 8) { const int e = 4 * lane + 2; const unsigned ps = __hip_atomic_fetch_add(cnt + 64 * e, 1u, RLX_AGENT); LTOK[(size_t)e * CAP + ps] = t; LW[(size_t)e * CAP + ps] = sc[u][2] * inv; EIDX[t * 8 + r2] = e; POS[t * 8 + r2] = (int)ps; }
            if (s3 && r3 < 8) { const int e = 4 * lane + 3; const unsigned ps = __hip_atomic_fetch_add(cnt + 64 * e, 1u, RLX_AGENT); LTOK[(size_t)e * CAP + ps] = t; LW[(size_t)e * CAP + ps] = sc[u][3] * inv; EIDX[t * 8 + r3] = e; POS[t * 8 + r3] = (int)ps; }
        }
    }
}

__device__ __forceinline__ void expert_prefix(Frame& F, LAS int* pref, LAS int* off) {
    if (F.wave == 0) { const unsigned* cnt = (const unsigned*)(F.ctl + CW_CNT); const int lane = F.lane;
        int c[4], nb[4]; int tc = 0, tb = 0;
#pragma unroll
        for (int j = 0; j < 4; ++j) { c[j] = (int)__hip_atomic_load(cnt + 64 * (4 * lane + j), RLX_AGENT); nb[j] = (c[j] + 127) >> 7; tc += c[j]; tb += nb[j]; }
        int xc = tc, xb = tb;
#pragma unroll
        for (int o = 1; o < 64; o <<= 1) { const int vc = __shfl_up(xc, o), vb = __shfl_up(xb, o); if (lane >= o) { xc += vc; xb += vb; } }
        int ec = xc - tc, eb = xb - tb;
#pragma unroll
        for (int j = 0; j < 4; ++j) { off[4 * lane + j] = ec; pref[4 * lane + j] = eb; ec += c[j]; eb += nb[j]; }
        if (lane == 63) { off[256] = ec; pref[256] = eb; } }
}

constexpr int EX_PREF = 0, EX_OFF = 1040, EX_TOK = 2176, EX_W = 2688, EX_BUF = 3200, EX_BUFSZ = 27648, EX_BOFF = 10240, EX_G = EX_BUF + 2 * EX_BUFSZ;
constexpr int ASB = 80, EXD = 4, EXNC = 96;
static_assert(EX_G + 128 * VSB <= LDSCTL_OFF, "expert LDS map");
template <int RS4, int STEP> __device__ __forceinline__ void tr_frag2(unsigned addr, bf16x8& f0, bf16x8& f1) {
    s16x4 l0, h0, l1, h1;
    asm volatile("ds_read_b64_tr_b16 %0, %4\n\tds_read_b64_tr_b16 %1, %4 offset:%5\n\tds_read_b64_tr_b16 %2, %4 offset:%6\n\tds_read_b64_tr_b16 %3, %4 offset:%7\n\ts_waitcnt lgkmcnt(0)"
                 : "=&v"(l0), "=&v"(h0), "=&v"(l1), "=&v"(h1) : "v"(addr), "i"(RS4), "i"(STEP), "i"(STEP + RS4) : "memory");
    f0 = __builtin_shufflevector(l0, h0, 0, 1, 2, 3, 4, 5, 6, 7); f1 = __builtin_shufflevector(l1, h1, 0, 1, 2, 3, 4, 5, 6, 7);
}
struct ExSet { f32x4 w[4]; v4u a; };
template <int ABL> __device__ __forceinline__ void p11_experts(Frame& F) {
    unsigned char* ws = F.ws; const bf16* H2 = (const bf16*)(ws + WS_HB); const int* LTOK = (const int*)(ws + WS_LTOK); const float* LW = (const float*)(ws + WS_LW); bf16* YP = (bf16*)(ws + WS_YP);
    LAS int* pref = (LAS int*)(F.lds + EX_PREF); LAS int* off = (LAS int*)(F.lds + EX_OFF); LAS int* tokl = (LAS int*)(F.lds + EX_TOK); LAS float* wl = (LAS float*)(F.lds + EX_W);
    LAS unsigned char* Gimg = F.lds + EX_G;
    const int tid = F.tid, w = F.wave, wr = w >> 2, wc = w & 3;
    expert_prefix(F, pref, off);
    __syncthreads();
    const int nitems = pref[256];
    for (int it = F.vcu; it < nitems; it += F.G) {
        int e = 0;
#pragma unroll
        for (int s = 128; s >= 1; s >>= 1) if (pref[e + s] <= it) e += s;
        e = __builtin_amdgcn_readfirstlane(e);
        const int rb = __builtin_amdgcn_readfirstlane(it - pref[e]), cnt_e = __builtin_amdgcn_readfirstlane(off[e + 1] - off[e]), r0 = rb * 128, slot0 = __builtin_amdgcn_readfirstlane(off[e]) + r0;
        if (tid < 128) { const int idx = r0 + tid; const bool ok = idx < cnt_e; tokl[tid] = LTOK[(size_t)e * CAP + (ok ? idx : r0)]; wl[tid] = ok ? LW[(size_t)e * CAP + idx] : 0.f; }
        __syncthreads();
        const float* Wg = F.w_eg + (size_t)e * D * EH; const float* Wu = F.w_eu + (size_t)e * D * EH; const float* Wd = F.w_ed + (size_t)e * EH * D;
        const bf16* asrc = H2 + (size_t)tokl[tid >> 2] * D + (tid & 3) * 8;
        f32x4 acc[4][4];
#define EX_ZERO() do { _Pragma("unroll") for (int i = 0; i < 4; ++i) _Pragma("unroll") for (int j = 0; j < 4; ++j) acc[i][j] = (f32x4){0.f, 0.f, 0.f, 0.f}; } while (0)
        EX_ZERO();
        ExSet S0, S1, S2, S3;
#define EX_L1(S, CC) do { const int cc_ = (CC) & 63, hp_ = cc_ >> 5, kc_ = cc_ & 31; int tl = tid; asm volatile("" : "+v"(tl));                         \
            unsigned o = (unsigned)((32 * kc_ + (tl >> 5)) * EH + 128 * hp_ + 4 * (tl & 31));                                                            \
            S.w[0] = *(const f32x4*)(Wg + o); S.w[1] = *(const f32x4*)(Wg + o + 16 * EH); S.w[2] = *(const f32x4*)(Wu + o); S.w[3] = *(const f32x4*)(Wu + o + 16 * EH); \
            S.a = *(const v4u*)(asrc + 32 * kc_); } while (0)
#define EX_W1(S, BUF) do { int tl = tid; asm volatile("" : "+v"(tl)); LAS unsigned char* b_ = (BUF) + EX_BOFF + (tl >> 5) * KSB + 8 * (tl & 31); v2u p_[4];  \
            _Pragma("unroll") for (int i = 0; i < 4; ++i) { p_[i].x = pk2(S.w[i].x, S.w[i].y); p_[i].y = pk2(S.w[i].z, S.w[i].w); }                        \
            *(LAS v2u*)b_ = p_[0]; *(LAS v2u*)(b_ + 16 * KSB) = p_[1]; *(LAS v2u*)(b_ + 32 * KSB) = p_[2]; *(LAS v2u*)(b_ + 48 * KSB) = p_[3];             \
            *(LAS v4u*)((BUF) + (tl >> 2) * ASB + (tl & 3) * 16) = S.a; } while (0)
#define EX_C1(C) do { int tl = tid; asm volatile("" : "+v"(tl)); const int g = (tl >> 4) & 3, fr = tl & 15, q = (tl & 15) >> 2, p = tl & 3;              \
            LAS unsigned char* buf = F.lds + EX_BUF + ((C) & 1) * EX_BUFSZ; const unsigned ta = F.ldsb + EX_BUF + (unsigned)(((C) & 1) * EX_BUFSZ + EX_BOFF + (8 * g + q) * KSB + (32 * wc + 4 * p) * 2); \
            bf16x8 af[4]; _Pragma("unroll") for (int rt = 0; rt < 4; ++rt) af[rt] = ldfrag(buf, 64 * wr + 16 * rt + fr, ASB, 8 * g);                     \
            bf16x8 b0, b1, b2, b3; tr_frag2<4 * KSB, 32>(ta, b0, b1); tr_frag2<4 * KSB, 32>(ta + 32 * KSB, b2, b3);                                       \
            _Pragma("unroll") for (int rt = 0; rt < 4; ++rt) { acc[rt][0] = MFMA16(b0, af[rt], acc[rt][0]); acc[rt][1] = MFMA16(b1, af[rt], acc[rt][1]); acc[rt][2] = MFMA16(b2, af[rt], acc[rt][2]); acc[rt][3] = MFMA16(b3, af[rt], acc[rt][3]); } } while (0)
#define EX_STEP1(SL, SW, C) do { EX_L1(SL, (C) + 4); EX_C1(C); EX_W1(SW, F.lds + EX_BUF + (((C) + 1) & 1) * EX_BUFSZ); __syncthreads(); } while (0)
        EX_L1(S0, 0); EX_L1(S1, 1); EX_L1(S2, 2); EX_L1(S3, 3);
        EX_W1(S0, F.lds + EX_BUF);
        __syncthreads();
#pragma unroll 1
        for (int c4 = 0; c4 < 64; c4 += 4) {
            EX_STEP1(S0, S1, c4); EX_STEP1(S1, S2, c4 + 1); EX_STEP1(S2, S3, c4 + 2); EX_STEP1(S3, S0, c4 + 3);
            if ((c4 & 31) == 28) { const int hp = c4 >> 5; int tl = tid; asm volatile("" : "+v"(tl)); const int g = (tl >> 4) & 3, fr = tl & 15;
#pragma unroll
                for (int rt = 0; rt < 4; ++rt)
#pragma unroll
                    for (int ct = 0; ct < 2; ++ct) { const f32x4 ga = acc[rt][ct], ua = acc[rt][ct + 2];
                        v2u wv; wv.x = pk2(siluf_(ga[0]) * ua[0], siluf_(ga[1]) * ua[1]); wv.y = pk2(siluf_(ga[2]) * ua[2], siluf_(ga[3]) * ua[3]);
                        *(LAS v2u*)(Gimg + (64 * wr + 16 * rt + fr) * VSB + (128 * hp + 32 * wc + 16 * ct + 4 * g) * 2) = wv; }
                EX_ZERO(); }
        }
#define EX_L2(S, CC) do { const int cc_ = (CC) & 31, np_ = cc_ >> 3, kc_ = cc_ & 7; int tl = tid; asm volatile("" : "+v"(tl));                           \
            unsigned o = (unsigned)((32 * kc_ + (tl >> 6)) * D + 256 * np_ + 4 * (tl & 63));                                                              \
            _Pragma("unroll") for (int i = 0; i < 4; ++i) S.w[i] = *(const f32x4*)(Wd + o + (unsigned)(8 * i * D)); } while (0)
#define EX_W2(S, BUF) do { int tl = tid; asm volatile("" : "+v"(tl)); LAS unsigned char* b_ = (BUF) + EX_BOFF + (tl >> 6) * VSB + 8 * (tl & 63);          \
            _Pragma("unroll") for (int i = 0; i < 4; ++i) { v2u p_; p_.x = pk2(S.w[i].x, S.w[i].y); p_.y = pk2(S.w[i].z, S.w[i].w); *(LAS v2u*)(b_ + (8 * i) * VSB) = p_; } } while (0)
#define EX_C2(C) do { int tl = tid; asm volatile("" : "+v"(tl)); const int g = (tl >> 4) & 3, fr = tl & 15, q = (tl & 15) >> 2, p = tl & 3;              \
            const unsigned ta = F.ldsb + EX_BUF + (unsigned)(((C) & 1) * EX_BUFSZ + EX_BOFF + (8 * g + q) * VSB + (64 * wc + 4 * p) * 2);                \
            bf16x8 gf[4]; _Pragma("unroll") for (int rt = 0; rt < 4; ++rt) gf[rt] = ldfrag(Gimg, 64 * wr + 16 * rt + fr, VSB, 32 * ((C) & 7) + 8 * g);   \
            bf16x8 b0, b1, b2, b3; tr_frag4<4 * VSB, 32>(ta, b0, b1, b2, b3);                                                                             \
            _Pragma("unroll") for (int rt = 0; rt < 4; ++rt) { acc[rt][0] = MFMA16(b0, gf[rt], acc[rt][0]); acc[rt][1] = MFMA16(b1, gf[rt], acc[rt][1]); acc[rt][2] = MFMA16(b2, gf[rt], acc[rt][2]); acc[rt][3] = MFMA16(b3, gf[rt], acc[rt][3]); } } while (0)
#define EX_STEP2(SL, SW, C) do { EX_L2(SL, (C) + 4); EX_C2(C); EX_W2(SW, F.lds + EX_BUF + (((C) + 1) & 1) * EX_BUFSZ); __syncthreads(); } while (0)
        EX_L2(S0, 0); EX_L2(S1, 1); EX_L2(S2, 2); EX_L2(S3, 3);
        EX_W2(S0, F.lds + EX_BUF);
        __syncthreads();
#pragma unroll 1
        for (int np = 0; np < 4; ++np) {
#pragma unroll 1
            for (int h4 = 0; h4 < 8; h4 += 4) { const int c4 = 8 * np + h4;
                EX_STEP2(S0, S1, c4); EX_STEP2(S1, S2, c4 + 1); EX_STEP2(S2, S3, c4 + 2); EX_STEP2(S3, S0, c4 + 3); }
            int tl = tid; asm volatile("" : "+v"(tl)); const int g = (tl >> 4) & 3, fr = tl & 15;
#pragma unroll
            for (int rt = 0; rt < 4; ++rt) { const int row = 64 * wr + 16 * rt + fr; const float rw = wl[row];
                if (!(ABL & 32) && r0 + row < cnt_e) { bf16* yp = YP + (size_t)(slot0 + row) * D + 256 * np + 64 * wc + 4 * g;
#pragma unroll
                    for (int ct = 0; ct < 4; ++ct) { const f32x4 o = acc[rt][ct] * rw; v2u wv; wv.x = pk2(o[0], o[1]); wv.y = pk2(o[2], o[3]); *(v2u*)(yp + 16 * ct) = wv; } } }
            EX_ZERO();
        }
#undef EX_L1
#undef EX_W1
#undef EX_C1
#undef EX_STEP1
#undef EX_L2
#undef EX_W2
#undef EX_C2
#undef EX_STEP2
#undef EX_ZERO
        __syncthreads();
    }
}

constexpr int K6_A = 3200, K6_BG = 21632, K6_BU = 39040, K6_G = 56448;
constexpr int ASB6 = 144;
#define K6MM(a, b, c) ((ABL & 1) ? k6_keep((a), (b), (c)) : MFMA16((a), (b), (c)))
__device__ __forceinline__ f32x4 k6_keep(bf16x8 a, bf16x8 b, f32x4 c) { asm volatile("" :: "v"(a), "v"(b)); return c; }
struct K6Set { f32x4 w[8]; v4u a0, a1; };
template <int ABL> __device__ __forceinline__ void p11_experts_k64(Frame& F) {
    unsigned char* ws = F.ws; const bf16* H2 = (const bf16*)(ws + WS_HB); const int* LTOK = (const int*)(ws + WS_LTOK); const float* LW = (const float*)(ws + WS_LW); bf16* YP = (bf16*)(ws + WS_YP);
    LAS int* pref = (LAS int*)(F.lds + EX_PREF); LAS int* off = (LAS int*)(F.lds + EX_OFF); LAS int* tokl = (LAS int*)(F.lds + EX_TOK); LAS float* wl = (LAS float*)(F.lds + EX_W);
    LAS unsigned char* Aimg = F.lds + K6_A; LAS unsigned char* Gimg = F.lds + K6_G;
    const int tid = F.tid, w = F.wave, wr = w >> 2, wc = w & 3;
    expert_prefix(F, pref, off);
    __syncthreads();
    const int nitems = pref[256];
    for (int it = F.vcu; it < nitems; it += F.G) {
        int e = 0;
#pragma unroll
        for (int s = 128; s >= 1; s >>= 1) if (pref[e + s] <= it) e += s;
        e = __builtin_amdgcn_readfirstlane(e);
        const int rb = __builtin_amdgcn_readfirstlane(it - pref[e]), cnt_e = __builtin_amdgcn_readfirstlane(off[e + 1] - off[e]), r0 = rb * 128, slot0 = __builtin_amdgcn_readfirstlane(off[e]) + r0;
        if (tid < 128) { const int idx = r0 + tid; const bool ok = idx < cnt_e; tokl[tid] = LTOK[(size_t)e * CAP + (ok ? idx : r0)]; wl[tid] = ok ? LW[(size_t)e * CAP + idx] : 0.f; }
        __syncthreads();
        const int ew = e;
        const float* Wg = F.w_eg + (size_t)ew * D * EH; const float* Wu = F.w_eu + (size_t)ew * D * EH; const float* Wd = F.w_ed + (size_t)ew * EH * D;
        const bf16* asrc = H2 + (size_t)tokl[tid >> 2] * D + (tid & 3) * 16;
        f32x4 acc[4][4];
#pragma unroll
        for (int i = 0; i < 4; ++i)
#pragma unroll
            for (int j = 0; j < 4; ++j) acc[i][j] = (f32x4){0.f, 0.f, 0.f, 0.f};
        K6Set S0, S1;
        if constexpr (ABL & 16) {
#pragma unroll
            for (int i = 0; i < 8; ++i) { S0.w[i] = (f32x4){1.f, 1.f, 1.f, 1.f}; S1.w[i] = (f32x4){1.f, 1.f, 1.f, 1.f}; } S0.a0 = S0.a1 = S1.a0 = S1.a1 = (v4u){0u, 0u, 0u, 0u}; }
#define K6_LOAD1(S, CC) do { const int cc_ = (CC) & 31, hp_ = cc_ >> 4, kc_ = cc_ & 15; int tl = tid; asm volatile("" : "+v"(tl));                      \
            unsigned o = (unsigned)((64 * kc_ + (tl >> 5)) * EH + 128 * hp_ + 4 * (tl & 31));                                                            \
            if constexpr (!(ABL & 16)) { _Pragma("unroll") for (int i = 0; i < 4; ++i) { S.w[i] = *(const f32x4*)(Wg + o + (unsigned)(16 * i * EH)); S.w[4 + i] = *(const f32x4*)(Wu + o + (unsigned)(16 * i * EH)); } \
            S.a0 = *(const v4u*)(asrc + 64 * kc_); S.a1 = *(const v4u*)(asrc + 64 * kc_ + 8); } } while (0)
#define K6_STEP1(S, CC) do { int tl = tid; asm volatile("" : "+v"(tl)); const int g = (tl >> 4) & 3, fr = tl & 15, q = (tl & 15) >> 2, p = tl & 3;    \
            if constexpr (!(ABL & 8)) __syncthreads();                                                                                                       \
            if constexpr (!(ABL & 2)) { *(LAS v4u*)(Aimg + (tl >> 2) * ASB6 + (tl & 3) * 32) = S.a0; *(LAS v4u*)(Aimg + (tl >> 2) * ASB6 + (tl & 3) * 32 + 16) = S.a1; }            \
            if constexpr (!(ABL & 2)) _Pragma("unroll") for (int i = 0; i < 4; ++i) { v2u wg, wu; wg.x = pk2(S.w[i].x, S.w[i].y); wg.y = pk2(S.w[i].z, S.w[i].w); wu.x = pk2(S.w[4 + i].x, S.w[4 + i].y); wu.y = pk2(S.w[4 + i].z, S.w[4 + i].w); \
                *(LAS v2u*)(F.lds + K6_BG + ((tl >> 5) + 16 * i) * KSB + 8 * (tl & 31)) = wg; *(LAS v2u*)(F.lds + K6_BU + ((tl >> 5) + 16 * i) * KSB + 8 * (tl & 31)) = wu; } \
            if constexpr (!(ABL & 8)) __syncthreads();                                                                                                       \
            K6_LOAD1(S, (CC) + 2);                                                                                                                       \
            const unsigned bga = F.ldsb + K6_BG + (unsigned)((8 * g + q) * KSB + (32 * wc + 4 * p) * 2), bua = bga + (K6_BU - K6_BG);                   \
            if constexpr (!(ABL & 4)) _Pragma("unroll") for (int s = 0; s < 2; ++s) { bf16x8 af[4];                                                                                \
                _Pragma("unroll") for (int rt = 0; rt < 4; ++rt) af[rt] = ldfrag(Aimg, 64 * wr + 16 * rt + fr, ASB6, 32 * s + 8 * g);                    \
                bf16x8 b0, b1, b2, b3; tr_frag2<4 * KSB, 32>(bga + s * 32 * KSB, b0, b1); tr_frag2<4 * KSB, 32>(bua + s * 32 * KSB, b2, b3);             \
                _Pragma("unroll") for (int rt = 0; rt < 4; ++rt) { acc[rt][0] = K6MM(b0, af[rt], acc[rt][0]); acc[rt][1] = K6MM(b1, af[rt], acc[rt][1]); acc[rt][2] = K6MM(b2, af[rt], acc[rt][2]); acc[rt][3] = K6MM(b3, af[rt], acc[rt][3]); } } } while (0)
        K6_LOAD1(S0, 0); K6_LOAD1(S1, 1);
#pragma unroll 1
        for (int cc = 0; cc < 32; cc += 2) {
            K6_STEP1(S0, cc); K6_STEP1(S1, cc + 1);
            if ((cc & 15) == 14) { const int hp = cc >> 4; int tl = tid; asm volatile("" : "+v"(tl)); const int g = (tl >> 4) & 3, fr = tl & 15;
#pragma unroll
                for (int rt = 0; rt < 4; ++rt)
#pragma unroll
                    for (int ct = 0; ct < 2; ++ct) { const f32x4 ga = acc[rt][ct], ua = acc[rt][ct + 2];
                        v2u wv; wv.x = pk2(siluf_(ga[0]) * ua[0], siluf_(ga[1]) * ua[1]); wv.y = pk2(siluf_(ga[2]) * ua[2], siluf_(ga[3]) * ua[3]);
                        *(LAS v2u*)(Gimg + (64 * wr + 16 * rt + fr) * VSB + (128 * hp + 32 * wc + 16 * ct + 4 * g) * 2) = wv; }
#pragma unroll
                for (int i = 0; i < 4; ++i)
#pragma unroll
                    for (int j = 0; j < 4; ++j) acc[i][j] = (f32x4){0.f, 0.f, 0.f, 0.f}; }
        }
#undef K6_STEP1
#undef K6_LOAD1
#define K6_LOAD2(S, CC) do { const int cc_ = (CC) & 15, np_ = cc_ >> 2, kc_ = cc_ & 3; int tl = tid; asm volatile("" : "+v"(tl));                       \
            unsigned o = (unsigned)((64 * kc_ + (tl >> 6)) * D + 256 * np_ + 4 * (tl & 63));                                                             \
            if constexpr (!(ABL & 16)) { _Pragma("unroll") for (int i = 0; i < 8; ++i) S.w[i] = *(const f32x4*)(Wd + o + (unsigned)(8 * i * D)); } } while (0)
#define K6_STEP2(S, CC, KC) do { int tl = tid; asm volatile("" : "+v"(tl)); const int g = (tl >> 4) & 3, fr = tl & 15, q = (tl & 15) >> 2, p = tl & 3; \
            if constexpr (!(ABL & 8)) __syncthreads();                                                                                                       \
            if constexpr (!(ABL & 2)) _Pragma("unroll") for (int i = 0; i < 8; ++i) { v2u wd; wd.x = pk2(S.w[i].x, S.w[i].y); wd.y = pk2(S.w[i].z, S.w[i].w); *(LAS v2u*)(F.lds + K6_BG + ((tl >> 6) + 8 * i) * VSB + 8 * (tl & 63)) = wd; } \
            if constexpr (!(ABL & 8)) __syncthreads();                                                                                                       \
            K6_LOAD2(S, (CC) + 2);                                                                                                                       \
            const unsigned bda = F.ldsb + K6_BG + (unsigned)((8 * g + q) * VSB + (64 * wc + 4 * p) * 2);                                                \
            if constexpr (!(ABL & 4)) _Pragma("unroll") for (int s = 0; s < 2; ++s) { bf16x8 gf[4];                                                                                \
                _Pragma("unroll") for (int rt = 0; rt < 4; ++rt) gf[rt] = ldfrag(Gimg, 64 * wr + 16 * rt + fr, VSB, 64 * (KC) + 32 * s + 8 * g);        \
                bf16x8 b0, b1, b2, b3; tr_frag4<4 * VSB, 32>(bda + s * 32 * VSB, b0, b1, b2, b3);                                                        \
                _Pragma("unroll") for (int rt = 0; rt < 4; ++rt) { acc[rt][0] = K6MM(b0, gf[rt], acc[rt][0]); acc[rt][1] = K6MM(b1, gf[rt], acc[rt][1]); acc[rt][2] = K6MM(b2, gf[rt], acc[rt][2]); acc[rt][3] = K6MM(b3, gf[rt], acc[rt][3]); } } } while (0)
        K6_LOAD2(S0, 0); K6_LOAD2(S1, 1);
#pragma unroll 1
        for (int np = 0; np < 4; ++np) {
            K6_STEP2(S0, 4 * np, 0); K6_STEP2(S1, 4 * np + 1, 1); K6_STEP2(S0, 4 * np + 2, 2); K6_STEP2(S1, 4 * np + 3, 3);
            int tl = tid; asm volatile("" : "+v"(tl)); const int g = (tl >> 4) & 3, fr = tl & 15;
#pragma unroll
            for (int rt = 0; rt < 4; ++rt) { const int row = 64 * wr + 16 * rt + fr; const float rw = wl[row];
                if (!(ABL & 32) && r0 + row < cnt_e) { bf16* yp = YP + (size_t)(slot0 + row) * D + 256 * np + 64 * wc + 4 * g;
#pragma unroll
                    for (int ct = 0; ct < 4; ++ct) { const f32x4 o = acc[rt][ct] * rw; v2u wv; wv.x = pk2(o[0], o[1]); wv.y = pk2(o[2], o[3]); *(v2u*)(yp + 16 * ct) = wv; } } }
#pragma unroll
            for (int i = 0; i < 4; ++i)
#pragma unroll
                for (int j = 0; j < 4; ++j) acc[i][j] = (f32x4){0.f, 0.f, 0.f, 0.f};
        }
#undef K6_STEP2
#undef K6_LOAD2
        __syncthreads();
    }
}

#undef K6MM
__device__ __forceinline__ void p12_final(Frame& F) {
    unsigned char* ws = F.ws; const float* X1 = (const float*)(ws + (MK_SKIP_SHARED ? WS_X1 : WS_MIXP)); const bf16* YP = (const bf16*)(ws + WS_YP); const int* EIDX = (const int*)(ws + WS_EIDX); const int* POS = (const int*)(ws + WS_POS);
    const float* mod = (const float*)(ws + WS_MOD);
    LAS int* pref = (LAS int*)(F.lds + EX_PREF); LAS int* off = (LAS int*)(F.lds + EX_OFF);
    expert_prefix(F, pref, off);
    __syncthreads();
    const int gw = F.vcu * NWAVES + F.wave, NGW = F.G * NWAVES, lane = F.lane;
    f32x4 gn[4];
#pragma unroll
    for (int j = 0; j < 4; ++j) gn[j] = *(const f32x4*)(F.norm_final_g + 4 * lane + 256 * j);
    for (int t = gw; t < M; t += NGW) {
        const int b = t >> 13;
        f32x4 y[4];
#pragma unroll
        for (int j = 0; j < 4; ++j) y[j] = (f32x4){0.f, 0.f, 0.f, 0.f};
#if !MK_SKIP_ROUTED
        int myslot = 0;
        if (lane < 8) myslot = off[EIDX[t * 8 + lane]] + POS[t * 8 + lane];
#pragma unroll
        for (int k = 0; k < 8; ++k) { const int slot = __shfl(myslot, k); const v2u* yp = (const v2u*)(YP + (size_t)slot * D) + lane;
#pragma unroll
            for (int j = 0; j < 4; ++j) { const v2u v = yp[64 * j]; y[j] += (f32x4){bflo(v.x), bfhi(v.x), bflo(v.y), bfhi(v.y)}; } }
#endif
        const f32x4* xr = (const f32x4*)(X1 + (size_t)t * D) + lane; f32x4 v[4]; float ss = 0.f;
#pragma unroll
        for (int j = 0; j < 4; ++j) { const f32x4 g2 = *(const f32x4*)(mod + b * NMOD + 5 * D + 4 * lane + 256 * j); v[j] = xr[64 * j] + g2 * y[j];
            ss += (v[j].x * v[j].x + v[j].y * v[j].y) + (v[j].z * v[j].z + v[j].w * v[j].w); }
        const float rstd = 1.0f / sqrtf(wave_sum(ss) * (1.0f / D) + EPS);
        f32x4* op = (f32x4*)(F.out + (size_t)t * D) + lane;
#pragma unroll
        for (int j = 0; j < 4; ++j) op[64 * j] = v[j] * rstd * gn[j];
    }
}

struct Args { const void* in[22]; float* out; unsigned char* ws; int ph_lo, ph_hi, li, abl; };
__global__ void __launch_bounds__(NT, 2) mk_fwd(Args args) {
    extern __shared__ __attribute__((aligned(16))) unsigned char lds[];
    Frame F;
    F.lds = (LAS unsigned char*)lds; F.ldsb = (unsigned)(size_t)F.lds;
    F.MISC = (volatile LAS unsigned*)(F.lds + MISC_OFF);
    F.tid = threadIdx.x; F.lane = F.tid & 63; F.wave = __builtin_amdgcn_readfirstlane(F.tid >> 6);
    F.G = gridDim.x; { const int bx = blockIdx.x; F.vcu = (F.G % 8 == 0) ? (bx % 8) * (F.G / 8) + bx / 8 : bx; }
    F.abl = MK_ABL_RT ? args.abl : 0;
    unsigned char* ws = args.ws; F.ws = ws; F.ctl = (gu32*)(ws + WS_CTL); F.out = args.out;
    F.x = (const float*)args.in[0]; F.c = (const float*)args.in[1]; F.pos = (const int*)args.in[2]; F.w_ada = (const float*)args.in[3]; F.b_ada = (const float*)args.in[4];
    F.norm_mix_g = (const float*)args.in[5]; F.w_in = (const float*)args.in[6]; F.ret_norm_g = (const float*)args.in[7]; F.conv_w = (const float*)args.in[8];
    F.w_br_ret = (const float*)args.in[9]; F.w_br_conv = (const float*)args.in[10]; F.w_out = (const float*)args.in[11]; F.norm_ffn_g = (const float*)args.in[12];
    F.w_router = (const float*)args.in[13]; F.router_bias = (const float*)args.in[14]; F.w_eg = (const float*)args.in[15]; F.w_eu = (const float*)args.in[16]; F.w_ed = (const float*)args.in[17];
    F.w_sg = (const float*)args.in[18]; F.w_su = (const float*)args.in[19]; F.w_sd = (const float*)args.in[20]; F.norm_final_g = (const float*)args.in[21];
    for (int u = F.tid; u < (LDS_BYTES - LDSCTL_OFF) / 4; u += NT) ((LAS unsigned*)(F.lds + LDSCTL_OFF))[u] = 0u;
    __syncthreads();
    XcdBarrier bar; bar.bar = (unsigned*)(F.ctl + CW_BAR) + args.li * XCD_BAR_WORDS; bar.x = 0; bar.st = nullptr;
    if (!MK_PER_PHASE) bar = xcd_barrier_post((unsigned*)(F.ctl + CW_BAR) + args.li * XCD_BAR_WORDS, F.MISC + 8);
    const int lo = args.ph_lo, hi = args.ph_hi;
#ifndef MK_PHASE_MASK
#define MK_PHASE_MASK 0x1fff
#endif
#define IN(k) (((MK_PHASE_MASK >> (k)) & 1) && lo <= (k) && (k) < hi)
#ifndef MK_BAR_REP
#define MK_BAR_REP 1
#endif
#define SEAM(k) do { if (IN(k) && IN((k) + 1)) { for (int br_ = 0; br_ < MK_BAR_REP; ++br_) xcd_barrier(bar); } } while (0)
#ifndef MK_DOUBLE_MASK
#define MK_DOUBLE_MASK 0
#endif
#define REP(k) for (int rep_ = 0; rep_ < (((MK_DOUBLE_MASK >> (k)) & 1) ? 2 : 1); ++rep_, (((MK_DOUBLE_MASK >> (k)) & 1) && rep_ == 1 ? xcd_barrier(bar) : (void)0))
    bf16* HB = (bf16*)(ws + WS_HB); bf16* PROJ = (bf16*)(ws + WS_PROJ); const float* mod = (const float*)(ws + WS_MOD);

    if (IN(0)) { p0_prologue(F); } SEAM(0);
    if (IN(1)) { norm_mod_rows(F, F.x, F.norm_mix_g, 1 * D, 0 * D, HB); } SEAM(1);
    if (IN(2)) {
        pg8::Gemm g{HB, (const bf16*)(ws + WS_WIN), M, NIN, D}; pg8::StaticOrder S; S.init(M, NIN, F.G, (int)blockIdx.x);
        pg8::EpiBf16 E{PROJ, NIN};
        pg8::gemm_phase<pg8::EpiBf16, pg8::StaticOrder, true, true>(F.lds, g, S, E);
    } SEAM(2);
    if (IN(3)) { p3_kv_conv(F); } SEAM(3);
    if (IN(4)) { p4_scan(F); } SEAM(4);
    if (IN(5)) { p5_retention(F); } SEAM(5);
    if (IN(6)) {
        { pg8::Gemm g{(const bf16*)(ws + WS_RETG), (const bf16*)(ws + WS_WBR), M, D, D}; pg8::StaticOrder S; S.init(M, D, F.G, (int)blockIdx.x);
          pg8::EpiGateF32 E{(float*)(ws + WS_MIXP), D, PROJ + OFF_MR, NIN};
          pg8::gemm_phase<pg8::EpiGateF32, pg8::StaticOrder, true, true>(F.lds, g, S, E); }
        asm volatile("s_waitcnt vmcnt(0)" ::: "memory"); __syncthreads();
        { pg8::Gemm g{(const bf16*)(ws + WS_CONVG), (const bf16*)(ws + WS_WBC), M, D, D}; pg8::StaticOrder S; S.init(M, D, F.G, (int)blockIdx.x);
          pg8::EpiMixBf16 E{(bf16*)(ws + WS_MIX), D, (const float*)(ws + WS_MIXP), PROJ + OFF_MC, NIN};
          pg8::gemm_phase<pg8::EpiMixBf16, pg8::StaticOrder, true, true>(F.lds, g, S, E); }
    } SEAM(6);
    if (IN(7)) {
#if MK_SKIP_MIXER
        for (size_t i = (size_t)F.vcu * NT + F.tid; i < (size_t)M * D / 4; i += (size_t)F.G * NT) ((f32x4*)(ws + WS_X1))[i] = ((const f32x4*)F.x)[i];
#else
        pg8::Gemm g{(const bf16*)(ws + WS_MIX), (const bf16*)(ws + WS_WO), M, D, D}; pg8::StaticOrder S; S.init(M, D, F.G, (int)blockIdx.x);
        pg8::EpiResid E{(float*)(ws + WS_X1), F.x, D, mod + 2 * D, NMOD, 13};
        pg8::gemm_phase<pg8::EpiResid, pg8::StaticOrder, true, true>(F.lds, g, S, E);
#endif
    } SEAM(7);
    if (IN(8)) { norm_mod_rows(F, (const float*)(ws + WS_X1), F.norm_ffn_g, 4 * D, 3 * D, HB); } SEAM(8);
    if (IN(9)) {
        { pg8::Gemm g{HB, (const bf16*)(ws + WS_WR), M, NE, D}; pg8::StaticOrder S; S.init(M, NE, F.G, (int)blockIdx.x);
          pg8::EpiF32 E{(float*)(ws + WS_LOGITS), NE};
          pg8::gemm_phase<pg8::EpiF32, pg8::StaticOrder, true, true>(F.lds, g, S, E); }
        { pg8::Gemm g{HB, (const bf16*)(ws + WS_WSGU), M, 2 * EH, D}; pg8::StaticOrder S; S.init(M, 2 * EH, F.G, (int)((blockIdx.x + F.G / 2) % F.G));
          pg8::EpiSwiglu E{(bf16*)(ws + WS_SHG), EH};
          pg8::gemm_phase<pg8::EpiSwiglu, pg8::StaticOrder, true, true>(F.lds, g, S, E); }
    } SEAM(9);
    if (IN(10)) {
#if !MK_SKIP_SHARED
        for (int rp_ = 0; rp_ < MK_P10_GEMM_REP; ++rp_)
        { pg8::Gemm g{(const bf16*)(ws + WS_SHG), (const bf16*)(ws + WS_WSD), M, D, EH}; pg8::StaticOrder S; S.init(M, D, F.G, (int)blockIdx.x);
          pg8::EpiResid E{(float*)(ws + WS_MIXP), (const float*)(ws + WS_X1), D, mod + 5 * D, NMOD, 13};
          pg8::gemm_phase<pg8::EpiResid, pg8::StaticOrder, true, true>(F.lds, g, S, E); }
#endif
        route_tokens(F);
    } SEAM(10);
    if (IN(11)) {
#if !MK_SKIP_ROUTED
#if MK_EXP_V == 1
#if MK_ABL_RT
        if (F.abl) p11_experts_k64<MK_ABL_PROBE>(F); else
#endif
        p11_experts_k64<0>(F);
#else
#if MK_ABL_RT
        if (F.abl) p11_experts<MK_ABL_PROBE>(F); else
#endif
        p11_experts<0>(F);
#endif
#endif
    } SEAM(11);
    if (IN(12)) { p12_final(F); }
#undef IN
#undef SEAM
}

extern "C" void kernel_launch(void* const* d_in, const int* in_sizes, int n_in, void* d_out, int out_size, void* d_ws, size_t ws_size, hipStream_t stream) {
    static int grid = 0;
    if (grid == 0) {
        if (n_in != 22 || in_sizes[0] != M * D || out_size != M * D || ws_size < WS_END) { fprintf(stderr, "kernel_launch: unexpected shapes (n_in %d, in0 %d, out %d, ws %zu, need %zu); nothing launched\n", n_in, n_in > 0 ? in_sizes[0] : -1, out_size, ws_size, (size_t)WS_END); grid = -1; return; }
        int dev = 0, cus = 0, per_cu = 0;
        if (hipGetDevice(&dev) != hipSuccess || hipDeviceGetAttribute(&cus, hipDeviceAttributeMultiprocessorCount, dev) != hipSuccess) { fprintf(stderr, "kernel_launch: device query failed\n"); grid = -1; return; }
        if (hipFuncSetAttribute((const void*)mk_fwd, hipFuncAttributeMaxDynamicSharedMemorySize, LDS_BYTES) != hipSuccess) { fprintf(stderr, "kernel_launch: hipFuncSetAttribute failed\n"); grid = -1; return; }
        if (hipOccupancyMaxActiveBlocksPerMultiprocessor(&per_cu, (const void*)mk_fwd, NT, LDS_BYTES) != hipSuccess || per_cu < 1) { fprintf(stderr, "kernel_launch: occupancy query reports %d workgroups per CU\n", per_cu); (void)hipGetLastError(); grid = -1; return; }
        grid = cus;
    }
    if (grid < 0) return;
    if (hipMemsetAsync((char*)d_ws + WS_CTL, 0, CTL_ZERO_BYTES, stream) != hipSuccess) { fprintf(stderr, "kernel_launch: hipMemsetAsync failed\n"); return; }
    Args a{};
    for (int i = 0; i < 22; ++i) a.in[i] = d_in[i];
    a.out = (float*)d_out; a.ws = (unsigned char*)d_ws;
#if MK_PER_PHASE
    for (int p = 0; p < NPHASE; ++p) { a.ph_lo = p; a.ph_hi = p + 1; hipLaunchKernelGGL(mk_fwd, dim3(grid), dim3(NT), LDS_BYTES, stream, a); }
#elif defined(MK_ABL_PROBE)
    a.ph_lo = 0; a.ph_hi = 12; a.li = 0; a.abl = 1; hipLaunchKernelGGL(mk_fwd, dim3(grid), dim3(NT), LDS_BYTES, stream, a);
    a.ph_lo = 11; a.ph_hi = NPHASE; a.li = 1; a.abl = 0; hipLaunchKernelGGL(mk_fwd, dim3(grid), dim3(NT), LDS_BYTES, stream, a);
#elif defined(MK_PROBE_LO)
    a.ph_lo = 0; a.ph_hi = MK_PROBE_HI; a.li = 0; hipLaunchKernelGGL(mk_fwd, dim3(grid), dim3(NT), LDS_BYTES, stream, a);
    a.ph_lo = MK_PROBE_LO; a.ph_hi = NPHASE; a.li = 1; hipLaunchKernelGGL(mk_fwd, dim3(grid), dim3(NT), LDS_BYTES, stream, a);
#else
    a.ph_lo = 0; a.ph_hi = NPHASE;
    hipLaunchKernelGGL(mk_fwd, dim3(grid), dim3(NT), LDS_BYTES, stream, a);
#endif
    const hipError_t le = hipPeekAtLastError();
    if (le != hipSuccess) fprintf(stderr, "kernel_launch: launch failed: %s\n", hipGetErrorName(le));
}
```

```cpp
#include <hip/hip_runtime.h>
#include <cstdio>
#include <cstdint>
namespace pg8 {
#define PG8_LAS __attribute__((address_space(3)))
typedef unsigned short bf16_t;
typedef short bf16x8 __attribute__((ext_vector_type(8)));
typedef float f32x4 __attribute__((ext_vector_type(4)));
typedef unsigned u32x4 __attribute__((ext_vector_type(4)));
constexpr int BM = 256, BK = 64, HALF = 128, HTB = HALF * BK * 2  , STAGE_BYTES = 8 * HTB, NXCD = 8, WGM = 8;

__host__ __device__ __forceinline__ int lds_byte(int r, int c) { const int st = (r >> 4) * 2 + (c >> 5), rr = r & 15, cc = c & 31, ob = rr * 64 + cc * 2; return st * 1024 + (ob ^ (((ob >> 9) & 1) << 5)); }
__host__ __device__ __forceinline__ void stage_rc(int b, int& R, int& C) { const int st = b / 1024, sb = b % 1024, swz = sb ^ (((sb >> 9) & 1) << 5); R = (st >> 1) * 16 + swz / 64; C = (st & 1) * 32 + (swz % 64) / 2; }
__host__ __device__ __forceinline__ int perm32(int rho) { const int n = rho >> 4, i = rho & 15; return 8 * (i >> 2) + 4 * n + (i & 3); }

struct Unit { int pm, pn; };
struct Gemm { const bf16_t* A; const bf16_t* Bt; int M, N, K; };

struct StaticOrder {
    int nM, nN, nwg, G, c;
    __host__ __device__ void init(int M, int N, int G_, int c_) { nM = M / BM; nN = N / BM; nwg = nM * nN; G = G_; c = c_; }
    __host__ __device__ bool next(int i, Unit& u) const {
        const long L = (long)i * G + c; if (L >= nwg) return false;
        int wgid = (int)L; { const int q = nwg / NXCD, r = nwg % NXCD, xcd = wgid % NXCD, off = wgid / NXCD; wgid = (xcd < r ? xcd * (q + 1) : r * (q + 1) + (xcd - r) * q) + off; }
        const int nig = WGM * nN, gid = wgid / nig, fm = gid * WGM, gsz = (nM - fm) < WGM ? (nM - fm) : WGM;
        u.pm = fm + ((wgid % nig) % gsz); u.pn = (wgid % nig) / gsz; return true;
    }
    __device__ __forceinline__ void a_ready(const Unit&) const {}
    __device__ __forceinline__ void done(const Unit&) const {}
};

__device__ __forceinline__ unsigned cvt_pk_bf16(float lo, float hi) { unsigned r; asm volatile("v_cvt_pk_bf16_f32 %0, %1, %2" : "=v"(r) : "v"(lo), "v"(hi)); return r; }
typedef float f32x2 __attribute__((ext_vector_type(2)));
typedef unsigned u32x2 __attribute__((ext_vector_type(2)));
__device__ __forceinline__ float bf_lo(unsigned w) { return __uint_as_float(w << 16); }
__device__ __forceinline__ float bf_hi(unsigned w) { return __uint_as_float(w & 0xffff0000u); }
__device__ __forceinline__ float sigm(float x) { return 1.0f / (1.0f + __expf(-x)); }
__device__ __forceinline__ float silu_f(float x) { return x / (1.0f + __expf(-x)); }

struct EpiBf16 {
    static constexpr bool PERM = true, AFTER_DRAIN = false;
    bf16_t* O; int ldc;
    __device__ __forceinline__ void operator()(const f32x4 (&acc)[2][2][4][2], const Unit& u, int wr, int wc, int fr, int fq) const {
        const int row0 = u.pm * BM + wr * 64 + fr; const int col0 = u.pn * BM + wc * 32 + 8 * fq;
#pragma unroll
        for (int ai = 0; ai < 2; ++ai)
#pragma unroll
            for (int m = 0; m < 4; ++m) { bf16_t* rowp = O + (size_t)(row0 + ai * HALF + m * 16) * ldc + col0;
#pragma unroll
                for (int bj = 0; bj < 2; ++bj) { const f32x4 v0 = acc[ai][bj][m][0], v1 = acc[ai][bj][m][1];
                    u32x4 w; w.x = cvt_pk_bf16(v0[0], v0[1]); w.y = cvt_pk_bf16(v0[2], v0[3]); w.z = cvt_pk_bf16(v1[0], v1[1]); w.w = cvt_pk_bf16(v1[2], v1[3]);
                    *(u32x4*)(rowp + bj * HALF) = w; } }
    }
};
struct EpiF32 {
    static constexpr bool PERM = false, AFTER_DRAIN = false;
    float* C; int ldc;
    __device__ __forceinline__ void operator()(const f32x4 (&acc)[2][2][4][2], const Unit& u, int wr, int wc, int fr, int fq) const {
        const int row0 = u.pm * BM + wr * 64 + fr, col0 = u.pn * BM + wc * 32 + 4 * fq;
#pragma unroll
        for (int ai = 0; ai < 2; ++ai)
#pragma unroll
            for (int m = 0; m < 4; ++m) { float* rowp = C + (size_t)(row0 + ai * HALF + m * 16) * ldc + col0;
#pragma unroll
                for (int bj = 0; bj < 2; ++bj)
#pragma unroll
                    for (int n = 0; n < 2; ++n) *(f32x4*)(rowp + bj * HALF + n * 16) = acc[ai][bj][m][n]; }
    }
};
struct EpiGateBf16 {
    static constexpr bool PERM = true, AFTER_DRAIN = false;
    bf16_t* O; int ldc; const bf16_t* gate; int ldg;
    __device__ __forceinline__ void operator()(const f32x4 (&acc)[2][2][4][2], const Unit& u, int wr, int wc, int fr, int fq) const {
        const int row0 = u.pm * BM + wr * 64 + fr; const int col0 = u.pn * BM + wc * 32 + 8 * fq;
#pragma unroll
        for (int ai = 0; ai < 2; ++ai)
#pragma unroll
            for (int m = 0; m < 4; ++m) { const size_t r = (size_t)(row0 + ai * HALF + m * 16); bf16_t* rowp = O + r * ldc + col0; const bf16_t* gp = gate + r * ldg + col0;
#pragma unroll
                for (int bj = 0; bj < 2; ++bj) { const f32x4 v0 = acc[ai][bj][m][0], v1 = acc[ai][bj][m][1]; const u32x4 g = *(const u32x4*)(gp + bj * HALF);
                    u32x4 w; w.x = cvt_pk_bf16(sigm(bf_lo(g.x)) * v0[0], sigm(bf_hi(g.x)) * v0[1]); w.y = cvt_pk_bf16(sigm(bf_lo(g.y)) * v0[2], sigm(bf_hi(g.y)) * v0[3]);
                    w.z = cvt_pk_bf16(sigm(bf_lo(g.z)) * v1[0], sigm(bf_hi(g.z)) * v1[1]); w.w = cvt_pk_bf16(sigm(bf_lo(g.w)) * v1[2], sigm(bf_hi(g.w)) * v1[3]);
                    *(u32x4*)(rowp + bj * HALF) = w; } }
    }
};
struct EpiMixBf16 {
    static constexpr bool PERM = true, AFTER_DRAIN = false;
    bf16_t* O; int ldc; const bf16_t* P; const bf16_t* gate; int ldg;
    __device__ __forceinline__ void operator()(const f32x4 (&acc)[2][2][4][2], const Unit& u, int wr, int wc, int fr, int fq) const {
        const int row0 = u.pm * BM + wr * 64 + fr; const int col0 = u.pn * BM + wc * 32 + 8 * fq;
#pragma unroll
        for (int ai = 0; ai < 2; ++ai)
#pragma unroll
            for (int m = 0; m < 4; ++m) { const size_t r = (size_t)(row0 + ai * HALF + m * 16); bf16_t* rowp = O + r * ldc + col0; const bf16_t* pp = P + r * ldc + col0; const bf16_t* gp = gate + r * ldg + col0;
#pragma unroll
                for (int bj = 0; bj < 2; ++bj) { const f32x4 v0 = acc[ai][bj][m][0], v1 = acc[ai][bj][m][1];
                    const u32x4 g = *(const u32x4*)(gp + bj * HALF); const u32x4 pq = *(const u32x4*)(pp + bj * HALF); const f32x4 p0 = {bf_lo(pq.x), bf_hi(pq.x), bf_lo(pq.y), bf_hi(pq.y)}, p1 = {bf_lo(pq.z), bf_hi(pq.z), bf_lo(pq.w), bf_hi(pq.w)};
                    const float o0 = p0[0] + sigm(bf_lo(g.x)) * v0[0], o1 = p0[1] + sigm(bf_hi(g.x)) * v0[1], o2 = p0[2] + sigm(bf_lo(g.y)) * v0[2], o3 = p0[3] + sigm(bf_hi(g.y)) * v0[3];
                    const float o4 = p1[0] + sigm(bf_lo(g.z)) * v1[0], o5 = p1[1] + sigm(bf_hi(g.z)) * v1[1], o6 = p1[2] + sigm(bf_lo(g.w)) * v1[2], o7 = p1[3] + sigm(bf_hi(g.w)) * v1[3];
                    u32x4 w; w.x = cvt_pk_bf16(o0, o1); w.y = cvt_pk_bf16(o2, o3); w.z = cvt_pk_bf16(o4, o5); w.w = cvt_pk_bf16(o6, o7);
                    *(u32x4*)(rowp + bj * HALF) = w; } }
    }
};
struct EpiResid {
    static constexpr bool PERM = false, AFTER_DRAIN = false;
    float* C; const float* base; int ldc; const float* gvec; int gstride; int rows_per_b_shift;
    __device__ __forceinline__ void operator()(const f32x4 (&acc)[2][2][4][2], const Unit& u, int wr, int wc, int fr, int fq) const {
        const int row0 = u.pm * BM + wr * 64 + fr, col0 = u.pn * BM + wc * 32 + 4 * fq;
        const float* gp = gvec + (size_t)((u.pm * BM) >> rows_per_b_shift) * gstride + col0;
        f32x4 gv[2][2];
#pragma unroll
        for (int bj = 0; bj < 2; ++bj)
#pragma unroll
            for (int n = 0; n < 2; ++n) gv[bj][n] = *(const f32x4*)(gp + bj * HALF + n * 16);
#pragma unroll
        for (int ai = 0; ai < 2; ++ai)
#pragma unroll
            for (int m = 0; m < 4; ++m) { const size_t off = (size_t)(row0 + ai * HALF + m * 16) * ldc + col0;
#pragma unroll
                for (int bj = 0; bj < 2; ++bj)
#pragma unroll
                    for (int n = 0; n < 2; ++n) { const f32x4 b = *(const f32x4*)(base + off + bj * HALF + n * 16);
                        *(f32x4*)(C + off + bj * HALF + n * 16) = b + gv[bj][n] * acc[ai][bj][m][n]; } }
    }
};
struct EpiSwiglu {
    static constexpr bool PERM = true, AFTER_DRAIN = false;
    bf16_t* O; int ldo;
    __device__ __forceinline__ void operator()(const f32x4 (&acc)[2][2][4][2], const Unit& u, int wr, int wc, int fr, int fq) const {
        const int row0 = u.pm * BM + wr * 64 + fr; const int col0 = u.pn * BM + wc * 32 + 8 * fq;
#pragma unroll
        for (int ai = 0; ai < 2; ++ai)
#pragma unroll
            for (int m = 0; m < 4; ++m) { bf16_t* rowp = O + (size_t)(row0 + ai * HALF + m * 16) * ldo + (col0 >> 1);
#pragma unroll
                for (int bj = 0; bj < 2; ++bj) { const f32x4 v0 = acc[ai][bj][m][0], v1 = acc[ai][bj][m][1];
                    const float g0 = silu_f(v0[0]) * v0[1], g1 = silu_f(v0[2]) * v0[3], g2 = silu_f(v1[0]) * v1[1], g3 = silu_f(v1[2]) * v1[3];
                    u32x2 w; w.x = cvt_pk_bf16(g0, g1); w.y = cvt_pk_bf16(g2, g3);
                    *(u32x2*)(rowp + bj * (HALF / 2)) = w; } }
    }
};
template <class Epi, class Sched, bool ALIGN_EPI = false, bool SP2 = false>
__device__ __forceinline__ void gemm_phase(PG8_LAS unsigned char* lds, const Gemm g, const Sched& S, const Epi& E) {
    const int tid = threadIdx.x, wid = __builtin_amdgcn_readfirstlane(tid >> 6), lane = tid & 63, wr = wid >> 2, wc = wid & 3, fr = lane & 15, fq = lane >> 4;
    const int K = g.K, nt = K / BK;
    unsigned voffA[2], voffB[2];
#pragma unroll
    for (int i = 0; i < 2; ++i) { int R, C; stage_rc(tid * 16 + i * 8192, R, C); const int Rb = Epi::PERM ? ((R & ~31) + perm32(R & 31)) : R;
        voffA[i] = (unsigned)(R * K + C) * 2u; voffB[i] = (unsigned)(Rb * K + C) * 2u; }
    const size_t kstep = (size_t)(BK * 2);
    const size_t hstep = (size_t)HALF * K * 2;
    const size_t tstep = 2 * hstep;
    const unsigned ldsw = (unsigned)wid * 1024u;
    const int aoff = lds_byte(wr * 64 + fr, fq * 8), boff = lds_byte(wc * 32 + fr, fq * 8);
#define PG8_SA(b, h) (((b) * 2 + (h)) * HTB)
#define PG8_SB(b, h) ((4 + (b) * 2 + (h)) * HTB)
#define PG8_STAGE(bufoff, gbase, voff) do { _Pragma("unroll") for (int _i = 0; _i < 2; ++_i) \
        __builtin_amdgcn_global_load_lds((const unsigned*)((const char*)(gbase) + (voff)[_i]), (PG8_LAS unsigned*)(lds + (bufoff) + ldsw + _i * 8192), 16, 0, 0); } while (0)
#define PG8_LDA(dst, b, h) do { _Pragma("unroll") for (int m = 0; m < 4; ++m) _Pragma("unroll") for (int k = 0; k < 2; ++k) dst[m][k] = *(const PG8_LAS bf16x8*)(lds + PG8_SA(b, h) + aoff + m * 2048 + k * 1024); } while (0)
#define PG8_LDB(dst, b, h) do { _Pragma("unroll") for (int n = 0; n < 2; ++n) _Pragma("unroll") for (int k = 0; k < 2; ++k) dst[n][k] = *(const PG8_LAS bf16x8*)(lds + PG8_SB(b, h) + boff + n * 2048 + k * 1024); } while (0)
#define PG8_MMA(ai, bj, At, Bt) do { __builtin_amdgcn_s_setprio(1); _Pragma("unroll") for (int m = 0; m < 4; ++m) _Pragma("unroll") for (int n = 0; n < 2; ++n) _Pragma("unroll") for (int k = 0; k < 2; ++k) \
        acc[ai][bj][m][n] = __builtin_amdgcn_mfma_f32_16x16x32_bf16(Bt[n][k], At[m][k], acc[ai][bj][m][n], 0, 0, 0); __builtin_amdgcn_s_setprio(0); } while (0)
#define PG8_WAIT_V(n) asm volatile("s_waitcnt vmcnt(" #n ")" ::: "memory")
#define PG8_WAIT_L(n) asm volatile("s_waitcnt lgkmcnt(" #n ")" ::: "memory")
#define PG8_BAR __builtin_amdgcn_s_barrier()
#define PG8_SCHED __builtin_amdgcn_sched_barrier(0)
    Unit cur, nxt; int ui = 0;
    if (!S.next(0, cur)) return;
    f32x4 acc[2][2][4][2];
#pragma unroll
    for (int a = 0; a < 2; ++a)
#pragma unroll
        for (int b = 0; b < 2; ++b)
#pragma unroll
            for (int m = 0; m < 4; ++m)
#pragma unroll
                for (int n = 0; n < 2; ++n) acc[a][b][m][n] = (f32x4){0.f, 0.f, 0.f, 0.f};
    bf16x8 At[4][2], B0[2][2], B1[2][2];
    const char* cA = (const char*)g.A + (size_t)cur.pm * tstep; const char* cB = (const char*)g.Bt + (size_t)cur.pn * tstep;
    S.a_ready(cur);
    if constexpr (SP2) {
        PG8_STAGE(PG8_SB(0, 0), cB, voffB); PG8_STAGE(PG8_SB(0, 1), cB + hstep, voffB); PG8_STAGE(PG8_SA(0, 0), cA, voffA); PG8_STAGE(PG8_SA(0, 1), cA + hstep, voffA);
        if (wr == 1) PG8_BAR;
        PG8_WAIT_V(2); PG8_BAR;
        PG8_STAGE(PG8_SB(1, 0), cB + kstep, voffB); PG8_STAGE(PG8_SA(1, 0), cA + kstep, voffA); PG8_STAGE(PG8_SB(1, 1), cB + hstep + kstep, voffB);
        PG8_WAIT_V(6); PG8_BAR;
    } else {
        PG8_STAGE(PG8_SB(0, 0), cB, voffB); PG8_STAGE(PG8_SA(0, 0), cA, voffA); PG8_STAGE(PG8_SB(0, 1), cB + hstep, voffB); PG8_STAGE(PG8_SA(0, 1), cA + hstep, voffA);
        if (wr == 1) PG8_BAR;
        PG8_WAIT_V(4); PG8_BAR;
        PG8_STAGE(PG8_SB(1, 0), cB + kstep, voffB); PG8_STAGE(PG8_SA(1, 0), cA + kstep, voffA); PG8_STAGE(PG8_SB(1, 1), cB + hstep + kstep, voffB);
        PG8_WAIT_V(6); PG8_BAR;
    }
    for (;;) {
        const bool has_next = S.next(ui + 1, nxt);
        const char* nA = has_next ? (const char*)g.A + (size_t)nxt.pm * tstep : cA; const char* nB = has_next ? (const char*)g.Bt + (size_t)nxt.pn * tstep : cB;
        for (int t = 0; t < nt; t += 2) {
            const bool last = (t == nt - 2);
            const char* a1 = cA + (size_t)(t + 1) * kstep;
            const char* a2 = last ? nA : cA + (size_t)(t + 2) * kstep; const char* b2 = last ? nB : cB + (size_t)(t + 2) * kstep;
            const char* a3 = a2 + kstep; const char* b3 = b2 + kstep;
            if (last && has_next) S.a_ready(nxt);
            if constexpr (SP2) {
            PG8_LDB(B0, 0, 0); PG8_LDB(B1, 0, 1); PG8_SCHED; PG8_LDA(At, 0, 0); PG8_STAGE(PG8_SA(1, 1), a1 + hstep, voffA);
            PG8_WAIT_V(8); PG8_WAIT_L(0); PG8_BAR; PG8_MMA(0, 0, At, B0); PG8_MMA(0, 1, At, B1); PG8_BAR; PG8_SCHED;
            PG8_LDA(At, 0, 1); PG8_STAGE(PG8_SB(0, 0), b2, voffB); PG8_STAGE(PG8_SB(0, 1), b2 + hstep, voffB); PG8_STAGE(PG8_SA(0, 0), a2, voffA);
            PG8_WAIT_V(8); PG8_WAIT_L(0); PG8_BAR; PG8_MMA(1, 0, At, B0); PG8_MMA(1, 1, At, B1); PG8_BAR; PG8_SCHED;
            PG8_LDB(B0, 1, 0); PG8_LDB(B1, 1, 1); PG8_SCHED; PG8_LDA(At, 1, 0); PG8_STAGE(PG8_SA(0, 1), a2 + hstep, voffA);
            PG8_WAIT_V(8); PG8_WAIT_L(0); PG8_BAR; PG8_MMA(0, 0, At, B0); PG8_MMA(0, 1, At, B1); PG8_BAR; PG8_SCHED;
            PG8_LDA(At, 1, 1); PG8_STAGE(PG8_SB(1, 0), b3, voffB); PG8_STAGE(PG8_SB(1, 1), b3 + hstep, voffB); PG8_STAGE(PG8_SA(1, 0), a3, voffA);
            PG8_WAIT_V(8); PG8_WAIT_L(0); PG8_BAR; PG8_MMA(1, 0, At, B0); PG8_MMA(1, 1, At, B1); PG8_BAR; PG8_SCHED;
            } else {
            PG8_LDB(B0, 0, 0); PG8_SCHED; PG8_LDA(At, 0, 0); PG8_STAGE(PG8_SA(1, 1), a1 + hstep, voffA);
            PG8_WAIT_L(8); PG8_BAR; PG8_WAIT_L(0); PG8_MMA(0, 0, At, B0); PG8_BAR; PG8_SCHED;
            PG8_LDB(B1, 0, 1); PG8_STAGE(PG8_SB(0, 0), b2, voffB);
            PG8_BAR; PG8_WAIT_L(0); PG8_MMA(0, 1, At, B1); PG8_BAR;
            PG8_LDA(At, 0, 1); PG8_STAGE(PG8_SA(0, 0), a2, voffA);
            PG8_BAR; PG8_WAIT_L(0); PG8_MMA(1, 0, At, B0); PG8_BAR; PG8_SCHED;
            PG8_STAGE(PG8_SB(0, 1), b2 + hstep, voffB);
            PG8_WAIT_V(6); PG8_BAR; PG8_MMA(1, 1, At, B1); PG8_BAR;
            PG8_LDB(B0, 1, 0); PG8_SCHED; PG8_LDA(At, 1, 0); PG8_STAGE(PG8_SA(0, 1), a2 + hstep, voffA);
            PG8_WAIT_L(8); PG8_BAR; PG8_WAIT_L(0); PG8_MMA(0, 0, At, B0); PG8_BAR; PG8_SCHED;
            PG8_LDB(B1, 1, 1); PG8_STAGE(PG8_SB(1, 0), b3, voffB);
            PG8_BAR; PG8_WAIT_L(0); PG8_MMA(0, 1, At, B1); PG8_BAR;
            PG8_LDA(At, 1, 1); PG8_STAGE(PG8_SA(1, 0), a3, voffA);
            PG8_BAR; PG8_WAIT_L(0); PG8_MMA(1, 0, At, B0); PG8_BAR; PG8_SCHED;
            PG8_STAGE(PG8_SB(1, 1), b3 + hstep, voffB);
            PG8_WAIT_V(6); PG8_BAR; PG8_MMA(1, 1, At, B1); PG8_BAR;
            }
        }
        if constexpr (ALIGN_EPI) { if (wr == 0) PG8_BAR; }
        if constexpr (!Epi::AFTER_DRAIN) { E(acc, cur, wr, wc, fr, fq); S.done(cur); }
        if (!has_next) break;
#pragma unroll
        for (int a = 0; a < 2; ++a)
#pragma unroll
            for (int b = 0; b < 2; ++b)
#pragma unroll
                for (int m = 0; m < 4; ++m)
#pragma unroll
                    for (int n = 0; n < 2; ++n) acc[a][b][m][n] = (f32x4){0.f, 0.f, 0.f, 0.f};
        cur = nxt; cA = nA; cB = nB; ++ui;
        if constexpr (ALIGN_EPI) { if (wr == 1) PG8_BAR; }
    }
    PG8_WAIT_V(0);
    if constexpr (!ALIGN_EPI) { if (wr == 0) PG8_BAR; }
    PG8_BAR;
    if constexpr (Epi::AFTER_DRAIN) { E.fused(acc, cur, wr, wc, fr, fq, lds, wid, lane); S.done(cur); }
#undef PG8_SA
#undef PG8_SB
#undef PG8_STAGE
#undef PG8_LDA
#undef PG8_LDB
#undef PG8_MMA
#undef PG8_WAIT_V
#undef PG8_WAIT_L
#undef PG8_BAR
#undef PG8_SCHED
}
}

constexpr int NWAVES = 8, NT = 512;
#ifndef MK_PER_PHASE
#define MK_PER_PHASE 0
#endif
#ifndef MK_EXP_V
#define MK_EXP_V 2
#endif
#ifndef MK_TIMER_PHASE
#define MK_TIMER_PHASE -1
#endif
#ifndef MK_ABL_RT
#define MK_ABL_RT 0
#endif
#ifndef MK_P10_GEMM_REP
#define MK_P10_GEMM_REP 1
#endif
#ifndef MK_GSYNC
#define MK_GSYNC 0
#endif
#ifndef MK_GSYNC_EVERY
#define MK_GSYNC_EVERY 16
#endif
#ifndef MK_GSTAG
#define MK_GSTAG 0
#endif
#ifndef MK_SKIP_MIXER
#define MK_SKIP_MIXER 0
#endif
#ifndef MK_SKIP_SHARED
#define MK_SKIP_SHARED 0
#endif
#ifndef MK_SKIP_ROUTED
#define MK_SKIP_ROUTED 0
#endif
constexpr int NPHASE = 13;
constexpr int BATCH = 2, SEQ = 8192, D = 1024, M = BATCH * SEQ, NIN = 8192, NMOD = 6144;
constexpr int OFF_Q = 0, OFF_K = 512, OFF_V = 1024, OFF_GR = 2048, OFF_U = 3072, OFF_GC = 4096, OFF_GB = 5120, OFF_MR = 6144, OFF_MC = 7168;
constexpr int NE = 256, TOPK = 8, EH = 256, CAP = 16384, NCH = 64, CH = 128, NH = 4, DK = 128, DV = 256;
constexpr float EPS = 1e-6f;

constexpr size_t MiB = (size_t)1 << 20;
constexpr size_t WS_CTL = 0, CTL_ZERO_BYTES = 1 * MiB;
constexpr size_t WS_MOD = 1 * MiB;
constexpr size_t WS_ROPE = 2 * MiB;
constexpr size_t WS_WR = 10 * MiB;
constexpr size_t WS_WSGU = 11 * MiB;
constexpr size_t WS_WSD = 12 * MiB;
constexpr size_t WS_WBR = 13 * MiB, WS_WBC = 15 * MiB, WS_WO = 17 * MiB;
constexpr size_t WS_WIN = 20 * MiB;
constexpr size_t WS_HB = 36 * MiB;
constexpr size_t WS_PROJ = 68 * MiB;
constexpr size_t WS_KV = 324 * MiB;
constexpr size_t WS_SP = 388 * MiB;
constexpr size_t WS_RETG = 420 * MiB;
constexpr size_t WS_CONVG = 452 * MiB;
constexpr size_t WS_MIXP = 484 * MiB;
constexpr size_t WS_MIX = 548 * MiB;
constexpr size_t WS_X1 = 580 * MiB;
constexpr size_t WS_LOGITS = 644 * MiB;
constexpr size_t WS_SHG = 660 * MiB;
constexpr size_t WS_EIDX = 668 * MiB, WS_POS = 669 * MiB;
constexpr size_t WS_LTOK = 670 * MiB, WS_LW = 686 * MiB;
constexpr size_t WS_YP = 702 * MiB;
constexpr size_t WS_END = 958 * MiB;
constexpr int CW_TMO = 0, CW_CODE = 1, CW_BAR = 4096, CW_CNT = 16384, CW_GS = 131072;

constexpr int LDSCTL_OFF = 143360, MISC_OFF = LDSCTL_OFF + 320, LDS_BYTES = 147456;

#define GAS __attribute__((address_space(1)))
#define LAS __attribute__((address_space(3)))
typedef unsigned short bf16;
typedef unsigned v4u __attribute__((ext_vector_type(4)));
typedef unsigned v2u __attribute__((ext_vector_type(2)));
typedef float f32x4 __attribute__((ext_vector_type(4)));
typedef float f32x2 __attribute__((ext_vector_type(2)));
typedef short bf16x8 __attribute__((ext_vector_type(8)));
typedef short s16x4 __attribute__((ext_vector_type(4)));
typedef GAS unsigned gu32;
#define RLX_AGENT __ATOMIC_RELAXED, __HIP_MEMORY_SCOPE_AGENT
__device__ __forceinline__ unsigned f2bf(float f) { unsigned u = __builtin_bit_cast(unsigned, f); return (u + 0x7fffu + ((u >> 16) & 1u)) >> 16; }
__device__ __forceinline__ unsigned pk2(float lo, float hi) { unsigned r; asm volatile("v_cvt_pk_bf16_f32 %0, %1, %2" : "=v"(r) : "v"(lo), "v"(hi)); return r; }
__device__ __forceinline__ float bflo(unsigned w) { return __uint_as_float(w << 16); }
__device__ __forceinline__ float bfhi(unsigned w) { return __uint_as_float(w & 0xffff0000u); }
__device__ __forceinline__ float sigmoidf_(float x) { return 1.0f / (1.0f + __expf(-x)); }
__device__ __forceinline__ float siluf_(float x) { return x / (1.0f + __expf(-x)); }

#define XB_TMO      128
#define XB_XCNT(j)  (256  + 64 * (j))
#define XB_XSUB(j)  (1280 + 64 * (j))
#define XB_XGEN(j)  (2304 + 64 * (j))
#define XB_TOP      3328
#define XB_TOPGEN   3392
#define XCD_BAR_WORDS 3456
#define XB_SPIN_CAP (1u << 18)

__device__ __forceinline__ unsigned xb_ld(unsigned* p)              { return __hip_atomic_load(p, __ATOMIC_RELAXED, __HIP_MEMORY_SCOPE_AGENT); }
__device__ __forceinline__ unsigned xb_add(unsigned* p, unsigned v) { return __hip_atomic_fetch_add(p, v, __ATOMIC_RELAXED, __HIP_MEMORY_SCOPE_AGENT); }
__device__ __forceinline__ unsigned xb_xcc_id() { return (unsigned)__builtin_amdgcn_s_getreg((3 << 11) | 20) & 0xFu; }
#define XB_SPIN(cond, bar) do { unsigned _sp = 0; while (cond) { __builtin_amdgcn_s_sleep(1); \
    if ((++_sp & 255u) == 0u) { if (xb_ld(&(bar)[XB_TMO])) break; if (_sp > XB_SPIN_CAP) { atomicAdd(&(bar)[XB_TMO], 1u); break; } } } } while (0)

struct XcdBarrier {
    unsigned* bar; unsigned x;
    volatile LAS unsigned* st;
};

__device__ __forceinline__ XcdBarrier xcd_barrier_post(unsigned* bar, volatile LAS unsigned* st) {
    XcdBarrier b; b.bar = bar; b.x = xb_xcc_id(); b.st = st;
    if (threadIdx.x == 0) (void)xb_add(&bar[XB_XCNT(b.x)], 1u);
    return b;
}
__device__ __forceinline__ void xcd_barrier_complete(unsigned* bar, unsigned x, unsigned& nloc, unsigned& nx) {
    const unsigned G = gridDim.x * gridDim.y * gridDim.z;
    unsigned sum, cnt, mine, sp = 0u;
    for (;;) {
        sum = 0u; cnt = 0u; mine = 0u;
#pragma unroll
        for (unsigned j = 0; j < 16; ++j) { const unsigned c = xb_ld(&bar[XB_XCNT(j)]); sum += c; cnt += (c > 0u) ? 1u : 0u; mine = (j == x) ? c : mine; }
        if (sum == G) break;
        __builtin_amdgcn_s_sleep(1);
        if ((++sp & 255u) == 0u) { if (xb_ld(&bar[XB_TMO])) break; if (sp > XB_SPIN_CAP) { atomicAdd(&bar[XB_TMO], 1u); break; } }
    }
    nloc = mine > 0u ? mine : 1u; nx = cnt > 0u ? cnt : 1u;
}

__device__ __forceinline__ void xcd_barrier(const XcdBarrier& b) {
    asm volatile("s_waitcnt vmcnt(0)" ::: "memory");
    __syncthreads();
    if (threadIdx.x == 0) {
        unsigned* bar = b.bar;
        __builtin_amdgcn_s_waitcnt(0);
        unsigned nloc = b.st[0], nx = b.st[1];
        if (nloc == 0u) { xcd_barrier_complete(bar, b.x, nloc, nx); b.st[0] = nloc; b.st[1] = nx; }
        const unsigned old = xb_add(&bar[XB_XSUB(b.x)], 1u);
        const unsigned gen = old / nloc;
        if (old + 1u == (gen + 1u) * nloc) {
            __builtin_amdgcn_fence(__ATOMIC_RELEASE, "agent");
            asm volatile("s_waitcnt vmcnt(0)" ::: "memory");
            const unsigned og = xb_add(&bar[XB_TOP], 1u);
            const unsigned tg = og / nx;
            if (og + 1u == (tg + 1u) * nx) xb_add(&bar[XB_TOPGEN], 1u);
            else XB_SPIN(xb_ld(&bar[XB_TOPGEN]) == tg, bar);
            __builtin_amdgcn_fence(__ATOMIC_ACQUIRE, "agent");
            xb_add(&bar[XB_XGEN(b.x)], 1u);
            asm volatile("s_waitcnt vmcnt(0)" ::: "memory");
        } else {
            XB_SPIN(xb_ld(&bar[XB_XGEN(b.x)]) == gen, bar);
            __builtin_amdgcn_fence(__ATOMIC_ACQUIRE, "agent");
            asm volatile("s_waitcnt vmcnt(0)" ::: "memory");
        }
    }
    __syncthreads();
}

struct Frame {
    LAS unsigned char* lds; unsigned ldsb;
    volatile LAS unsigned* MISC; gu32* ctl;
    int tid, lane, wave, vcu, G, abl;
    const float *x, *c; const int* pos; const float *w_ada, *b_ada, *norm_mix_g, *w_in, *ret_norm_g, *conv_w, *w_br_ret, *w_br_conv, *w_out, *norm_ffn_g, *w_router, *router_bias,
        *w_eg, *w_eu, *w_ed, *w_sg, *w_su, *w_sd, *norm_final_g;
    float* out; unsigned char* ws;
};
__device__ __forceinline__ float wave_sum(float v) {
#pragma unroll
    for (int o = 1; o < 64; o <<= 1) v += __shfl_xor(v, o);
    return v;
}

__device__ __forceinline__ void p0_mod_task(Frame& F, int j) {
    const int cq = F.tid & 15, kq = F.tid >> 4;
    f32x4 a0 = {0.f, 0.f, 0.f, 0.f}, a1 = {0.f, 0.f, 0.f, 0.f};
    const float* W = F.w_ada + 64 * j + 4 * cq;
#pragma unroll 8
    for (int i = 0; i < 32; ++i) { const int k = kq + 32 * i; const float c0 = F.c[k], c1 = F.c[1024 + k];
        const float s0 = c0 / (1.0f + expf(-c0)), s1 = c1 / (1.0f + expf(-c1));
        const f32x4 w = *(const f32x4*)(W + (size_t)k * NMOD); a0 += s0 * w; a1 += s1 * w; }
    LAS f32x4* red = (LAS f32x4*)F.lds;
    red[(kq * 2 + 0) * 16 + cq] = a0; red[(kq * 2 + 1) * 16 + cq] = a1;
    __syncthreads();
    if (F.tid < 32) { const int b = F.tid >> 4, c2 = F.tid & 15; f32x4 s = *(const f32x4*)(F.b_ada + 64 * j + 4 * c2);
        for (int k2 = 0; k2 < 32; ++k2) s += red[(k2 * 2 + b) * 16 + c2];
        *(f32x4*)((float*)(F.ws + WS_MOD) + b * NMOD + 64 * j + 4 * c2) = s; }
    __syncthreads();
}
__device__ __forceinline__ void p0_transpose_item(const float* W, int K, int N, bf16* WT, int row_off, int row_mul, LAS float* scr, int item, int lane) {
    const int nblk = N / 32, kb = item / nblk, nb = item % nblk, k0 = 64 * kb, n0 = 32 * nb;
#pragma unroll 8
    for (int i = 0; i < 32; ++i) { const int kk = 2 * i + (lane >> 5); scr[kk * 33 + (lane & 31)] = W[(size_t)(k0 + kk) * N + n0 + (lane & 31)]; }
    asm volatile("s_waitcnt lgkmcnt(0)" ::: "memory");
    const int c = lane & 7;
#pragma unroll
    for (int j = 0; j < 4; ++j) { const int n = (lane >> 3) + 8 * j; const LAS float* s = scr + (8 * c) * 33 + n;
        v4u o; o.x = pk2(s[0 * 33], s[1 * 33]); o.y = pk2(s[2 * 33], s[3 * 33]); o.z = pk2(s[4 * 33], s[5 * 33]); o.w = pk2(s[6 * 33], s[7 * 33]);
        *(v4u*)(WT + (size_t)(row_off + row_mul * (n0 + n)) * K + k0 + 8 * c) = o; }
    asm volatile("s_waitcnt lgkmcnt(0)" ::: "memory");
}
__device__ __forceinline__ void p0_prologue(Frame& F) {
    if ((int)blockIdx.x < NMOD / 64) p0_mod_task(F, (int)blockIdx.x);
    LAS float* scr = (LAS float*)(F.lds + F.wave * 16384);
    const int gw = F.vcu * NWAVES + F.wave, NGW = F.G * NWAVES;
    constexpr int I_IN = (D / 64) * (NIN / 32), I_SQ = (D / 64) * (D / 32), I_R = (D / 64) * (256 / 32), I_SD = (256 / 64) * (D / 32);
    constexpr int NITEMS = I_IN + 3 * I_SQ + 3 * I_R + I_SD;
    unsigned char* ws = F.ws;
    for (int it = gw; it < NITEMS; it += NGW) {
        int r = it;
        if (r < I_IN) { p0_transpose_item(F.w_in, D, NIN, (bf16*)(ws + WS_WIN), 0, 1, scr, r, F.lane); continue; } r -= I_IN;
        if (r < I_SQ) { p0_transpose_item(F.w_br_ret, D, D, (bf16*)(ws + WS_WBR), 0, 1, scr, r, F.lane); continue; } r -= I_SQ;
        if (r < I_SQ) { p0_transpose_item(F.w_br_conv, D, D, (bf16*)(ws + WS_WBC), 0, 1, scr, r, F.lane); continue; } r -= I_SQ;
        if (r < I_SQ) { p0_transpose_item(F.w_out, D, D, (bf16*)(ws + WS_WO), 0, 1, scr, r, F.lane); continue; } r -= I_SQ;
        if (r < I_R) { p0_transpose_item(F.w_router, D, NE, (bf16*)(ws + WS_WR), 0, 1, scr, r, F.lane); continue; } r -= I_R;
        if (r < I_R) { p0_transpose_item(F.w_sg, D, EH, (bf16*)(ws + WS_WSGU), 0, 2, scr, r, F.lane); continue; } r -= I_R;
        if (r < I_R) { p0_transpose_item(F.w_su, D, EH, (bf16*)(ws + WS_WSGU), 1, 2, scr, r, F.lane); continue; } r -= I_R;
        p0_transpose_item(F.w_sd, EH, D, (bf16*)(ws + WS_WSD), 0, 1, scr, r, F.lane);
    }
    f32x2* rope = (f32x2*)(ws + WS_ROPE);
    for (int idx = F.vcu * NT + F.tid; idx < M * 64; idx += F.G * NT) { const int t = idx >> 6, i = idx & 63;
        const float invf = powf(10000.0f, -(float)i * (1.0f / 64.0f)); const float ang = (float)F.pos[t] * invf;
        const double ad = (double)ang; const double rr = ad - 6.283185307179586 * rint(ad * 0.15915494309189535); const float rf = (float)rr;
        rope[idx] = (f32x2){cosf(rf), sinf(rf)}; }
}

__device__ __forceinline__ void norm_mod_rows(Frame& F, const float* X, const float* gain, int sc_off, int sh_off, bf16* O) {
    const int gw = F.vcu * NWAVES + F.wave, NGW = F.G * NWAVES;
    const float* mod = (const float*)(F.ws + WS_MOD);
    f32x4 g[4];
#pragma unroll
    for (int j = 0; j < 4; ++j) g[j] = *(const f32x4*)(gain + 4 * F.lane + 256 * j);
    for (int m = gw; m < M; m += NGW) {
        const int b = m >> 13; const f32x4* xr = (const f32x4*)(X + (size_t)m * D) + F.lane;
        f32x4 v[4]; float ss = 0.f;
#pragma unroll
        for (int j = 0; j < 4; ++j) { v[j] = xr[64 * j]; ss += (v[j].x * v[j].x + v[j].y * v[j].y) + (v[j].z * v[j].z + v[j].w * v[j].w); }
        const float rstd = 1.0f / sqrtf(wave_sum(ss) * (1.0f / D) + EPS);
        v2u* o8 = (v2u*)(O + (size_t)m * D) + F.lane;
#pragma unroll
        for (int j = 0; j < 4; ++j) { const f32x4 sc = *(const f32x4*)(mod + b * NMOD + sc_off + 4 * F.lane + 256 * j), sh = *(const f32x4*)(mod + b * NMOD + sh_off + 4 * F.lane + 256 * j);
            const f32x4 h = (v[j] * rstd * g[j]) * (1.0f + sc) + sh; v2u w; w.x = pk2(h.x, h.y); w.y = pk2(h.z, h.w); o8[64 * j] = w; }
    }
}

constexpr int KS = 136, KSB = KS * 2;
constexpr int VS = 264, VSB = VS * 2;
__device__ __forceinline__ float log_gamma(int h) { return log1pf(-exp2f(-5.0f - (float)h)); }
__device__ __forceinline__ bf16x8 ldfrag(const LAS unsigned char* img, int row, int rsb, int k) { return *(const LAS bf16x8*)(img + row * rsb + k * 2); }
template <int RS4> __device__ __forceinline__ bf16x8 tr_frag(unsigned addr) {
    s16x4 lo, hi;
    asm volatile("ds_read_b64_tr_b16 %0, %2\n\tds_read_b64_tr_b16 %1, %2 offset:%3\n\ts_waitcnt lgkmcnt(0)" : "=&v"(lo), "=&v"(hi) : "v"(addr), "i"(RS4) : "memory");
    return __builtin_shufflevector(lo, hi, 0, 1, 2, 3, 4, 5, 6, 7);
}
template <int RS4, int STEP> __device__ __forceinline__ void tr_frag4(unsigned addr, bf16x8& f0, bf16x8& f1, bf16x8& f2, bf16x8& f3) {
    s16x4 l0, h0, l1, h1, l2, h2, l3, h3;
    asm volatile("ds_read_b64_tr_b16 %0, %8\n\tds_read_b64_tr_b16 %1, %8 offset:%9\n\t"
                 "ds_read_b64_tr_b16 %2, %8 offset:%10\n\tds_read_b64_tr_b16 %3, %8 offset:%11\n\t"
                 "ds_read_b64_tr_b16 %4, %8 offset:%12\n\tds_read_b64_tr_b16 %5, %8 offset:%13\n\t"
                 "ds_read_b64_tr_b16 %6, %8 offset:%14\n\tds_read_b64_tr_b16 %7, %8 offset:%15\n\ts_waitcnt lgkmcnt(0)"
                 : "=&v"(l0), "=&v"(h0), "=&v"(l1), "=&v"(h1), "=&v"(l2), "=&v"(h2), "=&v"(l3), "=&v"(h3)
                 : "v"(addr), "i"(RS4), "i"(STEP), "i"(STEP + RS4), "i"(2 * STEP), "i"(2 * STEP + RS4), "i"(3 * STEP), "i"(3 * STEP + RS4) : "memory");
    f0 = __builtin_shufflevector(l0, h0, 0, 1, 2, 3, 4, 5, 6, 7); f1 = __builtin_shufflevector(l1, h1, 0, 1, 2, 3, 4, 5, 6, 7);
    f2 = __builtin_shufflevector(l2, h2, 0, 1, 2, 3, 4, 5, 6, 7); f3 = __builtin_shufflevector(l3, h3, 0, 1, 2, 3, 4, 5, 6, 7);
}
#define MFMA16(a, b, c) __builtin_amdgcn_mfma_f32_16x16x32_bf16((a), (b), (c), 0, 0, 0)

template <bool DECAY> __device__ __forceinline__ void stage_rope(Frame& F, LAS unsigned char* img, const bf16* src, const f32x2* rope, float s_const, float lg) {
#pragma unroll
    for (int i = 0; i < 4; ++i) { const int task = F.tid + NT * i, c = task >> 4, g = task & 15;
        const v2u lo = *(const v2u*)(src + (size_t)c * NIN + 4 * g), hi = *(const v2u*)(src + (size_t)c * NIN + 64 + 4 * g);
        const f32x4 r01 = *(const f32x4*)(rope + c * 64 + 4 * g), r23 = *(const f32x4*)(rope + c * 64 + 4 * g + 2);
        const float sc = DECAY ? s_const * __expf(lg * (float)(127 - c)) : s_const;
        const float x1[4] = {bflo(lo.x), bfhi(lo.x), bflo(lo.y), bfhi(lo.y)}, x2[4] = {bflo(hi.x), bfhi(hi.x), bflo(hi.y), bfhi(hi.y)};
        const float cs[4] = {r01.x, r01.z, r23.x, r23.z}, sn[4] = {r01.y, r01.w, r23.y, r23.w};
        float y1[4], y2[4];
#pragma unroll
        for (int j = 0; j < 4; ++j) { y1[j] = (x1[j] * cs[j] - x2[j] * sn[j]) * sc; y2[j] = (x2[j] * cs[j] + x1[j] * sn[j]) * sc; }
        v2u w1, w2; w1.x = pk2(y1[0], y1[1]); w1.y = pk2(y1[2], y1[3]); w2.x = pk2(y2[0], y2[1]); w2.y = pk2(y2[2], y2[3]);
        *(LAS v2u*)(img + c * KSB + 8 * g) = w1; *(LAS v2u*)(img + c * KSB + 128 + 8 * g) = w2; }
}
__device__ __forceinline__ void stage_v(Frame& F, LAS unsigned char* img, const bf16* src) {
#pragma unroll
    for (int i = 0; i < 8; ++i) { const int task = F.tid + NT * i, c = task >> 5, g = task & 31;
        *(LAS v4u*)(img + c * VSB + 16 * g) = *(const v4u*)(src + (size_t)c * NIN + 8 * g); }
}

__device__ __forceinline__ void p3_kv_conv(Frame& F) {
    unsigned char* ws = F.ws; const bf16* PROJ = (const bf16*)(ws + WS_PROJ); const f32x2* ROPE = (const f32x2*)(ws + WS_ROPE); bf16* KV = (bf16*)(ws + WS_KV);
    LAS unsigned char* Kimg = F.lds; LAS unsigned char* Vimg = F.lds + 34816;
    const int w = F.wave, lane = F.lane, g = lane >> 4, q = (lane & 15) >> 2, p = lane & 3;
    for (int it = (int)blockIdx.x; it < BATCH * NH * NCH; it += F.G) {
        const int n = it & 63, h = (it >> 6) & 3, b = it >> 8; const int t0 = b * SEQ + n * CH; const float lg = log_gamma(h);
        stage_rope<true>(F, Kimg, PROJ + (size_t)t0 * NIN + OFF_K + h * DK, ROPE + (size_t)t0 * 64, 1.0f, lg);
        stage_v(F, Vimg, PROJ + (size_t)t0 * NIN + OFF_V + h * DV);
        __syncthreads();
        f32x4 acc[16];
#pragma unroll
        for (int i = 0; i < 16; ++i) acc[i] = (f32x4){0.f, 0.f, 0.f, 0.f};
        const unsigned ka = F.ldsb + (unsigned)((8 * g + q) * KSB + (16 * w + 4 * p) * 2);
        const unsigned va = F.ldsb + 34816u + (unsigned)((8 * g + q) * VSB + (4 * p) * 2);
#pragma unroll
        for (int ks = 0; ks < 4; ++ks) {
            const bf16x8 a = tr_frag<4 * KSB>(ka + ks * 32 * KSB);
#pragma unroll
            for (int nt = 0; nt < 16; nt += 4) { bf16x8 b0, b1, b2, b3; tr_frag4<4 * VSB, 32>(va + ks * 32 * VSB + nt * 32, b0, b1, b2, b3);
                acc[nt] = MFMA16(a, b0, acc[nt]); acc[nt + 1] = MFMA16(a, b1, acc[nt + 1]); acc[nt + 2] = MFMA16(a, b2, acc[nt + 2]); acc[nt + 3] = MFMA16(a, b3, acc[nt + 3]); }
        }
        bf16* kvp = KV + (size_t)it * (DV * DK) + (size_t)(lane & 15) * DK + 16 * w + 4 * g;
#pragma unroll
        for (int nt = 0; nt < 16; ++nt) { v2u wv; wv.x = pk2(acc[nt][0], acc[nt][1]); wv.y = pk2(acc[nt][2], acc[nt][3]); *(v2u*)(kvp + (size_t)(16 * nt) * DK) = wv; }
        __syncthreads();
    }
    bf16* CONVG = (bf16*)(ws + WS_CONVG);
    const int gw = F.vcu * NWAVES + F.wave, NGW = F.G * NWAVES;
    for (int m = gw; m < M; m += NGW) { const int s = m & (SEQ - 1);
#pragma unroll
        for (int j = 0; j < 4; ++j) { const int ch = 4 * lane + 256 * j; const bf16* rp = PROJ + (size_t)m * NIN + ch;
            const f32x4 w0 = *(const f32x4*)(F.conv_w + ch), w1 = *(const f32x4*)(F.conv_w + D + ch), w2 = *(const f32x4*)(F.conv_w + 2 * D + ch);
            const v2u u0 = *(const v2u*)(rp + OFF_U), c0 = *(const v2u*)(rp + OFF_GC), gb = *(const v2u*)(rp + OFF_GB);
            v2u u1 = {0u, 0u}, c1 = {0u, 0u}, u2 = {0u, 0u}, c2 = {0u, 0u};
            if (s >= 1) { u1 = *(const v2u*)(rp - NIN + OFF_U); c1 = *(const v2u*)(rp - NIN + OFF_GC); }
            if (s >= 2) { u2 = *(const v2u*)(rp - 2 * NIN + OFF_U); c2 = *(const v2u*)(rp - 2 * NIN + OFF_GC); }
            f32x4 cu0 = {bflo(u0.x) * bflo(c0.x), bfhi(u0.x) * bfhi(c0.x), bflo(u0.y) * bflo(c0.y), bfhi(u0.y) * bfhi(c0.y)};
            f32x4 cu1 = {bflo(u1.x) * bflo(c1.x), bfhi(u1.x) * bfhi(c1.x), bflo(u1.y) * bflo(c1.y), bfhi(u1.y) * bfhi(c1.y)};
            f32x4 cu2 = {bflo(u2.x) * bflo(c2.x), bfhi(u2.x) * bfhi(c2.x), bflo(u2.y) * bflo(c2.y), bfhi(u2.y) * bfhi(c2.y)};
            const f32x4 gbf = {bflo(gb.x), bfhi(gb.x), bflo(gb.y), bfhi(gb.y)};
            const f32x4 o = gbf * (w0 * cu2 + w1 * cu1 + w2 * cu0);
            v2u wv; wv.x = pk2(o.x, o.y); wv.y = pk2(o.z, o.w); *(v2u*)(CONVG + (size_t)m * D + ch) = wv; }
    }
}

__device__ __forceinline__ void p4_scan(Frame& F) {
    const unsigned* KV = (const unsigned*)(F.ws + WS_KV); unsigned* SP = (unsigned*)(F.ws + WS_SP);
    for (int gid = F.vcu * NT + F.tid; gid < BATCH * NH * (DV * DK / 2); gid += F.G * NT) {
        const int bh = gid >> 14, e2 = gid & 16383, h = bh & 3; const float dec = __expf(log_gamma(h) * 128.0f);
        f32x2 S = {0.f, 0.f};
        const unsigned* kp = KV + (size_t)bh * NCH * 16384 + e2; unsigned* sp = SP + (size_t)bh * NCH * 16384 + e2;
#pragma unroll 8
        for (int n = 0; n < NCH; ++n) { const unsigned kw = kp[(size_t)n * 16384]; const f32x2 kv = {bflo(kw), bfhi(kw)}; sp[(size_t)n * 16384] = pk2(S.x, S.y); S = S * dec + kv; }
    }
}

__device__ __forceinline__ void p5_retention(Frame& F) {
    unsigned char* ws = F.ws; const bf16* PROJ = (const bf16*)(ws + WS_PROJ); const f32x2* ROPE = (const f32x2*)(ws + WS_ROPE); const bf16* SP = (const bf16*)(ws + WS_SP);
    bf16* RETG = (bf16*)(ws + WS_RETG);
    LAS unsigned char* Qimg = F.lds; LAS unsigned char* Kimg = F.lds + 34816; LAS unsigned char* Bimg = F.lds + 69632;
    const int w = F.wave, lane = F.lane, g = lane >> 4, q = (lane & 15) >> 2, p = lane & 3, fr = lane & 15;
    for (int it = (int)blockIdx.x; it < BATCH * NH * NCH; it += F.G) {
        const int n = it & 63, h = (it >> 6) & 3, b = it >> 8; const int t0 = b * SEQ + n * CH; const float lg = log_gamma(h);
        stage_rope<false>(F, Qimg, PROJ + (size_t)t0 * NIN + OFF_Q + h * DK, ROPE + (size_t)t0 * 64, 0.08838834764831845f, 0.f);
        stage_rope<false>(F, Kimg, PROJ + (size_t)t0 * NIN + OFF_K + h * DK, ROPE + (size_t)t0 * 64, 1.0f, 0.f);
        { const bf16* sp = SP + (size_t)it * (DV * DK);
#pragma unroll
          for (int i = 0; i < 8; ++i) { const int task = F.tid + NT * i, r = task >> 4, c16 = task & 15; *(LAS v4u*)(Bimg + r * KSB + 16 * c16) = *(const v4u*)(sp + r * DK + 8 * c16); } }
        __syncthreads();
        f32x4 acc[16];
#pragma unroll
        for (int i = 0; i < 16; ++i) acc[i] = (f32x4){0.f, 0.f, 0.f, 0.f};
        f32x4 sc[8];
#pragma unroll
        for (int i = 0; i < 8; ++i) sc[i] = (f32x4){0.f, 0.f, 0.f, 0.f};
#pragma unroll 1
        for (int ks = 0; ks < 4; ++ks) {
            const bf16x8 qf = ldfrag(Qimg, 16 * w + fr, KSB, 32 * ks + 8 * g);
#pragma unroll
            for (int nt = 0; nt < 16; ++nt) { const bf16x8 sf = ldfrag(Bimg, 16 * nt + fr, KSB, 32 * ks + 8 * g); acc[nt] = MFMA16(sf, qf, acc[nt]); }
#pragma unroll
            for (int jt = 0; jt < 8; ++jt) { const bf16x8 kf = ldfrag(Kimg, 16 * jt + fr, KSB, 32 * ks + 8 * g); sc[jt] = MFMA16(kf, qf, sc[jt]); }
        }
        const int irow = 16 * w + fr;
        { const float cd = __expf(lg * (float)(irow + 1));
#pragma unroll
          for (int nt = 0; nt < 16; ++nt) acc[nt] = acc[nt] * cd; }
        __syncthreads();
#pragma unroll
        for (int jt = 0; jt < 8; ++jt) { float pv[4];
#pragma unroll
            for (int r = 0; r < 4; ++r) { const int j = 16 * jt + 4 * g + r; pv[r] = (irow >= j) ? sc[jt][r] * __expf(lg * (float)(irow - j)) : 0.f; }
            v2u wv; wv.x = pk2(pv[0], pv[1]); wv.y = pk2(pv[2], pv[3]); *(LAS v2u*)(Kimg + irow * KSB + (16 * jt + 4 * g) * 2) = wv; }
        stage_v(F, Bimg, PROJ + (size_t)t0 * NIN + OFF_V + h * DV);
        __syncthreads();
        const unsigned va = F.ldsb + 69632u + (unsigned)((8 * g + q) * VSB + (4 * p) * 2);
#pragma unroll 1
        for (int ks = 0; ks < 4; ++ks) {
            const bf16x8 pf = ldfrag(Kimg, 16 * w + fr, KSB, 32 * ks + 8 * g);
#pragma unroll
            for (int nt = 0; nt < 16; nt += 4) { bf16x8 v0, v1, v2, v3; tr_frag4<4 * VSB, 32>(va + ks * 32 * VSB + nt * 32, v0, v1, v2, v3);
                acc[nt] = MFMA16(v0, pf, acc[nt]); acc[nt + 1] = MFMA16(v1, pf, acc[nt + 1]); acc[nt + 2] = MFMA16(v2, pf, acc[nt + 2]); acc[nt + 3] = MFMA16(v3, pf, acc[nt + 3]); }
        }
        float ss = 0.f;
#pragma unroll
        for (int nt = 0; nt < 16; ++nt) ss += (acc[nt][0] * acc[nt][0] + acc[nt][1] * acc[nt][1]) + (acc[nt][2] * acc[nt][2] + acc[nt][3] * acc[nt][3]);
        ss += __shfl_xor(ss, 16); ss += __shfl_xor(ss, 32);
        const float rstd = 1.0f / sqrtf(ss * (1.0f / DV) + EPS);
        const size_t trow = (size_t)(t0 + irow);
#pragma unroll
        for (int nt = 0; nt < 16; ++nt) { const int dv = 16 * nt + 4 * g; const f32x4 gn = *(const f32x4*)(F.ret_norm_g + h * DV + dv);
            const v2u gr = *(const v2u*)(PROJ + trow * NIN + OFF_GR + h * DV + dv);
            const f32x4 o = acc[nt] * rstd * gn * (f32x4){siluf_(bflo(gr.x)), siluf_(bfhi(gr.x)), siluf_(bflo(gr.y)), siluf_(bfhi(gr.y))};
            v2u wv; wv.x = pk2(o[0], o[1]); wv.y = pk2(o[2], o[3]); *(v2u*)(RETG + trow * D + h * DV + dv) = wv; }
        __syncthreads();
    }
}

__device__ __forceinline__ unsigned f32_key(float x) { const unsigned u = __float_as_uint(x); return (u & 0x80000000u) ? ~u : (u | 0x80000000u); }
__device__ __forceinline__ void route_tokens(Frame& F) {
    unsigned char* ws = F.ws; const float* LOGITS = (const float*)(ws + WS_LOGITS);
    int* EIDX = (int*)(ws + WS_EIDX); int* POS = (int*)(ws + WS_POS); int* LTOK = (int*)(ws + WS_LTOK); float* LW = (float*)(ws + WS_LW);
    unsigned* cnt = (unsigned*)(F.ctl + CW_CNT);
    const int gw = F.vcu * NWAVES + F.wave, NGW = F.G * NWAVES, lane = F.lane;
    const f32x4 bias = *(const f32x4*)(F.router_bias + 4 * lane);
    for (int t0 = 2 * gw; t0 < M; t0 += 2 * NGW) {
        float sc[2][4]; unsigned key[2][4];
#pragma unroll
        for (int u = 0; u < 2; ++u) {
            const f32x4 lgv = *(const f32x4*)(LOGITS + (size_t)(t0 + u) * NE + 4 * lane);
            sc[u][0] = 1.0f / (1.0f + __expf(-lgv.x)); sc[u][1] = 1.0f / (1.0f + __expf(-lgv.y)); sc[u][2] = 1.0f / (1.0f + __expf(-lgv.z)); sc[u][3] = 1.0f / (1.0f + __expf(-lgv.w));
            const float c0 = sc[u][0] + bias.x, c1 = sc[u][1] + bias.y, c2 = sc[u][2] + bias.z, c3 = sc[u][3] + bias.w;
            const float a = fmaxf(c0, c1), bq = fminf(c0, c1), cc = fmaxf(c2, c3), dd = fminf(c2, c3);
            float m1 = fmaxf(a, cc), m2 = fmaxf(fminf(a, cc), fmaxf(bq, dd));
#pragma unroll
            for (int o = 1; o < 8; o <<= 1) { const float o1 = __shfl_xor(m1, o), o2 = __shfl_xor(m2, o); const float n1 = fmaxf(m1, o1), n2 = fmaxf(fminf(m1, o1), fmaxf(m2, o2)); m1 = n1; m2 = n2; }
            const float gs = m1 + m2; const int myg = lane >> 3; int rank = 0;
#pragma unroll
            for (int g2 = 0; g2 < 8; ++g2) { const float sg = __uint_as_float((unsigned)__builtin_amdgcn_readlane((int)__float_as_uint(gs), g2 * 8)); rank += (sg > gs || (sg == gs && g2 < myg)) ? 1 : 0; }
            const bool gsel = rank < 4;
            key[u][0] = gsel ? f32_key(c0) : 0u; key[u][1] = gsel ? f32_key(c1) : 0u; key[u][2] = gsel ? f32_key(c2) : 0u; key[u][3] = gsel ? f32_key(c3) : 0u;
        }
        unsigned th0 = 0u, th1 = 0u;
#pragma unroll 4
        for (int bit = 31; bit >= 0; --bit) {
            const unsigned ca = th0 | (1u << bit), cb = th1 | (1u << bit);
            const int na = __popcll(__ballot(key[0][0] >= ca)) + __popcll(__ballot(key[0][1] >= ca)) + __popcll(__ballot(key[0][2] >= ca)) + __popcll(__ballot(key[0][3] >= ca));
            const int nb = __popcll(__ballot(key[1][0] >= cb)) + __popcll(__ballot(key[1][1] >= cb)) + __popcll(__ballot(key[1][2] >= cb)) + __popcll(__ballot(key[1][3] >= cb));
            th0 = na >= 8 ? ca : th0; th1 = nb >= 8 ? cb : th1;
        }
#pragma unroll
        for (int u = 0; u < 2; ++u) { const unsigned th = u ? th1 : th0; const int t = t0 + u;
            const bool s0 = key[u][0] >= th, s1 = key[u][1] >= th, s2 = key[u][2] >= th, s3 = key[u][3] >= th;
            const unsigned long long b0 = __ballot(s0), b1 = __ballot(s1), b2 = __ballot(s2), b3 = __ballot(s3);
            const unsigned long long lt = (1ull << lane) - 1ull;
            const int base = __popcll(b0 & lt) + __popcll(b1 & lt) + __popcll(b2 & lt) + __popcll(b3 & lt);
            const int r0 = base, r1 = r0 + (s0 ? 1 : 0), r2 = r1 + (s1 ? 1 : 0), r3 = r2 + (s2 ? 1 : 0);
            const float part = (s0 ? sc[u][0] : 0.f) + (s1 ? sc[u][1] : 0.f) + (s2 ? sc[u][2] : 0.f) + (s3 ? sc[u][3] : 0.f);
            const float inv = 2.5f / wave_sum(part);
            if (s0 && r0 < 8) { const int e = 4 * lane; const unsigned ps = __hip_atomic_fetch_add(cnt + 64 * e, 1u, RLX_AGENT); LTOK[(size_t)e * CAP + ps] = t; LW[(size_t)e * CAP + ps] = sc[u][0] * inv; EIDX[t * 8 + r0] = e; POS[t * 8 + r0] = (int)ps; }
            if (s1 && r1 < 8) { const int e = 4 * lane + 1; const unsigned ps = __hip_atomic_fetch_add(cnt + 64 * e, 1u, RLX_AGENT); LTOK[(size_t)e * CAP + ps] = t; LW[(size_t)e * CAP + ps] = sc[u][1] * inv; EIDX[t * 8 + r1] = e; POS[t * 8 + r1] = (int)ps; }
            if (s2 && r2 < 8) { const int e = 4 * lane + 2; const unsigned ps = __hip_atomic_fetch_add(cnt + 64 * e, 1u, RLX_AGENT); LTOK[(size_t)e * CAP + ps] = t; LW[(size_t)e * CAP + ps] = sc[u][2] * inv; EIDX[t * 8 + r2] = e; POS[t * 8 + r2] = (int)ps; }
            if (s3 && r3 < 8) { const int e = 4 * lane + 3; const unsigned ps = __hip_atomic_fetch_add(cnt + 64 * e, 1u, RLX_AGENT); LTOK[(size_t)e * CAP + ps] = t; LW[(size_t)e * CAP + ps] = sc[u][3] * inv; EIDX[t * 8 + r3] = e; POS[t * 8 + r3] = (int)ps; }
        }
    }
}

__device__ __forceinline__ void expert_prefix(Frame& F, LAS int* pref, LAS int* off) {
    if (F.wave == 0) { const unsigned* cnt = (const unsigned*)(F.ctl + CW_CNT); const int lane = F.lane;
        int c[4], nb[4]; int tc = 0, tb = 0;
#pragma unroll
        for (int j = 0; j < 4; ++j) { c[j] = (int)__hip_atomic_load(cnt + 64 * (4 * lane + j), RLX_AGENT); nb[j] = (c[j] + 127) >> 7; tc += c[j]; tb += nb[j]; }
        int xc = tc, xb = tb;
#pragma unroll
        for (int o = 1; o < 64; o <<= 1) { const int vc = __shfl_up(xc, o), vb = __shfl_up(xb, o); if (lane >= o) { xc += vc; xb += vb; } }
        int ec = xc - tc, eb = xb - tb;
#pragma unroll
        for (int j = 0; j < 4; ++j) { off[4 * lane + j] = ec; pref[4 * lane + j] = eb; ec += c[j]; eb += nb[j]; }
        if (lane == 63) { off[256] = ec; pref[256] = eb; } }
}

constexpr int EX_PREF = 0, EX_OFF = 1040, EX_TOK = 2176, EX_W = 2688, EX_BUF = 3200, EX_BUFSZ = 27648, EX_BOFF = 10240, EX_G = EX_BUF + 2 * EX_BUFSZ;
constexpr int ASB = 80, EXD = 4, EXNC = 96;
static_assert(EX_G + 128 * VSB <= LDSCTL_OFF, "expert LDS map");
template <int RS4, int STEP> __device__ __forceinline__ void tr_frag2(unsigned addr, bf16x8& f0, bf16x8& f1) {
    s16x4 l0, h0, l1, h1;
    asm volatile("ds_read_b64_tr_b16 %0, %4\n\tds_read_b64_tr_b16 %1, %4 offset:%5\n\tds_read_b64_tr_b16 %2, %4 offset:%6\n\tds_read_b64_tr_b16 %3, %4 offset:%7\n\ts_waitcnt lgkmcnt(0)"
                 : "=&v"(l0), "=&v"(h0), "=&v"(l1), "=&v"(h1) : "v"(addr), "i"(RS4), "i"(STEP), "i"(STEP + RS4) : "memory");
    f0 = __builtin_shufflevector(l0, h0, 0, 1, 2, 3, 4, 5, 6, 7); f1 = __builtin_shufflevector(l1, h1, 0, 1, 2, 3, 4, 5, 6, 7);
}
struct ExSet { f32x4 w[4]; v4u a; };
template <int ABL> __device__ __forceinline__ void p11_experts(Frame& F) {
    unsigned char* ws = F.ws; const bf16* H2 = (const bf16*)(ws + WS_HB); const int* LTOK = (const int*)(ws + WS_LTOK); const float* LW = (const float*)(ws + WS_LW); bf16* YP = (bf16*)(ws + WS_YP);
    LAS int* pref = (LAS int*)(F.lds + EX_PREF); LAS int* off = (LAS int*)(F.lds + EX_OFF); LAS int* tokl = (LAS int*)(F.lds + EX_TOK); LAS float* wl = (LAS float*)(F.lds + EX_W);
    LAS unsigned char* Gimg = F.lds + EX_G;
    const int tid = F.tid, w = F.wave, wr = w >> 2, wc = w & 3;
    expert_prefix(F, pref, off);
    __syncthreads();
    const int nitems = pref[256];
    for (int it = F.vcu; it < nitems; it += F.G) {
        int e = 0;
#pragma unroll
        for (int s = 128; s >= 1; s >>= 1) if (pref[e + s] <= it) e += s;
        e = __builtin_amdgcn_readfirstlane(e);
        const int rb = __builtin_amdgcn_readfirstlane(it - pref[e]), cnt_e = __builtin_amdgcn_readfirstlane(off[e + 1] - off[e]), r0 = rb * 128, slot0 = __builtin_amdgcn_readfirstlane(off[e]) + r0;
        if (tid < 128) { const int idx = r0 + tid; const bool ok = idx < cnt_e; tokl[tid] = LTOK[(size_t)e * CAP + (ok ? idx : r0)]; wl[tid] = ok ? LW[(size_t)e * CAP + idx] : 0.f; }
        __syncthreads();
        const float* Wg = F.w_eg + (size_t)e * D * EH; const float* Wu = F.w_eu + (size_t)e * D * EH; const float* Wd = F.w_ed + (size_t)e * EH * D;
        const bf16* asrc = H2 + (size_t)tokl[tid >> 2] * D + (tid & 3) * 8;
        int gs_lo, gs_n; { const int xs = (it / F.G) * F.G + (F.vcu & ~31); int lo = pref[e], hi = pref[e + 1]; lo = lo > xs ? lo : xs; hi = hi < xs + 32 ? hi : xs + 32; hi = hi < nitems ? hi : nitems;
            gs_lo = __builtin_amdgcn_readfirstlane(lo); gs_n = __builtin_amdgcn_readfirstlane(hi - lo); }
        unsigned gs_k = 0u;
#define EX_GSYNC() do { if (MK_GSYNC && gs_n > 1) { ++gs_k; if (tid == 0) { unsigned* cw = (unsigned*)(F.ctl + CW_GS) + 64 * gs_lo; __hip_atomic_fetch_add(cw, 1u, RLX_AGENT);               \
                const unsigned long long t0_ = __builtin_amdgcn_s_memrealtime(); const unsigned want = (unsigned)gs_n * gs_k;                                                                 \
                while (__hip_atomic_load(cw, RLX_AGENT) < want) { if (__builtin_amdgcn_s_memrealtime() - t0_ > 20000ull) break; __builtin_amdgcn_s_sleep(2); } }                            \
            __syncthreads(); } } while (0)
        EX_GSYNC();
        if (MK_GSTAG > 0 && gs_n > 1) { const unsigned long long t0_ = __builtin_amdgcn_s_memrealtime(); const unsigned long long d_ = (unsigned long long)(MK_GSTAG * (it - gs_lo)); while (__builtin_amdgcn_s_memrealtime() - t0_ < d_) __builtin_amdgcn_s_sleep(1); }
        f32x4 acc[4][4];
#define EX_ZERO() do { _Pragma("unroll") for (int i = 0; i < 4; ++i) _Pragma("unroll") for (int j = 0; j < 4; ++j) acc[i][j] = (f32x4){0.f, 0.f, 0.f, 0.f}; } while (0)
        EX_ZERO();
        ExSet S0, S1, S2, S3;
#define EX_L1(S, CC) do { const int cc_ = (CC) & 63, hp_ = cc_ >> 5, kc_ = cc_ & 31; int tl = tid; asm volatile("" : "+v"(tl));                         \
            unsigned o = (unsigned)((32 * kc_ + (tl >> 5)) * EH + 128 * hp_ + 4 * (tl & 31));                                                            \
            S.w[0] = *(const f32x4*)(Wg + o); S.w[1] = *(const f32x4*)(Wg + o + 16 * EH); S.w[2] = *(const f32x4*)(Wu + o); S.w[3] = *(const f32x4*)(Wu + o + 16 * EH); \
            S.a = *(const v4u*)(asrc + 32 * kc_); } while (0)
#define EX_W1(S, BUF) do { int tl = tid; asm volatile("" : "+v"(tl)); LAS unsigned char* b_ = (BUF) + EX_BOFF + (tl >> 5) * KSB + 8 * (tl & 31); v2u p_[4];  \
            _Pragma("unroll") for (int i = 0; i < 4; ++i) { p_[i].x = pk2(S.w[i].x, S.w[i].y); p_[i].y = pk2(S.w[i].z, S.w[i].w); }                        \
            *(LAS v2u*)b_ = p_[0]; *(LAS v2u*)(b_ + 16 * KSB) = p_[1]; *(LAS v2u*)(b_ + 32 * KSB) = p_[2]; *(LAS v2u*)(b_ + 48 * KSB) = p_[3];             \
            *(LAS v4u*)((BUF) + (tl >> 2) * ASB + (tl & 3) * 16) = S.a; } while (0)
#define EX_C1(C) do { int tl = tid; asm volatile("" : "+v"(tl)); const int g = (tl >> 4) & 3, fr = tl & 15, q = (tl & 15) >> 2, p = tl & 3;              \
            LAS unsigned char* buf = F.lds + EX_BUF + ((C) & 1) * EX_BUFSZ; const unsigned ta = F.ldsb + EX_BUF + (unsigned)(((C) & 1) * EX_BUFSZ + EX_BOFF + (8 * g + q) * KSB + (32 * wc + 4 * p) * 2); \
            bf16x8 af[4]; _Pragma("unroll") for (int rt = 0; rt < 4; ++rt) af[rt] = ldfrag(buf, 64 * wr + 16 * rt + fr, ASB, 8 * g);                     \
            bf16x8 b0, b1, b2, b3; tr_frag2<4 * KSB, 32>(ta, b0, b1); tr_frag2<4 * KSB, 32>(ta + 32 * KSB, b2, b3);                                       \
            _Pragma("unroll") for (int rt = 0; rt < 4; ++rt) { acc[rt][0] = MFMA16(b0, af[rt], acc[rt][0]); acc[rt][1] = MFMA16(b1, af[rt], acc[rt][1]); acc[rt][2] = MFMA16(b2, af[rt], acc[rt][2]); acc[rt][3] = MFMA16(b3, af[rt], acc[rt][3]); } } while (0)
#define EX_STEP1(SL, SW, C) do { EX_L1(SL, (C) + 4); EX_C1(C); EX_W1(SW, F.lds + EX_BUF + (((C) + 1) & 1) * EX_BUFSZ); __syncthreads(); } while (0)
        EX_L1(S0, 0); EX_L1(S1, 1); EX_L1(S2, 2); EX_L1(S3, 3);
        EX_W1(S0, F.lds + EX_BUF);
        __syncthreads();
#pragma unroll 1
        for (int c4 = 0; c4 < 64; c4 += 4) {
            if (MK_GSYNC_EVERY > 0 && (c4 & (MK_GSYNC_EVERY - 1)) == 0 && c4) EX_GSYNC();
            EX_STEP1(S0, S1, c4); EX_STEP1(S1, S2, c4 + 1); EX_STEP1(S2, S3, c4 + 2); EX_STEP1(S3, S0, c4 + 3);
            if ((c4 & 31) == 28) { const int hp = c4 >> 5; int tl = tid; asm volatile("" : "+v"(tl)); const int g = (tl >> 4) & 3, fr = tl & 15;
#pragma unroll
                for (int rt = 0; rt < 4; ++rt)
#pragma unroll
                    for (int ct = 0; ct < 2; ++ct) { const f32x4 ga = acc[rt][ct], ua = acc[rt][ct + 2];
                        v2u wv; wv.x = pk2(siluf_(ga[0]) * ua[0], siluf_(ga[1]) * ua[1]); wv.y = pk2(siluf_(ga[2]) * ua[2], siluf_(ga[3]) * ua[3]);
                        *(LAS v2u*)(Gimg + (64 * wr + 16 * rt + fr) * VSB + (128 * hp + 32 * wc + 16 * ct + 4 * g) * 2) = wv; }
                EX_ZERO(); }
        }
#define EX_L2(S, CC) do { const int cc_ = (CC) & 31, np_ = cc_ >> 3, kc_ = cc_ & 7; int tl = tid; asm volatile("" : "+v"(tl));                           \
            unsigned o = (unsigned)((32 * kc_ + (tl >> 6)) * D + 256 * np_ + 4 * (tl & 63));                                                              \
            _Pragma("unroll") for (int i = 0; i < 4; ++i) S.w[i] = *(const f32x4*)(Wd + o + (unsigned)(8 * i * D)); } while (0)
#define EX_W2(S, BUF) do { int tl = tid; asm volatile("" : "+v"(tl)); LAS unsigned char* b_ = (BUF) + EX_BOFF + (tl >> 6) * VSB + 8 * (tl & 63);          \
            _Pragma("unroll") for (int i = 0; i < 4; ++i) { v2u p_; p_.x = pk2(S.w[i].x, S.w[i].y); p_.y = pk2(S.w[i].z, S.w[i].w); *(LAS v2u*)(b_ + (8 * i) * VSB) = p_; } } while (0)
#define EX_C2(C) do { int tl = tid; asm volatile("" : "+v"(tl)); const int g = (tl >> 4) & 3, fr = tl & 15, q = (tl & 15) >> 2, p = tl & 3;              \
            const unsigned ta = F.ldsb + EX_BUF + (unsigned)(((C) & 1) * EX_BUFSZ + EX_BOFF + (8 * g + q) * VSB + (64 * wc + 4 * p) * 2);                \
            bf16x8 gf[4]; _Pragma("unroll") for (int rt = 0; rt < 4; ++rt) gf[rt] = ldfrag(Gimg, 64 * wr + 16 * rt + fr, VSB, 32 * ((C) & 7) + 8 * g);   \
            bf16x8 b0, b1, b2, b3; tr_frag4<4 * VSB, 32>(ta, b0, b1, b2, b3);                                                                             \
            _Pragma("unroll") for (int rt = 0; rt < 4; ++rt) { acc[rt][0] = MFMA16(b0, gf[rt], acc[rt][0]); acc[rt][1] = MFMA16(b1, gf[rt], acc[rt][1]); acc[rt][2] = MFMA16(b2, gf[rt], acc[rt][2]); acc[rt][3] = MFMA16(b3, gf[rt], acc[rt][3]); } } while (0)
#define EX_STEP2(SL, SW, C) do { EX_L2(SL, (C) + 4); EX_C2(C); EX_W2(SW, F.lds + EX_BUF + (((C) + 1) & 1) * EX_BUFSZ); __syncthreads(); } while (0)
        EX_L2(S0, 0); EX_L2(S1, 1); EX_L2(S2, 2); EX_L2(S3, 3);
        EX_W2(S0, F.lds + EX_BUF);
        __syncthreads();
#pragma unroll 1
        for (int np = 0; np < 4; ++np) {
            if (MK_GSYNC_EVERY > 0) EX_GSYNC();
#pragma unroll 1
            for (int h4 = 0; h4 < 8; h4 += 4) { const int c4 = 8 * np + h4;
                EX_STEP2(S0, S1, c4); EX_STEP2(S1, S2, c4 + 1); EX_STEP2(S2, S3, c4 + 2); EX_STEP2(S3, S0, c4 + 3); }
            int tl = tid; asm volatile("" : "+v"(tl)); const int g = (tl >> 4) & 3, fr = tl & 15;
#pragma unroll
            for (int rt = 0; rt < 4; ++rt) { const int row = 64 * wr + 16 * rt + fr; const float rw = wl[row];
                if (!(ABL & 32) && r0 + row < cnt_e) { bf16* yp = YP + (size_t)(slot0 + row) * D + 256 * np + 64 * wc + 4 * g;
#pragma unroll
                    for (int ct = 0; ct < 4; ++ct) { const f32x4 o = acc[rt][ct] * rw; v2u wv; wv.x = pk2(o[0], o[1]); wv.y = pk2(o[2], o[3]); *(v2u*)(yp + 16 * ct) = wv; } } }
            EX_ZERO();
        }
#undef EX_L1
#undef EX_W1
#undef EX_C1
#undef EX_STEP1
#undef EX_L2
#undef EX_W2
#undef EX_C2
#undef EX_STEP2
#undef EX_ZERO
#undef EX_GSYNC
        __syncthreads();
    }
}

constexpr int E5_TOK = 2176, E5_W = 3200, E5_BUF = 4224, E5_BUFSZ = 37888, E5_BOFF = 20480;
static_assert(E5_BUF + 2 * E5_BUFSZ <= LDSCTL_OFF, "expert v5 LDS map");
struct E5Set { f32x4 w[4]; v4u a0, a1; };
__device__ __forceinline__ void expert_prefix256(Frame& F, LAS int* pref, LAS int* off) {
    if (F.wave == 0) { const unsigned* cnt = (const unsigned*)(F.ctl + CW_CNT); const int lane = F.lane;
        int c[4], nb[4]; int tc = 0, tb = 0;
#pragma unroll
        for (int j = 0; j < 4; ++j) { c[j] = (int)__hip_atomic_load(cnt + 64 * (4 * lane + j), RLX_AGENT); nb[j] = (c[j] + 255) >> 8; tc += c[j]; tb += nb[j]; }
        int xc = tc, xb = tb;
#pragma unroll
        for (int o = 1; o < 64; o <<= 1) { const int vc = __shfl_up(xc, o), vb = __shfl_up(xb, o); if (lane >= o) { xc += vc; xb += vb; } }
        int ec = xc - tc, eb = xb - tb;
#pragma unroll
        for (int j = 0; j < 4; ++j) { off[4 * lane + j] = ec; pref[4 * lane + j] = eb; ec += c[j]; eb += nb[j]; }
        if (lane == 63) { off[256] = ec; pref[256] = eb; } }
}
__device__ __forceinline__ void p11_experts_v5(Frame& F) {
    unsigned char* ws = F.ws; const bf16* H2 = (const bf16*)(ws + WS_HB); const int* LTOK = (const int*)(ws + WS_LTOK); const float* LW = (const float*)(ws + WS_LW); bf16* YP = (bf16*)(ws + WS_YP);
    bf16* Gs = (bf16*)(ws + WS_RETG) + (size_t)blockIdx.x * 65536;
    LAS int* pref = (LAS int*)(F.lds + EX_PREF); LAS int* off = (LAS int*)(F.lds + EX_OFF); LAS int* tokl = (LAS int*)(F.lds + E5_TOK); LAS float* wl = (LAS float*)(F.lds + E5_W);
    const int tid = F.tid, w = F.wave, wr = w >> 2, wc = w & 3;
    expert_prefix256(F, pref, off);
    __syncthreads();
    const int nitems = pref[256];
    for (int it = F.vcu; it < nitems; it += F.G) {
        int e = 0;
#pragma unroll
        for (int s = 128; s >= 1; s >>= 1) if (pref[e + s] <= it) e += s;
        e = __builtin_amdgcn_readfirstlane(e);
        const int rb = __builtin_amdgcn_readfirstlane(it - pref[e]), cnt_e = __builtin_amdgcn_readfirstlane(off[e + 1] - off[e]), r0 = rb * 256, slot0 = __builtin_amdgcn_readfirstlane(off[e]) + r0;
        if (tid < 256) { const int idx = r0 + tid; const bool ok = idx < cnt_e; tokl[tid] = LTOK[(size_t)e * CAP + (ok ? idx : r0)]; wl[tid] = ok ? LW[(size_t)e * CAP + idx] : 0.f; }
        __syncthreads();
        const float* Wg = F.w_eg + (size_t)e * D * EH; const float* Wu = F.w_eu + (size_t)e * D * EH; const float* Wd = F.w_ed + (size_t)e * EH * D;
        const bf16* asrc = H2 + (size_t)tokl[tid >> 1] * D + (tid & 1) * 16;
        const bf16* gsrc = Gs + (size_t)(tid >> 1) * 256 + (tid & 1) * 16;
        f32x4 acc[2][4][4];
#define E5_ZERO() do { _Pragma("unroll") for (int s_ = 0; s_ < 2; ++s_) _Pragma("unroll") for (int i = 0; i < 4; ++i) _Pragma("unroll") for (int j = 0; j < 4; ++j) acc[s_][i][j] = (f32x4){0.f, 0.f, 0.f, 0.f}; } while (0)
        E5_ZERO();
        E5Set S0, S1;
#define E5_WA(S, BUF, TL) do { *(LAS v4u*)((BUF) + ((TL) >> 1) * ASB + ((TL) & 1) * 32) = S.a0; *(LAS v4u*)((BUF) + ((TL) >> 1) * ASB + ((TL) & 1) * 32 + 16) = S.a1; } while (0)
#define E5_MMA(BUF, B0, B1, B2, B3, FR, G_) do { _Pragma("unroll") for (int s_ = 0; s_ < 2; ++s_) _Pragma("unroll") for (int rt = 0; rt < 4; ++rt) {                       \
            const bf16x8 af = ldfrag((BUF), 128 * s_ + 64 * wr + 16 * rt + (FR), ASB, 8 * (G_));                                                                          \
            acc[s_][rt][0] = MFMA16(B0, af, acc[s_][rt][0]); acc[s_][rt][1] = MFMA16(B1, af, acc[s_][rt][1]); acc[s_][rt][2] = MFMA16(B2, af, acc[s_][rt][2]); acc[s_][rt][3] = MFMA16(B3, af, acc[s_][rt][3]); } } while (0)
#define E5_L1(S, CC) do { const int cc_ = (CC) & 63, hp_ = cc_ >> 5, kc_ = cc_ & 31; int tl = tid; asm volatile("" : "+v"(tl));                         \
            unsigned o = (unsigned)((32 * kc_ + (tl >> 5)) * EH + 128 * hp_ + 4 * (tl & 31));                                                            \
            S.w[0] = *(const f32x4*)(Wg + o); S.w[1] = *(const f32x4*)(Wg + o + 16 * EH); S.w[2] = *(const f32x4*)(Wu + o); S.w[3] = *(const f32x4*)(Wu + o + 16 * EH); \
            S.a0 = *(const v4u*)(asrc + 32 * kc_); S.a1 = *(const v4u*)(asrc + 32 * kc_ + 8); } while (0)
#define E5_W1(S, BUF) do { int tl = tid; asm volatile("" : "+v"(tl)); LAS unsigned char* b_ = (BUF) + E5_BOFF + (tl >> 5) * KSB + 8 * (tl & 31); v2u p_[4];  \
            _Pragma("unroll") for (int i = 0; i < 4; ++i) { p_[i].x = pk2(S.w[i].x, S.w[i].y); p_[i].y = pk2(S.w[i].z, S.w[i].w); }                        \
            *(LAS v2u*)b_ = p_[0]; *(LAS v2u*)(b_ + 16 * KSB) = p_[1]; *(LAS v2u*)(b_ + 32 * KSB) = p_[2]; *(LAS v2u*)(b_ + 48 * KSB) = p_[3];             \
            E5_WA(S, BUF, tl); } while (0)
#define E5_C1(BUFI) do { int tl = tid; asm volatile("" : "+v"(tl)); const int g = (tl >> 4) & 3, fr = tl & 15, q = (tl & 15) >> 2, p = tl & 3;          \
            LAS unsigned char* buf = F.lds + E5_BUF + (BUFI) * E5_BUFSZ; const unsigned ta = F.ldsb + E5_BUF + (unsigned)((BUFI) * E5_BUFSZ + E5_BOFF + (8 * g + q) * KSB + (32 * wc + 4 * p) * 2); \
            bf16x8 b0, b1, b2, b3; tr_frag2<4 * KSB, 32>(ta, b0, b1); tr_frag2<4 * KSB, 32>(ta + 32 * KSB, b2, b3);                                       \
            E5_MMA(buf, b0, b1, b2, b3, fr, g); } while (0)
        E5Set S2;
#define E5_GW(HP) do { int tl = tid; asm volatile("" : "+v"(tl)); const int g = (tl >> 4) & 3, fr = tl & 15;     \
            _Pragma("unroll") for (int s_ = 0; s_ < 2; ++s_) _Pragma("unroll") for (int rt = 0; rt < 4; ++rt) _Pragma("unroll") for (int ct = 0; ct < 2; ++ct) { const f32x4 ga = acc[s_][rt][ct], ua = acc[s_][rt][ct + 2]; \
                v2u wv; wv.x = pk2(siluf_(ga[0]) * ua[0], siluf_(ga[1]) * ua[1]); wv.y = pk2(siluf_(ga[2]) * ua[2], siluf_(ga[3]) * ua[3]);                   \
                *(v2u*)(Gs + (size_t)(128 * s_ + 64 * wr + 16 * rt + fr) * 256 + 128 * (HP) + 32 * wc + 16 * ct + 4 * g) = wv; }                              \
            E5_ZERO(); } while (0)
#define E5_STEP1(SL, SW, CC) do { const int bi_ = (CC) & 1; E5_L1(SL, (CC) + 3); E5_C1(bi_); E5_W1(SW, F.lds + E5_BUF + (1 - bi_) * E5_BUFSZ); __syncthreads(); } while (0)
        E5_L1(S0, 0); E5_L1(S1, 1); E5_L1(S2, 2);
        E5_W1(S0, F.lds + E5_BUF);
        __syncthreads();
#pragma unroll 1
        for (int c3 = 0; c3 < 63; c3 += 3) {
            E5_STEP1(S0, S1, c3); E5_STEP1(S1, S2, c3 + 1);
            if (c3 == 30) E5_GW(0);
            E5_STEP1(S2, S0, c3 + 2);
        }
        E5_STEP1(S0, S1, 63);
        E5_GW(1);
#undef E5_STEP1
#undef E5_GW
        asm volatile("s_waitcnt vmcnt(0)" ::: "memory");
        __syncthreads();
#define E5_L2(S, CC) do { const int cc_ = (CC) & 31, np_ = cc_ >> 3, kc_ = cc_ & 7; int tl = tid; asm volatile("" : "+v"(tl));                           \
            unsigned o = (unsigned)((32 * kc_ + (tl >> 6)) * D + 256 * np_ + 4 * (tl & 63));                                                              \
            _Pragma("unroll") for (int i = 0; i < 4; ++i) S.w[i] = *(const f32x4*)(Wd + o + (unsigned)(8 * i * D));                                       \
            S.a0 = *(const v4u*)(gsrc + 32 * kc_); S.a1 = *(const v4u*)(gsrc + 32 * kc_ + 8); } while (0)
#define E5_W2(S, BUF) do { int tl = tid; asm volatile("" : "+v"(tl)); LAS unsigned char* b_ = (BUF) + E5_BOFF + (tl >> 6) * VSB + 8 * (tl & 63);          \
            _Pragma("unroll") for (int i = 0; i < 4; ++i) { v2u p_; p_.x = pk2(S.w[i].x, S.w[i].y); p_.y = pk2(S.w[i].z, S.w[i].w); *(LAS v2u*)(b_ + (8 * i) * VSB) = p_; } \
            E5_WA(S, BUF, tl); } while (0)
#define E5_C2(BUFI) do { int tl = tid; asm volatile("" : "+v"(tl)); const int g = (tl >> 4) & 3, fr = tl & 15, q = (tl & 15) >> 2, p = tl & 3;          \
            LAS unsigned char* buf = F.lds + E5_BUF + (BUFI) * E5_BUFSZ; const unsigned ta = F.ldsb + E5_BUF + (unsigned)((BUFI) * E5_BUFSZ + E5_BOFF + (8 * g + q) * VSB + (64 * wc + 4 * p) * 2); \
            bf16x8 b0, b1, b2, b3; tr_frag4<4 * VSB, 32>(ta, b0, b1, b2, b3);                                                                             \
            E5_MMA(buf, b0, b1, b2, b3, fr, g); } while (0)
        E5_L2(S0, 0); E5_L2(S1, 1);
        E5_W2(S0, F.lds + E5_BUF);
        __syncthreads();
#pragma unroll 1
        for (int np = 0; np < 4; ++np) {
#pragma unroll 1
            for (int h2 = 0; h2 < 8; h2 += 2) { const int c2 = 8 * np + h2;
                E5_L2(S0, c2 + 2); E5_C2(0); E5_W2(S1, F.lds + E5_BUF + E5_BUFSZ); __syncthreads();
                E5_L2(S1, c2 + 3); E5_C2(1); E5_W2(S0, F.lds + E5_BUF); __syncthreads(); }
            int tl = tid; asm volatile("" : "+v"(tl)); const int g = (tl >> 4) & 3, fr = tl & 15;
#pragma unroll
            for (int s_ = 0; s_ < 2; ++s_)
#pragma unroll
                for (int rt = 0; rt < 4; ++rt) { const int row = 128 * s_ + 64 * wr + 16 * rt + fr; const float rw = wl[row];
                    if (r0 + row < cnt_e) { bf16* yp = YP + (size_t)(slot0 + row) * D + 256 * np + 64 * wc + 4 * g;
#pragma unroll
                        for (int ct = 0; ct < 4; ++ct) { const f32x4 o = acc[s_][rt][ct] * rw; v2u wv; wv.x = pk2(o[0], o[1]); wv.y = pk2(o[2], o[3]); *(v2u*)(yp + 16 * ct) = wv; } } }
            E5_ZERO();
        }
#undef E5_L1
#undef E5_W1
#undef E5_C1
#undef E5_L2
#undef E5_W2
#undef E5_C2
#undef E5_MMA
#undef E5_WA
#undef E5_ZERO
        asm volatile("s_waitcnt vmcnt(0)" ::: "memory");
        __syncthreads();
    }
}

constexpr int K6_A = 3200, K6_BG = 21632, K6_BU = 39040, K6_G = 56448;
constexpr int ASB6 = 144;
#define K6MM(a, b, c) ((ABL & 1) ? k6_keep((a), (b), (c)) : MFMA16((a), (b), (c)))
__device__ __forceinline__ f32x4 k6_keep(bf16x8 a, bf16x8 b, f32x4 c) { asm volatile("" :: "v"(a), "v"(b)); return c; }
struct K6Set { f32x4 w[8]; v4u a0, a1; };
template <int ABL> __device__ __forceinline__ void p11_experts_k64(Frame& F) {
    unsigned char* ws = F.ws; const bf16* H2 = (const bf16*)(ws + WS_HB); const int* LTOK = (const int*)(ws + WS_LTOK); const float* LW = (const float*)(ws + WS_LW); bf16* YP = (bf16*)(ws + WS_YP);
    LAS int* pref = (LAS int*)(F.lds + EX_PREF); LAS int* off = (LAS int*)(F.lds + EX_OFF); LAS int* tokl = (LAS int*)(F.lds + EX_TOK); LAS float* wl = (LAS float*)(F.lds + EX_W);
    LAS unsigned char* Aimg = F.lds + K6_A; LAS unsigned char* Gimg = F.lds + K6_G;
    const int tid = F.tid, w = F.wave, wr = w >> 2, wc = w & 3;
    expert_prefix(F, pref, off);
    __syncthreads();
    const int nitems = pref[256];
    for (int it = F.vcu; it < nitems; it += F.G) {
        int e = 0;
#pragma unroll
        for (int s = 128; s >= 1; s >>= 1) if (pref[e + s] <= it) e += s;
        e = __builtin_amdgcn_readfirstlane(e);
        const int rb = __builtin_amdgcn_readfirstlane(it - pref[e]), cnt_e = __builtin_amdgcn_readfirstlane(off[e + 1] - off[e]), r0 = rb * 128, slot0 = __builtin_amdgcn_readfirstlane(off[e]) + r0;
        if (tid < 128) { const int idx = r0 + tid; const bool ok = idx < cnt_e; tokl[tid] = LTOK[(size_t)e * CAP + (ok ? idx : r0)]; wl[tid] = ok ? LW[(size_t)e * CAP + idx] : 0.f; }
        __syncthreads();
        const int ew = e;
        const float* Wg = F.w_eg + (size_t)ew * D * EH; const float* Wu = F.w_eu + (size_t)ew * D * EH; const float* Wd = F.w_ed + (size_t)ew * EH * D;
        const bf16* asrc = H2 + (size_t)tokl[tid >> 2] * D + (tid & 3) * 16;
        f32x4 acc[4][4];
#pragma unroll
        for (int i = 0; i < 4; ++i)
#pragma unroll
            for (int j = 0; j < 4; ++j) acc[i][j] = (f32x4){0.f, 0.f, 0.f, 0.f};
        K6Set S0, S1;
        if constexpr (ABL & 16) {
#pragma unroll
            for (int i = 0; i < 8; ++i) { S0.w[i] = (f32x4){1.f, 1.f, 1.f, 1.f}; S1.w[i] = (f32x4){1.f, 1.f, 1.f, 1.f}; } S0.a0 = S0.a1 = S1.a0 = S1.a1 = (v4u){0u, 0u, 0u, 0u}; }
#define K6_LOAD1(S, CC) do { const int cc_ = (CC) & 31, hp_ = cc_ >> 4, kc_ = cc_ & 15; int tl = tid; asm volatile("" : "+v"(tl));                      \
            unsigned o = (unsigned)((64 * kc_ + (tl >> 5)) * EH + 128 * hp_ + 4 * (tl & 31));                                                            \
            if constexpr (!(ABL & 16)) { _Pragma("unroll") for (int i = 0; i < 4; ++i) { S.w[i] = *(const f32x4*)(Wg + o + (unsigned)(16 * i * EH)); S.w[4 + i] = *(const f32x4*)(Wu + o + (unsigned)(16 * i * EH)); } \
            S.a0 = *(const v4u*)(asrc + 64 * kc_); S.a1 = *(const v4u*)(asrc + 64 * kc_ + 8); } } while (0)
#define K6_STEP1(S, CC) do { int tl = tid; asm volatile("" : "+v"(tl)); const int g = (tl >> 4) & 3, fr = tl & 15, q = (tl & 15) >> 2, p = tl & 3;    \
            if constexpr (!(ABL & 8)) __syncthreads();                                                                                                       \
            if constexpr (!(ABL & 2)) { *(LAS v4u*)(Aimg + (tl >> 2) * ASB6 + (tl & 3) * 32) = S.a0; *(LAS v4u*)(Aimg + (tl >> 2) * ASB6 + (tl & 3) * 32 + 16) = S.a1; }            \
            if constexpr (!(ABL & 2)) _Pragma("unroll") for (int i = 0; i < 4; ++i) { v2u wg, wu; wg.x = pk2(S.w[i].x, S.w[i].y); wg.y = pk2(S.w[i].z, S.w[i].w); wu.x = pk2(S.w[4 + i].x, S.w[4 + i].y); wu.y = pk2(S.w[4 + i].z, S.w[4 + i].w); \
                *(LAS v2u*)(F.lds + K6_BG + ((tl >> 5) + 16 * i) * KSB + 8 * (tl & 31)) = wg; *(LAS v2u*)(F.lds + K6_BU + ((tl >> 5) + 16 * i) * KSB + 8 * (tl & 31)) = wu; } \
            if constexpr (!(ABL & 8)) __syncthreads();                                                                                                       \
            K6_LOAD1(S, (CC) + 2);                                                                                                                       \
            const unsigned bga = F.ldsb + K6_BG + (unsigned)((8 * g + q) * KSB + (32 * wc + 4 * p) * 2), bua = bga + (K6_BU - K6_BG);                   \
            if constexpr (!(ABL & 4)) _Pragma("unroll") for (int s = 0; s < 2; ++s) { bf16x8 af[4];                                                                                \
                _Pragma("unroll") for (int rt = 0; rt < 4; ++rt) af[rt] = ldfrag(Aimg, 64 * wr + 16 * rt + fr, ASB6, 32 * s + 8 * g);                    \
                bf16x8 b0, b1, b2, b3; tr_frag2<4 * KSB, 32>(bga + s * 32 * KSB, b0, b1); tr_frag2<4 * KSB, 32>(bua + s * 32 * KSB, b2, b3);             \
                _Pragma("unroll") for (int rt = 0; rt < 4; ++rt) { acc[rt][0] = K6MM(b0, af[rt], acc[rt][0]); acc[rt][1] = K6MM(b1, af[rt], acc[rt][1]); acc[rt][2] = K6MM(b2, af[rt], acc[rt][2]); acc[rt][3] = K6MM(b3, af[rt], acc[rt][3]); } } } while (0)
        K6_LOAD1(S0, 0); K6_LOAD1(S1, 1);
#pragma unroll 1
        for (int cc = 0; cc < 32; cc += 2) {
            K6_STEP1(S0, cc); K6_STEP1(S1, cc + 1);
            if ((cc & 15) == 14) { const int hp = cc >> 4; int tl = tid; asm volatile("" : "+v"(tl)); const int g = (tl >> 4) & 3, fr = tl & 15;
#pragma unroll
                for (int rt = 0; rt < 4; ++rt)
#pragma unroll
                    for (int ct = 0; ct < 2; ++ct) { const f32x4 ga = acc[rt][ct], ua = acc[rt][ct + 2];
                        v2u wv; wv.x = pk2(siluf_(ga[0]) * ua[0], siluf_(ga[1]) * ua[1]); wv.y = pk2(siluf_(ga[2]) * ua[2], siluf_(ga[3]) * ua[3]);
                        *(LAS v2u*)(Gimg + (64 * wr + 16 * rt + fr) * VSB + (128 * hp + 32 * wc + 16 * ct + 4 * g) * 2) = wv; }
#pragma unroll
                for (int i = 0; i < 4; ++i)
#pragma unroll
                    for (int j = 0; j < 4; ++j) acc[i][j] = (f32x4){0.f, 0.f, 0.f, 0.f}; }
        }
#undef K6_STEP1
#undef K6_LOAD1
#define K6_LOAD2(S, CC) do { const int cc_ = (CC) & 15, np_ = cc_ >> 2, kc_ = cc_ & 3; int tl = tid; asm volatile("" : "+v"(tl));                       \
            unsigned o = (unsigned)((64 * kc_ + (tl >> 6)) * D + 256 * np_ + 4 * (tl & 63));                                                             \
            if constexpr (!(ABL & 16)) { _Pragma("unroll") for (int i = 0; i < 8; ++i) S.w[i] = *(const f32x4*)(Wd + o + (unsigned)(8 * i * D)); } } while (0)
#define K6_STEP2(S, CC, KC) do { int tl = tid; asm volatile("" : "+v"(tl)); const int g = (tl >> 4) & 3, fr = tl & 15, q = (tl & 15) >> 2, p = tl & 3; \
            if constexpr (!(ABL & 8)) __syncthreads();                                                                                                       \
            if constexpr (!(ABL & 2)) _Pragma("unroll") for (int i = 0; i < 8; ++i) { v2u wd; wd.x = pk2(S.w[i].x, S.w[i].y); wd.y = pk2(S.w[i].z, S.w[i].w); *(LAS v2u*)(F.lds + K6_BG + ((tl >> 6) + 8 * i) * VSB + 8 * (tl & 63)) = wd; } \
            if constexpr (!(ABL & 8)) __syncthreads();                                                                                                       \
            K6_LOAD2(S, (CC) + 2);                                                                                                                       \
            const unsigned bda = F.ldsb + K6_BG + (unsigned)((8 * g + q) * VSB + (64 * wc + 4 * p) * 2);                                                \
            if constexpr (!(ABL & 4)) _Pragma("unroll") for (int s = 0; s < 2; ++s) { bf16x8 gf[4];                                                                                \
                _Pragma("unroll") for (int rt = 0; rt < 4; ++rt) gf[rt] = ldfrag(Gimg, 64 * wr + 16 * rt + fr, VSB, 64 * (KC) + 32 * s + 8 * g);        \
                bf16x8 b0, b1, b2, b3; tr_frag4<4 * VSB, 32>(bda + s * 32 * VSB, b0, b1, b2, b3);                                                        \
                _Pragma("unroll") for (int rt = 0; rt < 4; ++rt) { acc[rt][0] = K6MM(b0, gf[rt], acc[rt][0]); acc[rt][1] = K6MM(b1, gf[rt], acc[rt][1]); acc[rt][2] = K6MM(b2, gf[rt], acc[rt][2]); acc[rt][3] = K6MM(b3, gf[rt], acc[rt][3]); } } } while (0)
        K6_LOAD2(S0, 0); K6_LOAD2(S1, 1);
#pragma unroll 1
        for (int np = 0; np < 4; ++np) {
            K6_STEP2(S0, 4 * np, 0); K6_STEP2(S1, 4 * np + 1, 1); K6_STEP2(S0, 4 * np + 2, 2); K6_STEP2(S1, 4 * np + 3, 3);
            int tl = tid; asm volatile("" : "+v"(tl)); const int g = (tl >> 4) & 3, fr = tl & 15;
#pragma unroll
            for (int rt = 0; rt < 4; ++rt) { const int row = 64 * wr + 16 * rt + fr; const float rw = wl[row];
                if (!(ABL & 32) && r0 + row < cnt_e) { bf16* yp = YP + (size_t)(slot0 + row) * D + 256 * np + 64 * wc + 4 * g;
#pragma unroll
                    for (int ct = 0; ct < 4; ++ct) { const f32x4 o = acc[rt][ct] * rw; v2u wv; wv.x = pk2(o[0], o[1]); wv.y = pk2(o[2], o[3]); *(v2u*)(yp + 16 * ct) = wv; } } }
#pragma unroll
            for (int i = 0; i < 4; ++i)
#pragma unroll
                for (int j = 0; j < 4; ++j) acc[i][j] = (f32x4){0.f, 0.f, 0.f, 0.f};
        }
#undef K6_STEP2
#undef K6_LOAD2
        __syncthreads();
    }
}

#undef K6MM
__device__ __forceinline__ void p12_final(Frame& F) {
    unsigned char* ws = F.ws; const float* X1 = (const float*)(ws + (MK_SKIP_SHARED ? WS_X1 : WS_MIXP)); const bf16* YP = (const bf16*)(ws + WS_YP); const int* EIDX = (const int*)(ws + WS_EIDX); const int* POS = (const int*)(ws + WS_POS);
    const float* mod = (const float*)(ws + WS_MOD);
    LAS int* pref = (LAS int*)(F.lds + EX_PREF); LAS int* off = (LAS int*)(F.lds + EX_OFF);
    expert_prefix(F, pref, off);
    __syncthreads();
    const int gw = F.vcu * NWAVES + F.wave, NGW = F.G * NWAVES, lane = F.lane;
    f32x4 gn[4];
#pragma unroll
    for (int j = 0; j < 4; ++j) gn[j] = *(const f32x4*)(F.norm_final_g + 4 * lane + 256 * j);
    for (int t = gw; t < M; t += NGW) {
        const int b = t >> 13;
        f32x4 y[4];
#pragma unroll
        for (int j = 0; j < 4; ++j) y[j] = (f32x4){0.f, 0.f, 0.f, 0.f};
#if !MK_SKIP_ROUTED
        int myslot = 0;
        if (lane < 8) myslot = off[EIDX[t * 8 + lane]] + POS[t * 8 + lane];
#pragma unroll
        for (int k = 0; k < 8; ++k) { const int slot = __shfl(myslot, k); const v2u* yp = (const v2u*)(YP + (size_t)slot * D) + lane;
#pragma unroll
            for (int j = 0; j < 4; ++j) { const v2u v = yp[64 * j]; y[j] += (f32x4){bflo(v.x), bfhi(v.x), bflo(v.y), bfhi(v.y)}; } }
#endif
        const f32x4* xr = (const f32x4*)(X1 + (size_t)t * D) + lane; f32x4 v[4]; float ss = 0.f;
#pragma unroll
        for (int j = 0; j < 4; ++j) { const f32x4 g2 = *(const f32x4*)(mod + b * NMOD + 5 * D + 4 * lane + 256 * j); v[j] = xr[64 * j] + g2 * y[j];
            ss += (v[j].x * v[j].x + v[j].y * v[j].y) + (v[j].z * v[j].z + v[j].w * v[j].w); }
        const float rstd = 1.0f / sqrtf(wave_sum(ss) * (1.0f / D) + EPS);
        f32x4* op = (f32x4*)(F.out + (size_t)t * D) + lane;
#pragma unroll
        for (int j = 0; j < 4; ++j) op[64 * j] = v[j] * rstd * gn[j];
    }
}

struct Args { const void* in[22]; float* out; unsigned char* ws; int ph_lo, ph_hi, li, abl; };
__global__ void __launch_bounds__(NT, 2) mk_fwd(Args args) {
    extern __shared__ __attribute__((aligned(16))) unsigned char lds[];
    Frame F;
    F.lds = (LAS unsigned char*)lds; F.ldsb = (unsigned)(size_t)F.lds;
    F.MISC = (volatile LAS unsigned*)(F.lds + MISC_OFF);
    F.tid = threadIdx.x; F.lane = F.tid & 63; F.wave = __builtin_amdgcn_readfirstlane(F.tid >> 6);
    F.G = gridDim.x; { const int bx = blockIdx.x; F.vcu = (F.G % 8 == 0) ? (bx % 8) * (F.G / 8) + bx / 8 : bx; }
    F.abl = MK_ABL_RT ? args.abl : 0;
    unsigned char* ws = args.ws; F.ws = ws; F.ctl = (gu32*)(ws + WS_CTL); F.out = args.out;
    F.x = (const float*)args.in[0]; F.c = (const float*)args.in[1]; F.pos = (const int*)args.in[2]; F.w_ada = (const float*)args.in[3]; F.b_ada = (const float*)args.in[4];
    F.norm_mix_g = (const float*)args.in[5]; F.w_in = (const float*)args.in[6]; F.ret_norm_g = (const float*)args.in[7]; F.conv_w = (const float*)args.in[8];
    F.w_br_ret = (const float*)args.in[9]; F.w_br_conv = (const float*)args.in[10]; F.w_out = (const float*)args.in[11]; F.norm_ffn_g = (const float*)args.in[12];
    F.w_router = (const float*)args.in[13]; F.router_bias = (const float*)args.in[14]; F.w_eg = (const float*)args.in[15]; F.w_eu = (const float*)args.in[16]; F.w_ed = (const float*)args.in[17];
    F.w_sg = (const float*)args.in[18]; F.w_su = (const float*)args.in[19]; F.w_sd = (const float*)args.in[20]; F.norm_final_g = (const float*)args.in[21];
    for (int u = F.tid; u < (LDS_BYTES - LDSCTL_OFF) / 4; u += NT) ((LAS unsigned*)(F.lds + LDSCTL_OFF))[u] = 0u;
    __syncthreads();
    XcdBarrier bar; bar.bar = (unsigned*)(F.ctl + CW_BAR) + args.li * XCD_BAR_WORDS; bar.x = 0; bar.st = nullptr;
    if (!MK_PER_PHASE) bar = xcd_barrier_post((unsigned*)(F.ctl + CW_BAR) + args.li * XCD_BAR_WORDS, F.MISC + 8);
    const int lo = args.ph_lo, hi = args.ph_hi;
#ifndef MK_PHASE_MASK
#define MK_PHASE_MASK 0x1fff
#endif
#define IN(k) (((MK_PHASE_MASK >> (k)) & 1) && lo <= (k) && (k) < hi)
#ifndef MK_BAR_REP
#define MK_BAR_REP 1
#endif
#define SEAM(k) do { if (IN(k) && IN((k) + 1)) { for (int br_ = 0; br_ < MK_BAR_REP; ++br_) xcd_barrier(bar); } } while (0)
#ifndef MK_DOUBLE_MASK
#define MK_DOUBLE_MASK 0
#endif
#define REP(k) for (int rep_ = 0; rep_ < (((MK_DOUBLE_MASK >> (k)) & 1) ? 2 : 1); ++rep_, (((MK_DOUBLE_MASK >> (k)) & 1) && rep_ == 1 ? xcd_barrier(bar) : (void)0))
    bf16* HB = (bf16*)(ws + WS_HB); bf16* PROJ = (bf16*)(ws + WS_PROJ); const float* mod = (const float*)(ws + WS_MOD);

    if (IN(0)) { p0_prologue(F); } SEAM(0);
    if (IN(1)) { norm_mod_rows(F, F.x, F.norm_mix_g, 1 * D, 0 * D, HB); } SEAM(1);
    if (IN(2)) {
        pg8::Gemm g{HB, (const bf16*)(ws + WS_WIN), M, NIN, D}; pg8::StaticOrder S; S.init(M, NIN, F.G, (int)blockIdx.x);
        pg8::EpiBf16 E{PROJ, NIN};
        pg8::gemm_phase<pg8::EpiBf16, pg8::StaticOrder, true, true>(F.lds, g, S, E);
    } SEAM(2);
    if (IN(3)) { p3_kv_conv(F); } SEAM(3);
    if (IN(4)) { p4_scan(F); } SEAM(4);
    if (IN(5)) { p5_retention(F); } SEAM(5);
    if (IN(6)) {
        { pg8::Gemm g{(const bf16*)(ws + WS_RETG), (const bf16*)(ws + WS_WBR), M, D, D}; pg8::StaticOrder S; S.init(M, D, F.G, (int)blockIdx.x);
          pg8::EpiGateBf16 E{(bf16*)(ws + WS_MIXP), D, PROJ + OFF_MR, NIN};
          pg8::gemm_phase<pg8::EpiGateBf16, pg8::StaticOrder, true, true>(F.lds, g, S, E); }
        asm volatile("s_waitcnt vmcnt(0)" ::: "memory"); __syncthreads();
        { pg8::Gemm g{(const bf16*)(ws + WS_CONVG), (const bf16*)(ws + WS_WBC), M, D, D}; pg8::StaticOrder S; S.init(M, D, F.G, (int)blockIdx.x);
          pg8::EpiMixBf16 E{(bf16*)(ws + WS_MIX), D, (const bf16*)(ws + WS_MIXP), PROJ + OFF_MC, NIN};
          pg8::gemm_phase<pg8::EpiMixBf16, pg8::StaticOrder, true, true>(F.lds, g, S, E); }
    } SEAM(6);
    if (IN(7)) {
#if MK_SKIP_MIXER
        for (size_t i = (size_t)F.vcu * NT + F.tid; i < (size_t)M * D / 4; i += (size_t)F.G * NT) ((f32x4*)(ws + WS_X1))[i] = ((const f32x4*)F.x)[i];
#else
        pg8::Gemm g{(const bf16*)(ws + WS_MIX), (const bf16*)(ws + WS_WO), M, D, D}; pg8::StaticOrder S; S.init(M, D, F.G, (int)blockIdx.x);
        pg8::EpiResid E{(float*)(ws + WS_X1), F.x, D, mod + 2 * D, NMOD, 13};
        pg8::gemm_phase<pg8::EpiResid, pg8::StaticOrder, true, true>(F.lds, g, S, E);
#endif
    } SEAM(7);
    if (IN(8)) { norm_mod_rows(F, (const float*)(ws + WS_X1), F.norm_ffn_g, 4 * D, 3 * D, HB); } SEAM(8);
    if (IN(9)) {
        { pg8::Gemm g{HB, (const bf16*)(ws + WS_WR), M, NE, D}; pg8::StaticOrder S; S.init(M, NE, F.G, (int)blockIdx.x);
          pg8::EpiF32 E{(float*)(ws + WS_LOGITS), NE};
          pg8::gemm_phase<pg8::EpiF32, pg8::StaticOrder, true, true>(F.lds, g, S, E); }
        { pg8::Gemm g{HB, (const bf16*)(ws + WS_WSGU), M, 2 * EH, D}; pg8::StaticOrder S; S.init(M, 2 * EH, F.G, (int)((blockIdx.x + F.G / 2) % F.G));
          pg8::EpiSwiglu E{(bf16*)(ws + WS_SHG), EH};
          pg8::gemm_phase<pg8::EpiSwiglu, pg8::StaticOrder, true, true>(F.lds, g, S, E); }
    } SEAM(9);
    if (IN(10)) {
#if !MK_SKIP_SHARED
        for (int rp_ = 0; rp_ < MK_P10_GEMM_REP; ++rp_)
        { pg8::Gemm g{(const bf16*)(ws + WS_SHG), (const bf16*)(ws + WS_WSD), M, D, EH}; pg8::StaticOrder S; S.init(M, D, F.G, (int)blockIdx.x);
          pg8::EpiResid E{(float*)(ws + WS_MIXP), (const float*)(ws + WS_X1), D, mod + 5 * D, NMOD, 13};
          pg8::gemm_phase<pg8::EpiResid, pg8::StaticOrder, true, true>(F.lds, g, S, E); }
#endif
        route_tokens(F);
    } SEAM(10);
    if (IN(11)) {
#if !MK_SKIP_ROUTED
#if MK_EXP_V == 3
        p11_experts_v5(F);
#elif MK_EXP_V == 1
#if MK_ABL_RT
        if (F.abl) p11_experts_k64<MK_ABL_PROBE>(F); else
#endif
        p11_experts_k64<0>(F);
#else
#if MK_ABL_RT
        if (F.abl) p11_experts<MK_ABL_PROBE>(F); else
#endif
        p11_experts<0>(F);
#endif
#endif
    } SEAM(11);
    if (IN(12)) { p12_final(F); }
#undef IN
#undef SEAM
}

extern "C" void kernel_launch(void* const* d_in, const int* in_sizes, int n_in, void* d_out, int out_size, void* d_ws, size_t ws_size, hipStream_t stream) {
    static int grid = 0;
    if (grid == 0) {
        if (n_in != 22 || in_sizes[0] != M * D || out_size != M * D || ws_size < WS_END) { fprintf(stderr, "kernel_launch: unexpected shapes (n_in %d, in0 %d, out %d, ws %zu, need %zu); nothing launched\n", n_in, n_in > 0 ? in_sizes[0] : -1, out_size, ws_size, (size_t)WS_END); grid = -1; return; }
        int dev = 0, cus = 0, per_cu = 0;
        if (hipGetDevice(&dev) != hipSuccess || hipDeviceGetAttribute(&cus, hipDeviceAttributeMultiprocessorCount, dev) != hipSuccess) { fprintf(stderr, "kernel_launch: device query failed\n"); grid = -1; return; }
        if (hipFuncSetAttribute((const void*)mk_fwd, hipFuncAttributeMaxDynamicSharedMemorySize, LDS_BYTES) != hipSuccess) { fprintf(stderr, "kernel_launch: hipFuncSetAttribute failed\n"); grid = -1; return; }
        if (hipOccupancyMaxActiveBlocksPerMultiprocessor(&per_cu, (const void*)mk_fwd, NT, LDS_BYTES) != hipSuccess || per_cu < 1) { fprintf(stderr, "kernel_launch: occupancy query reports %d workgroups per CU\n", per_cu); (void)hipGetLastError(); grid = -1; return; }
        grid = cus;
    }
    if (grid < 0) return;
    if (hipMemsetAsync((char*)d_ws + WS_CTL, 0, CTL_ZERO_BYTES, stream) != hipSuccess) { fprintf(stderr, "kernel_launch: hipMemsetAsync failed\n"); return; }
    Args a{};
    for (int i = 0; i < 22; ++i) a.in[i] = d_in[i];
    a.out = (float*)d_out; a.ws = (unsigned char*)d_ws;
#if MK_PER_PHASE
    for (int p = 0; p < NPHASE; ++p) { a.ph_lo = p; a.ph_hi = p + 1; hipLaunchKernelGGL(mk_fwd, dim3(grid), dim3(NT), LDS_BYTES, stream, a); }
#elif defined(MK_ABL_PROBE)
    a.ph_lo = 0; a.ph_hi = 12; a.li = 0; a.abl = 1; hipLaunchKernelGGL(mk_fwd, dim3(grid), dim3(NT), LDS_BYTES, stream, a);
    a.ph_lo = 11; a.ph_hi = NPHASE; a.li = 1; a.abl = 0; hipLaunchKernelGGL(mk_fwd, dim3(grid), dim3(NT), LDS_BYTES, stream, a);
#elif defined(MK_PROBE_LO)
    a.ph_lo = 0; a.ph_hi = MK_PROBE_HI; a.li = 0; hipLaunchKernelGGL(mk_fwd, dim3(grid), dim3(NT), LDS_BYTES, stream, a);
    a.ph_lo = MK_PROBE_LO; a.ph_hi = NPHASE; a.li = 1; hipLaunchKernelGGL(mk_fwd, dim3(grid), dim3(NT), LDS_BYTES, stream, a);
#else
    a.ph_lo = 0; a.ph_hi = NPHASE;
    hipLaunchKernelGGL(mk_fwd, dim3(grid), dim3(NT), LDS_BYTES, stream, a);
#endif
    const hipError_t le = hipPeekAtLastError();
    if (le != hipSuccess) fprintf(stderr, "kernel_launch: launch failed: %s\n", hipGetErrorName(le));
}
```

```cpp
#include <hip/hip_runtime.h>
#include <cstdio>
#include <cstdint>
#define MK_EXP_V 4
namespace pg8 {
#define PG8_LAS __attribute__((address_space(3)))
typedef unsigned short bf16_t;
typedef short bf16x8 __attribute__((ext_vector_type(8)));
typedef float f32x4 __attribute__((ext_vector_type(4)));
typedef unsigned u32x4 __attribute__((ext_vector_type(4)));
constexpr int BM = 256, BK = 64, HALF = 128, HTB = HALF * BK * 2  , STAGE_BYTES = 8 * HTB, NXCD = 8, WGM = 8;

__host__ __device__ __forceinline__ int lds_byte(int r, int c) { const int st = (r >> 4) * 2 + (c >> 5), rr = r & 15, cc = c & 31, ob = rr * 64 + cc * 2; return st * 1024 + (ob ^ (((ob >> 9) & 1) << 5)); }
__host__ __device__ __forceinline__ void stage_rc(int b, int& R, int& C) { const int st = b / 1024, sb = b % 1024, swz = sb ^ (((sb >> 9) & 1) << 5); R = (st >> 1) * 16 + swz / 64; C = (st & 1) * 32 + (swz % 64) / 2; }
__host__ __device__ __forceinline__ int perm32(int rho) { const int n = rho >> 4, i = rho & 15; return 8 * (i >> 2) + 4 * n + (i & 3); }

struct Unit { int pm, pn; };
struct Gemm { const bf16_t* A; const bf16_t* Bt; int M, N, K; };

struct StaticOrder {
    int nM, nN, nwg, G, c;
    __host__ __device__ void init(int M, int N, int G_, int c_) { nM = M / BM; nN = N / BM; nwg = nM * nN; G = G_; c = c_; }
    __host__ __device__ bool next(int i, Unit& u) const {
        const long L = (long)i * G + c; if (L >= nwg) return false;
        int wgid = (int)L; { const int q = nwg / NXCD, r = nwg % NXCD, xcd = wgid % NXCD, off = wgid / NXCD; wgid = (xcd < r ? xcd * (q + 1) : r * (q + 1) + (xcd - r) * q) + off; }
        const int nig = WGM * nN, gid = wgid / nig, fm = gid * WGM, gsz = (nM - fm) < WGM ? (nM - fm) : WGM;
        u.pm = fm + ((wgid % nig) % gsz); u.pn = (wgid % nig) / gsz; return true;
    }
    __device__ __forceinline__ void a_ready(const Unit&) const {}
    __device__ __forceinline__ void done(const Unit&) const {}
};

__device__ __forceinline__ unsigned cvt_pk_bf16(float lo, float hi) { unsigned r; asm volatile("v_cvt_pk_bf16_f32 %0, %1, %2" : "=v"(r) : "v"(lo), "v"(hi)); return r; }
typedef float f32x2 __attribute__((ext_vector_type(2)));
typedef unsigned u32x2 __attribute__((ext_vector_type(2)));
__device__ __forceinline__ float bf_lo(unsigned w) { return __uint_as_float(w << 16); }
__device__ __forceinline__ float bf_hi(unsigned w) { return __uint_as_float(w & 0xffff0000u); }
__device__ __forceinline__ float sigm(float x) { return 1.0f / (1.0f + __expf(-x)); }
__device__ __forceinline__ float silu_f(float x) { return x / (1.0f + __expf(-x)); }

struct EpiBf16 {
    static constexpr bool PERM = true, AFTER_DRAIN = false;
    bf16_t* O; int ldc;
    __device__ __forceinline__ void operator()(const f32x4 (&acc)[2][2][4][2], const Unit& u, int wr, int wc, int fr, int fq) const {
        const int row0 = u.pm * BM + wr * 64 + fr; const int col0 = u.pn * BM + wc * 32 + 8 * fq;
#pragma unroll
        for (int ai = 0; ai < 2; ++ai)
#pragma unroll
            for (int m = 0; m < 4; ++m) { bf16_t* rowp = O + (size_t)(row0 + ai * HALF + m * 16) * ldc + col0;
#pragma unroll
                for (int bj = 0; bj < 2; ++bj) { const f32x4 v0 = acc[ai][bj][m][0], v1 = acc[ai][bj][m][1];
                    u32x4 w; w.x = cvt_pk_bf16(v0[0], v0[1]); w.y = cvt_pk_bf16(v0[2], v0[3]); w.z = cvt_pk_bf16(v1[0], v1[1]); w.w = cvt_pk_bf16(v1[2], v1[3]);
                    *(u32x4*)(rowp + bj * HALF) = w; } }
    }
};
struct EpiF32 {
    static constexpr bool PERM = false, AFTER_DRAIN = false;
    float* C; int ldc;
    __device__ __forceinline__ void operator()(const f32x4 (&acc)[2][2][4][2], const Unit& u, int wr, int wc, int fr, int fq) const {
        const int row0 = u.pm * BM + wr * 64 + fr, col0 = u.pn * BM + wc * 32 + 4 * fq;
#pragma unroll
        for (int ai = 0; ai < 2; ++ai)
#pragma unroll
            for (int m = 0; m < 4; ++m) { float* rowp = C + (size_t)(row0 + ai * HALF + m * 16) * ldc + col0;
#pragma unroll
                for (int bj = 0; bj < 2; ++bj)
#pragma unroll
                    for (int n = 0; n < 2; ++n) *(f32x4*)(rowp + bj * HALF + n * 16) = acc[ai][bj][m][n]; }
    }
};
struct EpiGateBf16 {
    static constexpr bool PERM = true, AFTER_DRAIN = false;
    bf16_t* O; int ldc; const bf16_t* gate; int ldg;
    __device__ __forceinline__ void operator()(const f32x4 (&acc)[2][2][4][2], const Unit& u, int wr, int wc, int fr, int fq) const {
        const int row0 = u.pm * BM + wr * 64 + fr; const int col0 = u.pn * BM + wc * 32 + 8 * fq;
#pragma unroll
        for (int ai = 0; ai < 2; ++ai)
#pragma unroll
            for (int m = 0; m < 4; ++m) { const size_t r = (size_t)(row0 + ai * HALF + m * 16); bf16_t* rowp = O + r * ldc + col0; const bf16_t* gp = gate + r * ldg + col0;
#pragma unroll
                for (int bj = 0; bj < 2; ++bj) { const f32x4 v0 = acc[ai][bj][m][0], v1 = acc[ai][bj][m][1]; const u32x4 g = *(const u32x4*)(gp + bj * HALF);
                    u32x4 w; w.x = cvt_pk_bf16(sigm(bf_lo(g.x)) * v0[0], sigm(bf_hi(g.x)) * v0[1]); w.y = cvt_pk_bf16(sigm(bf_lo(g.y)) * v0[2], sigm(bf_hi(g.y)) * v0[3]);
                    w.z = cvt_pk_bf16(sigm(bf_lo(g.z)) * v1[0], sigm(bf_hi(g.z)) * v1[1]); w.w = cvt_pk_bf16(sigm(bf_lo(g.w)) * v1[2], sigm(bf_hi(g.w)) * v1[3]);
                    *(u32x4*)(rowp + bj * HALF) = w; } }
    }
};
struct EpiMixBf16 {
    static constexpr bool PERM = true, AFTER_DRAIN = false;
    bf16_t* O; int ldc; const bf16_t* P; const bf16_t* gate; int ldg;
    __device__ __forceinline__ void operator()(const f32x4 (&acc)[2][2][4][2], const Unit& u, int wr, int wc, int fr, int fq) const {
        const int row0 = u.pm * BM + wr * 64 + fr; const int col0 = u.pn * BM + wc * 32 + 8 * fq;
#pragma unroll
        for (int ai = 0; ai < 2; ++ai)
#pragma unroll
            for (int m = 0; m < 4; ++m) { const size_t r = (size_t)(row0 + ai * HALF + m * 16); bf16_t* rowp = O + r * ldc + col0; const bf16_t* pp = P + r * ldc + col0; const bf16_t* gp = gate + r * ldg + col0;
#pragma unroll
                for (int bj = 0; bj < 2; ++bj) { const f32x4 v0 = acc[ai][bj][m][0], v1 = acc[ai][bj][m][1];
                    const u32x4 g = *(const u32x4*)(gp + bj * HALF); const u32x4 pq = *(const u32x4*)(pp + bj * HALF); const f32x4 p0 = {bf_lo(pq.x), bf_hi(pq.x), bf_lo(pq.y), bf_hi(pq.y)}, p1 = {bf_lo(pq.z), bf_hi(pq.z), bf_lo(pq.w), bf_hi(pq.w)};
                    const float o0 = p0[0] + sigm(bf_lo(g.x)) * v0[0], o1 = p0[1] + sigm(bf_hi(g.x)) * v0[1], o2 = p0[2] + sigm(bf_lo(g.y)) * v0[2], o3 = p0[3] + sigm(bf_hi(g.y)) * v0[3];
                    const float o4 = p1[0] + sigm(bf_lo(g.z)) * v1[0], o5 = p1[1] + sigm(bf_hi(g.z)) * v1[1], o6 = p1[2] + sigm(bf_lo(g.w)) * v1[2], o7 = p1[3] + sigm(bf_hi(g.w)) * v1[3];
                    u32x4 w; w.x = cvt_pk_bf16(o0, o1); w.y = cvt_pk_bf16(o2, o3); w.z = cvt_pk_bf16(o4, o5); w.w = cvt_pk_bf16(o6, o7);
                    *(u32x4*)(rowp + bj * HALF) = w; } }
    }
};
struct EpiResid {
    static constexpr bool PERM = false, AFTER_DRAIN = false;
    float* C; const float* base; int ldc; const float* gvec; int gstride; int rows_per_b_shift;
    __device__ __forceinline__ void operator()(const f32x4 (&acc)[2][2][4][2], const Unit& u, int wr, int wc, int fr, int fq) const {
        const int row0 = u.pm * BM + wr * 64 + fr, col0 = u.pn * BM + wc * 32 + 4 * fq;
        const float* gp = gvec + (size_t)((u.pm * BM) >> rows_per_b_shift) * gstride + col0;
        f32x4 gv[2][2];
#pragma unroll
        for (int bj = 0; bj < 2; ++bj)
#pragma unroll
            for (int n = 0; n < 2; ++n) gv[bj][n] = *(const f32x4*)(gp + bj * HALF + n * 16);
#pragma unroll
        for (int ai = 0; ai < 2; ++ai)
#pragma unroll
            for (int m = 0; m < 4; ++m) { const size_t off = (size_t)(row0 + ai * HALF + m * 16) * ldc + col0;
#pragma unroll
                for (int bj = 0; bj < 2; ++bj)
#pragma unroll
                    for (int n = 0; n < 2; ++n) { const f32x4 b = *(const f32x4*)(base + off + bj * HALF + n * 16);
                        *(f32x4*)(C + off + bj * HALF + n * 16) = b + gv[bj][n] * acc[ai][bj][m][n]; } }
    }
};
struct EpiSwiglu {
    static constexpr bool PERM = true, AFTER_DRAIN = false;
    bf16_t* O; int ldo;
    __device__ __forceinline__ void operator()(const f32x4 (&acc)[2][2][4][2], const Unit& u, int wr, int wc, int fr, int fq) const {
        const int row0 = u.pm * BM + wr * 64 + fr; const int col0 = u.pn * BM + wc * 32 + 8 * fq;
#pragma unroll
        for (int ai = 0; ai < 2; ++ai)
#pragma unroll
            for (int m = 0; m < 4; ++m) { bf16_t* rowp = O + (size_t)(row0 + ai * HALF + m * 16) * ldo + (col0 >> 1);
#pragma unroll
                for (int bj = 0; bj < 2; ++bj) { const f32x4 v0 = acc[ai][bj][m][0], v1 = acc[ai][bj][m][1];
                    const float g0 = silu_f(v0[0]) * v0[1], g1 = silu_f(v0[2]) * v0[3], g2 = silu_f(v1[0]) * v1[1], g3 = silu_f(v1[2]) * v1[3];
                    u32x2 w; w.x = cvt_pk_bf16(g0, g1); w.y = cvt_pk_bf16(g2, g3);
                    *(u32x2*)(rowp + bj * (HALF / 2)) = w; } }
    }
};
template <class Epi, class Sched, bool ALIGN_EPI = false, bool SP2 = false>
__device__ __forceinline__ void gemm_phase(PG8_LAS unsigned char* lds, const Gemm g, const Sched& S, const Epi& E) {
    const int tid = threadIdx.x, wid = __builtin_amdgcn_readfirstlane(tid >> 6), lane = tid & 63, wr = wid >> 2, wc = wid & 3, fr = lane & 15, fq = lane >> 4;
    const int K = g.K, nt = K / BK;
    unsigned voffA[2], voffB[2];
#pragma unroll
    for (int i = 0; i < 2; ++i) { int R, C; stage_rc(tid * 16 + i * 8192, R, C); const int Rb = Epi::PERM ? ((R & ~31) + perm32(R & 31)) : R;
        voffA[i] = (unsigned)(R * K + C) * 2u; voffB[i] = (unsigned)(Rb * K + C) * 2u; }
    const size_t kstep = (size_t)(BK * 2);
    const size_t hstep = (size_t)HALF * K * 2;
    const size_t tstep = 2 * hstep;
    const unsigned ldsw = (unsigned)wid * 1024u;
    const int aoff = lds_byte(wr * 64 + fr, fq * 8), boff = lds_byte(wc * 32 + fr, fq * 8);
#define PG8_SA(b, h) (((b) * 2 + (h)) * HTB)
#define PG8_SB(b, h) ((4 + (b) * 2 + (h)) * HTB)
#define PG8_STAGE(bufoff, gbase, voff) do { _Pragma("unroll") for (int _i = 0; _i < 2; ++_i) \
        __builtin_amdgcn_global_load_lds((const unsigned*)((const char*)(gbase) + (voff)[_i]), (PG8_LAS unsigned*)(lds + (bufoff) + ldsw + _i * 8192), 16, 0, 0); } while (0)
#define PG8_LDA(dst, b, h) do { _Pragma("unroll") for (int m = 0; m < 4; ++m) _Pragma("unroll") for (int k = 0; k < 2; ++k) dst[m][k] = *(const PG8_LAS bf16x8*)(lds + PG8_SA(b, h) + aoff + m * 2048 + k * 1024); } while (0)
#define PG8_LDB(dst, b, h) do { _Pragma("unroll") for (int n = 0; n < 2; ++n) _Pragma("unroll") for (int k = 0; k < 2; ++k) dst[n][k] = *(const PG8_LAS bf16x8*)(lds + PG8_SB(b, h) + boff + n * 2048 + k * 1024); } while (0)
#define PG8_MMA(ai, bj, At, Bt) do { __builtin_amdgcn_s_setprio(1); _Pragma("unroll") for (int m = 0; m < 4; ++m) _Pragma("unroll") for (int n = 0; n < 2; ++n) _Pragma("unroll") for (int k = 0; k < 2; ++k) \
        acc[ai][bj][m][n] = __builtin_amdgcn_mfma_f32_16x16x32_bf16(Bt[n][k], At[m][k], acc[ai][bj][m][n], 0, 0, 0); __builtin_amdgcn_s_setprio(0); } while (0)
#define PG8_WAIT_V(n) asm volatile("s_waitcnt vmcnt(" #n ")" ::: "memory")
#define PG8_WAIT_L(n) asm volatile("s_waitcnt lgkmcnt(" #n ")" ::: "memory")
#define PG8_BAR __builtin_amdgcn_s_barrier()
#define PG8_SCHED __builtin_amdgcn_sched_barrier(0)
    Unit cur, nxt; int ui = 0;
    if (!S.next(0, cur)) return;
    f32x4 acc[2][2][4][2];
#pragma unroll
    for (int a = 0; a < 2; ++a)
#pragma unroll
        for (int b = 0; b < 2; ++b)
#pragma unroll
            for (int m = 0; m < 4; ++m)
#pragma unroll
                for (int n = 0; n < 2; ++n) acc[a][b][m][n] = (f32x4){0.f, 0.f, 0.f, 0.f};
    bf16x8 At[4][2], B0[2][2], B1[2][2];
    const char* cA = (const char*)g.A + (size_t)cur.pm * tstep; const char* cB = (const char*)g.Bt + (size_t)cur.pn * tstep;
    S.a_ready(cur);
    if constexpr (SP2) {
        PG8_STAGE(PG8_SB(0, 0), cB, voffB); PG8_STAGE(PG8_SB(0, 1), cB + hstep, voffB); PG8_STAGE(PG8_SA(0, 0), cA, voffA); PG8_STAGE(PG8_SA(0, 1), cA + hstep, voffA);
        if (wr == 1) PG8_BAR;
        PG8_WAIT_V(2); PG8_BAR;
        PG8_STAGE(PG8_SB(1, 0), cB + kstep, voffB); PG8_STAGE(PG8_SA(1, 0), cA + kstep, voffA); PG8_STAGE(PG8_SB(1, 1), cB + hstep + kstep, voffB);
        PG8_WAIT_V(6); PG8_BAR;
    } else {
        PG8_STAGE(PG8_SB(0, 0), cB, voffB); PG8_STAGE(PG8_SA(0, 0), cA, voffA); PG8_STAGE(PG8_SB(0, 1), cB + hstep, voffB); PG8_STAGE(PG8_SA(0, 1), cA + hstep, voffA);
        if (wr == 1) PG8_BAR;
        PG8_WAIT_V(4); PG8_BAR;
        PG8_STAGE(PG8_SB(1, 0), cB + kstep, voffB); PG8_STAGE(PG8_SA(1, 0), cA + kstep, voffA); PG8_STAGE(PG8_SB(1, 1), cB + hstep + kstep, voffB);
        PG8_WAIT_V(6); PG8_BAR;
    }
    for (;;) {
        const bool has_next = S.next(ui + 1, nxt);
        const char* nA = has_next ? (const char*)g.A + (size_t)nxt.pm * tstep : cA; const char* nB = has_next ? (const char*)g.Bt + (size_t)nxt.pn * tstep : cB;
        for (int t = 0; t < nt; t += 2) {
            const bool last = (t == nt - 2);
            const char* a1 = cA + (size_t)(t + 1) * kstep;
            const char* a2 = last ? nA : cA + (size_t)(t + 2) * kstep; const char* b2 = last ? nB : cB + (size_t)(t + 2) * kstep;
            const char* a3 = a2 + kstep; const char* b3 = b2 + kstep;
            if (last && has_next) S.a_ready(nxt);
            if constexpr (SP2) {
            PG8_LDB(B0, 0, 0); PG8_LDB(B1, 0, 1); PG8_SCHED; PG8_LDA(At, 0, 0); PG8_STAGE(PG8_SA(1, 1), a1 + hstep, voffA);
            PG8_WAIT_V(8); PG8_WAIT_L(0); PG8_BAR; PG8_MMA(0, 0, At, B0); PG8_MMA(0, 1, At, B1); PG8_BAR; PG8_SCHED;
            PG8_LDA(At, 0, 1); PG8_STAGE(PG8_SB(0, 0), b2, voffB); PG8_STAGE(PG8_SB(0, 1), b2 + hstep, voffB); PG8_STAGE(PG8_SA(0, 0), a2, voffA);
            PG8_WAIT_V(8); PG8_WAIT_L(0); PG8_BAR; PG8_MMA(1, 0, At, B0); PG8_MMA(1, 1, At, B1); PG8_BAR; PG8_SCHED;
            PG8_LDB(B0, 1, 0); PG8_LDB(B1, 1, 1); PG8_SCHED; PG8_LDA(At, 1, 0); PG8_STAGE(PG8_SA(0, 1), a2 + hstep, voffA);
            PG8_WAIT_V(8); PG8_WAIT_L(0); PG8_BAR; PG8_MMA(0, 0, At, B0); PG8_MMA(0, 1, At, B1); PG8_BAR; PG8_SCHED;
            PG8_LDA(At, 1, 1); PG8_STAGE(PG8_SB(1, 0), b3, voffB); PG8_STAGE(PG8_SB(1, 1), b3 + hstep, voffB); PG8_STAGE(PG8_SA(1, 0), a3, voffA);
            PG8_WAIT_V(8); PG8_WAIT_L(0); PG8_BAR; PG8_MMA(1, 0, At, B0); PG8_MMA(1, 1, At, B1); PG8_BAR; PG8_SCHED;
            } else {
            PG8_LDB(B0, 0, 0); PG8_SCHED; PG8_LDA(At, 0, 0); PG8_STAGE(PG8_SA(1, 1), a1 + hstep, voffA);
            PG8_WAIT_L(8); PG8_BAR; PG8_WAIT_L(0); PG8_MMA(0, 0, At, B0); PG8_BAR; PG8_SCHED;
            PG8_LDB(B1, 0, 1); PG8_STAGE(PG8_SB(0, 0), b2, voffB);
            PG8_BAR; PG8_WAIT_L(0); PG8_MMA(0, 1, At, B1); PG8_BAR;
            PG8_LDA(At, 0, 1); PG8_STAGE(PG8_SA(0, 0), a2, voffA);
            PG8_BAR; PG8_WAIT_L(0); PG8_MMA(1, 0, At, B0); PG8_BAR; PG8_SCHED;
            PG8_STAGE(PG8_SB(0, 1), b2 + hstep, voffB);
            PG8_WAIT_V(6); PG8_BAR; PG8_MMA(1, 1, At, B1); PG8_BAR;
            PG8_LDB(B0, 1, 0); PG8_SCHED; PG8_LDA(At, 1, 0); PG8_STAGE(PG8_SA(0, 1), a2 + hstep, voffA);
            PG8_WAIT_L(8); PG8_BAR; PG8_WAIT_L(0); PG8_MMA(0, 0, At, B0); PG8_BAR; PG8_SCHED;
            PG8_LDB(B1, 1, 1); PG8_STAGE(PG8_SB(1, 0), b3, voffB);
            PG8_BAR; PG8_WAIT_L(0); PG8_MMA(0, 1, At, B1); PG8_BAR;
            PG8_LDA(At, 1, 1); PG8_STAGE(PG8_SA(1, 0), a3, voffA);
            PG8_BAR; PG8_WAIT_L(0); PG8_MMA(1, 0, At, B0); PG8_BAR; PG8_SCHED;
            PG8_STAGE(PG8_SB(1, 1), b3 + hstep, voffB);
            PG8_WAIT_V(6); PG8_BAR; PG8_MMA(1, 1, At, B1); PG8_BAR;
            }
        }
        if constexpr (ALIGN_EPI) { if (wr == 0) PG8_BAR; }
        if constexpr (!Epi::AFTER_DRAIN) { E(acc, cur, wr, wc, fr, fq); S.done(cur); }
        if (!has_next) break;
#pragma unroll
        for (int a = 0; a < 2; ++a)
#pragma unroll
            for (int b = 0; b < 2; ++b)
#pragma unroll
                for (int m = 0; m < 4; ++m)
#pragma unroll
                    for (int n = 0; n < 2; ++n) acc[a][b][m][n] = (f32x4){0.f, 0.f, 0.f, 0.f};
        cur = nxt; cA = nA; cB = nB; ++ui;
        if constexpr (ALIGN_EPI) { if (wr == 1) PG8_BAR; }
    }
    PG8_WAIT_V(0);
    if constexpr (!ALIGN_EPI) { if (wr == 0) PG8_BAR; }
    PG8_BAR;
    if constexpr (Epi::AFTER_DRAIN) { E.fused(acc, cur, wr, wc, fr, fq, lds, wid, lane); S.done(cur); }
#undef PG8_SA
#undef PG8_SB
#undef PG8_STAGE
#undef PG8_LDA
#undef PG8_LDB
#undef PG8_MMA
#undef PG8_WAIT_V
#undef PG8_WAIT_L
#undef PG8_BAR
#undef PG8_SCHED
}
}

constexpr int NWAVES = 8, NT = 512;
#ifndef MK_PER_PHASE
#define MK_PER_PHASE 0
#endif
#ifndef MK_EXP_V
#define MK_EXP_V 2
#endif
#ifndef MK_TIMER_PHASE
#define MK_TIMER_PHASE -1
#endif
#ifndef MK_ABL_RT
#define MK_ABL_RT 0
#endif
#ifndef MK_P10_GEMM_REP
#define MK_P10_GEMM_REP 1
#endif
#ifndef MK_GSYNC
#define MK_GSYNC 0
#endif
#ifndef MK_GSYNC_EVERY
#define MK_GSYNC_EVERY 16
#endif
#ifndef MK_GSTAG
#define MK_GSTAG 0
#endif
#ifndef MK_PFD
#define MK_PFD 0
#endif
#ifndef MK_ROUTE_DRY_REP
#define MK_ROUTE_DRY_REP 0
#endif
#ifndef MK_SKIP_MIXER
#define MK_SKIP_MIXER 0
#endif
#ifndef MK_SKIP_SHARED
#define MK_SKIP_SHARED 0
#endif
#ifndef MK_SKIP_ROUTED
#define MK_SKIP_ROUTED 0
#endif
constexpr int NPHASE = 13;
constexpr int BATCH = 2, SEQ = 8192, D = 1024, M = BATCH * SEQ, NIN = 8192, NMOD = 6144;
constexpr int OFF_Q = 0, OFF_K = 512, OFF_V = 1024, OFF_GR = 2048, OFF_U = 3072, OFF_GC = 4096, OFF_GB = 5120, OFF_MR = 6144, OFF_MC = 7168;
constexpr int NE = 256, TOPK = 8, EH = 256, CAP = 16384, NCH = 64, CH = 128, NH = 4, DK = 128, DV = 256;
constexpr float EPS = 1e-6f;

constexpr size_t MiB = (size_t)1 << 20;
constexpr size_t WS_CTL = 0, CTL_ZERO_BYTES = 1 * MiB;
constexpr size_t WS_MOD = 1 * MiB;
constexpr size_t WS_ROPE = 2 * MiB;
constexpr size_t WS_WR = 10 * MiB;
constexpr size_t WS_WSGU = 11 * MiB;
constexpr size_t WS_WSD = 12 * MiB;
constexpr size_t WS_WBR = 13 * MiB, WS_WBC = 15 * MiB, WS_WO = 17 * MiB;
constexpr size_t WS_WIN = 20 * MiB;
constexpr size_t WS_HB = 36 * MiB;
constexpr size_t WS_PROJ = 68 * MiB;
constexpr size_t WS_KV = 324 * MiB;
constexpr size_t WS_SP = 388 * MiB;
constexpr size_t WS_RETG = 420 * MiB;
constexpr size_t WS_CONVG = 452 * MiB;
constexpr size_t WS_MIXP = 484 * MiB;
constexpr size_t WS_MIX = 548 * MiB;
constexpr size_t WS_X1 = 580 * MiB;
constexpr size_t WS_LOGITS = 644 * MiB;
constexpr size_t WS_SHG = 660 * MiB;
constexpr size_t WS_EIDX = 668 * MiB, WS_POS = 669 * MiB;
constexpr size_t WS_LTOK = 670 * MiB, WS_LW = 686 * MiB;
constexpr size_t WS_YP = 702 * MiB;
constexpr size_t WS_END = 958 * MiB;
constexpr int CW_TMO = 0, CW_CODE = 1, CW_BAR = 4096, CW_CNT = 16384, CW_GS = 131072;

constexpr int LDSCTL_OFF = 143360, MISC_OFF = LDSCTL_OFF + 320, LDS_BYTES = 147456;

#define GAS __attribute__((address_space(1)))
#define LAS __attribute__((address_space(3)))
typedef unsigned short bf16;
typedef unsigned v4u __attribute__((ext_vector_type(4)));
typedef unsigned v2u __attribute__((ext_vector_type(2)));
typedef float f32x4 __attribute__((ext_vector_type(4)));
typedef float f32x2 __attribute__((ext_vector_type(2)));
typedef short bf16x8 __attribute__((ext_vector_type(8)));
typedef short s16x4 __attribute__((ext_vector_type(4)));
typedef GAS unsigned gu32;
#define RLX_AGENT __ATOMIC_RELAXED, __HIP_MEMORY_SCOPE_AGENT
__device__ __forceinline__ unsigned f2bf(float f) { unsigned u = __builtin_bit_cast(unsigned, f); return (u + 0x7fffu + ((u >> 16) & 1u)) >> 16; }
__device__ __forceinline__ unsigned pk2(float lo, float hi) { unsigned r; asm volatile("v_cvt_pk_bf16_f32 %0, %1, %2" : "=v"(r) : "v"(lo), "v"(hi)); return r; }
__device__ __forceinline__ float bflo(unsigned w) { return __uint_as_float(w << 16); }
__device__ __forceinline__ float bfhi(unsigned w) { return __uint_as_float(w & 0xffff0000u); }
__device__ __forceinline__ float sigmoidf_(float x) { return 1.0f / (1.0f + __expf(-x)); }
__device__ __forceinline__ float siluf_(float x) { return x / (1.0f + __expf(-x)); }

#define XB_TMO      128
#define XB_XCNT(j)  (256  + 64 * (j))
#define XB_XSUB(j)  (1280 + 64 * (j))
#define XB_XGEN(j)  (2304 + 64 * (j))
#define XB_TOP      3328
#define XB_TOPGEN   3392
#define XCD_BAR_WORDS 3456
#define XB_SPIN_CAP (1u << 18)

__device__ __forceinline__ unsigned xb_ld(unsigned* p)              { return __hip_atomic_load(p, __ATOMIC_RELAXED, __HIP_MEMORY_SCOPE_AGENT); }
__device__ __forceinline__ unsigned xb_add(unsigned* p, unsigned v) { return __hip_atomic_fetch_add(p, v, __ATOMIC_RELAXED, __HIP_MEMORY_SCOPE_AGENT); }
__device__ __forceinline__ unsigned xb_xcc_id() { return (unsigned)__builtin_amdgcn_s_getreg((3 << 11) | 20) & 0xFu; }
#define XB_SPIN(cond, bar) do { unsigned _sp = 0; while (cond) { __builtin_amdgcn_s_sleep(1); \
    if ((++_sp & 255u) == 0u) { if (xb_ld(&(bar)[XB_TMO])) break; if (_sp > XB_SPIN_CAP) { atomicAdd(&(bar)[XB_TMO], 1u); break; } } } } while (0)

struct XcdBarrier {
    unsigned* bar; unsigned x;
    volatile LAS unsigned* st;
};

__device__ __forceinline__ XcdBarrier xcd_barrier_post(unsigned* bar, volatile LAS unsigned* st) {
    XcdBarrier b; b.bar = bar; b.x = xb_xcc_id(); b.st = st;
    if (threadIdx.x == 0) (void)xb_add(&bar[XB_XCNT(b.x)], 1u);
    return b;
}
__device__ __forceinline__ void xcd_barrier_complete(unsigned* bar, unsigned x, unsigned& nloc, unsigned& nx) {
    const unsigned G = gridDim.x * gridDim.y * gridDim.z;
    unsigned sum, cnt, mine, sp = 0u;
    for (;;) {
        sum = 0u; cnt = 0u; mine = 0u;
#pragma unroll
        for (unsigned j = 0; j < 16; ++j) { const unsigned c = xb_ld(&bar[XB_XCNT(j)]); sum += c; cnt += (c > 0u) ? 1u : 0u; mine = (j == x) ? c : mine; }
        if (sum == G) break;
        __builtin_amdgcn_s_sleep(1);
        if ((++sp & 255u) == 0u) { if (xb_ld(&bar[XB_TMO])) break; if (sp > XB_SPIN_CAP) { atomicAdd(&bar[XB_TMO], 1u); break; } }
    }
    nloc = mine > 0u ? mine : 1u; nx = cnt > 0u ? cnt : 1u;
}

__device__ __forceinline__ void xcd_barrier(const XcdBarrier& b) {
    asm volatile("s_waitcnt vmcnt(0)" ::: "memory");
    __syncthreads();
    if (threadIdx.x == 0) {
        unsigned* bar = b.bar;
        __builtin_amdgcn_s_waitcnt(0);
        unsigned nloc = b.st[0], nx = b.st[1];
        if (nloc == 0u) { xcd_barrier_complete(bar, b.x, nloc, nx); b.st[0] = nloc; b.st[1] = nx; }
        const unsigned old = xb_add(&bar[XB_XSUB(b.x)], 1u);
        const unsigned gen = old / nloc;
        if (old + 1u == (gen + 1u) * nloc) {
            __builtin_amdgcn_fence(__ATOMIC_RELEASE, "agent");
            asm volatile("s_waitcnt vmcnt(0)" ::: "memory");
            const unsigned og = xb_add(&bar[XB_TOP], 1u);
            const unsigned tg = og / nx;
            if (og + 1u == (tg + 1u) * nx) xb_add(&bar[XB_TOPGEN], 1u);
            else XB_SPIN(xb_ld(&bar[XB_TOPGEN]) == tg, bar);
            __builtin_amdgcn_fence(__ATOMIC_ACQUIRE, "agent");
            xb_add(&bar[XB_XGEN(b.x)], 1u);
            asm volatile("s_waitcnt vmcnt(0)" ::: "memory");
        } else {
            XB_SPIN(xb_ld(&bar[XB_XGEN(b.x)]) == gen, bar);
            __builtin_amdgcn_fence(__ATOMIC_ACQUIRE, "agent");
            asm volatile("s_waitcnt vmcnt(0)" ::: "memory");
        }
    }
    __syncthreads();
}

struct Frame {
    LAS unsigned char* lds; unsigned ldsb;
    volatile LAS unsigned* MISC; gu32* ctl;
    int tid, lane, wave, vcu, G, abl;
    const float *x, *c; const int* pos; const float *w_ada, *b_ada, *norm_mix_g, *w_in, *ret_norm_g, *conv_w, *w_br_ret, *w_br_conv, *w_out, *norm_ffn_g, *w_router, *router_bias,
        *w_eg, *w_eu, *w_ed, *w_sg, *w_su, *w_sd, *norm_final_g;
    float* out; unsigned char* ws;
};
__device__ __forceinline__ float wave_sum(float v) {
#pragma unroll
    for (int o = 1; o < 64; o <<= 1) v += __shfl_xor(v, o);
    return v;
}

__device__ __forceinline__ void p0_mod_task(Frame& F, int j) {
    const int cq = F.tid & 15, kq = F.tid >> 4;
    f32x4 a0 = {0.f, 0.f, 0.f, 0.f}, a1 = {0.f, 0.f, 0.f, 0.f};
    const float* W = F.w_ada + 64 * j + 4 * cq;
#pragma unroll 8
    for (int i = 0; i < 32; ++i) { const int k = kq + 32 * i; const float c0 = F.c[k], c1 = F.c[1024 + k];
        const float s0 = c0 / (1.0f + expf(-c0)), s1 = c1 / (1.0f + expf(-c1));
        const f32x4 w = *(const f32x4*)(W + (size_t)k * NMOD); a0 += s0 * w; a1 += s1 * w; }
    LAS f32x4* red = (LAS f32x4*)F.lds;
    red[(kq * 2 + 0) * 16 + cq] = a0; red[(kq * 2 + 1) * 16 + cq] = a1;
    __syncthreads();
    if (F.tid < 32) { const int b = F.tid >> 4, c2 = F.tid & 15; f32x4 s = *(const f32x4*)(F.b_ada + 64 * j + 4 * c2);
        for (int k2 = 0; k2 < 32; ++k2) s += red[(k2 * 2 + b) * 16 + c2];
        *(f32x4*)((float*)(F.ws + WS_MOD) + b * NMOD + 64 * j + 4 * c2) = s; }
    __syncthreads();
}
__device__ __forceinline__ void p0_transpose_item(const float* W, int K, int N, bf16* WT, int row_off, int row_mul, LAS float* scr, int item, int lane) {
    const int nblk = N / 32, kb = item / nblk, nb = item % nblk, k0 = 64 * kb, n0 = 32 * nb;
#pragma unroll 8
    for (int i = 0; i < 32; ++i) { const int kk = 2 * i + (lane >> 5); scr[kk * 33 + (lane & 31)] = W[(size_t)(k0 + kk) * N + n0 + (lane & 31)]; }
    asm volatile("s_waitcnt lgkmcnt(0)" ::: "memory");
    const int c = lane & 7;
#pragma unroll
    for (int j = 0; j < 4; ++j) { const int n = (lane >> 3) + 8 * j; const LAS float* s = scr + (8 * c) * 33 + n;
        v4u o; o.x = pk2(s[0 * 33], s[1 * 33]); o.y = pk2(s[2 * 33], s[3 * 33]); o.z = pk2(s[4 * 33], s[5 * 33]); o.w = pk2(s[6 * 33], s[7 * 33]);
        *(v4u*)(WT + (size_t)(row_off + row_mul * (n0 + n)) * K + k0 + 8 * c) = o; }
    asm volatile("s_waitcnt lgkmcnt(0)" ::: "memory");
}
__device__ __forceinline__ void p0_prologue(Frame& F) {
    if ((int)blockIdx.x < NMOD / 64) p0_mod_task(F, (int)blockIdx.x);
    LAS float* scr = (LAS float*)(F.lds + F.wave * 16384);
    const int gw = F.vcu * NWAVES + F.wave, NGW = F.G * NWAVES;
    constexpr int I_IN = (D / 64) * (NIN / 32), I_SQ = (D / 64) * (D / 32), I_R = (D / 64) * (256 / 32), I_SD = (256 / 64) * (D / 32);
    constexpr int NITEMS = I_IN + 3 * I_SQ + 3 * I_R + I_SD;
    unsigned char* ws = F.ws;
    for (int it = gw; it < NITEMS; it += NGW) {
        int r = it;
        if (r < I_IN) { p0_transpose_item(F.w_in, D, NIN, (bf16*)(ws + WS_WIN), 0, 1, scr, r, F.lane); continue; } r -= I_IN;
        if (r < I_SQ) { p0_transpose_item(F.w_br_ret, D, D, (bf16*)(ws + WS_WBR), 0, 1, scr, r, F.lane); continue; } r -= I_SQ;
        if (r < I_SQ) { p0_transpose_item(F.w_br_conv, D, D, (bf16*)(ws + WS_WBC), 0, 1, scr, r, F.lane); continue; } r -= I_SQ;
        if (r < I_SQ) { p0_transpose_item(F.w_out, D, D, (bf16*)(ws + WS_WO), 0, 1, scr, r, F.lane); continue; } r -= I_SQ;
        if (r < I_R) { p0_transpose_item(F.w_router, D, NE, (bf16*)(ws + WS_WR), 0, 1, scr, r, F.lane); continue; } r -= I_R;
        if (r < I_R) { p0_transpose_item(F.w_sg, D, EH, (bf16*)(ws + WS_WSGU), 0, 2, scr, r, F.lane); continue; } r -= I_R;
        if (r < I_R) { p0_transpose_item(F.w_su, D, EH, (bf16*)(ws + WS_WSGU), 1, 2, scr, r, F.lane); continue; } r -= I_R;
        p0_transpose_item(F.w_sd, EH, D, (bf16*)(ws + WS_WSD), 0, 1, scr, r, F.lane);
    }
    f32x2* rope = (f32x2*)(ws + WS_ROPE);
    for (int idx = F.vcu * NT + F.tid; idx < M * 64; idx += F.G * NT) { const int t = idx >> 6, i = idx & 63;
        const float invf = powf(10000.0f, -(float)i * (1.0f / 64.0f)); const float ang = (float)F.pos[t] * invf;
        const double ad = (double)ang; const double rr = ad - 6.283185307179586 * rint(ad * 0.15915494309189535); const float rf = (float)rr;
        rope[idx] = (f32x2){cosf(rf), sinf(rf)}; }
}

__device__ __forceinline__ void norm_mod_rows(Frame& F, const float* X, const float* gain, int sc_off, int sh_off, bf16* O) {
    const int gw = F.vcu * NWAVES + F.wave, NGW = F.G * NWAVES;
    const float* mod = (const float*)(F.ws + WS_MOD);
    f32x4 g[4];
#pragma unroll
    for (int j = 0; j < 4; ++j) g[j] = *(const f32x4*)(gain + 4 * F.lane + 256 * j);
    for (int m = gw; m < M; m += NGW) {
        const int b = m >> 13; const f32x4* xr = (const f32x4*)(X + (size_t)m * D) + F.lane;
        f32x4 v[4]; float ss = 0.f;
#pragma unroll
        for (int j = 0; j < 4; ++j) { v[j] = xr[64 * j]; ss += (v[j].x * v[j].x + v[j].y * v[j].y) + (v[j].z * v[j].z + v[j].w * v[j].w); }
        const float rstd = 1.0f / sqrtf(wave_sum(ss) * (1.0f / D) + EPS);
        v2u* o8 = (v2u*)(O + (size_t)m * D) + F.lane;
#pragma unroll
        for (int j = 0; j < 4; ++j) { const f32x4 sc = *(const f32x4*)(mod + b * NMOD + sc_off + 4 * F.lane + 256 * j), sh = *(const f32x4*)(mod + b * NMOD + sh_off + 4 * F.lane + 256 * j);
            const f32x4 h = (v[j] * rstd * g[j]) * (1.0f + sc) + sh; v2u w; w.x = pk2(h.x, h.y); w.y = pk2(h.z, h.w); o8[64 * j] = w; }
    }
}

constexpr int KS = 136, KSB = KS * 2;
constexpr int VS = 264, VSB = VS * 2;
__device__ __forceinline__ float log_gamma(int h) { return log1pf(-exp2f(-5.0f - (float)h)); }
__device__ __forceinline__ bf16x8 ldfrag(const LAS unsigned char* img, int row, int rsb, int k) { return *(const LAS bf16x8*)(img + row * rsb + k * 2); }
template <int RS4> __device__ __forceinline__ bf16x8 tr_frag(unsigned addr) {
    s16x4 lo, hi;
    asm volatile("ds_read_b64_tr_b16 %0, %2\n\tds_read_b64_tr_b16 %1, %2 offset:%3\n\ts_waitcnt lgkmcnt(0)" : "=&v"(lo), "=&v"(hi) : "v"(addr), "i"(RS4) : "memory");
    return __builtin_shufflevector(lo, hi, 0, 1, 2, 3, 4, 5, 6, 7);
}
template <int RS4, int STEP> __device__ __forceinline__ void tr_frag4(unsigned addr, bf16x8& f0, bf16x8& f1, bf16x8& f2, bf16x8& f3) {
    s16x4 l0, h0, l1, h1, l2, h2, l3, h3;
    asm volatile("ds_read_b64_tr_b16 %0, %8\n\tds_read_b64_tr_b16 %1, %8 offset:%9\n\t"
                 "ds_read_b64_tr_b16 %2, %8 offset:%10\n\tds_read_b64_tr_b16 %3, %8 offset:%11\n\t"
                 "ds_read_b64_tr_b16 %4, %8 offset:%12\n\tds_read_b64_tr_b16 %5, %8 offset:%13\n\t"
                 "ds_read_b64_tr_b16 %6, %8 offset:%14\n\tds_read_b64_tr_b16 %7, %8 offset:%15\n\ts_waitcnt lgkmcnt(0)"
                 : "=&v"(l0), "=&v"(h0), "=&v"(l1), "=&v"(h1), "=&v"(l2), "=&v"(h2), "=&v"(l3), "=&v"(h3)
                 : "v"(addr), "i"(RS4), "i"(STEP), "i"(STEP + RS4), "i"(2 * STEP), "i"(2 * STEP + RS4), "i"(3 * STEP), "i"(3 * STEP + RS4) : "memory");
    f0 = __builtin_shufflevector(l0, h0, 0, 1, 2, 3, 4, 5, 6, 7); f1 = __builtin_shufflevector(l1, h1, 0, 1, 2, 3, 4, 5, 6, 7);
    f2 = __builtin_shufflevector(l2, h2, 0, 1, 2, 3, 4, 5, 6, 7); f3 = __builtin_shufflevector(l3, h3, 0, 1, 2, 3, 4, 5, 6, 7);
}
#define MFMA16(a, b, c) __builtin_amdgcn_mfma_f32_16x16x32_bf16((a), (b), (c), 0, 0, 0)

template <bool DECAY> __device__ __forceinline__ void stage_rope(Frame& F, LAS unsigned char* img, const bf16* src, const f32x2* rope, float s_const, float lg) {
#pragma unroll
    for (int i = 0; i < 4; ++i) { const int task = F.tid + NT * i, c = task >> 4, g = task & 15;
        const v2u lo = *(const v2u*)(src + (size_t)c * NIN + 4 * g), hi = *(const v2u*)(src + (size_t)c * NIN + 64 + 4 * g);
        const f32x4 r01 = *(const f32x4*)(rope + c * 64 + 4 * g), r23 = *(const f32x4*)(rope + c * 64 + 4 * g + 2);
        const float sc = DECAY ? s_const * __expf(lg * (float)(127 - c)) : s_const;
        const float x1[4] = {bflo(lo.x), bfhi(lo.x), bflo(lo.y), bfhi(lo.y)}, x2[4] = {bflo(hi.x), bfhi(hi.x), bflo(hi.y), bfhi(hi.y)};
        const float cs[4] = {r01.x, r01.z, r23.x, r23.z}, sn[4] = {r01.y, r01.w, r23.y, r23.w};
        float y1[4], y2[4];
#pragma unroll
        for (int j = 0; j < 4; ++j) { y1[j] = (x1[j] * cs[j] - x2[j] * sn[j]) * sc; y2[j] = (x2[j] * cs[j] + x1[j] * sn[j]) * sc; }
        v2u w1, w2; w1.x = pk2(y1[0], y1[1]); w1.y = pk2(y1[2], y1[3]); w2.x = pk2(y2[0], y2[1]); w2.y = pk2(y2[2], y2[3]);
        *(LAS v2u*)(img + c * KSB + 8 * g) = w1; *(LAS v2u*)(img + c * KSB + 128 + 8 * g) = w2; }
}
__device__ __forceinline__ void stage_v(Frame& F, LAS unsigned char* img, const bf16* src) {
#pragma unroll
    for (int i = 0; i < 8; ++i) { const int task = F.tid + NT * i, c = task >> 5, g = task & 31;
        *(LAS v4u*)(img + c * VSB + 16 * g) = *(const v4u*)(src + (size_t)c * NIN + 8 * g); }
}

__device__ __forceinline__ void p3_kv_conv(Frame& F) {
    unsigned char* ws = F.ws; const bf16* PROJ = (const bf16*)(ws + WS_PROJ); const f32x2* ROPE = (const f32x2*)(ws + WS_ROPE); bf16* KV = (bf16*)(ws + WS_KV);
    LAS unsigned char* Kimg = F.lds; LAS unsigned char* Vimg = F.lds + 34816;
    const int w = F.wave, lane = F.lane, g = lane >> 4, q = (lane & 15) >> 2, p = lane & 3;
    for (int it = (int)blockIdx.x; it < BATCH * NH * NCH; it += F.G) {
        const int n = it & 63, h = (it >> 6) & 3, b = it >> 8; const int t0 = b * SEQ + n * CH; const float lg = log_gamma(h);
        stage_rope<true>(F, Kimg, PROJ + (size_t)t0 * NIN + OFF_K + h * DK, ROPE + (size_t)t0 * 64, 1.0f, lg);
        stage_v(F, Vimg, PROJ + (size_t)t0 * NIN + OFF_V + h * DV);
        __syncthreads();
        f32x4 acc[16];
#pragma unroll
        for (int i = 0; i < 16; ++i) acc[i] = (f32x4){0.f, 0.f, 0.f, 0.f};
        const unsigned ka = F.ldsb + (unsigned)((8 * g + q) * KSB + (16 * w + 4 * p) * 2);
        const unsigned va = F.ldsb + 34816u + (unsigned)((8 * g + q) * VSB + (4 * p) * 2);
#pragma unroll
        for (int ks = 0; ks < 4; ++ks) {
            const bf16x8 a = tr_frag<4 * KSB>(ka + ks * 32 * KSB);
#pragma unroll
            for (int nt = 0; nt < 16; nt += 4) { bf16x8 b0, b1, b2, b3; tr_frag4<4 * VSB, 32>(va + ks * 32 * VSB + nt * 32, b0, b1, b2, b3);
                acc[nt] = MFMA16(a, b0, acc[nt]); acc[nt + 1] = MFMA16(a, b1, acc[nt + 1]); acc[nt + 2] = MFMA16(a, b2, acc[nt + 2]); acc[nt + 3] = MFMA16(a, b3, acc[nt + 3]); }
        }
        bf16* kvp = KV + (size_t)it * (DV * DK) + (size_t)(lane & 15) * DK + 16 * w + 4 * g;
#pragma unroll
        for (int nt = 0; nt < 16; ++nt) { v2u wv; wv.x = pk2(acc[nt][0], acc[nt][1]); wv.y = pk2(acc[nt][2], acc[nt][3]); *(v2u*)(kvp + (size_t)(16 * nt) * DK) = wv; }
        __syncthreads();
    }
    bf16* CONVG = (bf16*)(ws + WS_CONVG);
    const int gw = F.vcu * NWAVES + F.wave, NGW = F.G * NWAVES;
    for (int m = gw; m < M; m += NGW) { const int s = m & (SEQ - 1);
#pragma unroll
        for (int j = 0; j < 4; ++j) { const int ch = 4 * lane + 256 * j; const bf16* rp = PROJ + (size_t)m * NIN + ch;
            const f32x4 w0 = *(const f32x4*)(F.conv_w + ch), w1 = *(const f32x4*)(F.conv_w + D + ch), w2 = *(const f32x4*)(F.conv_w + 2 * D + ch);
            const v2u u0 = *(const v2u*)(rp + OFF_U), c0 = *(const v2u*)(rp + OFF_GC), gb = *(const v2u*)(rp + OFF_GB);
            v2u u1 = {0u, 0u}, c1 = {0u, 0u}, u2 = {0u, 0u}, c2 = {0u, 0u};
            if (s >= 1) { u1 = *(const v2u*)(rp - NIN + OFF_U); c1 = *(const v2u*)(rp - NIN + OFF_GC); }
            if (s >= 2) { u2 = *(const v2u*)(rp - 2 * NIN + OFF_U); c2 = *(const v2u*)(rp - 2 * NIN + OFF_GC); }
            f32x4 cu0 = {bflo(u0.x) * bflo(c0.x), bfhi(u0.x) * bfhi(c0.x), bflo(u0.y) * bflo(c0.y), bfhi(u0.y) * bfhi(c0.y)};
            f32x4 cu1 = {bflo(u1.x) * bflo(c1.x), bfhi(u1.x) * bfhi(c1.x), bflo(u1.y) * bflo(c1.y), bfhi(u1.y) * bfhi(c1.y)};
            f32x4 cu2 = {bflo(u2.x) * bflo(c2.x), bfhi(u2.x) * bfhi(c2.x), bflo(u2.y) * bflo(c2.y), bfhi(u2.y) * bfhi(c2.y)};
            const f32x4 gbf = {bflo(gb.x), bfhi(gb.x), bflo(gb.y), bfhi(gb.y)};
            const f32x4 o = gbf * (w0 * cu2 + w1 * cu1 + w2 * cu0);
            v2u wv; wv.x = pk2(o.x, o.y); wv.y = pk2(o.z, o.w); *(v2u*)(CONVG + (size_t)m * D + ch) = wv; }
    }
}

__device__ __forceinline__ void p4_scan(Frame& F) {
    const unsigned* KV = (const unsigned*)(F.ws + WS_KV); unsigned* SP = (unsigned*)(F.ws + WS_SP);
    for (int gid = F.vcu * NT + F.tid; gid < BATCH * NH * (DV * DK / 2); gid += F.G * NT) {
        const int bh = gid >> 14, e2 = gid & 16383, h = bh & 3; const float dec = __expf(log_gamma(h) * 128.0f);
        f32x2 S = {0.f, 0.f};
        const unsigned* kp = KV + (size_t)bh * NCH * 16384 + e2; unsigned* sp = SP + (size_t)bh * NCH * 16384 + e2;
#pragma unroll 8
        for (int n = 0; n < NCH; ++n) { const unsigned kw = kp[(size_t)n * 16384]; const f32x2 kv = {bflo(kw), bfhi(kw)}; sp[(size_t)n * 16384] = pk2(S.x, S.y); S = S * dec + kv; }
    }
}

__device__ __forceinline__ void p5_retention(Frame& F) {
    unsigned char* ws = F.ws; const bf16* PROJ = (const bf16*)(ws + WS_PROJ); const f32x2* ROPE = (const f32x2*)(ws + WS_ROPE); const bf16* SP = (const bf16*)(ws + WS_SP);
    bf16* RETG = (bf16*)(ws + WS_RETG);
    LAS unsigned char* Qimg = F.lds; LAS unsigned char* Kimg = F.lds + 34816; LAS unsigned char* Bimg = F.lds + 69632;
    const int w = F.wave, lane = F.lane, g = lane >> 4, q = (lane & 15) >> 2, p = lane & 3, fr = lane & 15;
    for (int it = (int)blockIdx.x; it < BATCH * NH * NCH; it += F.G) {
        const int n = it & 63, h = (it >> 6) & 3, b = it >> 8; const int t0 = b * SEQ + n * CH; const float lg = log_gamma(h);
        stage_rope<false>(F, Qimg, PROJ + (size_t)t0 * NIN + OFF_Q + h * DK, ROPE + (size_t)t0 * 64, 0.08838834764831845f, 0.f);
        stage_rope<false>(F, Kimg, PROJ + (size_t)t0 * NIN + OFF_K + h * DK, ROPE + (size_t)t0 * 64, 1.0f, 0.f);
        { const bf16* sp = SP + (size_t)it * (DV * DK);
#pragma unroll
          for (int i = 0; i < 8; ++i) { const int task = F.tid + NT * i, r = task >> 4, c16 = task & 15; *(LAS v4u*)(Bimg + r * KSB + 16 * c16) = *(const v4u*)(sp + r * DK + 8 * c16); } }
        __syncthreads();
        f32x4 acc[16];
#pragma unroll
        for (int i = 0; i < 16; ++i) acc[i] = (f32x4){0.f, 0.f, 0.f, 0.f};
        f32x4 sc[8];
#pragma unroll
        for (int i = 0; i < 8; ++i) sc[i] = (f32x4){0.f, 0.f, 0.f, 0.f};
#pragma unroll 1
        for (int ks = 0; ks < 4; ++ks) {
            const bf16x8 qf = ldfrag(Qimg, 16 * w + fr, KSB, 32 * ks + 8 * g);
#pragma unroll
            for (int nt = 0; nt < 16; ++nt) { const bf16x8 sf = ldfrag(Bimg, 16 * nt + fr, KSB, 32 * ks + 8 * g); acc[nt] = MFMA16(sf, qf, acc[nt]); }
#pragma unroll
            for (int jt = 0; jt < 8; ++jt) { const bf16x8 kf = ldfrag(Kimg, 16 * jt + fr, KSB, 32 * ks + 8 * g); sc[jt] = MFMA16(kf, qf, sc[jt]); }
        }
        const int irow = 16 * w + fr;
        { const float cd = __expf(lg * (float)(irow + 1));
#pragma unroll
          for (int nt = 0; nt < 16; ++nt) acc[nt] = acc[nt] * cd; }
        __syncthreads();
#pragma unroll
        for (int jt = 0; jt < 8; ++jt) { float pv[4];
#pragma unroll
            for (int r = 0; r < 4; ++r) { const int j = 16 * jt + 4 * g + r; pv[r] = (irow >= j) ? sc[jt][r] * __expf(lg * (float)(irow - j)) : 0.f; }
            v2u wv; wv.x = pk2(pv[0], pv[1]); wv.y = pk2(pv[2], pv[3]); *(LAS v2u*)(Kimg + irow * KSB + (16 * jt + 4 * g) * 2) = wv; }
        stage_v(F, Bimg, PROJ + (size_t)t0 * NIN + OFF_V + h * DV);
        __syncthreads();
        const unsigned va = F.ldsb + 69632u + (unsigned)((8 * g + q) * VSB + (4 * p) * 2);
#pragma unroll 1
        for (int ks = 0; ks < 4; ++ks) {
            const bf16x8 pf = ldfrag(Kimg, 16 * w + fr, KSB, 32 * ks + 8 * g);
#pragma unroll
            for (int nt = 0; nt < 16; nt += 4) { bf16x8 v0, v1, v2, v3; tr_frag4<4 * VSB, 32>(va + ks * 32 * VSB + nt * 32, v0, v1, v2, v3);
                acc[nt] = MFMA16(v0, pf, acc[nt]); acc[nt + 1] = MFMA16(v1, pf, acc[nt + 1]); acc[nt + 2] = MFMA16(v2, pf, acc[nt + 2]); acc[nt + 3] = MFMA16(v3, pf, acc[nt + 3]); }
        }
        float ss = 0.f;
#pragma unroll
        for (int nt = 0; nt < 16; ++nt) ss += (acc[nt][0] * acc[nt][0] + acc[nt][1] * acc[nt][1]) + (acc[nt][2] * acc[nt][2] + acc[nt][3] * acc[nt][3]);
        ss += __shfl_xor(ss, 16); ss += __shfl_xor(ss, 32);
        const float rstd = 1.0f / sqrtf(ss * (1.0f / DV) + EPS);
        const size_t trow = (size_t)(t0 + irow);
#pragma unroll
        for (int nt = 0; nt < 16; ++nt) { const int dv = 16 * nt + 4 * g; const f32x4 gn = *(const f32x4*)(F.ret_norm_g + h * DV + dv);
            const v2u gr = *(const v2u*)(PROJ + trow * NIN + OFF_GR + h * DV + dv);
            const f32x4 o = acc[nt] * rstd * gn * (f32x4){siluf_(bflo(gr.x)), siluf_(bfhi(gr.x)), siluf_(bflo(gr.y)), siluf_(bfhi(gr.y))};
            v2u wv; wv.x = pk2(o[0], o[1]); wv.y = pk2(o[2], o[3]); *(v2u*)(RETG + trow * D + h * DV + dv) = wv; }
        __syncthreads();
    }
}

__device__ __forceinline__ unsigned f32_key(float x) { const unsigned u = __float_as_uint(x); return (u & 0x80000000u) ? ~u : (u | 0x80000000u); }
template <bool DRY> __device__ __forceinline__ void route_tokens(Frame& F) {
    unsigned char* ws = F.ws; const float* LOGITS = (const float*)(ws + WS_LOGITS);
    int* EIDX = (int*)(ws + WS_EIDX); int* POS = (int*)(ws + WS_POS); int* LTOK = (int*)(ws + WS_LTOK); float* LW = (float*)(ws + WS_LW);
    unsigned* cnt = (unsigned*)(F.ctl + CW_CNT);
    const int gw = F.vcu * NWAVES + F.wave, NGW = F.G * NWAVES, lane = F.lane;
    const f32x4 bias = *(const f32x4*)(F.router_bias + 4 * lane);
    for (int t0 = 2 * gw; t0 < M; t0 += 2 * NGW) {
        float sc[2][4]; unsigned key[2][4];
#pragma unroll
        for (int u = 0; u < 2; ++u) {
            const f32x4 lgv = *(const f32x4*)(LOGITS + (size_t)(t0 + u) * NE + 4 * lane);
            sc[u][0] = 1.0f / (1.0f + __expf(-lgv.x)); sc[u][1] = 1.0f / (1.0f + __expf(-lgv.y)); sc[u][2] = 1.0f / (1.0f + __expf(-lgv.z)); sc[u][3] = 1.0f / (1.0f + __expf(-lgv.w));
            const float c0 = sc[u][0] + bias.x, c1 = sc[u][1] + bias.y, c2 = sc[u][2] + bias.z, c3 = sc[u][3] + bias.w;
            const float a = fmaxf(c0, c1), bq = fminf(c0, c1), cc = fmaxf(c2, c3), dd = fminf(c2, c3);
            float m1 = fmaxf(a, cc), m2 = fmaxf(fminf(a, cc), fmaxf(bq, dd));
#pragma unroll
            for (int o = 1; o < 8; o <<= 1) { const float o1 = __shfl_xor(m1, o), o2 = __shfl_xor(m2, o); const float n1 = fmaxf(m1, o1), n2 = fmaxf(fminf(m1, o1), fmaxf(m2, o2)); m1 = n1; m2 = n2; }
            const float gs = m1 + m2; const int myg = lane >> 3; int rank = 0;
#pragma unroll
            for (int g2 = 0; g2 < 8; ++g2) { const float sg = __uint_as_float((unsigned)__builtin_amdgcn_readlane((int)__float_as_uint(gs), g2 * 8)); rank += (sg > gs || (sg == gs && g2 < myg)) ? 1 : 0; }
            const bool gsel = rank < 4;
            key[u][0] = gsel ? f32_key(c0) : 0u; key[u][1] = gsel ? f32_key(c1) : 0u; key[u][2] = gsel ? f32_key(c2) : 0u; key[u][3] = gsel ? f32_key(c3) : 0u;
        }
        unsigned th0 = 0u, th1 = 0u;
#pragma unroll 4
        for (int bit = 31; bit >= 0; --bit) {
            const unsigned ca = th0 | (1u << bit), cb = th1 | (1u << bit);
            const int na = __popcll(__ballot(key[0][0] >= ca)) + __popcll(__ballot(key[0][1] >= ca)) + __popcll(__ballot(key[0][2] >= ca)) + __popcll(__ballot(key[0][3] >= ca));
            const int nb = __popcll(__ballot(key[1][0] >= cb)) + __popcll(__ballot(key[1][1] >= cb)) + __popcll(__ballot(key[1][2] >= cb)) + __popcll(__ballot(key[1][3] >= cb));
            th0 = na >= 8 ? ca : th0; th1 = nb >= 8 ? cb : th1;
        }
        unsigned pa[2][4]; int ra[2][4]; float inva[2];
#pragma unroll
        for (int u = 0; u < 2; ++u) { const unsigned th = u ? th1 : th0;
            const bool s0 = key[u][0] >= th, s1 = key[u][1] >= th, s2 = key[u][2] >= th, s3 = key[u][3] >= th;
            const unsigned long long b0 = __ballot(s0), b1 = __ballot(s1), b2 = __ballot(s2), b3 = __ballot(s3);
            const unsigned long long lt = (1ull << lane) - 1ull;
            const int base = __popcll(b0 & lt) + __popcll(b1 & lt) + __popcll(b2 & lt) + __popcll(b3 & lt);
            const int r0 = base, r1 = r0 + (s0 ? 1 : 0), r2 = r1 + (s1 ? 1 : 0), r3 = r2 + (s2 ? 1 : 0);
            const float part = (s0 ? sc[u][0] : 0.f) + (s1 ? sc[u][1] : 0.f) + (s2 ? sc[u][2] : 0.f) + (s3 ? sc[u][3] : 0.f);
            const float inv = 2.5f / wave_sum(part);
            const bool a0 = s0 && r0 < 8, a1 = s1 && r1 < 8, a2 = s2 && r2 < 8, a3 = s3 && r3 < 8; const int e0 = 4 * lane;
            unsigned p0 = 0u, p1 = 0u, p2 = 0u, p3 = 0u;
            if (DRY) { if (a0) p0 = __hip_atomic_load(cnt + 64 * e0, RLX_AGENT); if (a1) p1 = __hip_atomic_load(cnt + 64 * (e0 + 1), RLX_AGENT); if (a2) p2 = __hip_atomic_load(cnt + 64 * (e0 + 2), RLX_AGENT); if (a3) p3 = __hip_atomic_load(cnt + 64 * (e0 + 3), RLX_AGENT); } else {
            if (a0) p0 = __hip_atomic_fetch_add(cnt + 64 * e0, 1u, RLX_AGENT);
            if (a1) p1 = __hip_atomic_fetch_add(cnt + 64 * (e0 + 1), 1u, RLX_AGENT);
            if (a2) p2 = __hip_atomic_fetch_add(cnt + 64 * (e0 + 2), 1u, RLX_AGENT);
            if (a3) p3 = __hip_atomic_fetch_add(cnt + 64 * (e0 + 3), 1u, RLX_AGENT); }
            pa[u][0] = p0; pa[u][1] = p1; pa[u][2] = p2; pa[u][3] = p3; ra[u][0] = a0 ? r0 : -1; ra[u][1] = a1 ? r1 : -1; ra[u][2] = a2 ? r2 : -1; ra[u][3] = a3 ? r3 : -1; inva[u] = inv;
        }
#pragma unroll
        for (int u = 0; u < 2; ++u) { const int t = t0 + u;
#pragma unroll
            for (int j = 0; j < 4; ++j) if (ra[u][j] >= 0) { const int e = 4 * lane + j; const unsigned ps = DRY ? (unsigned)(CAP - 1 - (t & 1023)) : pa[u][j]; if (DRY && pa[u][j] == 0xffffffffu) continue;
                LTOK[(size_t)e * CAP + ps] = t; LW[(size_t)e * CAP + ps] = sc[u][j] * inva[u]; EIDX[t * 8 + ra[u][j]] = e; POS[t * 8 + ra[u][j]] = (int)ps; }
        }
    }
}

__device__ __forceinline__ void expert_prefix(Frame& F, LAS int* pref, LAS int* off) {
    if (F.wave == 0) { const unsigned* cnt = (const unsigned*)(F.ctl + CW_CNT); const int lane = F.lane;
        int c[4], nb[4]; int tc = 0, tb = 0;
#pragma unroll
        for (int j = 0; j < 4; ++j) { c[j] = (int)__hip_atomic_load(cnt + 64 * (4 * lane + j), RLX_AGENT); nb[j] = (c[j] + 127) >> 7; tc += c[j]; tb += nb[j]; }
        int xc = tc, xb = tb;
#pragma unroll
        for (int o = 1; o < 64; o <<= 1) { const int vc = __shfl_up(xc, o), vb = __shfl_up(xb, o); if (lane >= o) { xc += vc; xb += vb; } }
        int ec = xc - tc, eb = xb - tb;
#pragma unroll
        for (int j = 0; j < 4; ++j) { off[4 * lane + j] = ec; pref[4 * lane + j] = eb; ec += c[j]; eb += nb[j]; }
        if (lane == 63) { off[256] = ec; pref[256] = eb; } }
}

constexpr int EX_PREF = 0, EX_OFF = 1040, EX_TOK = 2176, EX_W = 2688, EX_BUF = 3200, EX_BUFSZ = 27648, EX_BOFF = 10240, EX_G = EX_BUF + 2 * EX_BUFSZ;
constexpr int ASB = 80, EXD = 4, EXNC = 96;
static_assert(EX_G + 128 * VSB <= LDSCTL_OFF, "expert LDS map");
template <int RS4, int STEP> __device__ __forceinline__ void tr_frag2(unsigned addr, bf16x8& f0, bf16x8& f1) {
    s16x4 l0, h0, l1, h1;
    asm volatile("ds_read_b64_tr_b16 %0, %4\n\tds_read_b64_tr_b16 %1, %4 offset:%5\n\tds_read_b64_tr_b16 %2, %4 offset:%6\n\tds_read_b64_tr_b16 %3, %4 offset:%7\n\ts_waitcnt lgkmcnt(0)"
                 : "=&v"(l0), "=&v"(h0), "=&v"(l1), "=&v"(h1) : "v"(addr), "i"(RS4), "i"(STEP), "i"(STEP + RS4) : "memory");
    f0 = __builtin_shufflevector(l0, h0, 0, 1, 2, 3, 4, 5, 6, 7); f1 = __builtin_shufflevector(l1, h1, 0, 1, 2, 3, 4, 5, 6, 7);
}
struct ExSet { f32x4 w[4]; v4u a; };
constexpr int PF_OFF = 140288;
__device__ __forceinline__ void pf_dma(const void* gsrc, unsigned lds_dst) {
    unsigned keep;
    asm volatile("s_mov_b32 %0, m0\n\ts_mov_b32 m0, %2\n\ts_nop 0\n\tglobal_load_lds_dword %1, off\n\ts_mov_b32 m0, %0" : "=&s"(keep) : "v"(gsrc), "s"(lds_dst) : "memory");
}
template <int ABL> __device__ __forceinline__ void p11_experts(Frame& F) {
    unsigned char* ws = F.ws; const bf16* H2 = (const bf16*)(ws + WS_HB); const int* LTOK = (const int*)(ws + WS_LTOK); const float* LW = (const float*)(ws + WS_LW); bf16* YP = (bf16*)(ws + WS_YP);
    LAS int* pref = (LAS int*)(F.lds + EX_PREF); LAS int* off = (LAS int*)(F.lds + EX_OFF); LAS int* tokl = (LAS int*)(F.lds + EX_TOK); LAS float* wl = (LAS float*)(F.lds + EX_W);
    LAS unsigned char* Gimg = F.lds + EX_G;
    const int tid = F.tid, w = F.wave, wr = w >> 2, wc = w & 3;
    const unsigned pfl = F.ldsb + PF_OFF + (unsigned)w * 256u;
    expert_prefix(F, pref, off);
    __syncthreads();
    const int nitems = pref[256];
    for (int it = F.vcu; it < nitems; it += F.G) {
        int e = 0;
#pragma unroll
        for (int s = 128; s >= 1; s >>= 1) if (pref[e + s] <= it) e += s;
        e = __builtin_amdgcn_readfirstlane(e);
        const int rb = __builtin_amdgcn_readfirstlane(it - pref[e]), cnt_e = __builtin_amdgcn_readfirstlane(off[e + 1] - off[e]), r0 = rb * 128, slot0 = __builtin_amdgcn_readfirstlane(off[e]) + r0;
        if (tid < 128) { const int idx = r0 + tid; const bool ok = idx < cnt_e; tokl[tid] = LTOK[(size_t)e * CAP + (ok ? idx : r0)]; wl[tid] = ok ? LW[(size_t)e * CAP + idx] : 0.f; }
        __syncthreads();
        const float* Wg = F.w_eg + (size_t)e * D * EH; const float* Wu = F.w_eu + (size_t)e * D * EH; const float* Wd = F.w_ed + (size_t)e * EH * D;
        const bf16* asrc = H2 + (size_t)tokl[tid >> 2] * D + (tid & 3) * 8;
        int gs_lo, gs_n; { const int xs = (it / F.G) * F.G + (F.vcu & ~31); int lo = pref[e], hi = pref[e + 1]; lo = lo > xs ? lo : xs; hi = hi < xs + 32 ? hi : xs + 32; hi = hi < nitems ? hi : nitems;
            gs_lo = __builtin_amdgcn_readfirstlane(lo); gs_n = __builtin_amdgcn_readfirstlane(hi - lo); }
        unsigned gs_k = 0u;
#define EX_GSYNC() do { if (MK_GSYNC && gs_n > 1) { ++gs_k; if (tid == 0) { unsigned* cw = (unsigned*)(F.ctl + CW_GS) + 64 * gs_lo; __hip_atomic_fetch_add(cw, 1u, RLX_AGENT);               \
                const unsigned long long t0_ = __builtin_amdgcn_s_memrealtime(); const unsigned want = (unsigned)gs_n * gs_k;                                                                 \
                while (__hip_atomic_load(cw, RLX_AGENT) < want) { if (__builtin_amdgcn_s_memrealtime() - t0_ > 20000ull) break; __builtin_amdgcn_s_sleep(2); } }                            \
            __syncthreads(); } } while (0)
        EX_GSYNC();
        if (MK_GSTAG > 0 && gs_n > 1) { const unsigned long long t0_ = __builtin_amdgcn_s_memrealtime(); const unsigned long long d_ = (unsigned long long)(MK_GSTAG * (it - gs_lo)); while (__builtin_amdgcn_s_memrealtime() - t0_ < d_) __builtin_amdgcn_s_sleep(1); }
        f32x4 acc[4][4];
#define EX_ZERO() do { _Pragma("unroll") for (int i = 0; i < 4; ++i) _Pragma("unroll") for (int j = 0; j < 4; ++j) acc[i][j] = (f32x4){0.f, 0.f, 0.f, 0.f}; } while (0)
        EX_ZERO();
        ExSet S0, S1, S2, S3;
#define EX_L1(S, CC) do { const int cc_ = (CC) & 63, hp_ = cc_ >> 5, kc_ = cc_ & 31; int tl = tid; asm volatile("" : "+v"(tl));                         \
            unsigned o = (unsigned)((32 * kc_ + (tl >> 5)) * EH + 128 * hp_ + 4 * (tl & 31));                                                            \
            S.w[0] = *(const f32x4*)(Wg + o); S.w[1] = *(const f32x4*)(Wg + o + 16 * EH); S.w[2] = *(const f32x4*)(Wu + o); S.w[3] = *(const f32x4*)(Wu + o + 16 * EH); \
            S.a = *(const v4u*)(asrc + 32 * kc_); } while (0)
#define EX_PF1(CC) do { if (MK_PFD > 0) { const int cc_ = (CC) & 63, hp_ = cc_ >> 5, kc_ = cc_ & 31; int tl = tid; asm volatile("" : "+v"(tl)); const int ln_ = tl & 63;   \
            if (w < 4) { const float* wm_ = (w & 2) ? Wu : Wg; pf_dma(wm_ + (size_t)(32 * kc_ + (w & 1) * 16 + (ln_ >> 2)) * EH + 128 * hp_ + 32 * (ln_ & 3), pfl); }              \
            else if (w < 6) { pf_dma(H2 + (size_t)tokl[(w - 4) * 64 + ln_] * D + 32 * kc_, pfl); } } } while (0)
#define EX_W1(S, BUF) do { int tl = tid; asm volatile("" : "+v"(tl)); LAS unsigned char* b_ = (BUF) + EX_BOFF + (tl >> 5) * KSB + 8 * (tl & 31); v2u p_[4];  \
            _Pragma("unroll") for (int i = 0; i < 4; ++i) { p_[i].x = pk2(S.w[i].x, S.w[i].y); p_[i].y = pk2(S.w[i].z, S.w[i].w); }                        \
            *(LAS v2u*)b_ = p_[0]; *(LAS v2u*)(b_ + 16 * KSB) = p_[1]; *(LAS v2u*)(b_ + 32 * KSB) = p_[2]; *(LAS v2u*)(b_ + 48 * KSB) = p_[3];             \
            *(LAS v4u*)((BUF) + (tl >> 2) * ASB + (tl & 3) * 16) = S.a; } while (0)
#define EX_C1(C) do { int tl = tid; asm volatile("" : "+v"(tl)); const int g = (tl >> 4) & 3, fr = tl & 15, q = (tl & 15) >> 2, p = tl & 3;              \
            LAS unsigned char* buf = F.lds + EX_BUF + ((C) & 1) * EX_BUFSZ; const unsigned ta = F.ldsb + EX_BUF + (unsigned)(((C) & 1) * EX_BUFSZ + EX_BOFF + (8 * g + q) * KSB + (32 * wc + 4 * p) * 2); \
            bf16x8 af[4]; _Pragma("unroll") for (int rt = 0; rt < 4; ++rt) af[rt] = ldfrag(buf, 64 * wr + 16 * rt + fr, ASB, 8 * g);                     \
            bf16x8 b0, b1, b2, b3; tr_frag2<4 * KSB, 32>(ta, b0, b1); tr_frag2<4 * KSB, 32>(ta + 32 * KSB, b2, b3);                                       \
            _Pragma("unroll") for (int rt = 0; rt < 4; ++rt) { acc[rt][0] = MFMA16(b0, af[rt], acc[rt][0]); acc[rt][1] = MFMA16(b1, af[rt], acc[rt][1]); acc[rt][2] = MFMA16(b2, af[rt], acc[rt][2]); acc[rt][3] = MFMA16(b3, af[rt], acc[rt][3]); } } while (0)
#define EX_STEP1(SL, SW, C) do { EX_L1(SL, (C) + 4); EX_PF1((C) + 4 + MK_PFD); EX_C1(C); EX_W1(SW, F.lds + EX_BUF + (((C) + 1) & 1) * EX_BUFSZ); __syncthreads(); } while (0)
        EX_L1(S0, 0); EX_L1(S1, 1); EX_L1(S2, 2); EX_L1(S3, 3);
        EX_W1(S0, F.lds + EX_BUF);
        __syncthreads();
#pragma unroll 1
        for (int c4 = 0; c4 < 64; c4 += 4) {
            if (MK_GSYNC_EVERY > 0 && (c4 & (MK_GSYNC_EVERY - 1)) == 0 && c4) EX_GSYNC();
            EX_STEP1(S0, S1, c4); EX_STEP1(S1, S2, c4 + 1); EX_STEP1(S2, S3, c4 + 2); EX_STEP1(S3, S0, c4 + 3);
            if ((c4 & 31) == 28) { const int hp = c4 >> 5; int tl = tid; asm volatile("" : "+v"(tl)); const int g = (tl >> 4) & 3, fr = tl & 15;
#pragma unroll
                for (int rt = 0; rt < 4; ++rt)
#pragma unroll
                    for (int ct = 0; ct < 2; ++ct) { const f32x4 ga = acc[rt][ct], ua = acc[rt][ct + 2];
                        v2u wv; wv.x = pk2(siluf_(ga[0]) * ua[0], siluf_(ga[1]) * ua[1]); wv.y = pk2(siluf_(ga[2]) * ua[2], siluf_(ga[3]) * ua[3]);
                        *(LAS v2u*)(Gimg + (64 * wr + 16 * rt + fr) * VSB + (128 * hp + 32 * wc + 16 * ct + 4 * g) * 2) = wv; }
                EX_ZERO(); }
        }
#define EX_L2(S, CC) do { const int cc_ = (CC) & 31, np_ = cc_ >> 3, kc_ = cc_ & 7; int tl = tid; asm volatile("" : "+v"(tl));                           \
            unsigned o = (unsigned)((32 * kc_ + (tl >> 6)) * D + 256 * np_ + 4 * (tl & 63));                                                              \
            _Pragma("unroll") for (int i = 0; i < 4; ++i) S.w[i] = *(const f32x4*)(Wd + o + (unsigned)(8 * i * D)); } while (0)
#define EX_PF2(CC) do { if (MK_PFD > 0) { const int cc_ = (CC) & 31, np_ = cc_ >> 3, kc_ = cc_ & 7; int tl = tid; asm volatile("" : "+v"(tl)); const int ln_ = tl & 63;    \
            if (w < 4) pf_dma(Wd + (size_t)(32 * kc_ + w * 8 + (ln_ >> 3)) * D + 256 * np_ + 32 * (ln_ & 7), pfl); } } while (0)
#define EX_W2(S, BUF) do { int tl = tid; asm volatile("" : "+v"(tl)); LAS unsigned char* b_ = (BUF) + EX_BOFF + (tl >> 6) * VSB + 8 * (tl & 63);          \
            _Pragma("unroll") for (int i = 0; i < 4; ++i) { v2u p_; p_.x = pk2(S.w[i].x, S.w[i].y); p_.y = pk2(S.w[i].z, S.w[i].w); *(LAS v2u*)(b_ + (8 * i) * VSB) = p_; } } while (0)
#define EX_C2(C) do { int tl = tid; asm volatile("" : "+v"(tl)); const int g = (tl >> 4) & 3, fr = tl & 15, q = (tl & 15) >> 2, p = tl & 3;              \
            const unsigned ta = F.ldsb + EX_BUF + (unsigned)(((C) & 1) * EX_BUFSZ + EX_BOFF + (8 * g + q) * VSB + (64 * wc + 4 * p) * 2);                \
            bf16x8 gf[4]; _Pragma("unroll") for (int rt = 0; rt < 4; ++rt) gf[rt] = ldfrag(Gimg, 64 * wr + 16 * rt + fr, VSB, 32 * ((C) & 7) + 8 * g);   \
            bf16x8 b0, b1, b2, b3; tr_frag4<4 * VSB, 32>(ta, b0, b1, b2, b3);                                                                             \
            _Pragma("unroll") for (int rt = 0; rt < 4; ++rt) { acc[rt][0] = MFMA16(b0, gf[rt], acc[rt][0]); acc[rt][1] = MFMA16(b1, gf[rt], acc[rt][1]); acc[rt][2] = MFMA16(b2, gf[rt], acc[rt][2]); acc[rt][3] = MFMA16(b3, gf[rt], acc[rt][3]); } } while (0)
#define EX_STEP2(SL, SW, C) do { EX_L2(SL, (C) + 4); EX_PF2((C) + 4 + MK_PFD); EX_C2(C); EX_W2(SW, F.lds + EX_BUF + (((C) + 1) & 1) * EX_BUFSZ); __syncthreads(); } while (0)
        EX_L2(S0, 0); EX_L2(S1, 1); EX_L2(S2, 2); EX_L2(S3, 3);
        EX_W2(S0, F.lds + EX_BUF);
        __syncthreads();
#pragma unroll 1
        for (int np = 0; np < 4; ++np) {
            if (MK_GSYNC_EVERY > 0) EX_GSYNC();
#pragma unroll 1
            for (int h4 = 0; h4 < 8; h4 += 4) { const int c4 = 8 * np + h4;
                EX_STEP2(S0, S1, c4); EX_STEP2(S1, S2, c4 + 1); EX_STEP2(S2, S3, c4 + 2); EX_STEP2(S3, S0, c4 + 3); }
            int tl = tid; asm volatile("" : "+v"(tl)); const int g = (tl >> 4) & 3, fr = tl & 15;
#pragma unroll
            for (int rt = 0; rt < 4; ++rt) { const int row = 64 * wr + 16 * rt + fr; const float rw = wl[row];
                if (!(ABL & 32) && r0 + row < cnt_e) { bf16* yp = YP + (size_t)(slot0 + row) * D + 256 * np + 64 * wc + 4 * g;
#pragma unroll
                    for (int ct = 0; ct < 4; ++ct) { const f32x4 o = acc[rt][ct] * rw; v2u wv; wv.x = pk2(o[0], o[1]); wv.y = pk2(o[2], o[3]); *(v2u*)(yp + 16 * ct) = wv; } } }
            EX_ZERO();
        }
#undef EX_L1
#undef EX_PF1
#undef EX_PF2
#undef EX_W1
#undef EX_C1
#undef EX_STEP1
#undef EX_L2
#undef EX_W2
#undef EX_C2
#undef EX_STEP2
#undef EX_ZERO
#undef EX_GSYNC
        __syncthreads();
    }
    asm volatile("s_waitcnt vmcnt(0)" ::: "memory");
}

constexpr int E5_TOK = 2176, E5_W = 3200, E5_BUF = 4224, E5_BUFSZ = 37888, E5_BOFF = 20480;
static_assert(E5_BUF + 2 * E5_BUFSZ <= LDSCTL_OFF, "expert v5 LDS map");
struct E5Set { f32x4 w[4]; v4u a0, a1; };
__device__ __forceinline__ void expert_prefix256(Frame& F, LAS int* pref, LAS int* off) {
    if (F.wave == 0) { const unsigned* cnt = (const unsigned*)(F.ctl + CW_CNT); const int lane = F.lane;
        int c[4], nb[4]; int tc = 0, tb = 0;
#pragma unroll
        for (int j = 0; j < 4; ++j) { c[j] = (int)__hip_atomic_load(cnt + 64 * (4 * lane + j), RLX_AGENT); nb[j] = (c[j] + 255) >> 8; tc += c[j]; tb += nb[j]; }
        int xc = tc, xb = tb;
#pragma unroll
        for (int o = 1; o < 64; o <<= 1) { const int vc = __shfl_up(xc, o), vb = __shfl_up(xb, o); if (lane >= o) { xc += vc; xb += vb; } }
        int ec = xc - tc, eb = xb - tb;
#pragma unroll
        for (int j = 0; j < 4; ++j) { off[4 * lane + j] = ec; pref[4 * lane + j] = eb; ec += c[j]; eb += nb[j]; }
        if (lane == 63) { off[256] = ec; pref[256] = eb; } }
}
__device__ __forceinline__ void p11_experts_v5(Frame& F) {
    unsigned char* ws = F.ws; const bf16* H2 = (const bf16*)(ws + WS_HB); const int* LTOK = (const int*)(ws + WS_LTOK); const float* LW = (const float*)(ws + WS_LW); bf16* YP = (bf16*)(ws + WS_YP);
    bf16* Gs = (bf16*)(ws + WS_RETG) + (size_t)blockIdx.x * 65536;
    LAS int* pref = (LAS int*)(F.lds + EX_PREF); LAS int* off = (LAS int*)(F.lds + EX_OFF); LAS int* tokl = (LAS int*)(F.lds + E5_TOK); LAS float* wl = (LAS float*)(F.lds + E5_W);
    const int tid = F.tid, w = F.wave, wr = w >> 2, wc = w & 3;
    expert_prefix256(F, pref, off);
    __syncthreads();
    const int nitems = pref[256];
    for (int it = F.vcu; it < nitems; it += F.G) {
        int e = 0;
#pragma unroll
        for (int s = 128; s >= 1; s >>= 1) if (pref[e + s] <= it) e += s;
        e = __builtin_amdgcn_readfirstlane(e);
        const int rb = __builtin_amdgcn_readfirstlane(it - pref[e]), cnt_e = __builtin_amdgcn_readfirstlane(off[e + 1] - off[e]), r0 = rb * 256, slot0 = __builtin_amdgcn_readfirstlane(off[e]) + r0;
        if (tid < 256) { const int idx = r0 + tid; const bool ok = idx < cnt_e; tokl[tid] = LTOK[(size_t)e * CAP + (ok ? idx : r0)]; wl[tid] = ok ? LW[(size_t)e * CAP + idx] : 0.f; }
        __syncthreads();
        const float* Wg = F.w_eg + (size_t)e * D * EH; const float* Wu = F.w_eu + (size_t)e * D * EH; const float* Wd = F.w_ed + (size_t)e * EH * D;
        const bf16* asrc = H2 + (size_t)tokl[tid >> 1] * D + (tid & 1) * 16;
        const bf16* gsrc = Gs + (size_t)(tid >> 1) * 256 + (tid & 1) * 16;
        f32x4 acc[2][4][4];
#define E5_ZERO() do { _Pragma("unroll") for (int s_ = 0; s_ < 2; ++s_) _Pragma("unroll") for (int i = 0; i < 4; ++i) _Pragma("unroll") for (int j = 0; j < 4; ++j) acc[s_][i][j] = (f32x4){0.f, 0.f, 0.f, 0.f}; } while (0)
        E5_ZERO();
        E5Set S0, S1;
#define E5_WA(S, BUF, TL) do { *(LAS v4u*)((BUF) + ((TL) >> 1) * ASB + ((TL) & 1) * 32) = S.a0; *(LAS v4u*)((BUF) + ((TL) >> 1) * ASB + ((TL) & 1) * 32 + 16) = S.a1; } while (0)
#define E5_MMA(BUF, B0, B1, B2, B3, FR, G_) do { _Pragma("unroll") for (int s_ = 0; s_ < 2; ++s_) _Pragma("unroll") for (int rt = 0; rt < 4; ++rt) {                       \
            const bf16x8 af = ldfrag((BUF), 128 * s_ + 64 * wr + 16 * rt + (FR), ASB, 8 * (G_));                                                                          \
            acc[s_][rt][0] = MFMA16(B0, af, acc[s_][rt][0]); acc[s_][rt][1] = MFMA16(B1, af, acc[s_][rt][1]); acc[s_][rt][2] = MFMA16(B2, af, acc[s_][rt][2]); acc[s_][rt][3] = MFMA16(B3, af, acc[s_][rt][3]); } } while (0)
#define E5_L1(S, CC) do { const int cc_ = (CC) & 63, hp_ = cc_ >> 5, kc_ = cc_ & 31; int tl = tid; asm volatile("" : "+v"(tl));                         \
            unsigned o = (unsigned)((32 * kc_ + (tl >> 5)) * EH + 128 * hp_ + 4 * (tl & 31));                                                            \
            S.w[0] = *(const f32x4*)(Wg + o); S.w[1] = *(const f32x4*)(Wg + o + 16 * EH); S.w[2] = *(const f32x4*)(Wu + o); S.w[3] = *(const f32x4*)(Wu + o + 16 * EH); \
            S.a0 = *(const v4u*)(asrc + 32 * kc_); S.a1 = *(const v4u*)(asrc + 32 * kc_ + 8); } while (0)
#define E5_W1(S, BUF) do { int tl = tid; asm volatile("" : "+v"(tl)); LAS unsigned char* b_ = (BUF) + E5_BOFF + (tl >> 5) * KSB + 8 * (tl & 31); v2u p_[4];  \
            _Pragma("unroll") for (int i = 0; i < 4; ++i) { p_[i].x = pk2(S.w[i].x, S.w[i].y); p_[i].y = pk2(S.w[i].z, S.w[i].w); }                        \
            *(LAS v2u*)b_ = p_[0]; *(LAS v2u*)(b_ + 16 * KSB) = p_[1]; *(LAS v2u*)(b_ + 32 * KSB) = p_[2]; *(LAS v2u*)(b_ + 48 * KSB) = p_[3];             \
            E5_WA(S, BUF, tl); } while (0)
#define E5_C1(BUFI) do { int tl = tid; asm volatile("" : "+v"(tl)); const int g = (tl >> 4) & 3, fr = tl & 15, q = (tl & 15) >> 2, p = tl & 3;          \
            LAS unsigned char* buf = F.lds + E5_BUF + (BUFI) * E5_BUFSZ; const unsigned ta = F.ldsb + E5_BUF + (unsigned)((BUFI) * E5_BUFSZ + E5_BOFF + (8 * g + q) * KSB + (32 * wc + 4 * p) * 2); \
            bf16x8 b0, b1, b2, b3; tr_frag2<4 * KSB, 32>(ta, b0, b1); tr_frag2<4 * KSB, 32>(ta + 32 * KSB, b2, b3);                                       \
            E5_MMA(buf, b0, b1, b2, b3, fr, g); } while (0)
        E5Set S2;
#define E5_GW(HP) do { int tl = tid; asm volatile("" : "+v"(tl)); const int g = (tl >> 4) & 3, fr = tl & 15;     \
            _Pragma("unroll") for (int s_ = 0; s_ < 2; ++s_) _Pragma("unroll") for (int rt = 0; rt < 4; ++rt) _Pragma("unroll") for (int ct = 0; ct < 2; ++ct) { const f32x4 ga = acc[s_][rt][ct], ua = acc[s_][rt][ct + 2]; \
                v2u wv; wv.x = pk2(siluf_(ga[0]) * ua[0], siluf_(ga[1]) * ua[1]); wv.y = pk2(siluf_(ga[2]) * ua[2], siluf_(ga[3]) * ua[3]);                   \
                *(v2u*)(Gs + (size_t)(128 * s_ + 64 * wr + 16 * rt + fr) * 256 + 128 * (HP) + 32 * wc + 16 * ct + 4 * g) = wv; }                              \
            E5_ZERO(); } while (0)
#define E5_STEP1(SL, SW, CC) do { const int bi_ = (CC) & 1; E5_L1(SL, (CC) + 3); E5_C1(bi_); E5_W1(SW, F.lds + E5_BUF + (1 - bi_) * E5_BUFSZ); __syncthreads(); } while (0)
        E5_L1(S0, 0); E5_L1(S1, 1); E5_L1(S2, 2);
        E5_W1(S0, F.lds + E5_BUF);
        __syncthreads();
#pragma unroll 1
        for (int c3 = 0; c3 < 63; c3 += 3) {
            E5_STEP1(S0, S1, c3); E5_STEP1(S1, S2, c3 + 1);
            if (c3 == 30) E5_GW(0);
            E5_STEP1(S2, S0, c3 + 2);
        }
        E5_STEP1(S0, S1, 63);
        E5_GW(1);
#undef E5_STEP1
#undef E5_GW
        asm volatile("s_waitcnt vmcnt(0)" ::: "memory");
        __syncthreads();
#define E5_L2(S, CC) do { const int cc_ = (CC) & 31, np_ = cc_ >> 3, kc_ = cc_ & 7; int tl = tid; asm volatile("" : "+v"(tl));                           \
            unsigned o = (unsigned)((32 * kc_ + (tl >> 6)) * D + 256 * np_ + 4 * (tl & 63));                                                              \
            _Pragma("unroll") for (int i = 0; i < 4; ++i) S.w[i] = *(const f32x4*)(Wd + o + (unsigned)(8 * i * D));                                       \
            S.a0 = *(const v4u*)(gsrc + 32 * kc_); S.a1 = *(const v4u*)(gsrc + 32 * kc_ + 8); } while (0)
#define E5_W2(S, BUF) do { int tl = tid; asm volatile("" : "+v"(tl)); LAS unsigned char* b_ = (BUF) + E5_BOFF + (tl >> 6) * VSB + 8 * (tl & 63);          \
            _Pragma("unroll") for (int i = 0; i < 4; ++i) { v2u p_; p_.x = pk2(S.w[i].x, S.w[i].y); p_.y = pk2(S.w[i].z, S.w[i].w); *(LAS v2u*)(b_ + (8 * i) * VSB) = p_; } \
            E5_WA(S, BUF, tl); } while (0)
#define E5_C2(BUFI) do { int tl = tid; asm volatile("" : "+v"(tl)); const int g = (tl >> 4) & 3, fr = tl & 15, q = (tl & 15) >> 2, p = tl & 3;          \
            LAS unsigned char* buf = F.lds + E5_BUF + (BUFI) * E5_BUFSZ; const unsigned ta = F.ldsb + E5_BUF + (unsigned)((BUFI) * E5_BUFSZ + E5_BOFF + (8 * g + q) * VSB + (64 * wc + 4 * p) * 2); \
            bf16x8 b0, b1, b2, b3; tr_frag4<4 * VSB, 32>(ta, b0, b1, b2, b3);                                                                             \
            E5_MMA(buf, b0, b1, b2, b3, fr, g); } while (0)
        E5_L2(S0, 0); E5_L2(S1, 1);
        E5_W2(S0, F.lds + E5_BUF);
        __syncthreads();
#pragma unroll 1
        for (int np = 0; np < 4; ++np) {
#pragma unroll 1
            for (int h2 = 0; h2 < 8; h2 += 2) { const int c2 = 8 * np + h2;
                E5_L2(S0, c2 + 2); E5_C2(0); E5_W2(S1, F.lds + E5_BUF + E5_BUFSZ); __syncthreads();
                E5_L2(S1, c2 + 3); E5_C2(1); E5_W2(S0, F.lds + E5_BUF); __syncthreads(); }
            int tl = tid; asm volatile("" : "+v"(tl)); const int g = (tl >> 4) & 3, fr = tl & 15;
#pragma unroll
            for (int s_ = 0; s_ < 2; ++s_)
#pragma unroll
                for (int rt = 0; rt < 4; ++rt) { const int row = 128 * s_ + 64 * wr + 16 * rt + fr; const float rw = wl[row];
                    if (r0 + row < cnt_e) { bf16* yp = YP + (size_t)(slot0 + row) * D + 256 * np + 64 * wc + 4 * g;
#pragma unroll
                        for (int ct = 0; ct < 4; ++ct) { const f32x4 o = acc[s_][rt][ct] * rw; v2u wv; wv.x = pk2(o[0], o[1]); wv.y = pk2(o[2], o[3]); *(v2u*)(yp + 16 * ct) = wv; } } }
            E5_ZERO();
        }
#undef E5_L1
#undef E5_W1
#undef E5_C1
#undef E5_L2
#undef E5_W2
#undef E5_C2
#undef E5_MMA
#undef E5_WA
#undef E5_ZERO
        asm volatile("s_waitcnt vmcnt(0)" ::: "memory");
        __syncthreads();
    }
}

constexpr int E6_TOK = 2176, E6_W = 3200, E6_AR = 4224, E6_ASL = 16384, E6_BI = E6_AR + 4 * E6_ASL, E6_BSZ = 17408;
static_assert(E6_BI + 2 * E6_BSZ <= PF_OFF, "expert v6 LDS map");
__device__ __forceinline__ void dma16(const void* gsrc, unsigned lds_dst) {
    unsigned keep;
    asm volatile("s_mov_b32 %0, m0\n\ts_mov_b32 m0, %2\n\ts_nop 0\n\tglobal_load_lds_dwordx4 %1, off\n\ts_mov_b32 m0, %0" : "=&s"(keep) : "v"(gsrc), "s"(lds_dst) : "memory");
}
struct E6Set { f32x4 w[4]; };
__device__ __forceinline__ void p11_experts_v6(Frame& F) {
    unsigned char* ws = F.ws; const bf16* H2 = (const bf16*)(ws + WS_HB); const int* LTOK = (const int*)(ws + WS_LTOK); const float* LW = (const float*)(ws + WS_LW); bf16* YP = (bf16*)(ws + WS_YP);
    bf16* Gs = (bf16*)(ws + WS_RETG) + (size_t)blockIdx.x * 65536;
    LAS int* pref = (LAS int*)(F.lds + EX_PREF); LAS int* off = (LAS int*)(F.lds + EX_OFF); LAS int* tokl = (LAS int*)(F.lds + E6_TOK); LAS float* wl = (LAS float*)(F.lds + E6_W);
    const int tid = F.tid, w = F.wave, wr = w >> 2, wc = w & 3;
    expert_prefix256(F, pref, off);
    __syncthreads();
    const int nitems = pref[256];
    for (int it = F.vcu; it < nitems; it += F.G) {
        int e = 0;
#pragma unroll
        for (int s = 128; s >= 1; s >>= 1) if (pref[e + s] <= it) e += s;
        e = __builtin_amdgcn_readfirstlane(e);
        const int rb = __builtin_amdgcn_readfirstlane(it - pref[e]), cnt_e = __builtin_amdgcn_readfirstlane(off[e + 1] - off[e]), r0 = rb * 256, slot0 = __builtin_amdgcn_readfirstlane(off[e]) + r0;
        if (tid < 256) { const int idx = r0 + tid; const bool ok = idx < cnt_e; tokl[tid] = LTOK[(size_t)e * CAP + (ok ? idx : r0)]; wl[tid] = ok ? LW[(size_t)e * CAP + idx] : 0.f; }
        __syncthreads();
        const float* Wg = F.w_eg + (size_t)e * D * EH; const float* Wu = F.w_eu + (size_t)e * D * EH; const float* Wd = F.w_ed + (size_t)e * EH * D;
        int tli = tid; asm volatile("" : "+v"(tli));
        const int ln = tli & 63, arow0 = 32 * w + (ln >> 2), aseg = ((ln & 3) ^ ((ln >> 4) & 3)) * 8;
        const bf16* ap0 = H2 + (size_t)tokl[arow0] * D + aseg; const bf16* ap1 = H2 + (size_t)tokl[arow0 + 16] * D + aseg;
        f32x4 acc[2][4][4];
#define E6_ZERO() do { _Pragma("unroll") for (int s_ = 0; s_ < 2; ++s_) _Pragma("unroll") for (int i = 0; i < 4; ++i) _Pragma("unroll") for (int j = 0; j < 4; ++j) acc[s_][i][j] = (f32x4){0.f, 0.f, 0.f, 0.f}; } while (0)
        E6_ZERO();
        E6Set S0, S1, S2;
#define E6_ADMA(KOFF, CC) do { const unsigned sl_ = F.ldsb + E6_AR + (unsigned)(((CC) & 3) * E6_ASL + 2048 * w); const bf16* a0_ = ap0; const bf16* a1_ = ap1; asm volatile("" : "+v"(a0_), "+v"(a1_)); dma16(a0_ + (KOFF), sl_); dma16(a1_ + (KOFF), sl_ + 1024u); } while (0)
#define E6_MMA(C, B0, B1, B2, B3) do { int tl = tid; asm volatile("" : "+v"(tl)); const int g = (tl >> 4) & 3, fr = tl & 15, q = (tl & 15) >> 2;                              \
            const LAS unsigned char* ab_ = F.lds + E6_AR + ((C) & 3) * E6_ASL + (64 * wr + fr) * 64 + ((g ^ q) << 4);                                                      \
            _Pragma("unroll") for (int s_ = 0; s_ < 2; ++s_) { if (s_) __builtin_amdgcn_sched_barrier(0); _Pragma("unroll") for (int rt = 0; rt < 4; ++rt) {                \
                const bf16x8 af = *(const LAS bf16x8*)(ab_ + (128 * s_ + 16 * rt) * 64);                                                                                  \
                acc[s_][rt][0] = MFMA16(B0, af, acc[s_][rt][0]); acc[s_][rt][1] = MFMA16(B1, af, acc[s_][rt][1]); acc[s_][rt][2] = MFMA16(B2, af, acc[s_][rt][2]); acc[s_][rt][3] = MFMA16(B3, af, acc[s_][rt][3]); } } } while (0)
#define E6_L1(S, CC) do { const int cc_ = (CC) & 63, hp_ = cc_ >> 5, kc_ = cc_ & 31; int tl = tid; asm volatile("" : "+v"(tl));                         \
            E6_ADMA(32 * kc_, CC);                                                                                                                       \
            unsigned o = (unsigned)((32 * kc_ + (tl >> 5)) * EH + 128 * hp_ + 4 * (tl & 31));                                                            \
            S.w[0] = *(const f32x4*)(Wg + o); S.w[1] = *(const f32x4*)(Wg + o + 16 * EH); S.w[2] = *(const f32x4*)(Wu + o); S.w[3] = *(const f32x4*)(Wu + o + 16 * EH); } while (0)
#define E6_W1(S, CC) do { int tl = tid; asm volatile("" : "+v"(tl)); LAS unsigned char* b_ = F.lds + E6_BI + ((CC) & 1) * E6_BSZ + (tl >> 5) * KSB + 8 * (tl & 31); v2u p_[4];  \
            _Pragma("unroll") for (int i = 0; i < 4; ++i) { p_[i].x = pk2(S.w[i].x, S.w[i].y); p_[i].y = pk2(S.w[i].z, S.w[i].w); }                        \
            *(LAS v2u*)b_ = p_[0]; *(LAS v2u*)(b_ + 16 * KSB) = p_[1]; *(LAS v2u*)(b_ + 32 * KSB) = p_[2]; *(LAS v2u*)(b_ + 48 * KSB) = p_[3]; } while (0)
#define E6_C1(C) do { int tl = tid; asm volatile("" : "+v"(tl)); const int g = (tl >> 4) & 3, q = (tl & 15) >> 2, p = tl & 3;                            \
            const unsigned ta = F.ldsb + E6_BI + (unsigned)(((C) & 1) * E6_BSZ + (8 * g + q) * KSB + (32 * wc + 4 * p) * 2);                             \
            bf16x8 b0, b1, b2, b3; tr_frag2<4 * KSB, 32>(ta, b0, b1); tr_frag2<4 * KSB, 32>(ta + 32 * KSB, b2, b3);                                       \
            E6_MMA(C, b0, b1, b2, b3); } while (0)
#define E6_GW(HP) do { int tl = tid; asm volatile("" : "+v"(tl)); const int g = (tl >> 4) & 3, fr = tl & 15;     \
            _Pragma("unroll") for (int s_ = 0; s_ < 2; ++s_) _Pragma("unroll") for (int rt = 0; rt < 4; ++rt) _Pragma("unroll") for (int ct = 0; ct < 2; ++ct) { const f32x4 ga = acc[s_][rt][ct], ua = acc[s_][rt][ct + 2]; \
                v2u wv; wv.x = pk2(siluf_(ga[0]) * ua[0], siluf_(ga[1]) * ua[1]); wv.y = pk2(siluf_(ga[2]) * ua[2], siluf_(ga[3]) * ua[3]);                   \
                *(v2u*)(Gs + (size_t)(128 * s_ + 64 * wr + 16 * rt + fr) * 256 + 128 * (HP) + 32 * wc + 16 * ct + 4 * g) = wv; }                              \
            E6_ZERO(); } while (0)
#define E6_STEP1(SL, SW, C) do { E6_L1(SL, (C) + 3); E6_C1(C); E6_W1(SW, (C) + 1); if (((C) & 31) == 31) E6_GW((C) >> 5); __syncthreads(); } while (0)
        E6_L1(S0, 0); E6_L1(S1, 1);
        E6_W1(S0, 0);
        E6_L1(S2, 2);
        __syncthreads();
#pragma unroll 1
        for (int c3 = 0; c3 < 63; c3 += 3) { E6_STEP1(S0, S1, c3); E6_STEP1(S1, S2, c3 + 1); E6_STEP1(S2, S0, c3 + 2); }
        E6_STEP1(S0, S1, 63);
        asm volatile("s_waitcnt vmcnt(0)" ::: "memory");
        __syncthreads();
        { int tl = tid; asm volatile("" : "+v"(tl)); const int l2_ = tl & 63, ar_ = 32 * w + (l2_ >> 2), as_ = ((l2_ & 3) ^ ((l2_ >> 4) & 3)) * 8; ap0 = Gs + (size_t)ar_ * 256 + as_; ap1 = Gs + (size_t)(ar_ + 16) * 256 + as_; }
#define E6_L2(S, CC) do { const int cc_ = (CC) & 31, np_ = cc_ >> 3, kc_ = cc_ & 7; int tl = tid; asm volatile("" : "+v"(tl));                           \
            E6_ADMA(32 * kc_, CC);                                                                                                                       \
            unsigned o = (unsigned)((32 * kc_ + (tl >> 6)) * D + 256 * np_ + 4 * (tl & 63));                                                              \
            _Pragma("unroll") for (int i = 0; i < 4; ++i) S.w[i] = *(const f32x4*)(Wd + o + (unsigned)(8 * i * D)); } while (0)
#define E6_W2(S, CC) do { int tl = tid; asm volatile("" : "+v"(tl)); LAS unsigned char* b_ = F.lds + E6_BI + ((CC) & 1) * E6_BSZ + (tl >> 6) * VSB + 8 * (tl & 63);  \
            _Pragma("unroll") for (int i = 0; i < 4; ++i) { v2u p_; p_.x = pk2(S.w[i].x, S.w[i].y); p_.y = pk2(S.w[i].z, S.w[i].w); *(LAS v2u*)(b_ + (8 * i) * VSB) = p_; } } while (0)
#define E6_C2(C) do { int tl = tid; asm volatile("" : "+v"(tl)); const int g = (tl >> 4) & 3, q = (tl & 15) >> 2, p = tl & 3;                            \
            const unsigned ta = F.ldsb + E6_BI + (unsigned)(((C) & 1) * E6_BSZ + (8 * g + q) * VSB + (64 * wc + 4 * p) * 2);                             \
            bf16x8 b0, b1, b2, b3; tr_frag4<4 * VSB, 32>(ta, b0, b1, b2, b3);                                                                             \
            E6_MMA(C, b0, b1, b2, b3); } while (0)
#define E6_YP(NP) do { int tl = tid; asm volatile("" : "+v"(tl)); const int g = (tl >> 4) & 3, fr = tl & 15;                                            \
            _Pragma("unroll") for (int s_ = 0; s_ < 2; ++s_) _Pragma("unroll") for (int rt = 0; rt < 4; ++rt) { const int row = 128 * s_ + 64 * wr + 16 * rt + fr; const float rw = wl[row]; \
                if (r0 + row < cnt_e) { bf16* yp = YP + (size_t)(slot0 + row) * D + 256 * (NP) + 64 * wc + 4 * g;                                         \
                    _Pragma("unroll") for (int ct = 0; ct < 4; ++ct) { const f32x4 o = acc[s_][rt][ct] * rw; v2u wv; wv.x = pk2(o[0], o[1]); wv.y = pk2(o[2], o[3]); *(v2u*)(yp + 16 * ct) = wv; } } } \
            E6_ZERO(); } while (0)
#define E6_STEP2(SL, SW, C) do { E6_L2(SL, (C) + 3); E6_C2(C); E6_W2(SW, (C) + 1); if (((C) & 7) == 7) E6_YP((C) >> 3); __syncthreads(); } while (0)
        E6_L2(S0, 0); E6_L2(S1, 1);
        E6_W2(S0, 0);
        E6_L2(S2, 2);
        __syncthreads();
#pragma unroll 1
        for (int c3 = 0; c3 < 30; c3 += 3) { E6_STEP2(S0, S1, c3); E6_STEP2(S1, S2, c3 + 1); E6_STEP2(S2, S0, c3 + 2); }
        E6_STEP2(S0, S1, 30); E6_STEP2(S1, S2, 31);
#undef E6_L1
#undef E6_W1
#undef E6_C1
#undef E6_GW
#undef E6_STEP1
#undef E6_L2
#undef E6_W2
#undef E6_C2
#undef E6_YP
#undef E6_STEP2
#undef E6_MMA
#undef E6_ADMA
#undef E6_ZERO
        asm volatile("s_waitcnt vmcnt(0)" ::: "memory");
        __syncthreads();
    }
}

constexpr int K6_A = 3200, K6_BG = 21632, K6_BU = 39040, K6_G = 56448;
constexpr int ASB6 = 144;
#define K6MM(a, b, c) ((ABL & 1) ? k6_keep((a), (b), (c)) : MFMA16((a), (b), (c)))
__device__ __forceinline__ f32x4 k6_keep(bf16x8 a, bf16x8 b, f32x4 c) { asm volatile("" :: "v"(a), "v"(b)); return c; }
struct K6Set { f32x4 w[8]; v4u a0, a1; };
template <int ABL> __device__ __forceinline__ void p11_experts_k64(Frame& F) {
    unsigned char* ws = F.ws; const bf16* H2 = (const bf16*)(ws + WS_HB); const int* LTOK = (const int*)(ws + WS_LTOK); const float* LW = (const float*)(ws + WS_LW); bf16* YP = (bf16*)(ws + WS_YP);
    LAS int* pref = (LAS int*)(F.lds + EX_PREF); LAS int* off = (LAS int*)(F.lds + EX_OFF); LAS int* tokl = (LAS int*)(F.lds + EX_TOK); LAS float* wl = (LAS float*)(F.lds + EX_W);
    LAS unsigned char* Aimg = F.lds + K6_A; LAS unsigned char* Gimg = F.lds + K6_G;
    const int tid = F.tid, w = F.wave, wr = w >> 2, wc = w & 3;
    expert_prefix(F, pref, off);
    __syncthreads();
    const int nitems = pref[256];
    for (int it = F.vcu; it < nitems; it += F.G) {
        int e = 0;
#pragma unroll
        for (int s = 128; s >= 1; s >>= 1) if (pref[e + s] <= it) e += s;
        e = __builtin_amdgcn_readfirstlane(e);
        const int rb = __builtin_amdgcn_readfirstlane(it - pref[e]), cnt_e = __builtin_amdgcn_readfirstlane(off[e + 1] - off[e]), r0 = rb * 128, slot0 = __builtin_amdgcn_readfirstlane(off[e]) + r0;
        if (tid < 128) { const int idx = r0 + tid; const bool ok = idx < cnt_e; tokl[tid] = LTOK[(size_t)e * CAP + (ok ? idx : r0)]; wl[tid] = ok ? LW[(size_t)e * CAP + idx] : 0.f; }
        __syncthreads();
        const int ew = e;
        const float* Wg = F.w_eg + (size_t)ew * D * EH; const float* Wu = F.w_eu + (size_t)ew * D * EH; const float* Wd = F.w_ed + (size_t)ew * EH * D;
        const bf16* asrc = H2 + (size_t)tokl[tid >> 2] * D + (tid & 3) * 16;
        f32x4 acc[4][4];
#pragma unroll
        for (int i = 0; i < 4; ++i)
#pragma unroll
            for (int j = 0; j < 4; ++j) acc[i][j] = (f32x4){0.f, 0.f, 0.f, 0.f};
        K6Set S0, S1;
        if constexpr (ABL & 16) {
#pragma unroll
            for (int i = 0; i < 8; ++i) { S0.w[i] = (f32x4){1.f, 1.f, 1.f, 1.f}; S1.w[i] = (f32x4){1.f, 1.f, 1.f, 1.f}; } S0.a0 = S0.a1 = S1.a0 = S1.a1 = (v4u){0u, 0u, 0u, 0u}; }
#define K6_LOAD1(S, CC) do { const int cc_ = (CC) & 31, hp_ = cc_ >> 4, kc_ = cc_ & 15; int tl = tid; asm volatile("" : "+v"(tl));                      \
            unsigned o = (unsigned)((64 * kc_ + (tl >> 5)) * EH + 128 * hp_ + 4 * (tl & 31));                                                            \
            if constexpr (!(ABL & 16)) { _Pragma("unroll") for (int i = 0; i < 4; ++i) { S.w[i] = *(const f32x4*)(Wg + o + (unsigned)(16 * i * EH)); S.w[4 + i] = *(const f32x4*)(Wu + o + (unsigned)(16 * i * EH)); } \
            S.a0 = *(const v4u*)(asrc + 64 * kc_); S.a1 = *(const v4u*)(asrc + 64 * kc_ + 8); } } while (0)
#define K6_STEP1(S, CC) do { int tl = tid; asm volatile("" : "+v"(tl)); const int g = (tl >> 4) & 3, fr = tl & 15, q = (tl & 15) >> 2, p = tl & 3;    \
            if constexpr (!(ABL & 8)) __syncthreads();                                                                                                       \
            if constexpr (!(ABL & 2)) { *(LAS v4u*)(Aimg + (tl >> 2) * ASB6 + (tl & 3) * 32) = S.a0; *(LAS v4u*)(Aimg + (tl >> 2) * ASB6 + (tl & 3) * 32 + 16) = S.a1; }            \
            if constexpr (!(ABL & 2)) _Pragma("unroll") for (int i = 0; i < 4; ++i) { v2u wg, wu; wg.x = pk2(S.w[i].x, S.w[i].y); wg.y = pk2(S.w[i].z, S.w[i].w); wu.x = pk2(S.w[4 + i].x, S.w[4 + i].y); wu.y = pk2(S.w[4 + i].z, S.w[4 + i].w); \
                *(LAS v2u*)(F.lds + K6_BG + ((tl >> 5) + 16 * i) * KSB + 8 * (tl & 31)) = wg; *(LAS v2u*)(F.lds + K6_BU + ((tl >> 5) + 16 * i) * KSB + 8 * (tl & 31)) = wu; } \
            if constexpr (!(ABL & 8)) __syncthreads();                                                                                                       \
            K6_LOAD1(S, (CC) + 2);                                                                                                                       \
            const unsigned bga = F.ldsb + K6_BG + (unsigned)((8 * g + q) * KSB + (32 * wc + 4 * p) * 2), bua = bga + (K6_BU - K6_BG);                   \
            if constexpr (!(ABL & 4)) _Pragma("unroll") for (int s = 0; s < 2; ++s) { bf16x8 af[4];                                                                                \
                _Pragma("unroll") for (int rt = 0; rt < 4; ++rt) af[rt] = ldfrag(Aimg, 64 * wr + 16 * rt + fr, ASB6, 32 * s + 8 * g);                    \
                bf16x8 b0, b1, b2, b3; tr_frag2<4 * KSB, 32>(bga + s * 32 * KSB, b0, b1); tr_frag2<4 * KSB, 32>(bua + s * 32 * KSB, b2, b3);             \
                _Pragma("unroll") for (int rt = 0; rt < 4; ++rt) { acc[rt][0] = K6MM(b0, af[rt], acc[rt][0]); acc[rt][1] = K6MM(b1, af[rt], acc[rt][1]); acc[rt][2] = K6MM(b2, af[rt], acc[rt][2]); acc[rt][3] = K6MM(b3, af[rt], acc[rt][3]); } } } while (0)
        K6_LOAD1(S0, 0); K6_LOAD1(S1, 1);
#pragma unroll 1
        for (int cc = 0; cc < 32; cc += 2) {
            K6_STEP1(S0, cc); K6_STEP1(S1, cc + 1);
            if ((cc & 15) == 14) { const int hp = cc >> 4; int tl = tid; asm volatile("" : "+v"(tl)); const int g = (tl >> 4) & 3, fr = tl & 15;
#pragma unroll
                for (int rt = 0; rt < 4; ++rt)
#pragma unroll
                    for (int ct = 0; ct < 2; ++ct) { const f32x4 ga = acc[rt][ct], ua = acc[rt][ct + 2];
                        v2u wv; wv.x = pk2(siluf_(ga[0]) * ua[0], siluf_(ga[1]) * ua[1]); wv.y = pk2(siluf_(ga[2]) * ua[2], siluf_(ga[3]) * ua[3]);
                        *(LAS v2u*)(Gimg + (64 * wr + 16 * rt + fr) * VSB + (128 * hp + 32 * wc + 16 * ct + 4 * g) * 2) = wv; }
#pragma unroll
                for (int i = 0; i < 4; ++i)
#pragma unroll
                    for (int j = 0; j < 4; ++j) acc[i][j] = (f32x4){0.f, 0.f, 0.f, 0.f}; }
        }
#undef K6_STEP1
#undef K6_LOAD1
#define K6_LOAD2(S, CC) do { const int cc_ = (CC) & 15, np_ = cc_ >> 2, kc_ = cc_ & 3; int tl = tid; asm volatile("" : "+v"(tl));                       \
            unsigned o = (unsigned)((64 * kc_ + (tl >> 6)) * D + 256 * np_ + 4 * (tl & 63));                                                             \
            if constexpr (!(ABL & 16)) { _Pragma("unroll") for (int i = 0; i < 8; ++i) S.w[i] = *(const f32x4*)(Wd + o + (unsigned)(8 * i * D)); } } while (0)
#define K6_STEP2(S, CC, KC) do { int tl = tid; asm volatile("" : "+v"(tl)); const int g = (tl >> 4) & 3, fr = tl & 15, q = (tl & 15) >> 2, p = tl & 3; \
            if constexpr (!(ABL & 8)) __syncthreads();                                                                                                       \
            if constexpr (!(ABL & 2)) _Pragma("unroll") for (int i = 0; i < 8; ++i) { v2u wd; wd.x = pk2(S.w[i].x, S.w[i].y); wd.y = pk2(S.w[i].z, S.w[i].w); *(LAS v2u*)(F.lds + K6_BG + ((tl >> 6) + 8 * i) * VSB + 8 * (tl & 63)) = wd; } \
            if constexpr (!(ABL & 8)) __syncthreads();                                                                                                       \
            K6_LOAD2(S, (CC) + 2);                                                                                                                       \
            const unsigned bda = F.ldsb + K6_BG + (unsigned)((8 * g + q) * VSB + (64 * wc + 4 * p) * 2);                                                \
            if constexpr (!(ABL & 4)) _Pragma("unroll") for (int s = 0; s < 2; ++s) { bf16x8 gf[4];                                                                                \
                _Pragma("unroll") for (int rt = 0; rt < 4; ++rt) gf[rt] = ldfrag(Gimg, 64 * wr + 16 * rt + fr, VSB, 64 * (KC) + 32 * s + 8 * g);        \
                bf16x8 b0, b1, b2, b3; tr_frag4<4 * VSB, 32>(bda + s * 32 * VSB, b0, b1, b2, b3);                                                        \
                _Pragma("unroll") for (int rt = 0; rt < 4; ++rt) { acc[rt][0] = K6MM(b0, gf[rt], acc[rt][0]); acc[rt][1] = K6MM(b1, gf[rt], acc[rt][1]); acc[rt][2] = K6MM(b2, gf[rt], acc[rt][2]); acc[rt][3] = K6MM(b3, gf[rt], acc[rt][3]); } } } while (0)
        K6_LOAD2(S0, 0); K6_LOAD2(S1, 1);
#pragma unroll 1
        for (int np = 0; np < 4; ++np) {
            K6_STEP2(S0, 4 * np, 0); K6_STEP2(S1, 4 * np + 1, 1); K6_STEP2(S0, 4 * np + 2, 2); K6_STEP2(S1, 4 * np + 3, 3);
            int tl = tid; asm volatile("" : "+v"(tl)); const int g = (tl >> 4) & 3, fr = tl & 15;
#pragma unroll
            for (int rt = 0; rt < 4; ++rt) { const int row = 64 * wr + 16 * rt + fr; const float rw = wl[row];
                if (!(ABL & 32) && r0 + row < cnt_e) { bf16* yp = YP + (size_t)(slot0 + row) * D + 256 * np + 64 * wc + 4 * g;
#pragma unroll
                    for (int ct = 0; ct < 4; ++ct) { const f32x4 o = acc[rt][ct] * rw; v2u wv; wv.x = pk2(o[0], o[1]); wv.y = pk2(o[2], o[3]); *(v2u*)(yp + 16 * ct) = wv; } } }
#pragma unroll
            for (int i = 0; i < 4; ++i)
#pragma unroll
                for (int j = 0; j < 4; ++j) acc[i][j] = (f32x4){0.f, 0.f, 0.f, 0.f};
        }
#undef K6_STEP2
#undef K6_LOAD2
        __syncthreads();
    }
}

#undef K6MM
__device__ __forceinline__ void p12_final(Frame& F) {
    unsigned char* ws = F.ws; const float* X1 = (const float*)(ws + (MK_SKIP_SHARED ? WS_X1 : WS_MIXP)); const bf16* YP = (const bf16*)(ws + WS_YP); const int* EIDX = (const int*)(ws + WS_EIDX); const int* POS = (const int*)(ws + WS_POS);
    const float* mod = (const float*)(ws + WS_MOD);
    LAS int* pref = (LAS int*)(F.lds + EX_PREF); LAS int* off = (LAS int*)(F.lds + EX_OFF);
    expert_prefix(F, pref, off);
    __syncthreads();
    const int lane = F.lane;
    const int gw = F.vcu * NWAVES + F.wave, NGW = F.G * NWAVES;
    f32x4 gn[4];
#pragma unroll
    for (int j = 0; j < 4; ++j) gn[j] = *(const f32x4*)(F.norm_final_g + 4 * lane + 256 * j);
    for (int t = gw; t < M; t += NGW) {
        const int b = t >> 13;
        f32x4 y[4];
#pragma unroll
        for (int j = 0; j < 4; ++j) y[j] = (f32x4){0.f, 0.f, 0.f, 0.f};
#if !MK_SKIP_ROUTED
        int myslot = 0;
        if (lane < 8) myslot = off[EIDX[t * 8 + lane]] + POS[t * 8 + lane];
#pragma unroll
        for (int k = 0; k < 8; ++k) { const int slot = __shfl(myslot, k); const v2u* yp = (const v2u*)(YP + (size_t)slot * D) + lane;
#pragma unroll
            for (int j = 0; j < 4; ++j) { const v2u v = yp[64 * j]; y[j] += (f32x4){bflo(v.x), bfhi(v.x), bflo(v.y), bfhi(v.y)}; } }
#endif
        const f32x4* xr = (const f32x4*)(X1 + (size_t)t * D) + lane; f32x4 v[4]; float ss = 0.f;
#pragma unroll
        for (int j = 0; j < 4; ++j) { const f32x4 g2 = *(const f32x4*)(mod + b * NMOD + 5 * D + 4 * lane + 256 * j); v[j] = xr[64 * j] + g2 * y[j];
            ss += (v[j].x * v[j].x + v[j].y * v[j].y) + (v[j].z * v[j].z + v[j].w * v[j].w); }
        const float rstd = 1.0f / sqrtf(wave_sum(ss) * (1.0f / D) + EPS);
        f32x4* op = (f32x4*)(F.out + (size_t)t * D) + lane;
#pragma unroll
        for (int j = 0; j < 4; ++j) op[64 * j] = v[j] * rstd * gn[j];
    }
}

struct Args { const void* in[22]; float* out; unsigned char* ws; int ph_lo, ph_hi, li, abl; };
__global__ void __launch_bounds__(NT, 2) mk_fwd(Args args) {
    extern __shared__ __attribute__((aligned(16))) unsigned char lds[];
    Frame F;
    F.lds = (LAS unsigned char*)lds; F.ldsb = (unsigned)(size_t)F.lds;
    F.MISC = (volatile LAS unsigned*)(F.lds + MISC_OFF);
    F.tid = threadIdx.x; F.lane = F.tid & 63; F.wave = __builtin_amdgcn_readfirstlane(F.tid >> 6);
    F.G = gridDim.x; { const int bx = blockIdx.x; F.vcu = (F.G % 8 == 0) ? (bx % 8) * (F.G / 8) + bx / 8 : bx; }
    F.abl = MK_ABL_RT ? args.abl : 0;
    unsigned char* ws = args.ws; F.ws = ws; F.ctl = (gu32*)(ws + WS_CTL); F.out = args.out;
    F.x = (const float*)args.in[0]; F.c = (const float*)args.in[1]; F.pos = (const int*)args.in[2]; F.w_ada = (const float*)args.in[3]; F.b_ada = (const float*)args.in[4];
    F.norm_mix_g = (const float*)args.in[5]; F.w_in = (const float*)args.in[6]; F.ret_norm_g = (const float*)args.in[7]; F.conv_w = (const float*)args.in[8];
    F.w_br_ret = (const float*)args.in[9]; F.w_br_conv = (const float*)args.in[10]; F.w_out = (const float*)args.in[11]; F.norm_ffn_g = (const float*)args.in[12];
    F.w_router = (const float*)args.in[13]; F.router_bias = (const float*)args.in[14]; F.w_eg = (const float*)args.in[15]; F.w_eu = (const float*)args.in[16]; F.w_ed = (const float*)args.in[17];
    F.w_sg = (const float*)args.in[18]; F.w_su = (const float*)args.in[19]; F.w_sd = (const float*)args.in[20]; F.norm_final_g = (const float*)args.in[21];
    for (int u = F.tid; u < (LDS_BYTES - LDSCTL_OFF) / 4; u += NT) ((LAS unsigned*)(F.lds + LDSCTL_OFF))[u] = 0u;
    __syncthreads();
    XcdBarrier bar; bar.bar = (unsigned*)(F.ctl + CW_BAR) + args.li * XCD_BAR_WORDS; bar.x = 0; bar.st = nullptr;
    if (!MK_PER_PHASE) bar = xcd_barrier_post((unsigned*)(F.ctl + CW_BAR) + args.li * XCD_BAR_WORDS, F.MISC + 8);
    const int lo = args.ph_lo, hi = args.ph_hi;
#ifndef MK_PHASE_MASK
#define MK_PHASE_MASK 0x1fff
#endif
#define IN(k) (((MK_PHASE_MASK >> (k)) & 1) && lo <= (k) && (k) < hi)
#ifndef MK_BAR_REP
#define MK_BAR_REP 1
#endif
#define SEAM(k) do { if (IN(k) && IN((k) + 1)) { for (int br_ = 0; br_ < MK_BAR_REP; ++br_) xcd_barrier(bar); } } while (0)
#ifndef MK_DOUBLE_MASK
#define MK_DOUBLE_MASK 0
#endif
#define REP(k) for (int rep_ = 0; rep_ < (((MK_DOUBLE_MASK >> (k)) & 1) ? 2 : 1); ++rep_, (((MK_DOUBLE_MASK >> (k)) & 1) && rep_ == 1 ? xcd_barrier(bar) : (void)0))
    bf16* HB = (bf16*)(ws + WS_HB); bf16* PROJ = (bf16*)(ws + WS_PROJ); const float* mod = (const float*)(ws + WS_MOD);

    if (IN(0)) { p0_prologue(F); } SEAM(0);
    if (IN(1)) { norm_mod_rows(F, F.x, F.norm_mix_g, 1 * D, 0 * D, HB); } SEAM(1);
    if (IN(2)) {
        pg8::Gemm g{HB, (const bf16*)(ws + WS_WIN), M, NIN, D}; pg8::StaticOrder S; S.init(M, NIN, F.G, (int)blockIdx.x);
        pg8::EpiBf16 E{PROJ, NIN};
        pg8::gemm_phase<pg8::EpiBf16, pg8::StaticOrder, true, true>(F.lds, g, S, E);
    } SEAM(2);
    if (IN(3)) { p3_kv_conv(F); } SEAM(3);
    if (IN(4)) { p4_scan(F); } SEAM(4);
    if (IN(5)) { p5_retention(F); } SEAM(5);
    if (IN(6)) {
        { pg8::Gemm g{(const bf16*)(ws + WS_RETG), (const bf16*)(ws + WS_WBR), M, D, D}; pg8::StaticOrder S; S.init(M, D, F.G, (int)blockIdx.x);
          pg8::EpiGateBf16 E{(bf16*)(ws + WS_MIXP), D, PROJ + OFF_MR, NIN};
          pg8::gemm_phase<pg8::EpiGateBf16, pg8::StaticOrder, true, true>(F.lds, g, S, E); }
        asm volatile("s_waitcnt vmcnt(0)" ::: "memory"); __syncthreads();
        { pg8::Gemm g{(const bf16*)(ws + WS_CONVG), (const bf16*)(ws + WS_WBC), M, D, D}; pg8::StaticOrder S; S.init(M, D, F.G, (int)blockIdx.x);
          pg8::EpiMixBf16 E{(bf16*)(ws + WS_MIX), D, (const bf16*)(ws + WS_MIXP), PROJ + OFF_MC, NIN};
          pg8::gemm_phase<pg8::EpiMixBf16, pg8::StaticOrder, true, true>(F.lds, g, S, E); }
    } SEAM(6);
    if (IN(7)) {
#if MK_SKIP_MIXER
        for (size_t i = (size_t)F.vcu * NT + F.tid; i < (size_t)M * D / 4; i += (size_t)F.G * NT) ((f32x4*)(ws + WS_X1))[i] = ((const f32x4*)F.x)[i];
#else
        pg8::Gemm g{(const bf16*)(ws + WS_MIX), (const bf16*)(ws + WS_WO), M, D, D}; pg8::StaticOrder S; S.init(M, D, F.G, (int)blockIdx.x);
        pg8::EpiResid E{(float*)(ws + WS_X1), F.x, D, mod + 2 * D, NMOD, 13};
        pg8::gemm_phase<pg8::EpiResid, pg8::StaticOrder, true, true>(F.lds, g, S, E);
#endif
    } SEAM(7);
    if (IN(8)) { norm_mod_rows(F, (const float*)(ws + WS_X1), F.norm_ffn_g, 4 * D, 3 * D, HB); } SEAM(8);
    if (IN(9)) {
        { pg8::Gemm g{HB, (const bf16*)(ws + WS_WR), M, NE, D}; pg8::StaticOrder S; S.init(M, NE, F.G, (int)blockIdx.x);
          pg8::EpiF32 E{(float*)(ws + WS_LOGITS), NE};
          pg8::gemm_phase<pg8::EpiF32, pg8::StaticOrder, true, true>(F.lds, g, S, E); }
        { pg8::Gemm g{HB, (const bf16*)(ws + WS_WSGU), M, 2 * EH, D}; pg8::StaticOrder S; S.init(M, 2 * EH, F.G, (int)((blockIdx.x + F.G / 2) % F.G));
          pg8::EpiSwiglu E{(bf16*)(ws + WS_SHG), EH};
          pg8::gemm_phase<pg8::EpiSwiglu, pg8::StaticOrder, true, true>(F.lds, g, S, E); }
    } SEAM(9);
    if (IN(10)) {
#if !MK_SKIP_SHARED
        for (int rp_ = 0; rp_ < MK_P10_GEMM_REP; ++rp_)
        { pg8::Gemm g{(const bf16*)(ws + WS_SHG), (const bf16*)(ws + WS_WSD), M, D, EH}; pg8::StaticOrder S; S.init(M, D, F.G, (int)blockIdx.x);
          pg8::EpiResid E{(float*)(ws + WS_MIXP), (const float*)(ws + WS_X1), D, mod + 5 * D, NMOD, 13};
          pg8::gemm_phase<pg8::EpiResid, pg8::StaticOrder, true, true>(F.lds, g, S, E); }
#endif
        for (int rr_ = 0; rr_ < MK_ROUTE_DRY_REP; ++rr_) route_tokens<true>(F);
        route_tokens<false>(F);
    } SEAM(10);
    if (IN(11)) {
#if !MK_SKIP_ROUTED
#if MK_EXP_V == 4
        p11_experts_v6(F);
#elif MK_EXP_V == 3
        p11_experts_v5(F);
#elif MK_EXP_V == 1
#if MK_ABL_RT
        if (F.abl) p11_experts_k64<MK_ABL_PROBE>(F); else
#endif
        p11_experts_k64<0>(F);
#else
#if MK_ABL_RT
        if (F.abl) p11_experts<MK_ABL_PROBE>(F); else
#endif
        p11_experts<0>(F);
#endif
#endif
    } SEAM(11);
    if (IN(12)) { int t_ = (int)threadIdx.x; asm volatile("" : "+v"(t_)); F.tid = t_; F.lane = t_ & 63;
        p12_final(F); }
#undef IN
#undef SEAM
}

extern "C" void kernel_launch(void* const* d_in, const int* in_sizes, int n_in, void* d_out, int out_size, void* d_ws, size_t ws_size, hipStream_t stream) {
    static int grid = 0;
    if (grid == 0) {
        if (n_in != 22 || in_sizes[0] != M * D || out_size != M * D || ws_size < WS_END) { fprintf(stderr, "kernel_launch: unexpected shapes (n_in %d, in0 %d, out %d, ws %zu, need %zu); nothing launched\n", n_in, n_in > 0 ? in_sizes[0] : -1, out_size, ws_size, (size_t)WS_END); grid = -1; return; }
        int dev = 0, cus = 0, per_cu = 0;
        if (hipGetDevice(&dev) != hipSuccess || hipDeviceGetAttribute(&cus, hipDeviceAttributeMultiprocessorCount, dev) != hipSuccess) { fprintf(stderr, "kernel_launch: device query failed\n"); grid = -1; return; }
        if (hipFuncSetAttribute((const void*)mk_fwd, hipFuncAttributeMaxDynamicSharedMemorySize, LDS_BYTES) != hipSuccess) { fprintf(stderr, "kernel_launch: hipFuncSetAttribute failed\n"); grid = -1; return; }
        if (hipOccupancyMaxActiveBlocksPerMultiprocessor(&per_cu, (const void*)mk_fwd, NT, LDS_BYTES) != hipSuccess || per_cu < 1) { fprintf(stderr, "kernel_launch: occupancy query reports %d workgroups per CU\n", per_cu); (void)hipGetLastError(); grid = -1; return; }
        grid = cus;
    }
    if (grid < 0) return;
    if (hipMemsetAsync((char*)d_ws + WS_CTL, 0, CTL_ZERO_BYTES, stream) != hipSuccess) { fprintf(stderr, "kernel_launch: hipMemsetAsync failed\n"); return; }
    Args a{};
    for (int i = 0; i < 22; ++i) a.in[i] = d_in[i];
    a.out = (float*)d_out; a.ws = (unsigned char*)d_ws;
#if MK_PER_PHASE
    for (int p = 0; p < NPHASE; ++p) { a.ph_lo = p; a.ph_hi = p + 1; hipLaunchKernelGGL(mk_fwd, dim3(grid), dim3(NT), LDS_BYTES, stream, a); }
#elif defined(MK_ABL_PROBE)
    a.ph_lo = 0; a.ph_hi = 12; a.li = 0; a.abl = 1; hipLaunchKernelGGL(mk_fwd, dim3(grid), dim3(NT), LDS_BYTES, stream, a);
    a.ph_lo = 11; a.ph_hi = NPHASE; a.li = 1; a.abl = 0; hipLaunchKernelGGL(mk_fwd, dim3(grid), dim3(NT), LDS_BYTES, stream, a);
#elif defined(MK_PROBE_LO)
    a.ph_lo = 0; a.ph_hi = MK_PROBE_HI; a.li = 0; hipLaunchKernelGGL(mk_fwd, dim3(grid), dim3(NT), LDS_BYTES, stream, a);
    a.ph_lo = MK_PROBE_LO; a.ph_hi = NPHASE; a.li = 1; hipLaunchKernelGGL(mk_fwd, dim3(grid), dim3(NT), LDS_BYTES, stream, a);
#else
    a.ph_lo = 0; a.ph_hi = NPHASE;
    hipLaunchKernelGGL(mk_fwd, dim3(grid), dim3(NT), LDS_BYTES, stream, a);
#endif
    const hipError_t le = hipPeekAtLastError();
    if (le != hipSuccess) fprintf(stderr, "kernel_launch: launch failed: %s\n", hipGetErrorName(le));
}
```

```cpp
#include <hip/hip_runtime.h>
#include <cstdio>
#include <cstdint>
#define MK_EXP_V 2
#define MK_SPREAD 1
namespace pg8 {
#define PG8_LAS __attribute__((address_space(3)))
typedef unsigned short bf16_t;
typedef short bf16x8 __attribute__((ext_vector_type(8)));
typedef float f32x4 __attribute__((ext_vector_type(4)));
typedef unsigned u32x4 __attribute__((ext_vector_type(4)));
constexpr int BM = 256, BK = 64, HALF = 128, HTB = HALF * BK * 2  , STAGE_BYTES = 8 * HTB, NXCD = 8, WGM = 8;

__host__ __device__ __forceinline__ int lds_byte(int r, int c) { const int st = (r >> 4) * 2 + (c >> 5), rr = r & 15, cc = c & 31, ob = rr * 64 + cc * 2; return st * 1024 + (ob ^ (((ob >> 9) & 1) << 5)); }
__host__ __device__ __forceinline__ void stage_rc(int b, int& R, int& C) { const int st = b / 1024, sb = b % 1024, swz = sb ^ (((sb >> 9) & 1) << 5); R = (st >> 1) * 16 + swz / 64; C = (st & 1) * 32 + (swz % 64) / 2; }
__host__ __device__ __forceinline__ int perm32(int rho) { const int n = rho >> 4, i = rho & 15; return 8 * (i >> 2) + 4 * n + (i & 3); }

struct Unit { int pm, pn; };
struct Gemm { const bf16_t* A; const bf16_t* Bt; int M, N, K; };

struct StaticOrder {
    int nM, nN, nwg, G, c;
    __host__ __device__ void init(int M, int N, int G_, int c_) { nM = M / BM; nN = N / BM; nwg = nM * nN; G = G_; c = c_; }
    __host__ __device__ bool next(int i, Unit& u) const {
        const long L = (long)i * G + c; if (L >= nwg) return false;
        int wgid = (int)L; { const int q = nwg / NXCD, r = nwg % NXCD, xcd = wgid % NXCD, off = wgid / NXCD; wgid = (xcd < r ? xcd * (q + 1) : r * (q + 1) + (xcd - r) * q) + off; }
        const int nig = WGM * nN, gid = wgid / nig, fm = gid * WGM, gsz = (nM - fm) < WGM ? (nM - fm) : WGM;
        u.pm = fm + ((wgid % nig) % gsz); u.pn = (wgid % nig) / gsz; return true;
    }
    __device__ __forceinline__ void a_ready(const Unit&) const {}
    __device__ __forceinline__ void done(const Unit&) const {}
};

__device__ __forceinline__ unsigned cvt_pk_bf16(float lo, float hi) { unsigned r; asm volatile("v_cvt_pk_bf16_f32 %0, %1, %2" : "=v"(r) : "v"(lo), "v"(hi)); return r; }
typedef float f32x2 __attribute__((ext_vector_type(2)));
typedef unsigned u32x2 __attribute__((ext_vector_type(2)));
__device__ __forceinline__ float bf_lo(unsigned w) { return __uint_as_float(w << 16); }
__device__ __forceinline__ float bf_hi(unsigned w) { return __uint_as_float(w & 0xffff0000u); }
__device__ __forceinline__ float sigm(float x) { return 1.0f / (1.0f + __expf(-x)); }
__device__ __forceinline__ float silu_f(float x) { return x / (1.0f + __expf(-x)); }

struct EpiBf16 {
    static constexpr bool PERM = true, AFTER_DRAIN = false;
    bf16_t* O; int ldc;
    __device__ __forceinline__ void operator()(const f32x4 (&acc)[2][2][4][2], const Unit& u, int wr, int wc, int fr, int fq) const {
        const int row0 = u.pm * BM + wr * 64 + fr; const int col0 = u.pn * BM + wc * 32 + 8 * fq;
#pragma unroll
        for (int ai = 0; ai < 2; ++ai)
#pragma unroll
            for (int m = 0; m < 4; ++m) { bf16_t* rowp = O + (size_t)(row0 + ai * HALF + m * 16) * ldc + col0;
#pragma unroll
                for (int bj = 0; bj < 2; ++bj) { const f32x4 v0 = acc[ai][bj][m][0], v1 = acc[ai][bj][m][1];
                    u32x4 w; w.x = cvt_pk_bf16(v0[0], v0[1]); w.y = cvt_pk_bf16(v0[2], v0[3]); w.z = cvt_pk_bf16(v1[0], v1[1]); w.w = cvt_pk_bf16(v1[2], v1[3]);
                    *(u32x4*)(rowp + bj * HALF) = w; } }
    }
};
struct EpiF32 {
    static constexpr bool PERM = false, AFTER_DRAIN = false;
    float* C; int ldc;
    __device__ __forceinline__ void operator()(const f32x4 (&acc)[2][2][4][2], const Unit& u, int wr, int wc, int fr, int fq) const {
        const int row0 = u.pm * BM + wr * 64 + fr, col0 = u.pn * BM + wc * 32 + 4 * fq;
#pragma unroll
        for (int ai = 0; ai < 2; ++ai)
#pragma unroll
            for (int m = 0; m < 4; ++m) { float* rowp = C + (size_t)(row0 + ai * HALF + m * 16) * ldc + col0;
#pragma unroll
                for (int bj = 0; bj < 2; ++bj)
#pragma unroll
                    for (int n = 0; n < 2; ++n) *(f32x4*)(rowp + bj * HALF + n * 16) = acc[ai][bj][m][n]; }
    }
};
struct EpiGateBf16 {
    static constexpr bool PERM = true, AFTER_DRAIN = false;
    bf16_t* O; int ldc; const bf16_t* gate; int ldg;
    __device__ __forceinline__ void operator()(const f32x4 (&acc)[2][2][4][2], const Unit& u, int wr, int wc, int fr, int fq) const {
        const int row0 = u.pm * BM + wr * 64 + fr; const int col0 = u.pn * BM + wc * 32 + 8 * fq;
#pragma unroll
        for (int ai = 0; ai < 2; ++ai)
#pragma unroll
            for (int m = 0; m < 4; ++m) { const size_t r = (size_t)(row0 + ai * HALF + m * 16); bf16_t* rowp = O + r * ldc + col0; const bf16_t* gp = gate + r * ldg + col0;
#pragma unroll
                for (int bj = 0; bj < 2; ++bj) { const f32x4 v0 = acc[ai][bj][m][0], v1 = acc[ai][bj][m][1]; const u32x4 g = *(const u32x4*)(gp + bj * HALF);
                    u32x4 w; w.x = cvt_pk_bf16(sigm(bf_lo(g.x)) * v0[0], sigm(bf_hi(g.x)) * v0[1]); w.y = cvt_pk_bf16(sigm(bf_lo(g.y)) * v0[2], sigm(bf_hi(g.y)) * v0[3]);
                    w.z = cvt_pk_bf16(sigm(bf_lo(g.z)) * v1[0], sigm(bf_hi(g.z)) * v1[1]); w.w = cvt_pk_bf16(sigm(bf_lo(g.w)) * v1[2], sigm(bf_hi(g.w)) * v1[3]);
                    *(u32x4*)(rowp + bj * HALF) = w; } }
    }
};
struct EpiMixBf16 {
    static constexpr bool PERM = true, AFTER_DRAIN = false;
    bf16_t* O; int ldc; const bf16_t* P; const bf16_t* gate; int ldg;
    __device__ __forceinline__ void operator()(const f32x4 (&acc)[2][2][4][2], const Unit& u, int wr, int wc, int fr, int fq) const {
        const int row0 = u.pm * BM + wr * 64 + fr; const int col0 = u.pn * BM + wc * 32 + 8 * fq;
#pragma unroll
        for (int ai = 0; ai < 2; ++ai)
#pragma unroll
            for (int m = 0; m < 4; ++m) { const size_t r = (size_t)(row0 + ai * HALF + m * 16); bf16_t* rowp = O + r * ldc + col0; const bf16_t* pp = P + r * ldc + col0; const bf16_t* gp = gate + r * ldg + col0;
#pragma unroll
                for (int bj = 0; bj < 2; ++bj) { const f32x4 v0 = acc[ai][bj][m][0], v1 = acc[ai][bj][m][1];
                    const u32x4 g = *(const u32x4*)(gp + bj * HALF); const u32x4 pq = *(const u32x4*)(pp + bj * HALF); const f32x4 p0 = {bf_lo(pq.x), bf_hi(pq.x), bf_lo(pq.y), bf_hi(pq.y)}, p1 = {bf_lo(pq.z), bf_hi(pq.z), bf_lo(pq.w), bf_hi(pq.w)};
                    const float o0 = p0[0] + sigm(bf_lo(g.x)) * v0[0], o1 = p0[1] + sigm(bf_hi(g.x)) * v0[1], o2 = p0[2] + sigm(bf_lo(g.y)) * v0[2], o3 = p0[3] + sigm(bf_hi(g.y)) * v0[3];
                    const float o4 = p1[0] + sigm(bf_lo(g.z)) * v1[0], o5 = p1[1] + sigm(bf_hi(g.z)) * v1[1], o6 = p1[2] + sigm(bf_lo(g.w)) * v1[2], o7 = p1[3] + sigm(bf_hi(g.w)) * v1[3];
                    u32x4 w; w.x = cvt_pk_bf16(o0, o1); w.y = cvt_pk_bf16(o2, o3); w.z = cvt_pk_bf16(o4, o5); w.w = cvt_pk_bf16(o6, o7);
                    *(u32x4*)(rowp + bj * HALF) = w; } }
    }
};
struct EpiResid {
    static constexpr bool PERM = false, AFTER_DRAIN = false;
    float* C; const float* base; int ldc; const float* gvec; int gstride; int rows_per_b_shift;
    __device__ __forceinline__ void operator()(const f32x4 (&acc)[2][2][4][2], const Unit& u, int wr, int wc, int fr, int fq) const {
        const int row0 = u.pm * BM + wr * 64 + fr, col0 = u.pn * BM + wc * 32 + 4 * fq;
        const float* gp = gvec + (size_t)((u.pm * BM) >> rows_per_b_shift) * gstride + col0;
        f32x4 gv[2][2];
#pragma unroll
        for (int bj = 0; bj < 2; ++bj)
#pragma unroll
            for (int n = 0; n < 2; ++n) gv[bj][n] = *(const f32x4*)(gp + bj * HALF + n * 16);
#pragma unroll
        for (int ai = 0; ai < 2; ++ai)
#pragma unroll
            for (int m = 0; m < 4; ++m) { const size_t off = (size_t)(row0 + ai * HALF + m * 16) * ldc + col0;
#pragma unroll
                for (int bj = 0; bj < 2; ++bj)
#pragma unroll
                    for (int n = 0; n < 2; ++n) { const f32x4 b = *(const f32x4*)(base + off + bj * HALF + n * 16);
                        *(f32x4*)(C + off + bj * HALF + n * 16) = b + gv[bj][n] * acc[ai][bj][m][n]; } }
    }
};
struct EpiSwiglu {
    static constexpr bool PERM = true, AFTER_DRAIN = false;
    bf16_t* O; int ldo;
    __device__ __forceinline__ void operator()(const f32x4 (&acc)[2][2][4][2], const Unit& u, int wr, int wc, int fr, int fq) const {
        const int row0 = u.pm * BM + wr * 64 + fr; const int col0 = u.pn * BM + wc * 32 + 8 * fq;
#pragma unroll
        for (int ai = 0; ai < 2; ++ai)
#pragma unroll
            for (int m = 0; m < 4; ++m) { bf16_t* rowp = O + (size_t)(row0 + ai * HALF + m * 16) * ldo + (col0 >> 1);
#pragma unroll
                for (int bj = 0; bj < 2; ++bj) { const f32x4 v0 = acc[ai][bj][m][0], v1 = acc[ai][bj][m][1];
                    const float g0 = silu_f(v0[0]) * v0[1], g1 = silu_f(v0[2]) * v0[3], g2 = silu_f(v1[0]) * v1[1], g3 = silu_f(v1[2]) * v1[3];
                    u32x2 w; w.x = cvt_pk_bf16(g0, g1); w.y = cvt_pk_bf16(g2, g3);
                    *(u32x2*)(rowp + bj * (HALF / 2)) = w; } }
    }
};
template <class Epi, class Sched, bool ALIGN_EPI = false, bool SP2 = false>
__device__ __forceinline__ void gemm_phase(PG8_LAS unsigned char* lds, const Gemm g, const Sched& S, const Epi& E) {
    const int tid = threadIdx.x, wid = __builtin_amdgcn_readfirstlane(tid >> 6), lane = tid & 63, wr = wid >> 2, wc = wid & 3, fr = lane & 15, fq = lane >> 4;
    const int K = g.K, nt = K / BK;
    unsigned voffA[2], voffB[2];
#pragma unroll
    for (int i = 0; i < 2; ++i) { int R, C; stage_rc(tid * 16 + i * 8192, R, C); const int Rb = Epi::PERM ? ((R & ~31) + perm32(R & 31)) : R;
        voffA[i] = (unsigned)(R * K + C) * 2u; voffB[i] = (unsigned)(Rb * K + C) * 2u; }
    const size_t kstep = (size_t)(BK * 2);
    const size_t hstep = (size_t)HALF * K * 2;
    const size_t tstep = 2 * hstep;
    const unsigned ldsw = (unsigned)wid * 1024u;
    const int aoff = lds_byte(wr * 64 + fr, fq * 8), boff = lds_byte(wc * 32 + fr, fq * 8);
#define PG8_SA(b, h) (((b) * 2 + (h)) * HTB)
#define PG8_SB(b, h) ((4 + (b) * 2 + (h)) * HTB)
#define PG8_STAGE(bufoff, gbase, voff) do { _Pragma("unroll") for (int _i = 0; _i < 2; ++_i) \
        __builtin_amdgcn_global_load_lds((const unsigned*)((const char*)(gbase) + (voff)[_i]), (PG8_LAS unsigned*)(lds + (bufoff) + ldsw + _i * 8192), 16, 0, 0); } while (0)
#define PG8_LDA(dst, b, h) do { _Pragma("unroll") for (int m = 0; m < 4; ++m) _Pragma("unroll") for (int k = 0; k < 2; ++k) dst[m][k] = *(const PG8_LAS bf16x8*)(lds + PG8_SA(b, h) + aoff + m * 2048 + k * 1024); } while (0)
#define PG8_LDB(dst, b, h) do { _Pragma("unroll") for (int n = 0; n < 2; ++n) _Pragma("unroll") for (int k = 0; k < 2; ++k) dst[n][k] = *(const PG8_LAS bf16x8*)(lds + PG8_SB(b, h) + boff + n * 2048 + k * 1024); } while (0)
#define PG8_MMA(ai, bj, At, Bt) do { __builtin_amdgcn_s_setprio(1); _Pragma("unroll") for (int m = 0; m < 4; ++m) _Pragma("unroll") for (int n = 0; n < 2; ++n) _Pragma("unroll") for (int k = 0; k < 2; ++k) \
        acc[ai][bj][m][n] = __builtin_amdgcn_mfma_f32_16x16x32_bf16(Bt[n][k], At[m][k], acc[ai][bj][m][n], 0, 0, 0); __builtin_amdgcn_s_setprio(0); } while (0)
#define PG8_WAIT_V(n) asm volatile("s_waitcnt vmcnt(" #n ")" ::: "memory")
#define PG8_WAIT_L(n) asm volatile("s_waitcnt lgkmcnt(" #n ")" ::: "memory")
#define PG8_BAR __builtin_amdgcn_s_barrier()
#define PG8_SCHED __builtin_amdgcn_sched_barrier(0)
    Unit cur, nxt; int ui = 0;
    if (!S.next(0, cur)) return;
    f32x4 acc[2][2][4][2];
#pragma unroll
    for (int a = 0; a < 2; ++a)
#pragma unroll
        for (int b = 0; b < 2; ++b)
#pragma unroll
            for (int m = 0; m < 4; ++m)
#pragma unroll
                for (int n = 0; n < 2; ++n) acc[a][b][m][n] = (f32x4){0.f, 0.f, 0.f, 0.f};
    bf16x8 At[4][2], B0[2][2], B1[2][2];
    const char* cA = (const char*)g.A + (size_t)cur.pm * tstep; const char* cB = (const char*)g.Bt + (size_t)cur.pn * tstep;
    S.a_ready(cur);
    if constexpr (SP2) {
        PG8_STAGE(PG8_SB(0, 0), cB, voffB); PG8_STAGE(PG8_SB(0, 1), cB + hstep, voffB); PG8_STAGE(PG8_SA(0, 0), cA, voffA); PG8_STAGE(PG8_SA(0, 1), cA + hstep, voffA);
        if (wr == 1) PG8_BAR;
        PG8_WAIT_V(2); PG8_BAR;
        PG8_STAGE(PG8_SB(1, 0), cB + kstep, voffB); PG8_STAGE(PG8_SA(1, 0), cA + kstep, voffA); PG8_STAGE(PG8_SB(1, 1), cB + hstep + kstep, voffB);
        PG8_WAIT_V(6); PG8_BAR;
    } else {
        PG8_STAGE(PG8_SB(0, 0), cB, voffB); PG8_STAGE(PG8_SA(0, 0), cA, voffA); PG8_STAGE(PG8_SB(0, 1), cB + hstep, voffB); PG8_STAGE(PG8_SA(0, 1), cA + hstep, voffA);
        if (wr == 1) PG8_BAR;
        PG8_WAIT_V(4); PG8_BAR;
        PG8_STAGE(PG8_SB(1, 0), cB + kstep, voffB); PG8_STAGE(PG8_SA(1, 0), cA + kstep, voffA); PG8_STAGE(PG8_SB(1, 1), cB + hstep + kstep, voffB);
        PG8_WAIT_V(6); PG8_BAR;
    }
    for (;;) {
        const bool has_next = S.next(ui + 1, nxt);
        const char* nA = has_next ? (const char*)g.A + (size_t)nxt.pm * tstep : cA; const char* nB = has_next ? (const char*)g.Bt + (size_t)nxt.pn * tstep : cB;
        for (int t = 0; t < nt; t += 2) {
            const bool last = (t == nt - 2);
            const char* a1 = cA + (size_t)(t + 1) * kstep;
            const char* a2 = last ? nA : cA + (size_t)(t + 2) * kstep; const char* b2 = last ? nB : cB + (size_t)(t + 2) * kstep;
            const char* a3 = a2 + kstep; const char* b3 = b2 + kstep;
            if (last && has_next) S.a_ready(nxt);
            if constexpr (SP2) {
            PG8_LDB(B0, 0, 0); PG8_LDB(B1, 0, 1); PG8_SCHED; PG8_LDA(At, 0, 0); PG8_STAGE(PG8_SA(1, 1), a1 + hstep, voffA);
            PG8_WAIT_V(8); PG8_WAIT_L(0); PG8_BAR; PG8_MMA(0, 0, At, B0); PG8_MMA(0, 1, At, B1); PG8_BAR; PG8_SCHED;
            PG8_LDA(At, 0, 1); PG8_STAGE(PG8_SB(0, 0), b2, voffB); PG8_STAGE(PG8_SB(0, 1), b2 + hstep, voffB); PG8_STAGE(PG8_SA(0, 0), a2, voffA);
            PG8_WAIT_V(8); PG8_WAIT_L(0); PG8_BAR; PG8_MMA(1, 0, At, B0); PG8_MMA(1, 1, At, B1); PG8_BAR; PG8_SCHED;
            PG8_LDB(B0, 1, 0); PG8_LDB(B1, 1, 1); PG8_SCHED; PG8_LDA(At, 1, 0); PG8_STAGE(PG8_SA(0, 1), a2 + hstep, voffA);
            PG8_WAIT_V(8); PG8_WAIT_L(0); PG8_BAR; PG8_MMA(0, 0, At, B0); PG8_MMA(0, 1, At, B1); PG8_BAR; PG8_SCHED;
            PG8_LDA(At, 1, 1); PG8_STAGE(PG8_SB(1, 0), b3, voffB); PG8_STAGE(PG8_SB(1, 1), b3 + hstep, voffB); PG8_STAGE(PG8_SA(1, 0), a3, voffA);
            PG8_WAIT_V(8); PG8_WAIT_L(0); PG8_BAR; PG8_MMA(1, 0, At, B0); PG8_MMA(1, 1, At, B1); PG8_BAR; PG8_SCHED;
            } else {
            PG8_LDB(B0, 0, 0); PG8_SCHED; PG8_LDA(At, 0, 0); PG8_STAGE(PG8_SA(1, 1), a1 + hstep, voffA);
            PG8_WAIT_L(8); PG8_BAR; PG8_WAIT_L(0); PG8_MMA(0, 0, At, B0); PG8_BAR; PG8_SCHED;
            PG8_LDB(B1, 0, 1); PG8_STAGE(PG8_SB(0, 0), b2, voffB);
            PG8_BAR; PG8_WAIT_L(0); PG8_MMA(0, 1, At, B1); PG8_BAR;
            PG8_LDA(At, 0, 1); PG8_STAGE(PG8_SA(0, 0), a2, voffA);
            PG8_BAR; PG8_WAIT_L(0); PG8_MMA(1, 0, At, B0); PG8_BAR; PG8_SCHED;
            PG8_STAGE(PG8_SB(0, 1), b2 + hstep, voffB);
            PG8_WAIT_V(6); PG8_BAR; PG8_MMA(1, 1, At, B1); PG8_BAR;
            PG8_LDB(B0, 1, 0); PG8_SCHED; PG8_LDA(At, 1, 0); PG8_STAGE(PG8_SA(0, 1), a2 + hstep, voffA);
            PG8_WAIT_L(8); PG8_BAR; PG8_WAIT_L(0); PG8_MMA(0, 0, At, B0); PG8_BAR; PG8_SCHED;
            PG8_LDB(B1, 1, 1); PG8_STAGE(PG8_SB(1, 0), b3, voffB);
            PG8_BAR; PG8_WAIT_L(0); PG8_MMA(0, 1, At, B1); PG8_BAR;
            PG8_LDA(At, 1, 1); PG8_STAGE(PG8_SA(1, 0), a3, voffA);
            PG8_BAR; PG8_WAIT_L(0); PG8_MMA(1, 0, At, B0); PG8_BAR; PG8_SCHED;
            PG8_STAGE(PG8_SB(1, 1), b3 + hstep, voffB);
            PG8_WAIT_V(6); PG8_BAR; PG8_MMA(1, 1, At, B1); PG8_BAR;
            }
        }
        if constexpr (ALIGN_EPI) { if (wr == 0) PG8_BAR; }
        if constexpr (!Epi::AFTER_DRAIN) { E(acc, cur, wr, wc, fr, fq); S.done(cur); }
        if (!has_next) break;
#pragma unroll
        for (int a = 0; a < 2; ++a)
#pragma unroll
            for (int b = 0; b < 2; ++b)
#pragma unroll
                for (int m = 0; m < 4; ++m)
#pragma unroll
                    for (int n = 0; n < 2; ++n) acc[a][b][m][n] = (f32x4){0.f, 0.f, 0.f, 0.f};
        cur = nxt; cA = nA; cB = nB; ++ui;
        if constexpr (ALIGN_EPI) { if (wr == 1) PG8_BAR; }
    }
    PG8_WAIT_V(0);
    if constexpr (!ALIGN_EPI) { if (wr == 0) PG8_BAR; }
    PG8_BAR;
    if constexpr (Epi::AFTER_DRAIN) { E.fused(acc, cur, wr, wc, fr, fq, lds, wid, lane); S.done(cur); }
#undef PG8_SA
#undef PG8_SB
#undef PG8_STAGE
#undef PG8_LDA
#undef PG8_LDB
#undef PG8_MMA
#undef PG8_WAIT_V
#undef PG8_WAIT_L
#undef PG8_BAR
#undef PG8_SCHED
}
}

constexpr int NWAVES = 8, NT = 512;
#ifndef MK_PER_PHASE
#define MK_PER_PHASE 0
#endif
#ifndef MK_EXP_V
#define MK_EXP_V 4
#endif
#ifndef MK_TIMER_PHASE
#define MK_TIMER_PHASE -1
#endif
#ifndef MK_ABL_RT
#define MK_ABL_RT 0
#endif
#ifndef MK_P10_GEMM_REP
#define MK_P10_GEMM_REP 1
#endif
#ifndef MK_GSYNC
#define MK_GSYNC 0
#endif
#ifndef MK_GSYNC_EVERY
#define MK_GSYNC_EVERY 16
#endif
#ifndef MK_GSTAG
#define MK_GSTAG 0
#endif
#ifndef MK_PFD
#define MK_PFD 0
#endif
#ifndef MK_ROUTE_DRY_REP
#define MK_ROUTE_DRY_REP 0
#endif
#ifndef MK_LATE_ISSUE
#define MK_LATE_ISSUE 0
#endif
#ifndef MK_SPREAD
#define MK_SPREAD 0
#endif
#ifndef MK_SKIP_MIXER
#define MK_SKIP_MIXER 0
#endif
#ifndef MK_SKIP_SHARED
#define MK_SKIP_SHARED 0
#endif
#ifndef MK_SKIP_ROUTED
#define MK_SKIP_ROUTED 0
#endif
constexpr int NPHASE = 13;
constexpr int BATCH = 2, SEQ = 8192, D = 1024, M = BATCH * SEQ, NIN = 8192, NMOD = 6144;
constexpr int OFF_Q = 0, OFF_K = 512, OFF_V = 1024, OFF_GR = 2048, OFF_U = 3072, OFF_GC = 4096, OFF_GB = 5120, OFF_MR = 6144, OFF_MC = 7168;
constexpr int NE = 256, TOPK = 8, EH = 256, CAP = 16384, NCH = 64, CH = 128, NH = 4, DK = 128, DV = 256;
constexpr float EPS = 1e-6f;

constexpr size_t MiB = (size_t)1 << 20;
constexpr size_t WS_CTL = 0, CTL_ZERO_BYTES = 1 * MiB;
constexpr size_t WS_MOD = 1 * MiB;
constexpr size_t WS_ROPE = 2 * MiB;
constexpr size_t WS_WR = 10 * MiB;
constexpr size_t WS_WSGU = 11 * MiB;
constexpr size_t WS_WSD = 12 * MiB;
constexpr size_t WS_WBR = 13 * MiB, WS_WBC = 15 * MiB, WS_WO = 17 * MiB;
constexpr size_t WS_WIN = 20 * MiB;
constexpr size_t WS_HB = 36 * MiB;
constexpr size_t WS_PROJ = 68 * MiB;
constexpr size_t WS_KV = 324 * MiB;
constexpr size_t WS_SP = 388 * MiB;
constexpr size_t WS_RETG = 420 * MiB;
constexpr size_t WS_CONVG = 452 * MiB;
constexpr size_t WS_MIXP = 484 * MiB;
constexpr size_t WS_MIX = 548 * MiB;
constexpr size_t WS_X1 = 580 * MiB;
constexpr size_t WS_LOGITS = 644 * MiB;
constexpr size_t WS_SHG = 660 * MiB;
constexpr size_t WS_EIDX = 668 * MiB, WS_POS = 669 * MiB;
constexpr size_t WS_LTOK = 670 * MiB, WS_LW = 686 * MiB;
constexpr size_t WS_YP = 702 * MiB;
constexpr size_t WS_END = 958 * MiB;
constexpr int CW_TMO = 0, CW_CODE = 1, CW_BAR = 4096, CW_CNT = 16384, CW_GS = 131072;

constexpr int LDSCTL_OFF = 143360, MISC_OFF = LDSCTL_OFF + 320, LDS_BYTES = 147456;

#define GAS __attribute__((address_space(1)))
#define LAS __attribute__((address_space(3)))
typedef unsigned short bf16;
typedef unsigned v4u __attribute__((ext_vector_type(4)));
typedef unsigned v2u __attribute__((ext_vector_type(2)));
typedef float f32x4 __attribute__((ext_vector_type(4)));
typedef float f32x2 __attribute__((ext_vector_type(2)));
typedef short bf16x8 __attribute__((ext_vector_type(8)));
typedef short s16x4 __attribute__((ext_vector_type(4)));
typedef GAS unsigned gu32;
#define RLX_AGENT __ATOMIC_RELAXED, __HIP_MEMORY_SCOPE_AGENT
__device__ __forceinline__ unsigned f2bf(float f) { unsigned u = __builtin_bit_cast(unsigned, f); return (u + 0x7fffu + ((u >> 16) & 1u)) >> 16; }
__device__ __forceinline__ unsigned pk2(float lo, float hi) { unsigned r; asm volatile("v_cvt_pk_bf16_f32 %0, %1, %2" : "=v"(r) : "v"(lo), "v"(hi)); return r; }
__device__ __forceinline__ float bflo(unsigned w) { return __uint_as_float(w << 16); }
__device__ __forceinline__ float bfhi(unsigned w) { return __uint_as_float(w & 0xffff0000u); }
__device__ __forceinline__ float sigmoidf_(float x) { return 1.0f / (1.0f + __expf(-x)); }
__device__ __forceinline__ float siluf_(float x) { return x / (1.0f + __expf(-x)); }

#define XB_TMO      128
#define XB_XCNT(j)  (256  + 64 * (j))
#define XB_XSUB(j)  (1280 + 64 * (j))
#define XB_XGEN(j)  (2304 + 64 * (j))
#define XB_TOP      3328
#define XB_TOPGEN   3392
#define XCD_BAR_WORDS 3456
#define XB_SPIN_CAP (1u << 18)

__device__ __forceinline__ unsigned xb_ld(unsigned* p)              { return __hip_atomic_load(p, __ATOMIC_RELAXED, __HIP_MEMORY_SCOPE_AGENT); }
__device__ __forceinline__ unsigned xb_add(unsigned* p, unsigned v) { return __hip_atomic_fetch_add(p, v, __ATOMIC_RELAXED, __HIP_MEMORY_SCOPE_AGENT); }
__device__ __forceinline__ unsigned xb_xcc_id() { return (unsigned)__builtin_amdgcn_s_getreg((3 << 11) | 20) & 0xFu; }
#define XB_SPIN(cond, bar) do { unsigned _sp = 0; while (cond) { __builtin_amdgcn_s_sleep(1); \
    if ((++_sp & 255u) == 0u) { if (xb_ld(&(bar)[XB_TMO])) break; if (_sp > XB_SPIN_CAP) { atomicAdd(&(bar)[XB_TMO], 1u); break; } } } } while (0)

struct XcdBarrier {
    unsigned* bar; unsigned x;
    volatile LAS unsigned* st;
};

__device__ __forceinline__ XcdBarrier xcd_barrier_post(unsigned* bar, volatile LAS unsigned* st) {
    XcdBarrier b; b.bar = bar; b.x = xb_xcc_id(); b.st = st;
    if (threadIdx.x == 0) (void)xb_add(&bar[XB_XCNT(b.x)], 1u);
    return b;
}
__device__ __forceinline__ void xcd_barrier_complete(unsigned* bar, unsigned x, unsigned& nloc, unsigned& nx) {
    const unsigned G = gridDim.x * gridDim.y * gridDim.z;
    unsigned sum, cnt, mine, sp = 0u;
    for (;;) {
        sum = 0u; cnt = 0u; mine = 0u;
#pragma unroll
        for (unsigned j = 0; j < 16; ++j) { const unsigned c = xb_ld(&bar[XB_XCNT(j)]); sum += c; cnt += (c > 0u) ? 1u : 0u; mine = (j == x) ? c : mine; }
        if (sum == G) break;
        __builtin_amdgcn_s_sleep(1);
        if ((++sp & 255u) == 0u) { if (xb_ld(&bar[XB_TMO])) break; if (sp > XB_SPIN_CAP) { atomicAdd(&bar[XB_TMO], 1u); break; } }
    }
    nloc = mine > 0u ? mine : 1u; nx = cnt > 0u ? cnt : 1u;
}

__device__ __forceinline__ void xcd_barrier(const XcdBarrier& b) {
    asm volatile("s_waitcnt vmcnt(0)" ::: "memory");
    __syncthreads();
    if (threadIdx.x == 0) {
        unsigned* bar = b.bar;
        __builtin_amdgcn_s_waitcnt(0);
        unsigned nloc = b.st[0], nx = b.st[1];
        if (nloc == 0u) { xcd_barrier_complete(bar, b.x, nloc, nx); b.st[0] = nloc; b.st[1] = nx; }
        const unsigned old = xb_add(&bar[XB_XSUB(b.x)], 1u);
        const unsigned gen = old / nloc;
        if (old + 1u == (gen + 1u) * nloc) {
            __builtin_amdgcn_fence(__ATOMIC_RELEASE, "agent");
            asm volatile("s_waitcnt vmcnt(0)" ::: "memory");
            const unsigned og = xb_add(&bar[XB_TOP], 1u);
            const unsigned tg = og / nx;
            if (og + 1u == (tg + 1u) * nx) xb_add(&bar[XB_TOPGEN], 1u);
            else XB_SPIN(xb_ld(&bar[XB_TOPGEN]) == tg, bar);
            __builtin_amdgcn_fence(__ATOMIC_ACQUIRE, "agent");
            xb_add(&bar[XB_XGEN(b.x)], 1u);
            asm volatile("s_waitcnt vmcnt(0)" ::: "memory");
        } else {
            XB_SPIN(xb_ld(&bar[XB_XGEN(b.x)]) == gen, bar);
            __builtin_amdgcn_fence(__ATOMIC_ACQUIRE, "agent");
            asm volatile("s_waitcnt vmcnt(0)" ::: "memory");
        }
    }
    __syncthreads();
}

struct Frame {
    LAS unsigned char* lds; unsigned ldsb;
    volatile LAS unsigned* MISC; gu32* ctl;
    int tid, lane, wave, vcu, G, abl;
    const float *x, *c; const int* pos; const float *w_ada, *b_ada, *norm_mix_g, *w_in, *ret_norm_g, *conv_w, *w_br_ret, *w_br_conv, *w_out, *norm_ffn_g, *w_router, *router_bias,
        *w_eg, *w_eu, *w_ed, *w_sg, *w_su, *w_sd, *norm_final_g;
    float* out; unsigned char* ws;
};
__device__ __forceinline__ float wave_sum(float v) {
#pragma unroll
    for (int o = 1; o < 64; o <<= 1) v += __shfl_xor(v, o);
    return v;
}

__device__ __forceinline__ void p0_mod_task(Frame& F, int j) {
    const int cq = F.tid & 15, kq = F.tid >> 4;
    f32x4 a0 = {0.f, 0.f, 0.f, 0.f}, a1 = {0.f, 0.f, 0.f, 0.f};
    const float* W = F.w_ada + 64 * j + 4 * cq;
#pragma unroll 8
    for (int i = 0; i < 32; ++i) { const int k = kq + 32 * i; const float c0 = F.c[k], c1 = F.c[1024 + k];
        const float s0 = c0 / (1.0f + expf(-c0)), s1 = c1 / (1.0f + expf(-c1));
        const f32x4 w = *(const f32x4*)(W + (size_t)k * NMOD); a0 += s0 * w; a1 += s1 * w; }
    LAS f32x4* red = (LAS f32x4*)F.lds;
    red[(kq * 2 + 0) * 16 + cq] = a0; red[(kq * 2 + 1) * 16 + cq] = a1;
    __syncthreads();
    if (F.tid < 32) { const int b = F.tid >> 4, c2 = F.tid & 15; f32x4 s = *(const f32x4*)(F.b_ada + 64 * j + 4 * c2);
        for (int k2 = 0; k2 < 32; ++k2) s += red[(k2 * 2 + b) * 16 + c2];
        *(f32x4*)((float*)(F.ws + WS_MOD) + b * NMOD + 64 * j + 4 * c2) = s; }
    __syncthreads();
}
__device__ __forceinline__ void p0_transpose_item(const float* W, int K, int N, bf16* WT, int row_off, int row_mul, LAS float* scr, int item, int lane) {
    const int nblk = N / 32, kb = item / nblk, nb = item % nblk, k0 = 64 * kb, n0 = 32 * nb;
#pragma unroll 8
    for (int i = 0; i < 32; ++i) { const int kk = 2 * i + (lane >> 5); scr[kk * 33 + (lane & 31)] = W[(size_t)(k0 + kk) * N + n0 + (lane & 31)]; }
    asm volatile("s_waitcnt lgkmcnt(0)" ::: "memory");
    const int c = lane & 7;
#pragma unroll
    for (int j = 0; j < 4; ++j) { const int n = (lane >> 3) + 8 * j; const LAS float* s = scr + (8 * c) * 33 + n;
        v4u o; o.x = pk2(s[0 * 33], s[1 * 33]); o.y = pk2(s[2 * 33], s[3 * 33]); o.z = pk2(s[4 * 33], s[5 * 33]); o.w = pk2(s[6 * 33], s[7 * 33]);
        *(v4u*)(WT + (size_t)(row_off + row_mul * (n0 + n)) * K + k0 + 8 * c) = o; }
    asm volatile("s_waitcnt lgkmcnt(0)" ::: "memory");
}
__device__ __forceinline__ void p0_prologue(Frame& F) {
    if ((int)blockIdx.x < NMOD / 64) p0_mod_task(F, (int)blockIdx.x);
    LAS float* scr = (LAS float*)(F.lds + F.wave * 16384);
    const int gw = F.vcu * NWAVES + F.wave, NGW = F.G * NWAVES;
    constexpr int I_IN = (D / 64) * (NIN / 32), I_SQ = (D / 64) * (D / 32), I_R = (D / 64) * (256 / 32), I_SD = (256 / 64) * (D / 32);
    constexpr int NITEMS = I_IN + 3 * I_SQ + 3 * I_R + I_SD;
    unsigned char* ws = F.ws;
    for (int it = gw; it < NITEMS; it += NGW) {
        int r = it;
        if (r < I_IN) { p0_transpose_item(F.w_in, D, NIN, (bf16*)(ws + WS_WIN), 0, 1, scr, r, F.lane); continue; } r -= I_IN;
        if (r < I_SQ) { p0_transpose_item(F.w_br_ret, D, D, (bf16*)(ws + WS_WBR), 0, 1, scr, r, F.lane); continue; } r -= I_SQ;
        if (r < I_SQ) { p0_transpose_item(F.w_br_conv, D, D, (bf16*)(ws + WS_WBC), 0, 1, scr, r, F.lane); continue; } r -= I_SQ;
        if (r < I_SQ) { p0_transpose_item(F.w_out, D, D, (bf16*)(ws + WS_WO), 0, 1, scr, r, F.lane); continue; } r -= I_SQ;
        if (r < I_R) { p0_transpose_item(F.w_router, D, NE, (bf16*)(ws + WS_WR), 0, 1, scr, r, F.lane); continue; } r -= I_R;
        if (r < I_R) { p0_transpose_item(F.w_sg, D, EH, (bf16*)(ws + WS_WSGU), 0, 2, scr, r, F.lane); continue; } r -= I_R;
        if (r < I_R) { p0_transpose_item(F.w_su, D, EH, (bf16*)(ws + WS_WSGU), 1, 2, scr, r, F.lane); continue; } r -= I_R;
        p0_transpose_item(F.w_sd, EH, D, (bf16*)(ws + WS_WSD), 0, 1, scr, r, F.lane);
    }
    f32x2* rope = (f32x2*)(ws + WS_ROPE);
    for (int idx = F.vcu * NT + F.tid; idx < M * 64; idx += F.G * NT) { const int t = idx >> 6, i = idx & 63;
        const float invf = powf(10000.0f, -(float)i * (1.0f / 64.0f)); const float ang = (float)F.pos[t] * invf;
        const double ad = (double)ang; const double rr = ad - 6.283185307179586 * rint(ad * 0.15915494309189535); const float rf = (float)rr;
        rope[idx] = (f32x2){cosf(rf), sinf(rf)}; }
}

__device__ __forceinline__ void norm_mod_rows(Frame& F, const float* X, const float* gain, int sc_off, int sh_off, bf16* O) {
    const int gw = F.vcu * NWAVES + F.wave, NGW = F.G * NWAVES;
    const float* mod = (const float*)(F.ws + WS_MOD);
    f32x4 g[4];
#pragma unroll
    for (int j = 0; j < 4; ++j) g[j] = *(const f32x4*)(gain + 4 * F.lane + 256 * j);
    for (int m = gw; m < M; m += NGW) {
        const int b = m >> 13; const f32x4* xr = (const f32x4*)(X + (size_t)m * D) + F.lane;
        f32x4 v[4]; float ss = 0.f;
#pragma unroll
        for (int j = 0; j < 4; ++j) { v[j] = xr[64 * j]; ss += (v[j].x * v[j].x + v[j].y * v[j].y) + (v[j].z * v[j].z + v[j].w * v[j].w); }
        const float rstd = 1.0f / sqrtf(wave_sum(ss) * (1.0f / D) + EPS);
        v2u* o8 = (v2u*)(O + (size_t)m * D) + F.lane;
#pragma unroll
        for (int j = 0; j < 4; ++j) { const f32x4 sc = *(const f32x4*)(mod + b * NMOD + sc_off + 4 * F.lane + 256 * j), sh = *(const f32x4*)(mod + b * NMOD + sh_off + 4 * F.lane + 256 * j);
            const f32x4 h = (v[j] * rstd * g[j]) * (1.0f + sc) + sh; v2u w; w.x = pk2(h.x, h.y); w.y = pk2(h.z, h.w); o8[64 * j] = w; }
    }
}

constexpr int KS = 136, KSB = KS * 2;
constexpr int VS = 264, VSB = VS * 2;
__device__ __forceinline__ float log_gamma(int h) { return log1pf(-exp2f(-5.0f - (float)h)); }
__device__ __forceinline__ bf16x8 ldfrag(const LAS unsigned char* img, int row, int rsb, int k) { return *(const LAS bf16x8*)(img + row * rsb + k * 2); }
template <int RS4> __device__ __forceinline__ bf16x8 tr_frag(unsigned addr) {
    s16x4 lo, hi;
    asm volatile("ds_read_b64_tr_b16 %0, %2\n\tds_read_b64_tr_b16 %1, %2 offset:%3\n\ts_waitcnt lgkmcnt(0)" : "=&v"(lo), "=&v"(hi) : "v"(addr), "i"(RS4) : "memory");
    return __builtin_shufflevector(lo, hi, 0, 1, 2, 3, 4, 5, 6, 7);
}
template <int RS4, int STEP> __device__ __forceinline__ void tr_frag4(unsigned addr, bf16x8& f0, bf16x8& f1, bf16x8& f2, bf16x8& f3) {
    s16x4 l0, h0, l1, h1, l2, h2, l3, h3;
    asm volatile("ds_read_b64_tr_b16 %0, %8\n\tds_read_b64_tr_b16 %1, %8 offset:%9\n\t"
                 "ds_read_b64_tr_b16 %2, %8 offset:%10\n\tds_read_b64_tr_b16 %3, %8 offset:%11\n\t"
                 "ds_read_b64_tr_b16 %4, %8 offset:%12\n\tds_read_b64_tr_b16 %5, %8 offset:%13\n\t"
                 "ds_read_b64_tr_b16 %6, %8 offset:%14\n\tds_read_b64_tr_b16 %7, %8 offset:%15\n\ts_waitcnt lgkmcnt(0)"
                 : "=&v"(l0), "=&v"(h0), "=&v"(l1), "=&v"(h1), "=&v"(l2), "=&v"(h2), "=&v"(l3), "=&v"(h3)
                 : "v"(addr), "i"(RS4), "i"(STEP), "i"(STEP + RS4), "i"(2 * STEP), "i"(2 * STEP + RS4), "i"(3 * STEP), "i"(3 * STEP + RS4) : "memory");
    f0 = __builtin_shufflevector(l0, h0, 0, 1, 2, 3, 4, 5, 6, 7); f1 = __builtin_shufflevector(l1, h1, 0, 1, 2, 3, 4, 5, 6, 7);
    f2 = __builtin_shufflevector(l2, h2, 0, 1, 2, 3, 4, 5, 6, 7); f3 = __builtin_shufflevector(l3, h3, 0, 1, 2, 3, 4, 5, 6, 7);
}
#define MFMA16(a, b, c) __builtin_amdgcn_mfma_f32_16x16x32_bf16((a), (b), (c), 0, 0, 0)

template <bool DECAY> __device__ __forceinline__ void stage_rope(Frame& F, LAS unsigned char* img, const bf16* src, const f32x2* rope, float s_const, float lg) {
#pragma unroll
    for (int i = 0; i < 4; ++i) { const int task = F.tid + NT * i, c = task >> 4, g = task & 15;
        const v2u lo = *(const v2u*)(src + (size_t)c * NIN + 4 * g), hi = *(const v2u*)(src + (size_t)c * NIN + 64 + 4 * g);
        const f32x4 r01 = *(const f32x4*)(rope + c * 64 + 4 * g), r23 = *(const f32x4*)(rope + c * 64 + 4 * g + 2);
        const float sc = DECAY ? s_const * __expf(lg * (float)(127 - c)) : s_const;
        const float x1[4] = {bflo(lo.x), bfhi(lo.x), bflo(lo.y), bfhi(lo.y)}, x2[4] = {bflo(hi.x), bfhi(hi.x), bflo(hi.y), bfhi(hi.y)};
        const float cs[4] = {r01.x, r01.z, r23.x, r23.z}, sn[4] = {r01.y, r01.w, r23.y, r23.w};
        float y1[4], y2[4];
#pragma unroll
        for (int j = 0; j < 4; ++j) { y1[j] = (x1[j] * cs[j] - x2[j] * sn[j]) * sc; y2[j] = (x2[j] * cs[j] + x1[j] * sn[j]) * sc; }
        v2u w1, w2; w1.x = pk2(y1[0], y1[1]); w1.y = pk2(y1[2], y1[3]); w2.x = pk2(y2[0], y2[1]); w2.y = pk2(y2[2], y2[3]);
        *(LAS v2u*)(img + c * KSB + 8 * g) = w1; *(LAS v2u*)(img + c * KSB + 128 + 8 * g) = w2; }
}
__device__ __forceinline__ void stage_v(Frame& F, LAS unsigned char* img, const bf16* src) {
#pragma unroll
    for (int i = 0; i < 8; ++i) { const int task = F.tid + NT * i, c = task >> 5, g = task & 31;
        *(LAS v4u*)(img + c * VSB + 16 * g) = *(const v4u*)(src + (size_t)c * NIN + 8 * g); }
}

__device__ __forceinline__ void p3_kv_conv(Frame& F) {
    unsigned char* ws = F.ws; const bf16* PROJ = (const bf16*)(ws + WS_PROJ); const f32x2* ROPE = (const f32x2*)(ws + WS_ROPE); bf16* KV = (bf16*)(ws + WS_KV);
    LAS unsigned char* Kimg = F.lds; LAS unsigned char* Vimg = F.lds + 34816;
    const int w = F.wave, lane = F.lane, g = lane >> 4, q = (lane & 15) >> 2, p = lane & 3;
    for (int it = (int)blockIdx.x; it < BATCH * NH * NCH; it += F.G) {
        const int n = it & 63, h = (it >> 6) & 3, b = it >> 8; const int t0 = b * SEQ + n * CH; const float lg = log_gamma(h);
        stage_rope<true>(F, Kimg, PROJ + (size_t)t0 * NIN + OFF_K + h * DK, ROPE + (size_t)t0 * 64, 1.0f, lg);
        stage_v(F, Vimg, PROJ + (size_t)t0 * NIN + OFF_V + h * DV);
        __syncthreads();
        f32x4 acc[16];
#pragma unroll
        for (int i = 0; i < 16; ++i) acc[i] = (f32x4){0.f, 0.f, 0.f, 0.f};
        const unsigned ka = F.ldsb + (unsigned)((8 * g + q) * KSB + (16 * w + 4 * p) * 2);
        const unsigned va = F.ldsb + 34816u + (unsigned)((8 * g + q) * VSB + (4 * p) * 2);
#pragma unroll
        for (int ks = 0; ks < 4; ++ks) {
            const bf16x8 a = tr_frag<4 * KSB>(ka + ks * 32 * KSB);
#pragma unroll
            for (int nt = 0; nt < 16; nt += 4) { bf16x8 b0, b1, b2, b3; tr_frag4<4 * VSB, 32>(va + ks * 32 * VSB + nt * 32, b0, b1, b2, b3);
                acc[nt] = MFMA16(a, b0, acc[nt]); acc[nt + 1] = MFMA16(a, b1, acc[nt + 1]); acc[nt + 2] = MFMA16(a, b2, acc[nt + 2]); acc[nt + 3] = MFMA16(a, b3, acc[nt + 3]); }
        }
        bf16* kvp = KV + (size_t)it * (DV * DK) + (size_t)(lane & 15) * DK + 16 * w + 4 * g;
#pragma unroll
        for (int nt = 0; nt < 16; ++nt) { v2u wv; wv.x = pk2(acc[nt][0], acc[nt][1]); wv.y = pk2(acc[nt][2], acc[nt][3]); *(v2u*)(kvp + (size_t)(16 * nt) * DK) = wv; }
        __syncthreads();
    }
    bf16* CONVG = (bf16*)(ws + WS_CONVG);
    const int gw = F.vcu * NWAVES + F.wave, NGW = F.G * NWAVES;
    for (int m = gw; m < M; m += NGW) { const int s = m & (SEQ - 1);
#pragma unroll
        for (int j = 0; j < 4; ++j) { const int ch = 4 * lane + 256 * j; const bf16* rp = PROJ + (size_t)m * NIN + ch;
            const f32x4 w0 = *(const f32x4*)(F.conv_w + ch), w1 = *(const f32x4*)(F.conv_w + D + ch), w2 = *(const f32x4*)(F.conv_w + 2 * D + ch);
            const v2u u0 = *(const v2u*)(rp + OFF_U), c0 = *(const v2u*)(rp + OFF_GC), gb = *(const v2u*)(rp + OFF_GB);
            v2u u1 = {0u, 0u}, c1 = {0u, 0u}, u2 = {0u, 0u}, c2 = {0u, 0u};
            if (s >= 1) { u1 = *(const v2u*)(rp - NIN + OFF_U); c1 = *(const v2u*)(rp - NIN + OFF_GC); }
            if (s >= 2) { u2 = *(const v2u*)(rp - 2 * NIN + OFF_U); c2 = *(const v2u*)(rp - 2 * NIN + OFF_GC); }
            f32x4 cu0 = {bflo(u0.x) * bflo(c0.x), bfhi(u0.x) * bfhi(c0.x), bflo(u0.y) * bflo(c0.y), bfhi(u0.y) * bfhi(c0.y)};
            f32x4 cu1 = {bflo(u1.x) * bflo(c1.x), bfhi(u1.x) * bfhi(c1.x), bflo(u1.y) * bflo(c1.y), bfhi(u1.y) * bfhi(c1.y)};
            f32x4 cu2 = {bflo(u2.x) * bflo(c2.x), bfhi(u2.x) * bfhi(c2.x), bflo(u2.y) * bflo(c2.y), bfhi(u2.y) * bfhi(c2.y)};
            const f32x4 gbf = {bflo(gb.x), bfhi(gb.x), bflo(gb.y), bfhi(gb.y)};
            const f32x4 o = gbf * (w0 * cu2 + w1 * cu1 + w2 * cu0);
            v2u wv; wv.x = pk2(o.x, o.y); wv.y = pk2(o.z, o.w); *(v2u*)(CONVG + (size_t)m * D + ch) = wv; }
    }
}

__device__ __forceinline__ void p4_scan(Frame& F) {
    const unsigned* KV = (const unsigned*)(F.ws + WS_KV); unsigned* SP = (unsigned*)(F.ws + WS_SP);
    for (int gid = F.vcu * NT + F.tid; gid < BATCH * NH * (DV * DK / 2); gid += F.G * NT) {
        const int bh = gid >> 14, e2 = gid & 16383, h = bh & 3; const float dec = __expf(log_gamma(h) * 128.0f);
        f32x2 S = {0.f, 0.f};
        const unsigned* kp = KV + (size_t)bh * NCH * 16384 + e2; unsigned* sp = SP + (size_t)bh * NCH * 16384 + e2;
#pragma unroll 8
        for (int n = 0; n < NCH; ++n) { const unsigned kw = kp[(size_t)n * 16384]; const f32x2 kv = {bflo(kw), bfhi(kw)}; sp[(size_t)n * 16384] = pk2(S.x, S.y); S = S * dec + kv; }
    }
}

__device__ __forceinline__ void p5_retention(Frame& F) {
    unsigned char* ws = F.ws; const bf16* PROJ = (const bf16*)(ws + WS_PROJ); const f32x2* ROPE = (const f32x2*)(ws + WS_ROPE); const bf16* SP = (const bf16*)(ws + WS_SP);
    bf16* RETG = (bf16*)(ws + WS_RETG);
    LAS unsigned char* Qimg = F.lds; LAS unsigned char* Kimg = F.lds + 34816; LAS unsigned char* Bimg = F.lds + 69632;
    const int w = F.wave, lane = F.lane, g = lane >> 4, q = (lane & 15) >> 2, p = lane & 3, fr = lane & 15;
    for (int it = (int)blockIdx.x; it < BATCH * NH * NCH; it += F.G) {
        const int n = it & 63, h = (it >> 6) & 3, b = it >> 8; const int t0 = b * SEQ + n * CH; const float lg = log_gamma(h);
        stage_rope<false>(F, Qimg, PROJ + (size_t)t0 * NIN + OFF_Q + h * DK, ROPE + (size_t)t0 * 64, 0.08838834764831845f, 0.f);
        stage_rope<false>(F, Kimg, PROJ + (size_t)t0 * NIN + OFF_K + h * DK, ROPE + (size_t)t0 * 64, 1.0f, 0.f);
        { const bf16* sp = SP + (size_t)it * (DV * DK);
#pragma unroll
          for (int i = 0; i < 8; ++i) { const int task = F.tid + NT * i, r = task >> 4, c16 = task & 15; *(LAS v4u*)(Bimg + r * KSB + 16 * c16) = *(const v4u*)(sp + r * DK + 8 * c16); } }
        __syncthreads();
        f32x4 acc[16];
#pragma unroll
        for (int i = 0; i < 16; ++i) acc[i] = (f32x4){0.f, 0.f, 0.f, 0.f};
        f32x4 sc[8];
#pragma unroll
        for (int i = 0; i < 8; ++i) sc[i] = (f32x4){0.f, 0.f, 0.f, 0.f};
#pragma unroll 1
        for (int ks = 0; ks < 4; ++ks) {
            const bf16x8 qf = ldfrag(Qimg, 16 * w + fr, KSB, 32 * ks + 8 * g);
#pragma unroll
            for (int nt = 0; nt < 16; ++nt) { const bf16x8 sf = ldfrag(Bimg, 16 * nt + fr, KSB, 32 * ks + 8 * g); acc[nt] = MFMA16(sf, qf, acc[nt]); }
#pragma unroll
            for (int jt = 0; jt < 8; ++jt) { const bf16x8 kf = ldfrag(Kimg, 16 * jt + fr, KSB, 32 * ks + 8 * g); sc[jt] = MFMA16(kf, qf, sc[jt]); }
        }
        const int irow = 16 * w + fr;
        { const float cd = __expf(lg * (float)(irow + 1));
#pragma unroll
          for (int nt = 0; nt < 16; ++nt) acc[nt] = acc[nt] * cd; }
        __syncthreads();
#pragma unroll
        for (int jt = 0; jt < 8; ++jt) { float pv[4];
#pragma unroll
            for (int r = 0; r < 4; ++r) { const int j = 16 * jt + 4 * g + r; pv[r] = (irow >= j) ? sc[jt][r] * __expf(lg * (float)(irow - j)) : 0.f; }
            v2u wv; wv.x = pk2(pv[0], pv[1]); wv.y = pk2(pv[2], pv[3]); *(LAS v2u*)(Kimg + irow * KSB + (16 * jt + 4 * g) * 2) = wv; }
        stage_v(F, Bimg, PROJ + (size_t)t0 * NIN + OFF_V + h * DV);
        __syncthreads();
        const unsigned va = F.ldsb + 69632u + (unsigned)((8 * g + q) * VSB + (4 * p) * 2);
#pragma unroll 1
        for (int ks = 0; ks < 4; ++ks) {
            const bf16x8 pf = ldfrag(Kimg, 16 * w + fr, KSB, 32 * ks + 8 * g);
#pragma unroll
            for (int nt = 0; nt < 16; nt += 4) { bf16x8 v0, v1, v2, v3; tr_frag4<4 * VSB, 32>(va + ks * 32 * VSB + nt * 32, v0, v1, v2, v3);
                acc[nt] = MFMA16(v0, pf, acc[nt]); acc[nt + 1] = MFMA16(v1, pf, acc[nt + 1]); acc[nt + 2] = MFMA16(v2, pf, acc[nt + 2]); acc[nt + 3] = MFMA16(v3, pf, acc[nt + 3]); }
        }
        float ss = 0.f;
#pragma unroll
        for (int nt = 0; nt < 16; ++nt) ss += (acc[nt][0] * acc[nt][0] + acc[nt][1] * acc[nt][1]) + (acc[nt][2] * acc[nt][2] + acc[nt][3] * acc[nt][3]);
        ss += __shfl_xor(ss, 16); ss += __shfl_xor(ss, 32);
        const float rstd = 1.0f / sqrtf(ss * (1.0f / DV) + EPS);
        const size_t trow = (size_t)(t0 + irow);
#pragma unroll
        for (int nt = 0; nt < 16; ++nt) { const int dv = 16 * nt + 4 * g; const f32x4 gn = *(const f32x4*)(F.ret_norm_g + h * DV + dv);
            const v2u gr = *(const v2u*)(PROJ + trow * NIN + OFF_GR + h * DV + dv);
            const f32x4 o = acc[nt] * rstd * gn * (f32x4){siluf_(bflo(gr.x)), siluf_(bfhi(gr.x)), siluf_(bflo(gr.y)), siluf_(bfhi(gr.y))};
            v2u wv; wv.x = pk2(o[0], o[1]); wv.y = pk2(o[2], o[3]); *(v2u*)(RETG + trow * D + h * DV + dv) = wv; }
        __syncthreads();
    }
}

__device__ __forceinline__ unsigned f32_key(float x) { const unsigned u = __float_as_uint(x); return (u & 0x80000000u) ? ~u : (u | 0x80000000u); }
template <bool DRY> __device__ __forceinline__ void route_tokens(Frame& F) {
    unsigned char* ws = F.ws; const float* LOGITS = (const float*)(ws + WS_LOGITS);
    int* EIDX = (int*)(ws + WS_EIDX); int* POS = (int*)(ws + WS_POS); int* LTOK = (int*)(ws + WS_LTOK); float* LW = (float*)(ws + WS_LW);
    unsigned* cnt = (unsigned*)(F.ctl + CW_CNT);
    const int gw = F.vcu * NWAVES + F.wave, NGW = F.G * NWAVES, lane = F.lane;
    const f32x4 bias = *(const f32x4*)(F.router_bias + 4 * lane);
    for (int t0 = 2 * gw; t0 < M; t0 += 2 * NGW) {
        float sc[2][4]; unsigned key[2][4];
#pragma unroll
        for (int u = 0; u < 2; ++u) {
            const f32x4 lgv = *(const f32x4*)(LOGITS + (size_t)(t0 + u) * NE + 4 * lane);
            sc[u][0] = 1.0f / (1.0f + __expf(-lgv.x)); sc[u][1] = 1.0f / (1.0f + __expf(-lgv.y)); sc[u][2] = 1.0f / (1.0f + __expf(-lgv.z)); sc[u][3] = 1.0f / (1.0f + __expf(-lgv.w));
            const float c0 = sc[u][0] + bias.x, c1 = sc[u][1] + bias.y, c2 = sc[u][2] + bias.z, c3 = sc[u][3] + bias.w;
            const float a = fmaxf(c0, c1), bq = fminf(c0, c1), cc = fmaxf(c2, c3), dd = fminf(c2, c3);
            float m1 = fmaxf(a, cc), m2 = fmaxf(fminf(a, cc), fmaxf(bq, dd));
#pragma unroll
            for (int o = 1; o < 8; o <<= 1) { const float o1 = __shfl_xor(m1, o), o2 = __shfl_xor(m2, o); const float n1 = fmaxf(m1, o1), n2 = fmaxf(fminf(m1, o1), fmaxf(m2, o2)); m1 = n1; m2 = n2; }
            const float gs = m1 + m2; const int myg = lane >> 3; int rank = 0;
#pragma unroll
            for (int g2 = 0; g2 < 8; ++g2) { const float sg = __uint_as_float((unsigned)__builtin_amdgcn_readlane((int)__float_as_uint(gs), g2 * 8)); rank += (sg > gs || (sg == gs && g2 < myg)) ? 1 : 0; }
            const bool gsel = rank < 4;
            key[u][0] = gsel ? f32_key(c0) : 0u; key[u][1] = gsel ? f32_key(c1) : 0u; key[u][2] = gsel ? f32_key(c2) : 0u; key[u][3] = gsel ? f32_key(c3) : 0u;
        }
        unsigned th0 = 0u, th1 = 0u;
#pragma unroll 4
        for (int bit = 31; bit >= 0; --bit) {
            const unsigned ca = th0 | (1u << bit), cb = th1 | (1u << bit);
            const int na = __popcll(__ballot(key[0][0] >= ca)) + __popcll(__ballot(key[0][1] >= ca)) + __popcll(__ballot(key[0][2] >= ca)) + __popcll(__ballot(key[0][3] >= ca));
            const int nb = __popcll(__ballot(key[1][0] >= cb)) + __popcll(__ballot(key[1][1] >= cb)) + __popcll(__ballot(key[1][2] >= cb)) + __popcll(__ballot(key[1][3] >= cb));
            th0 = na >= 8 ? ca : th0; th1 = nb >= 8 ? cb : th1;
        }
        unsigned pa[2][4]; int ra[2][4]; float inva[2];
#pragma unroll
        for (int u = 0; u < 2; ++u) { const unsigned th = u ? th1 : th0;
            const bool s0 = key[u][0] >= th, s1 = key[u][1] >= th, s2 = key[u][2] >= th, s3 = key[u][3] >= th;
            const unsigned long long b0 = __ballot(s0), b1 = __ballot(s1), b2 = __ballot(s2), b3 = __ballot(s3);
            const unsigned long long lt = (1ull << lane) - 1ull;
            const int base = __popcll(b0 & lt) + __popcll(b1 & lt) + __popcll(b2 & lt) + __popcll(b3 & lt);
            const int r0 = base, r1 = r0 + (s0 ? 1 : 0), r2 = r1 + (s1 ? 1 : 0), r3 = r2 + (s2 ? 1 : 0);
            const float part = (s0 ? sc[u][0] : 0.f) + (s1 ? sc[u][1] : 0.f) + (s2 ? sc[u][2] : 0.f) + (s3 ? sc[u][3] : 0.f);
            const float inv = 2.5f / wave_sum(part);
            const bool a0 = s0 && r0 < 8, a1 = s1 && r1 < 8, a2 = s2 && r2 < 8, a3 = s3 && r3 < 8; const int e0 = 4 * lane;
            unsigned p0 = 0u, p1 = 0u, p2 = 0u, p3 = 0u;
            if (DRY) { if (a0) p0 = __hip_atomic_load(cnt + 64 * e0, RLX_AGENT); if (a1) p1 = __hip_atomic_load(cnt + 64 * (e0 + 1), RLX_AGENT); if (a2) p2 = __hip_atomic_load(cnt + 64 * (e0 + 2), RLX_AGENT); if (a3) p3 = __hip_atomic_load(cnt + 64 * (e0 + 3), RLX_AGENT); } else {
            if (a0) p0 = __hip_atomic_fetch_add(cnt + 64 * e0, 1u, RLX_AGENT);
            if (a1) p1 = __hip_atomic_fetch_add(cnt + 64 * (e0 + 1), 1u, RLX_AGENT);
            if (a2) p2 = __hip_atomic_fetch_add(cnt + 64 * (e0 + 2), 1u, RLX_AGENT);
            if (a3) p3 = __hip_atomic_fetch_add(cnt + 64 * (e0 + 3), 1u, RLX_AGENT); }
            pa[u][0] = p0; pa[u][1] = p1; pa[u][2] = p2; pa[u][3] = p3; ra[u][0] = a0 ? r0 : -1; ra[u][1] = a1 ? r1 : -1; ra[u][2] = a2 ? r2 : -1; ra[u][3] = a3 ? r3 : -1; inva[u] = inv;
        }
#pragma unroll
        for (int u = 0; u < 2; ++u) { const int t = t0 + u;
#pragma unroll
            for (int j = 0; j < 4; ++j) if (ra[u][j] >= 0) { const int e = 4 * lane + j; const unsigned ps = DRY ? (unsigned)(CAP - 1 - (t & 1023)) : pa[u][j]; if (DRY && pa[u][j] == 0xffffffffu) continue;
                LTOK[(size_t)e * CAP + ps] = t; LW[(size_t)e * CAP + ps] = sc[u][j] * inva[u]; EIDX[t * 8 + ra[u][j]] = e; POS[t * 8 + ra[u][j]] = (int)ps; }
        }
    }
}

__device__ __forceinline__ void expert_prefix(Frame& F, LAS int* pref, LAS int* off) {
    if (F.wave == 0) { const unsigned* cnt = (const unsigned*)(F.ctl + CW_CNT); const int lane = F.lane;
        int c[4], nb[4]; int tc = 0, tb = 0;
#pragma unroll
        for (int j = 0; j < 4; ++j) { c[j] = (int)__hip_atomic_load(cnt + 64 * (4 * lane + j), RLX_AGENT); nb[j] = (c[j] + 127) >> 7; tc += c[j]; tb += nb[j]; }
        int xc = tc, xb = tb;
#pragma unroll
        for (int o = 1; o < 64; o <<= 1) { const int vc = __shfl_up(xc, o), vb = __shfl_up(xb, o); if (lane >= o) { xc += vc; xb += vb; } }
        int ec = xc - tc, eb = xb - tb;
#pragma unroll
        for (int j = 0; j < 4; ++j) { off[4 * lane + j] = ec; pref[4 * lane + j] = eb; ec += c[j]; eb += nb[j]; }
        if (lane == 63) { off[256] = ec; pref[256] = eb; } }
}

constexpr int EX_PREF = 0, EX_OFF = 1040, EX_TOK = 2176, EX_W = 2688, EX_BUF = 3200, EX_BUFSZ = 27648, EX_BOFF = 10240, EX_G = EX_BUF + 2 * EX_BUFSZ;
constexpr int ASB = 80, EXD = 4, EXNC = 96;
static_assert(EX_G + 128 * VSB <= LDSCTL_OFF, "expert LDS map");
template <int RS4, int STEP> __device__ __forceinline__ void tr_frag2(unsigned addr, bf16x8& f0, bf16x8& f1) {
    s16x4 l0, h0, l1, h1;
    asm volatile("ds_read_b64_tr_b16 %0, %4\n\tds_read_b64_tr_b16 %1, %4 offset:%5\n\tds_read_b64_tr_b16 %2, %4 offset:%6\n\tds_read_b64_tr_b16 %3, %4 offset:%7\n\ts_waitcnt lgkmcnt(0)"
                 : "=&v"(l0), "=&v"(h0), "=&v"(l1), "=&v"(h1) : "v"(addr), "i"(RS4), "i"(STEP), "i"(STEP + RS4) : "memory");
    f0 = __builtin_shufflevector(l0, h0, 0, 1, 2, 3, 4, 5, 6, 7); f1 = __builtin_shufflevector(l1, h1, 0, 1, 2, 3, 4, 5, 6, 7);
}
struct ExSet { f32x4 w[4]; v4u a; };
constexpr int PF_OFF = 140288;
__device__ __forceinline__ void pf_dma(const void* gsrc, unsigned lds_dst) {
    unsigned keep;
    asm volatile("s_mov_b32 %0, m0\n\ts_mov_b32 m0, %2\n\ts_nop 0\n\tglobal_load_lds_dword %1, off\n\ts_mov_b32 m0, %0" : "=&s"(keep) : "v"(gsrc), "s"(lds_dst) : "memory");
}
template <int ABL> __device__ __forceinline__ void p11_experts(Frame& F) {
    unsigned char* ws = F.ws; const bf16* H2 = (const bf16*)(ws + WS_HB); const int* LTOK = (const int*)(ws + WS_LTOK); const float* LW = (const float*)(ws + WS_LW); bf16* YP = (bf16*)(ws + WS_YP);
    LAS int* pref = (LAS int*)(F.lds + EX_PREF); LAS int* off = (LAS int*)(F.lds + EX_OFF); LAS int* tokl = (LAS int*)(F.lds + EX_TOK); LAS float* wl = (LAS float*)(F.lds + EX_W);
    LAS unsigned char* Gimg = F.lds + EX_G;
    const int tid = F.tid, w = F.wave, wr = w >> 2, wc = w & 3;
    const unsigned pfl = F.ldsb + PF_OFF + (unsigned)w * 256u;
    expert_prefix(F, pref, off);
    __syncthreads();
    const int nitems = pref[256];
    for (int it = F.vcu; it < nitems; it += F.G) {
        int e = 0;
#pragma unroll
        for (int s = 128; s >= 1; s >>= 1) if (pref[e + s] <= it) e += s;
        e = __builtin_amdgcn_readfirstlane(e);
        const int rb = __builtin_amdgcn_readfirstlane(it - pref[e]), cnt_e = __builtin_amdgcn_readfirstlane(off[e + 1] - off[e]), r0 = rb * 128, slot0 = __builtin_amdgcn_readfirstlane(off[e]) + r0;
        if (tid < 128) { const int idx = r0 + tid; const bool ok = idx < cnt_e; tokl[tid] = LTOK[(size_t)e * CAP + (ok ? idx : r0)]; wl[tid] = ok ? LW[(size_t)e * CAP + idx] : 0.f; }
        __syncthreads();
        const float* Wg = F.w_eg + (size_t)e * D * EH; const float* Wu = F.w_eu + (size_t)e * D * EH; const float* Wd = F.w_ed + (size_t)e * EH * D;
        const bf16* asrc = H2 + (size_t)tokl[tid >> 2] * D + (tid & 3) * 8;
        int gs_lo, gs_n; { const int xs = (it / F.G) * F.G + (F.vcu & ~31); int lo = pref[e], hi = pref[e + 1]; lo = lo > xs ? lo : xs; hi = hi < xs + 32 ? hi : xs + 32; hi = hi < nitems ? hi : nitems;
            gs_lo = __builtin_amdgcn_readfirstlane(lo); gs_n = __builtin_amdgcn_readfirstlane(hi - lo); }
        unsigned gs_k = 0u;
#define EX_GSYNC() do { if (MK_GSYNC && gs_n > 1) { ++gs_k; if (tid == 0) { unsigned* cw = (unsigned*)(F.ctl + CW_GS) + 64 * gs_lo; __hip_atomic_fetch_add(cw, 1u, RLX_AGENT);               \
                const unsigned long long t0_ = __builtin_amdgcn_s_memrealtime(); const unsigned want = (unsigned)gs_n * gs_k;                                                                 \
                while (__hip_atomic_load(cw, RLX_AGENT) < want) { if (__builtin_amdgcn_s_memrealtime() - t0_ > 20000ull) break; __builtin_amdgcn_s_sleep(2); } }                            \
            __syncthreads(); } } while (0)
        EX_GSYNC();
        if (MK_GSTAG > 0 && gs_n > 1) { const unsigned long long t0_ = __builtin_amdgcn_s_memrealtime(); const unsigned long long d_ = (unsigned long long)(MK_GSTAG * (it - gs_lo)); while (__builtin_amdgcn_s_memrealtime() - t0_ < d_) __builtin_amdgcn_s_sleep(1); }
        f32x4 acc[4][4];
#define EX_ZERO() do { _Pragma("unroll") for (int i = 0; i < 4; ++i) _Pragma("unroll") for (int j = 0; j < 4; ++j) acc[i][j] = (f32x4){0.f, 0.f, 0.f, 0.f}; } while (0)
        EX_ZERO();
        ExSet S0, S1, S2, S3;
        if (ABL & 16) { _Pragma("unroll") for (int i = 0; i < 4; ++i) { S0.w[i] = S1.w[i] = S2.w[i] = S3.w[i] = (f32x4){1.f, 1.f, 1.f, 1.f}; } S0.a = S1.a = S2.a = S3.a = (v4u){0u, 0u, 0u, 0u}; }
#define EX_L1(S, CC) do { if (ABL & 16) break; const int cc_ = (CC) & 63, hp_ = cc_ >> 5, kc_ = cc_ & 31; int tl = tid; asm volatile("" : "+v"(tl));                         \
            unsigned o = (unsigned)((32 * kc_ + (tl >> 5)) * EH + 128 * hp_ + 4 * (tl & 31));                                                            \
            S.w[0] = *(const f32x4*)(Wg + o); S.w[1] = *(const f32x4*)(Wg + o + 16 * EH); S.w[2] = *(const f32x4*)(Wu + o); S.w[3] = *(const f32x4*)(Wu + o + 16 * EH); \
            S.a = *(const v4u*)(asrc + 32 * kc_); } while (0)
#define EX_PF1(CC) do { if (MK_PFD > 0) { const int cc_ = (CC) & 63, hp_ = cc_ >> 5, kc_ = cc_ & 31; int tl = tid; asm volatile("" : "+v"(tl)); const int ln_ = tl & 63;   \
            if (w < 4) { const float* wm_ = (w & 2) ? Wu : Wg; pf_dma(wm_ + (size_t)(32 * kc_ + (w & 1) * 16 + (ln_ >> 2)) * EH + 128 * hp_ + 32 * (ln_ & 3), pfl); }              \
            else if (w < 6) { pf_dma(H2 + (size_t)tokl[(w - 4) * 64 + ln_] * D + 32 * kc_, pfl); } } } while (0)
#define EX_W1(S, BUF) do { if (ABL & 2) { asm volatile("" :: "v"(S.w[0]), "v"(S.w[1]), "v"(S.w[2]), "v"(S.w[3]), "v"(S.a)); break; } int tl = tid; asm volatile("" : "+v"(tl)); LAS unsigned char* b_ = (BUF) + EX_BOFF + (tl >> 5) * KSB + 8 * (tl & 31); v2u p_[4];  \
            _Pragma("unroll") for (int i = 0; i < 4; ++i) { p_[i].x = pk2(S.w[i].x, S.w[i].y); p_[i].y = pk2(S.w[i].z, S.w[i].w); }                        \
            *(LAS v2u*)b_ = p_[0]; *(LAS v2u*)(b_ + 16 * KSB) = p_[1]; *(LAS v2u*)(b_ + 32 * KSB) = p_[2]; *(LAS v2u*)(b_ + 48 * KSB) = p_[3];             \
            *(LAS v4u*)((BUF) + (tl >> 2) * ASB + (tl & 3) * 16) = S.a; } while (0)
#define EX_C1(C) do { if (ABL & 1) break; int tl = tid; asm volatile("" : "+v"(tl)); const int g = (tl >> 4) & 3, fr = tl & 15, q = (tl & 15) >> 2, p = tl & 3;              \
            LAS unsigned char* buf = F.lds + EX_BUF + ((C) & 1) * EX_BUFSZ; const unsigned ta = F.ldsb + EX_BUF + (unsigned)(((C) & 1) * EX_BUFSZ + EX_BOFF + (8 * g + q) * KSB + (32 * wc + 4 * p) * 2); \
            bf16x8 af[4]; _Pragma("unroll") for (int rt = 0; rt < 4; ++rt) af[rt] = ldfrag(buf, 64 * wr + 16 * rt + fr, ASB, 8 * g);                     \
            bf16x8 b0, b1, b2, b3; tr_frag2<4 * KSB, 32>(ta, b0, b1); tr_frag2<4 * KSB, 32>(ta + 32 * KSB, b2, b3);                                       \
            _Pragma("unroll") for (int rt = 0; rt < 4; ++rt) { acc[rt][0] = MFMA16(b0, af[rt], acc[rt][0]); acc[rt][1] = MFMA16(b1, af[rt], acc[rt][1]); acc[rt][2] = MFMA16(b2, af[rt], acc[rt][2]); acc[rt][3] = MFMA16(b3, af[rt], acc[rt][3]); } } while (0)
#define EX_C1S(SL, C) do { int tl = tid; asm volatile("" : "+v"(tl)); const int g = (tl >> 4) & 3, fr = tl & 15, q = (tl & 15) >> 2, p = tl & 3;      \
            const int cc_ = ((C) + 4) & 63, hp_ = cc_ >> 5, kc_ = cc_ & 31; const unsigned o = (unsigned)((32 * kc_ + (tl >> 5)) * EH + 128 * hp_ + 4 * (tl & 31));        \
            LAS unsigned char* buf = F.lds + EX_BUF + ((C) & 1) * EX_BUFSZ; const unsigned ta = F.ldsb + EX_BUF + (unsigned)(((C) & 1) * EX_BUFSZ + EX_BOFF + (8 * g + q) * KSB + (32 * wc + 4 * p) * 2); \
            bf16x8 af[4]; _Pragma("unroll") for (int rt = 0; rt < 4; ++rt) af[rt] = ldfrag(buf, 64 * wr + 16 * rt + fr, ASB, 8 * g);                     \
            bf16x8 b0, b1, b2, b3; tr_frag2<4 * KSB, 32>(ta, b0, b1); tr_frag2<4 * KSB, 32>(ta + 32 * KSB, b2, b3);                                       \
            __builtin_amdgcn_sched_barrier(0); SL.w[0] = *(const f32x4*)(Wg + o); __builtin_amdgcn_sched_barrier(0);                                       \
            acc[0][0] = MFMA16(b0, af[0], acc[0][0]); acc[0][1] = MFMA16(b1, af[0], acc[0][1]); acc[0][2] = MFMA16(b2, af[0], acc[0][2]); acc[0][3] = MFMA16(b3, af[0], acc[0][3]); \
            __builtin_amdgcn_sched_barrier(0); SL.w[1] = *(const f32x4*)(Wg + o + 16 * EH); __builtin_amdgcn_sched_barrier(0);                             \
            acc[1][0] = MFMA16(b0, af[1], acc[1][0]); acc[1][1] = MFMA16(b1, af[1], acc[1][1]); acc[1][2] = MFMA16(b2, af[1], acc[1][2]); acc[1][3] = MFMA16(b3, af[1], acc[1][3]); \
            __builtin_amdgcn_sched_barrier(0); SL.w[2] = *(const f32x4*)(Wu + o); __builtin_amdgcn_sched_barrier(0);                                       \
            acc[2][0] = MFMA16(b0, af[2], acc[2][0]); acc[2][1] = MFMA16(b1, af[2], acc[2][1]); acc[2][2] = MFMA16(b2, af[2], acc[2][2]); acc[2][3] = MFMA16(b3, af[2], acc[2][3]); \
            __builtin_amdgcn_sched_barrier(0); SL.w[3] = *(const f32x4*)(Wu + o + 16 * EH); SL.a = *(const v4u*)(asrc + 32 * kc_); __builtin_amdgcn_sched_barrier(0);   \
            acc[3][0] = MFMA16(b0, af[3], acc[3][0]); acc[3][1] = MFMA16(b1, af[3], acc[3][1]); acc[3][2] = MFMA16(b2, af[3], acc[3][2]); acc[3][3] = MFMA16(b3, af[3], acc[3][3]); } while (0)
#define EX_STEP1(SL, SW, C) do { if (MK_SPREAD) { EX_C1S(SL, C); EX_W1(SW, F.lds + EX_BUF + (((C) + 1) & 1) * EX_BUFSZ); __syncthreads(); break; } if (!MK_LATE_ISSUE) { EX_L1(SL, (C) + 4); } EX_C1(C); EX_W1(SW, F.lds + EX_BUF + (((C) + 1) & 1) * EX_BUFSZ); if (MK_LATE_ISSUE) { EX_L1(SL, (C) + 4); } __syncthreads(); } while (0)
        EX_L1(S0, 0); EX_L1(S1, 1); EX_L1(S2, 2); EX_L1(S3, 3);
        EX_W1(S0, F.lds + EX_BUF);
        __syncthreads();
#pragma unroll 1
        for (int c4 = 0; c4 < 64; c4 += 4) {
            if (MK_GSYNC_EVERY > 0 && (c4 & (MK_GSYNC_EVERY - 1)) == 0 && c4) EX_GSYNC();
            EX_STEP1(S0, S1, c4); EX_STEP1(S1, S2, c4 + 1); EX_STEP1(S2, S3, c4 + 2); EX_STEP1(S3, S0, c4 + 3);
            if ((c4 & 31) == 28) { const int hp = c4 >> 5; int tl = tid; asm volatile("" : "+v"(tl)); const int g = (tl >> 4) & 3, fr = tl & 15;
#pragma unroll
                for (int rt = 0; rt < 4; ++rt)
#pragma unroll
                    for (int ct = 0; ct < 2; ++ct) { const f32x4 ga = acc[rt][ct], ua = acc[rt][ct + 2];
                        v2u wv; wv.x = pk2(siluf_(ga[0]) * ua[0], siluf_(ga[1]) * ua[1]); wv.y = pk2(siluf_(ga[2]) * ua[2], siluf_(ga[3]) * ua[3]);
                        *(LAS v2u*)(Gimg + (64 * wr + 16 * rt + fr) * VSB + (128 * hp + 32 * wc + 16 * ct + 4 * g) * 2) = wv; }
                EX_ZERO(); }
        }
#define EX_L2(S, CC) do { if (ABL & 16) break; const int cc_ = (CC) & 31, np_ = cc_ >> 3, kc_ = cc_ & 7; int tl = tid; asm volatile("" : "+v"(tl));                           \
            unsigned o = (unsigned)((32 * kc_ + (tl >> 6)) * D + 256 * np_ + 4 * (tl & 63));                                                              \
            _Pragma("unroll") for (int i = 0; i < 4; ++i) S.w[i] = *(const f32x4*)(Wd + o + (unsigned)(8 * i * D)); } while (0)
#define EX_PF2(CC) do { if (MK_PFD > 0) { const int cc_ = (CC) & 31, np_ = cc_ >> 3, kc_ = cc_ & 7; int tl = tid; asm volatile("" : "+v"(tl)); const int ln_ = tl & 63;    \
            if (w < 4) pf_dma(Wd + (size_t)(32 * kc_ + w * 8 + (ln_ >> 3)) * D + 256 * np_ + 32 * (ln_ & 7), pfl); } } while (0)
#define EX_W2(S, BUF) do { if (ABL & 2) { asm volatile("" :: "v"(S.w[0]), "v"(S.w[1]), "v"(S.w[2]), "v"(S.w[3])); break; } int tl = tid; asm volatile("" : "+v"(tl)); LAS unsigned char* b_ = (BUF) + EX_BOFF + (tl >> 6) * VSB + 8 * (tl & 63);          \
            _Pragma("unroll") for (int i = 0; i < 4; ++i) { v2u p_; p_.x = pk2(S.w[i].x, S.w[i].y); p_.y = pk2(S.w[i].z, S.w[i].w); *(LAS v2u*)(b_ + (8 * i) * VSB) = p_; } } while (0)
#define EX_C2(C) do { if (ABL & 1) break; int tl = tid; asm volatile("" : "+v"(tl)); const int g = (tl >> 4) & 3, fr = tl & 15, q = (tl & 15) >> 2, p = tl & 3;              \
            const unsigned ta = F.ldsb + EX_BUF + (unsigned)(((C) & 1) * EX_BUFSZ + EX_BOFF + (8 * g + q) * VSB + (64 * wc + 4 * p) * 2);                \
            bf16x8 gf[4]; _Pragma("unroll") for (int rt = 0; rt < 4; ++rt) gf[rt] = ldfrag(Gimg, 64 * wr + 16 * rt + fr, VSB, 32 * ((C) & 7) + 8 * g);   \
            bf16x8 b0, b1, b2, b3; tr_frag4<4 * VSB, 32>(ta, b0, b1, b2, b3);                                                                             \
            _Pragma("unroll") for (int rt = 0; rt < 4; ++rt) { acc[rt][0] = MFMA16(b0, gf[rt], acc[rt][0]); acc[rt][1] = MFMA16(b1, gf[rt], acc[rt][1]); acc[rt][2] = MFMA16(b2, gf[rt], acc[rt][2]); acc[rt][3] = MFMA16(b3, gf[rt], acc[rt][3]); } } while (0)
#define EX_STEP2(SL, SW, C) do { if (!MK_LATE_ISSUE) { EX_L2(SL, (C) + 4); } EX_C2(C); EX_W2(SW, F.lds + EX_BUF + (((C) + 1) & 1) * EX_BUFSZ); if (MK_LATE_ISSUE) { EX_L2(SL, (C) + 4); } __syncthreads(); } while (0)
        EX_L2(S0, 0); EX_L2(S1, 1); EX_L2(S2, 2); EX_L2(S3, 3);
        EX_W2(S0, F.lds + EX_BUF);
        __syncthreads();
#pragma unroll 1
        for (int np = 0; np < 4; ++np) {
            if (MK_GSYNC_EVERY > 0) EX_GSYNC();
#pragma unroll 1
            for (int h4 = 0; h4 < 8; h4 += 4) { const int c4 = 8 * np + h4;
                EX_STEP2(S0, S1, c4); EX_STEP2(S1, S2, c4 + 1); EX_STEP2(S2, S3, c4 + 2); EX_STEP2(S3, S0, c4 + 3); }
            int tl = tid; asm volatile("" : "+v"(tl)); const int g = (tl >> 4) & 3, fr = tl & 15;
#pragma unroll
            for (int rt = 0; rt < 4; ++rt) { const int row = 64 * wr + 16 * rt + fr; const float rw = wl[row];
                if (!(ABL & 32) && r0 + row < cnt_e) { bf16* yp = YP + (size_t)(slot0 + row) * D + 256 * np + 64 * wc + 4 * g;
#pragma unroll
                    for (int ct = 0; ct < 4; ++ct) { const f32x4 o = acc[rt][ct] * rw; v2u wv; wv.x = pk2(o[0], o[1]); wv.y = pk2(o[2], o[3]); *(v2u*)(yp + 16 * ct) = wv; } } }
            EX_ZERO();
        }
#undef EX_L1
#undef EX_C1S
#undef EX_PF1
#undef EX_PF2
#undef EX_W1
#undef EX_C1
#undef EX_STEP1
#undef EX_L2
#undef EX_W2
#undef EX_C2
#undef EX_STEP2
#undef EX_ZERO
#undef EX_GSYNC
        __syncthreads();
    }
    asm volatile("s_waitcnt vmcnt(0)" ::: "memory");
}

constexpr int E5_TOK = 2176, E5_W = 3200, E5_BUF = 4224, E5_BUFSZ = 37888, E5_BOFF = 20480;
static_assert(E5_BUF + 2 * E5_BUFSZ <= LDSCTL_OFF, "expert v5 LDS map");
struct E5Set { f32x4 w[4]; v4u a0, a1; };
__device__ __forceinline__ void expert_prefix256(Frame& F, LAS int* pref, LAS int* off) {
    if (F.wave == 0) { const unsigned* cnt = (const unsigned*)(F.ctl + CW_CNT); const int lane = F.lane;
        int c[4], nb[4]; int tc = 0, tb = 0;
#pragma unroll
        for (int j = 0; j < 4; ++j) { c[j] = (int)__hip_atomic_load(cnt + 64 * (4 * lane + j), RLX_AGENT); nb[j] = (c[j] + 255) >> 8; tc += c[j]; tb += nb[j]; }
        int xc = tc, xb = tb;
#pragma unroll
        for (int o = 1; o < 64; o <<= 1) { const int vc = __shfl_up(xc, o), vb = __shfl_up(xb, o); if (lane >= o) { xc += vc; xb += vb; } }
        int ec = xc - tc, eb = xb - tb;
#pragma unroll
        for (int j = 0; j < 4; ++j) { off[4 * lane + j] = ec; pref[4 * lane + j] = eb; ec += c[j]; eb += nb[j]; }
        if (lane == 63) { off[256] = ec; pref[256] = eb; } }
}
__device__ __forceinline__ void p11_experts_v5(Frame& F) {
    unsigned char* ws = F.ws; const bf16* H2 = (const bf16*)(ws + WS_HB); const int* LTOK = (const int*)(ws + WS_LTOK); const float* LW = (const float*)(ws + WS_LW); bf16* YP = (bf16*)(ws + WS_YP);
    bf16* Gs = (bf16*)(ws + WS_RETG) + (size_t)blockIdx.x * 65536;
    LAS int* pref = (LAS int*)(F.lds + EX_PREF); LAS int* off = (LAS int*)(F.lds + EX_OFF); LAS int* tokl = (LAS int*)(F.lds + E5_TOK); LAS float* wl = (LAS float*)(F.lds + E5_W);
    const int tid = F.tid, w = F.wave, wr = w >> 2, wc = w & 3;
    expert_prefix256(F, pref, off);
    __syncthreads();
    const int nitems = pref[256];
    for (int it = F.vcu; it < nitems; it += F.G) {
        int e = 0;
#pragma unroll
        for (int s = 128; s >= 1; s >>= 1) if (pref[e + s] <= it) e += s;
        e = __builtin_amdgcn_readfirstlane(e);
        const int rb = __builtin_amdgcn_readfirstlane(it - pref[e]), cnt_e = __builtin_amdgcn_readfirstlane(off[e + 1] - off[e]), r0 = rb * 256, slot0 = __builtin_amdgcn_readfirstlane(off[e]) + r0;
        if (tid < 256) { const int idx = r0 + tid; const bool ok = idx < cnt_e; tokl[tid] = LTOK[(size_t)e * CAP + (ok ? idx : r0)]; wl[tid] = ok ? LW[(size_t)e * CAP + idx] : 0.f; }
        __syncthreads();
        const float* Wg = F.w_eg + (size_t)e * D * EH; const float* Wu = F.w_eu + (size_t)e * D * EH; const float* Wd = F.w_ed + (size_t)e * EH * D;
        const bf16* asrc = H2 + (size_t)tokl[tid >> 1] * D + (tid & 1) * 16;
        const bf16* gsrc = Gs + (size_t)(tid >> 1) * 256 + (tid & 1) * 16;
        f32x4 acc[2][4][4];
#define E5_ZERO() do { _Pragma("unroll") for (int s_ = 0; s_ < 2; ++s_) _Pragma("unroll") for (int i = 0; i < 4; ++i) _Pragma("unroll") for (int j = 0; j < 4; ++j) acc[s_][i][j] = (f32x4){0.f, 0.f, 0.f, 0.f}; } while (0)
        E5_ZERO();
        E5Set S0, S1;
#define E5_WA(S, BUF, TL) do { *(LAS v4u*)((BUF) + ((TL) >> 1) * ASB + ((TL) & 1) * 32) = S.a0; *(LAS v4u*)((BUF) + ((TL) >> 1) * ASB + ((TL) & 1) * 32 + 16) = S.a1; } while (0)
#define E5_MMA(BUF, B0, B1, B2, B3, FR, G_) do { _Pragma("unroll") for (int s_ = 0; s_ < 2; ++s_) _Pragma("unroll") for (int rt = 0; rt < 4; ++rt) {                       \
            const bf16x8 af = ldfrag((BUF), 128 * s_ + 64 * wr + 16 * rt + (FR), ASB, 8 * (G_));                                                                          \
            acc[s_][rt][0] = MFMA16(B0, af, acc[s_][rt][0]); acc[s_][rt][1] = MFMA16(B1, af, acc[s_][rt][1]); acc[s_][rt][2] = MFMA16(B2, af, acc[s_][rt][2]); acc[s_][rt][3] = MFMA16(B3, af, acc[s_][rt][3]); } } while (0)
#define E5_L1(S, CC) do { const int cc_ = (CC) & 63, hp_ = cc_ >> 5, kc_ = cc_ & 31; int tl = tid; asm volatile("" : "+v"(tl));                         \
            unsigned o = (unsigned)((32 * kc_ + (tl >> 5)) * EH + 128 * hp_ + 4 * (tl & 31));                                                            \
            S.w[0] = *(const f32x4*)(Wg + o); S.w[1] = *(const f32x4*)(Wg + o + 16 * EH); S.w[2] = *(const f32x4*)(Wu + o); S.w[3] = *(const f32x4*)(Wu + o + 16 * EH); \
            S.a0 = *(const v4u*)(asrc + 32 * kc_); S.a1 = *(const v4u*)(asrc + 32 * kc_ + 8); } while (0)
#define E5_W1(S, BUF) do { int tl = tid; asm volatile("" : "+v"(tl)); LAS unsigned char* b_ = (BUF) + E5_BOFF + (tl >> 5) * KSB + 8 * (tl & 31); v2u p_[4];  \
            _Pragma("unroll") for (int i = 0; i < 4; ++i) { p_[i].x = pk2(S.w[i].x, S.w[i].y); p_[i].y = pk2(S.w[i].z, S.w[i].w); }                        \
            *(LAS v2u*)b_ = p_[0]; *(LAS v2u*)(b_ + 16 * KSB) = p_[1]; *(LAS v2u*)(b_ + 32 * KSB) = p_[2]; *(LAS v2u*)(b_ + 48 * KSB) = p_[3];             \
            E5_WA(S, BUF, tl); } while (0)
#define E5_C1(BUFI) do { int tl = tid; asm volatile("" : "+v"(tl)); const int g = (tl >> 4) & 3, fr = tl & 15, q = (tl & 15) >> 2, p = tl & 3;          \
            LAS unsigned char* buf = F.lds + E5_BUF + (BUFI) * E5_BUFSZ; const unsigned ta = F.ldsb + E5_BUF + (unsigned)((BUFI) * E5_BUFSZ + E5_BOFF + (8 * g + q) * KSB + (32 * wc + 4 * p) * 2); \
            bf16x8 b0, b1, b2, b3; tr_frag2<4 * KSB, 32>(ta, b0, b1); tr_frag2<4 * KSB, 32>(ta + 32 * KSB, b2, b3);                                       \
            E5_MMA(buf, b0, b1, b2, b3, fr, g); } while (0)
        E5Set S2;
#define E5_GW(HP) do { int tl = tid; asm volatile("" : "+v"(tl)); const int g = (tl >> 4) & 3, fr = tl & 15;     \
            _Pragma("unroll") for (int s_ = 0; s_ < 2; ++s_) _Pragma("unroll") for (int rt = 0; rt < 4; ++rt) _Pragma("unroll") for (int ct = 0; ct < 2; ++ct) { const f32x4 ga = acc[s_][rt][ct], ua = acc[s_][rt][ct + 2]; \
                v2u wv; wv.x = pk2(siluf_(ga[0]) * ua[0], siluf_(ga[1]) * ua[1]); wv.y = pk2(siluf_(ga[2]) * ua[2], siluf_(ga[3]) * ua[3]);                   \
                *(v2u*)(Gs + (size_t)(128 * s_ + 64 * wr + 16 * rt + fr) * 256 + 128 * (HP) + 32 * wc + 16 * ct + 4 * g) = wv; }                              \
            E5_ZERO(); } while (0)
#define E5_STEP1(SL, SW, CC) do { const int bi_ = (CC) & 1; E5_L1(SL, (CC) + 3); E5_C1(bi_); E5_W1(SW, F.lds + E5_BUF + (1 - bi_) * E5_BUFSZ); __syncthreads(); } while (0)
        E5_L1(S0, 0); E5_L1(S1, 1); E5_L1(S2, 2);
        E5_W1(S0, F.lds + E5_BUF);
        __syncthreads();
#pragma unroll 1
        for (int c3 = 0; c3 < 63; c3 += 3) {
            E5_STEP1(S0, S1, c3); E5_STEP1(S1, S2, c3 + 1);
            if (c3 == 30) E5_GW(0);
            E5_STEP1(S2, S0, c3 + 2);
        }
        E5_STEP1(S0, S1, 63);
        E5_GW(1);
#undef E5_STEP1
#undef E5_GW
        asm volatile("s_waitcnt vmcnt(0)" ::: "memory");
        __syncthreads();
#define E5_L2(S, CC) do { const int cc_ = (CC) & 31, np_ = cc_ >> 3, kc_ = cc_ & 7; int tl = tid; asm volatile("" : "+v"(tl));                           \
            unsigned o = (unsigned)((32 * kc_ + (tl >> 6)) * D + 256 * np_ + 4 * (tl & 63));                                                              \
            _Pragma("unroll") for (int i = 0; i < 4; ++i) S.w[i] = *(const f32x4*)(Wd + o + (unsigned)(8 * i * D));                                       \
            S.a0 = *(const v4u*)(gsrc + 32 * kc_); S.a1 = *(const v4u*)(gsrc + 32 * kc_ + 8); } while (0)
#define E5_W2(S, BUF) do { int tl = tid; asm volatile("" : "+v"(tl)); LAS unsigned char* b_ = (BUF) + E5_BOFF + (tl >> 6) * VSB + 8 * (tl & 63);          \
            _Pragma("unroll") for (int i = 0; i < 4; ++i) { v2u p_; p_.x = pk2(S.w[i].x, S.w[i].y); p_.y = pk2(S.w[i].z, S.w[i].w); *(LAS v2u*)(b_ + (8 * i) * VSB) = p_; } \
            E5_WA(S, BUF, tl); } while (0)
#define E5_C2(BUFI) do { int tl = tid; asm volatile("" : "+v"(tl)); const int g = (tl >> 4) & 3, fr = tl & 15, q = (tl & 15) >> 2, p = tl & 3;          \
            LAS unsigned char* buf = F.lds + E5_BUF + (BUFI) * E5_BUFSZ; const unsigned ta = F.ldsb + E5_BUF + (unsigned)((BUFI) * E5_BUFSZ + E5_BOFF + (8 * g + q) * VSB + (64 * wc + 4 * p) * 2); \
            bf16x8 b0, b1, b2, b3; tr_frag4<4 * VSB, 32>(ta, b0, b1, b2, b3);                                                                             \
            E5_MMA(buf, b0, b1, b2, b3, fr, g); } while (0)
        E5_L2(S0, 0); E5_L2(S1, 1);
        E5_W2(S0, F.lds + E5_BUF);
        __syncthreads();
#pragma unroll 1
        for (int np = 0; np < 4; ++np) {
#pragma unroll 1
            for (int h2 = 0; h2 < 8; h2 += 2) { const int c2 = 8 * np + h2;
                E5_L2(S0, c2 + 2); E5_C2(0); E5_W2(S1, F.lds + E5_BUF + E5_BUFSZ); __syncthreads();
                E5_L2(S1, c2 + 3); E5_C2(1); E5_W2(S0, F.lds + E5_BUF); __syncthreads(); }
            int tl = tid; asm volatile("" : "+v"(tl)); const int g = (tl >> 4) & 3, fr = tl & 15;
#pragma unroll
            for (int s_ = 0; s_ < 2; ++s_)
#pragma unroll
                for (int rt = 0; rt < 4; ++rt) { const int row = 128 * s_ + 64 * wr + 16 * rt + fr; const float rw = wl[row];
                    if (r0 + row < cnt_e) { bf16* yp = YP + (size_t)(slot0 + row) * D + 256 * np + 64 * wc + 4 * g;
#pragma unroll
                        for (int ct = 0; ct < 4; ++ct) { const f32x4 o = acc[s_][rt][ct] * rw; v2u wv; wv.x = pk2(o[0], o[1]); wv.y = pk2(o[2], o[3]); *(v2u*)(yp + 16 * ct) = wv; } } }
            E5_ZERO();
        }
#undef E5_L1
#undef E5_W1
#undef E5_C1
#undef E5_L2
#undef E5_W2
#undef E5_C2
#undef E5_MMA
#undef E5_WA
#undef E5_ZERO
        asm volatile("s_waitcnt vmcnt(0)" ::: "memory");
        __syncthreads();
    }
}

constexpr int E6_TOK = 2176, E6_W = 3200, E6_AR = 4224, E6_ASL = 16384, E6_BI = E6_AR + 4 * E6_ASL, E6_BSZ = 17408;
static_assert(E6_BI + 2 * E6_BSZ <= PF_OFF, "expert v6 LDS map");
__device__ __forceinline__ void dma16(const void* gsrc, unsigned lds_dst) {
    unsigned keep;
    asm volatile("s_mov_b32 %0, m0\n\ts_mov_b32 m0, %2\n\ts_nop 0\n\tglobal_load_lds_dwordx4 %1, off\n\ts_mov_b32 m0, %0" : "=&s"(keep) : "v"(gsrc), "s"(lds_dst) : "memory");
}
struct E6Set { f32x4 w[4]; };
__device__ __forceinline__ void p11_experts_v6(Frame& F) {
    unsigned char* ws = F.ws; const bf16* H2 = (const bf16*)(ws + WS_HB); const int* LTOK = (const int*)(ws + WS_LTOK); const float* LW = (const float*)(ws + WS_LW); bf16* YP = (bf16*)(ws + WS_YP);
    bf16* Gs = (bf16*)(ws + WS_RETG) + (size_t)blockIdx.x * 65536;
    LAS int* pref = (LAS int*)(F.lds + EX_PREF); LAS int* off = (LAS int*)(F.lds + EX_OFF); LAS int* tokl = (LAS int*)(F.lds + E6_TOK); LAS float* wl = (LAS float*)(F.lds + E6_W);
    const int tid = F.tid, w = F.wave, wr = w >> 2, wc = w & 3;
    expert_prefix256(F, pref, off);
    __syncthreads();
    const int nitems = pref[256];
    for (int it = F.vcu; it < nitems; it += F.G) {
        int e = 0;
#pragma unroll
        for (int s = 128; s >= 1; s >>= 1) if (pref[e + s] <= it) e += s;
        e = __builtin_amdgcn_readfirstlane(e);
        const int rb = __builtin_amdgcn_readfirstlane(it - pref[e]), cnt_e = __builtin_amdgcn_readfirstlane(off[e + 1] - off[e]), r0 = rb * 256, slot0 = __builtin_amdgcn_readfirstlane(off[e]) + r0;
        if (tid < 256) { const int idx = r0 + tid; const bool ok = idx < cnt_e; tokl[tid] = LTOK[(size_t)e * CAP + (ok ? idx : r0)]; wl[tid] = ok ? LW[(size_t)e * CAP + idx] : 0.f; }
        __syncthreads();
        const float* Wg = F.w_eg + (size_t)e * D * EH; const float* Wu = F.w_eu + (size_t)e * D * EH; const float* Wd = F.w_ed + (size_t)e * EH * D;
        int tli = tid; asm volatile("" : "+v"(tli));
        const int ln = tli & 63, arow0 = 32 * w + (ln >> 2), aseg = ((ln & 3) ^ ((ln >> 4) & 3)) * 8;
        const bf16* ap0 = H2 + (size_t)tokl[arow0] * D + aseg; const bf16* ap1 = H2 + (size_t)tokl[arow0 + 16] * D + aseg;
        f32x4 acc[2][4][4];
#define E6_ZERO() do { _Pragma("unroll") for (int s_ = 0; s_ < 2; ++s_) _Pragma("unroll") for (int i = 0; i < 4; ++i) _Pragma("unroll") for (int j = 0; j < 4; ++j) acc[s_][i][j] = (f32x4){0.f, 0.f, 0.f, 0.f}; } while (0)
        E6_ZERO();
        E6Set S0, S1, S2;
#define E6_ADMA(KOFF, CC) do { const unsigned sl_ = F.ldsb + E6_AR + (unsigned)(((CC) & 3) * E6_ASL + 2048 * w); const bf16* a0_ = ap0; const bf16* a1_ = ap1; asm volatile("" : "+v"(a0_), "+v"(a1_)); dma16(a0_ + (KOFF), sl_); dma16(a1_ + (KOFF), sl_ + 1024u); } while (0)
#define E6_MMA(C, B0, B1, B2, B3) do { int tl = tid; asm volatile("" : "+v"(tl)); const int g = (tl >> 4) & 3, fr = tl & 15, q = (tl & 15) >> 2;                              \
            const LAS unsigned char* ab_ = F.lds + E6_AR + ((C) & 3) * E6_ASL + (64 * wr + fr) * 64 + ((g ^ q) << 4);                                                      \
            _Pragma("unroll") for (int s_ = 0; s_ < 2; ++s_) { if (s_) __builtin_amdgcn_sched_barrier(0); _Pragma("unroll") for (int rt = 0; rt < 4; ++rt) {                \
                const bf16x8 af = *(const LAS bf16x8*)(ab_ + (128 * s_ + 16 * rt) * 64);                                                                                  \
                acc[s_][rt][0] = MFMA16(B0, af, acc[s_][rt][0]); acc[s_][rt][1] = MFMA16(B1, af, acc[s_][rt][1]); acc[s_][rt][2] = MFMA16(B2, af, acc[s_][rt][2]); acc[s_][rt][3] = MFMA16(B3, af, acc[s_][rt][3]); } } } while (0)
#define E6_L1(S, CC) do { const int cc_ = (CC) & 63, hp_ = cc_ >> 5, kc_ = cc_ & 31; int tl = tid; asm volatile("" : "+v"(tl));                         \
            E6_ADMA(32 * kc_, CC);                                                                                                                       \
            unsigned o = (unsigned)((32 * kc_ + (tl >> 5)) * EH + 128 * hp_ + 4 * (tl & 31));                                                            \
            S.w[0] = *(const f32x4*)(Wg + o); S.w[1] = *(const f32x4*)(Wg + o + 16 * EH); S.w[2] = *(const f32x4*)(Wu + o); S.w[3] = *(const f32x4*)(Wu + o + 16 * EH); } while (0)
#define E6_W1(S, CC) do { int tl = tid; asm volatile("" : "+v"(tl)); LAS unsigned char* b_ = F.lds + E6_BI + ((CC) & 1) * E6_BSZ + (tl >> 5) * KSB + 8 * (tl & 31); v2u p_[4];  \
            _Pragma("unroll") for (int i = 0; i < 4; ++i) { p_[i].x = pk2(S.w[i].x, S.w[i].y); p_[i].y = pk2(S.w[i].z, S.w[i].w); }                        \
            *(LAS v2u*)b_ = p_[0]; *(LAS v2u*)(b_ + 16 * KSB) = p_[1]; *(LAS v2u*)(b_ + 32 * KSB) = p_[2]; *(LAS v2u*)(b_ + 48 * KSB) = p_[3]; } while (0)
#define E6_C1(C) do { int tl = tid; asm volatile("" : "+v"(tl)); const int g = (tl >> 4) & 3, q = (tl & 15) >> 2, p = tl & 3;                            \
            const unsigned ta = F.ldsb + E6_BI + (unsigned)(((C) & 1) * E6_BSZ + (8 * g + q) * KSB + (32 * wc + 4 * p) * 2);                             \
            bf16x8 b0, b1, b2, b3; tr_frag2<4 * KSB, 32>(ta, b0, b1); tr_frag2<4 * KSB, 32>(ta + 32 * KSB, b2, b3);                                       \
            E6_MMA(C, b0, b1, b2, b3); } while (0)
#define E6_GW(HP) do { int tl = tid; asm volatile("" : "+v"(tl)); const int g = (tl >> 4) & 3, fr = tl & 15;     \
            _Pragma("unroll") for (int s_ = 0; s_ < 2; ++s_) _Pragma("unroll") for (int rt = 0; rt < 4; ++rt) _Pragma("unroll") for (int ct = 0; ct < 2; ++ct) { const f32x4 ga = acc[s_][rt][ct], ua = acc[s_][rt][ct + 2]; \
                v2u wv; wv.x = pk2(siluf_(ga[0]) * ua[0], siluf_(ga[1]) * ua[1]); wv.y = pk2(siluf_(ga[2]) * ua[2], siluf_(ga[3]) * ua[3]);                   \
                *(v2u*)(Gs + (size_t)(128 * s_ + 64 * wr + 16 * rt + fr) * 256 + 128 * (HP) + 32 * wc + 16 * ct + 4 * g) = wv; }                              \
            E6_ZERO(); } while (0)
#define E6_STEP1(SL, SW, C) do { if (!MK_LATE_ISSUE) { E6_L1(SL, (C) + 3); } E6_C1(C); E6_W1(SW, (C) + 1); if (((C) & 31) == 31) E6_GW((C) >> 5); if (MK_LATE_ISSUE) { E6_L1(SL, (C) + 3); } __syncthreads(); } while (0)
        E6_L1(S0, 0); E6_L1(S1, 1);
        E6_W1(S0, 0);
        E6_L1(S2, 2);
        __syncthreads();
#pragma unroll 1
        for (int c3 = 0; c3 < 63; c3 += 3) { E6_STEP1(S0, S1, c3); E6_STEP1(S1, S2, c3 + 1); E6_STEP1(S2, S0, c3 + 2); }
        E6_STEP1(S0, S1, 63);
        asm volatile("s_waitcnt vmcnt(0)" ::: "memory");
        __syncthreads();
        { int tl = tid; asm volatile("" : "+v"(tl)); const int l2_ = tl & 63, ar_ = 32 * w + (l2_ >> 2), as_ = ((l2_ & 3) ^ ((l2_ >> 4) & 3)) * 8; ap0 = Gs + (size_t)ar_ * 256 + as_; ap1 = Gs + (size_t)(ar_ + 16) * 256 + as_; }
#define E6_L2(S, CC) do { const int cc_ = (CC) & 31, np_ = cc_ >> 3, kc_ = cc_ & 7; int tl = tid; asm volatile("" : "+v"(tl));                           \
            E6_ADMA(32 * kc_, CC);                                                                                                                       \
            unsigned o = (unsigned)((32 * kc_ + (tl >> 6)) * D + 256 * np_ + 4 * (tl & 63));                                                              \
            _Pragma("unroll") for (int i = 0; i < 4; ++i) S.w[i] = *(const f32x4*)(Wd + o + (unsigned)(8 * i * D)); } while (0)
#define E6_W2(S, CC) do { int tl = tid; asm volatile("" : "+v"(tl)); LAS unsigned char* b_ = F.lds + E6_BI + ((CC) & 1) * E6_BSZ + (tl >> 6) * VSB + 8 * (tl & 63);  \
            _Pragma("unroll") for (int i = 0; i < 4; ++i) { v2u p_; p_.x = pk2(S.w[i].x, S.w[i].y); p_.y = pk2(S.w[i].z, S.w[i].w); *(LAS v2u*)(b_ + (8 * i) * VSB) = p_; } } while (0)
#define E6_C2(C) do { int tl = tid; asm volatile("" : "+v"(tl)); const int g = (tl >> 4) & 3, q = (tl & 15) >> 2, p = tl & 3;                            \
            const unsigned ta = F.ldsb + E6_BI + (unsigned)(((C) & 1) * E6_BSZ + (8 * g + q) * VSB + (64 * wc + 4 * p) * 2);                             \
            bf16x8 b0, b1, b2, b3; tr_frag4<4 * VSB, 32>(ta, b0, b1, b2, b3);                                                                             \
            E6_MMA(C, b0, b1, b2, b3); } while (0)
#define E6_YP(NP) do { int tl = tid; asm volatile("" : "+v"(tl)); const int g = (tl >> 4) & 3, fr = tl & 15;                                            \
            _Pragma("unroll") for (int s_ = 0; s_ < 2; ++s_) _Pragma("unroll") for (int rt = 0; rt < 4; ++rt) { const int row = 128 * s_ + 64 * wr + 16 * rt + fr; const float rw = wl[row]; \
                if (r0 + row < cnt_e) { bf16* yp = YP + (size_t)(slot0 + row) * D + 256 * (NP) + 64 * wc + 4 * g;                                         \
                    _Pragma("unroll") for (int ct = 0; ct < 4; ++ct) { const f32x4 o = acc[s_][rt][ct] * rw; v2u wv; wv.x = pk2(o[0], o[1]); wv.y = pk2(o[2], o[3]); *(v2u*)(yp + 16 * ct) = wv; } } } \
            E6_ZERO(); } while (0)
#define E6_STEP2(SL, SW, C) do { if (!MK_LATE_ISSUE) { E6_L2(SL, (C) + 3); } E6_C2(C); E6_W2(SW, (C) + 1); if (((C) & 7) == 7) E6_YP((C) >> 3); if (MK_LATE_ISSUE) { E6_L2(SL, (C) + 3); } __syncthreads(); } while (0)
        E6_L2(S0, 0); E6_L2(S1, 1);
        E6_W2(S0, 0);
        E6_L2(S2, 2);
        __syncthreads();
#pragma unroll 1
        for (int c3 = 0; c3 < 30; c3 += 3) { E6_STEP2(S0, S1, c3); E6_STEP2(S1, S2, c3 + 1); E6_STEP2(S2, S0, c3 + 2); }
        E6_STEP2(S0, S1, 30); E6_STEP2(S1, S2, 31);
#undef E6_L1
#undef E6_W1
#undef E6_C1
#undef E6_GW
#undef E6_STEP1
#undef E6_L2
#undef E6_W2
#undef E6_C2
#undef E6_YP
#undef E6_STEP2
#undef E6_MMA
#undef E6_ADMA
#undef E6_ZERO
        asm volatile("s_waitcnt vmcnt(0)" ::: "memory");
        __syncthreads();
    }
}

constexpr int E7_BUF = 3200, E7_BUFSZ = 53248, E7_BOFF = 18432, E7_ASB = 144;
static_assert(E7_BUF + 2 * E7_BUFSZ <= PF_OFF, "expert v7 LDS map");
struct E7Set { f32x4 w[8]; v4u a0, a1; };
struct E7Frag { bf16x8 a[4]; s16x4 l[4], h[4]; };
template <int STAGE> __device__ __forceinline__ void e7_stage(Frame& F, const float* Wg, const float* Wu, const float* Wd, const bf16* arow, bf16* Gs, bf16* YP, LAS float* wl, int r0, int cnt_e, int slot0) {
    const int tid = F.tid, w = F.wave, wr = w >> 2, wc = w & 3;
    constexpr int NC = STAGE == 0 ? 32 : 16;
    f32x4 acc[4][4];
#define E7_ZERO() do { _Pragma("unroll") for (int i = 0; i < 4; ++i) _Pragma("unroll") for (int j = 0; j < 4; ++j) acc[i][j] = (f32x4){0.f, 0.f, 0.f, 0.f}; } while (0)
    E7_ZERO();
    E7Set S0, S1;
#define E7_LD(S, CC) do { int tl = tid; asm volatile("" : "+v"(tl)); const int cc_ = (CC) & (NC - 1);                                                           \
        if (STAGE == 0) { const int hp_ = cc_ >> 4, kc_ = cc_ & 15; unsigned o = (unsigned)((64 * kc_ + (tl >> 5)) * EH + 128 * hp_ + 4 * (tl & 31));            \
            _Pragma("unroll") for (int i = 0; i < 4; ++i) { S.w[i] = *(const f32x4*)(Wg + o + (unsigned)(16 * i * EH)); S.w[4 + i] = *(const f32x4*)(Wu + o + (unsigned)(16 * i * EH)); } \
            S.a0 = *(const v4u*)(arow + 64 * kc_); S.a1 = *(const v4u*)(arow + 64 * kc_ + 8);                                                                      \
        } else { const int np_ = cc_ >> 2, kc_ = cc_ & 3; unsigned o = (unsigned)((64 * kc_ + (tl >> 6)) * D + 256 * np_ + 4 * (tl & 63));                         \
            _Pragma("unroll") for (int i = 0; i < 8; ++i) S.w[i] = *(const f32x4*)(Wd + o + (unsigned)(8 * i * D));                                                  \
            S.a0 = *(const v4u*)(arow + 64 * kc_); S.a1 = *(const v4u*)(arow + 64 * kc_ + 8); } } while (0)
#define E7_WR(S, BI) do { int tl = tid; asm volatile("" : "+v"(tl)); LAS unsigned char* buf_ = F.lds + E7_BUF + (BI) * E7_BUFSZ;                                  \
        if (STAGE == 0) { LAS unsigned char* b_ = buf_ + E7_BOFF + (tl >> 5) * KSB + 8 * (tl & 31);                                                                \
            _Pragma("unroll") for (int i = 0; i < 4; ++i) { v2u pg, pu; pg.x = pk2(S.w[i].x, S.w[i].y); pg.y = pk2(S.w[i].z, S.w[i].w); pu.x = pk2(S.w[4 + i].x, S.w[4 + i].y); pu.y = pk2(S.w[4 + i].z, S.w[4 + i].w); \
                *(LAS v2u*)(b_ + (16 * i) * KSB) = pg; *(LAS v2u*)(b_ + (64 + 16 * i) * KSB) = pu; }                                                                \
        } else { LAS unsigned char* b_ = buf_ + E7_BOFF + (tl >> 6) * VSB + 8 * (tl & 63);                                                                          \
            _Pragma("unroll") for (int i = 0; i < 8; ++i) { v2u p_; p_.x = pk2(S.w[i].x, S.w[i].y); p_.y = pk2(S.w[i].z, S.w[i].w); *(LAS v2u*)(b_ + (8 * i) * VSB) = p_; } } \
        *(LAS v4u*)(buf_ + (tl >> 2) * E7_ASB + (tl & 3) * 32) = S.a0; *(LAS v4u*)(buf_ + (tl >> 2) * E7_ASB + (tl & 3) * 32 + 16) = S.a1; } while (0)
    int tlc = tid; asm volatile("" : "+v"(tlc)); const int g = (tlc >> 4) & 3, fr = tlc & 15, q = (tlc & 15) >> 2, p = tlc & 3;
    const unsigned aoff = F.ldsb + E7_BUF + (unsigned)((64 * wr + fr) * E7_ASB + 16 * g);
    const unsigned boff = F.ldsb + E7_BUF + (unsigned)(E7_BOFF + (STAGE == 0 ? (8 * g + q) * KSB + (32 * wc + 4 * p) * 2 : (8 * g + q) * VSB + (64 * wc + 4 * p) * 2));
    constexpr int RS = STAGE == 0 ? KSB : VSB;
#define E7_ISSUE(FS, BI, HS) do { const unsigned aa_ = aoff + (unsigned)((BI) * E7_BUFSZ + 64 * (HS)), bb_ = boff + (unsigned)((BI) * E7_BUFSZ + 32 * (HS) * RS);       \
        asm volatile("ds_read_b128 %0, %4\n\tds_read_b128 %1, %4 offset:%5\n\tds_read_b128 %2, %4 offset:%6\n\tds_read_b128 %3, %4 offset:%7"                         \
            : "=&v"(FS.a[0]), "=&v"(FS.a[1]), "=&v"(FS.a[2]), "=&v"(FS.a[3]) : "v"(aa_), "i"(16 * E7_ASB), "i"(32 * E7_ASB), "i"(48 * E7_ASB) : "memory");            \
        asm volatile("ds_read_b64_tr_b16 %0, %8\n\tds_read_b64_tr_b16 %1, %8 offset:%9\n\tds_read_b64_tr_b16 %2, %8 offset:%10\n\tds_read_b64_tr_b16 %3, %8 offset:%11\n\t" \
                     "ds_read_b64_tr_b16 %4, %8 offset:%12\n\tds_read_b64_tr_b16 %5, %8 offset:%13\n\tds_read_b64_tr_b16 %6, %8 offset:%14\n\tds_read_b64_tr_b16 %7, %8 offset:%15" \
            : "=&v"(FS.l[0]), "=&v"(FS.h[0]), "=&v"(FS.l[1]), "=&v"(FS.h[1]), "=&v"(FS.l[2]), "=&v"(FS.h[2]), "=&v"(FS.l[3]), "=&v"(FS.h[3])                              \
            : "v"(bb_), "i"(4 * RS), "i"(32), "i"(32 + 4 * RS), "i"(STAGE == 0 ? 64 * KSB : 64), "i"(STAGE == 0 ? 64 * KSB + 4 * KSB : 64 + 4 * VSB),                     \
              "i"(STAGE == 0 ? 64 * KSB + 32 : 96), "i"(STAGE == 0 ? 64 * KSB + 32 + 4 * KSB : 96 + 4 * VSB) : "memory"); } while (0)
#define E7_WAIT(FS) do { asm volatile("s_waitcnt lgkmcnt(0)" : "+v"(FS.a[0]), "+v"(FS.a[1]), "+v"(FS.a[2]), "+v"(FS.a[3]), "+v"(FS.l[0]), "+v"(FS.h[0]), "+v"(FS.l[1]), "+v"(FS.h[1]), "+v"(FS.l[2]), "+v"(FS.h[2]), "+v"(FS.l[3]), "+v"(FS.h[3]) :: "memory"); } while (0)
#define E7_MMA(FS) do { _Pragma("unroll") for (int ct = 0; ct < 4; ++ct) { const bf16x8 bb = __builtin_shufflevector(FS.l[ct], FS.h[ct], 0, 1, 2, 3, 4, 5, 6, 7);     \
            _Pragma("unroll") for (int rt = 0; rt < 4; ++rt) acc[rt][ct] = MFMA16(bb, FS.a[rt], acc[rt][ct]); } } while (0)
#define E7_COMPUTE(BI) do { E7Frag Fa, Fb; E7_ISSUE(Fa, BI, 0); E7_WAIT(Fa); E7_ISSUE(Fb, BI, 1); __builtin_amdgcn_sched_barrier(0); E7_MMA(Fa); __builtin_amdgcn_sched_barrier(0); E7_WAIT(Fb); E7_MMA(Fb); } while (0)
#define E7_EPI(C) do { if (STAGE == 0) { if (((C) & 15) == 15) { const int hp = (C) >> 4;     \
                _Pragma("unroll") for (int rt = 0; rt < 4; ++rt) _Pragma("unroll") for (int ct = 0; ct < 2; ++ct) { const f32x4 ga = acc[rt][ct], ua = acc[rt][ct + 2];               \
                    v2u wv; wv.x = pk2(siluf_(ga[0]) * ua[0], siluf_(ga[1]) * ua[1]); wv.y = pk2(siluf_(ga[2]) * ua[2], siluf_(ga[3]) * ua[3]);                                  \
                    *(v2u*)(Gs + (size_t)(64 * wr + 16 * rt + fr) * 256 + 128 * hp + 32 * wc + 16 * ct + 4 * g) = wv; }                                                          \
                E7_ZERO(); }                                                                                                                                                      \
        } else if (((C) & 3) == 3) { const int np = (C) >> 2;                                                                                                                     \
            _Pragma("unroll") for (int rt = 0; rt < 4; ++rt) { const int row = 64 * wr + 16 * rt + fr; const float rw = wl[row];                                                  \
                if (r0 + row < cnt_e) { bf16* yp = YP + (size_t)(slot0 + row) * D + 256 * np + 64 * wc + 4 * g;                                                                  \
                    _Pragma("unroll") for (int ct = 0; ct < 4; ++ct) { const f32x4 o = acc[rt][ct] * rw; v2u wv; wv.x = pk2(o[0], o[1]); wv.y = pk2(o[2], o[3]); *(v2u*)(yp + 16 * ct) = wv; } } } \
            E7_ZERO(); } } while (0)
    E7_LD(S0, 0); E7_LD(S1, 1);
    E7_WR(S0, 0);
    __syncthreads();
#pragma unroll 1
    for (int c2 = 0; c2 < NC; c2 += 2) {
        E7_LD(S0, c2 + 2); E7_COMPUTE(0); E7_WR(S1, 1); E7_EPI(c2); __syncthreads();
        E7_LD(S1, c2 + 3); E7_COMPUTE(1); E7_WR(S0, 0); E7_EPI(c2 + 1); __syncthreads();
    }
#undef E7_ZERO
#undef E7_LD
#undef E7_WR
#undef E7_ISSUE
#undef E7_WAIT
#undef E7_MMA
#undef E7_COMPUTE
#undef E7_EPI
}
__device__ __forceinline__ void p11_experts_v7(Frame& F) {
    unsigned char* ws = F.ws; const bf16* H2 = (const bf16*)(ws + WS_HB); const int* LTOK = (const int*)(ws + WS_LTOK); const float* LW = (const float*)(ws + WS_LW); bf16* YP = (bf16*)(ws + WS_YP);
    bf16* Gs = (bf16*)(ws + WS_RETG) + (size_t)blockIdx.x * 32768;
    LAS int* pref = (LAS int*)(F.lds + EX_PREF); LAS int* off = (LAS int*)(F.lds + EX_OFF); LAS int* tokl = (LAS int*)(F.lds + EX_TOK); LAS float* wl = (LAS float*)(F.lds + EX_W);
    const int tid = F.tid;
    expert_prefix(F, pref, off);
    __syncthreads();
    const int nitems = pref[256];
    for (int it = F.vcu; it < nitems; it += F.G) {
        int e = 0;
#pragma unroll
        for (int s = 128; s >= 1; s >>= 1) if (pref[e + s] <= it) e += s;
        e = __builtin_amdgcn_readfirstlane(e);
        const int rb = __builtin_amdgcn_readfirstlane(it - pref[e]), cnt_e = __builtin_amdgcn_readfirstlane(off[e + 1] - off[e]), r0 = rb * 128, slot0 = __builtin_amdgcn_readfirstlane(off[e]) + r0;
        if (tid < 128) { const int idx = r0 + tid; const bool ok = idx < cnt_e; tokl[tid] = LTOK[(size_t)e * CAP + (ok ? idx : r0)]; wl[tid] = ok ? LW[(size_t)e * CAP + idx] : 0.f; }
        __syncthreads();
        const float* Wg = F.w_eg + (size_t)e * D * EH; const float* Wu = F.w_eu + (size_t)e * D * EH; const float* Wd = F.w_ed + (size_t)e * EH * D;
        int tli = tid; asm volatile("" : "+v"(tli));
        e7_stage<0>(F, Wg, Wu, Wd, H2 + (size_t)tokl[tli >> 2] * D + (tli & 3) * 16, Gs, YP, wl, r0, cnt_e, slot0);
        asm volatile("s_waitcnt vmcnt(0)" ::: "memory");
        __syncthreads();
        e7_stage<1>(F, Wg, Wu, Wd, Gs + (size_t)(tli >> 2) * 256 + (tli & 3) * 16, Gs, YP, wl, r0, cnt_e, slot0);
        asm volatile("s_waitcnt vmcnt(0)" ::: "memory");
        __syncthreads();
    }
}

constexpr int K6_A = 3200, K6_BG = 21632, K6_BU = 39040, K6_G = 56448;
constexpr int ASB6 = 144;
#define K6MM(a, b, c) ((ABL & 1) ? k6_keep((a), (b), (c)) : MFMA16((a), (b), (c)))
__device__ __forceinline__ f32x4 k6_keep(bf16x8 a, bf16x8 b, f32x4 c) { asm volatile("" :: "v"(a), "v"(b)); return c; }
struct K6Set { f32x4 w[8]; v4u a0, a1; };
template <int ABL> __device__ __forceinline__ void p11_experts_k64(Frame& F) {
    unsigned char* ws = F.ws; const bf16* H2 = (const bf16*)(ws + WS_HB); const int* LTOK = (const int*)(ws + WS_LTOK); const float* LW = (const float*)(ws + WS_LW); bf16* YP = (bf16*)(ws + WS_YP);
    LAS int* pref = (LAS int*)(F.lds + EX_PREF); LAS int* off = (LAS int*)(F.lds + EX_OFF); LAS int* tokl = (LAS int*)(F.lds + EX_TOK); LAS float* wl = (LAS float*)(F.lds + EX_W);
    LAS unsigned char* Aimg = F.lds + K6_A; LAS unsigned char* Gimg = F.lds + K6_G;
    const int tid = F.tid, w = F.wave, wr = w >> 2, wc = w & 3;
    expert_prefix(F, pref, off);
    __syncthreads();
    const int nitems = pref[256];
    for (int it = F.vcu; it < nitems; it += F.G) {
        int e = 0;
#pragma unroll
        for (int s = 128; s >= 1; s >>= 1) if (pref[e + s] <= it) e += s;
        e = __builtin_amdgcn_readfirstlane(e);
        const int rb = __builtin_amdgcn_readfirstlane(it - pref[e]), cnt_e = __builtin_amdgcn_readfirstlane(off[e + 1] - off[e]), r0 = rb * 128, slot0 = __builtin_amdgcn_readfirstlane(off[e]) + r0;
        if (tid < 128) { const int idx = r0 + tid; const bool ok = idx < cnt_e; tokl[tid] = LTOK[(size_t)e * CAP + (ok ? idx : r0)]; wl[tid] = ok ? LW[(size_t)e * CAP + idx] : 0.f; }
        __syncthreads();
        const int ew = e;
        const float* Wg = F.w_eg + (size_t)ew * D * EH; const float* Wu = F.w_eu + (size_t)ew * D * EH; const float* Wd = F.w_ed + (size_t)ew * EH * D;
        const bf16* asrc = H2 + (size_t)tokl[tid >> 2] * D + (tid & 3) * 16;
        f32x4 acc[4][4];
#pragma unroll
        for (int i = 0; i < 4; ++i)
#pragma unroll
            for (int j = 0; j < 4; ++j) acc[i][j] = (f32x4){0.f, 0.f, 0.f, 0.f};
        K6Set S0, S1;
        if constexpr (ABL & 16) {
#pragma unroll
            for (int i = 0; i < 8; ++i) { S0.w[i] = (f32x4){1.f, 1.f, 1.f, 1.f}; S1.w[i] = (f32x4){1.f, 1.f, 1.f, 1.f}; } S0.a0 = S0.a1 = S1.a0 = S1.a1 = (v4u){0u, 0u, 0u, 0u}; }
#define K6_LOAD1(S, CC) do { const int cc_ = (CC) & 31, hp_ = cc_ >> 4, kc_ = cc_ & 15; int tl = tid; asm volatile("" : "+v"(tl));                      \
            unsigned o = (unsigned)((64 * kc_ + (tl >> 5)) * EH + 128 * hp_ + 4 * (tl & 31));                                                            \
            if constexpr (!(ABL & 16)) { _Pragma("unroll") for (int i = 0; i < 4; ++i) { S.w[i] = *(const f32x4*)(Wg + o + (unsigned)(16 * i * EH)); S.w[4 + i] = *(const f32x4*)(Wu + o + (unsigned)(16 * i * EH)); } \
            S.a0 = *(const v4u*)(asrc + 64 * kc_); S.a1 = *(const v4u*)(asrc + 64 * kc_ + 8); } } while (0)
#define K6_STEP1(S, CC) do { int tl = tid; asm volatile("" : "+v"(tl)); const int g = (tl >> 4) & 3, fr = tl & 15, q = (tl & 15) >> 2, p = tl & 3;    \
            if constexpr (!(ABL & 8)) __syncthreads();                                                                                                       \
            if constexpr (!(ABL & 2)) { *(LAS v4u*)(Aimg + (tl >> 2) * ASB6 + (tl & 3) * 32) = S.a0; *(LAS v4u*)(Aimg + (tl >> 2) * ASB6 + (tl & 3) * 32 + 16) = S.a1; }            \
            if constexpr (!(ABL & 2)) _Pragma("unroll") for (int i = 0; i < 4; ++i) { v2u wg, wu; wg.x = pk2(S.w[i].x, S.w[i].y); wg.y = pk2(S.w[i].z, S.w[i].w); wu.x = pk2(S.w[4 + i].x, S.w[4 + i].y); wu.y = pk2(S.w[4 + i].z, S.w[4 + i].w); \
                *(LAS v2u*)(F.lds + K6_BG + ((tl >> 5) + 16 * i) * KSB + 8 * (tl & 31)) = wg; *(LAS v2u*)(F.lds + K6_BU + ((tl >> 5) + 16 * i) * KSB + 8 * (tl & 31)) = wu; } \
            if constexpr (!(ABL & 8)) __syncthreads();                                                                                                       \
            K6_LOAD1(S, (CC) + 2);                                                                                                                       \
            const unsigned bga = F.ldsb + K6_BG + (unsigned)((8 * g + q) * KSB + (32 * wc + 4 * p) * 2), bua = bga + (K6_BU - K6_BG);                   \
            if constexpr (!(ABL & 4)) _Pragma("unroll") for (int s = 0; s < 2; ++s) { bf16x8 af[4];                                                                                \
                _Pragma("unroll") for (int rt = 0; rt < 4; ++rt) af[rt] = ldfrag(Aimg, 64 * wr + 16 * rt + fr, ASB6, 32 * s + 8 * g);                    \
                bf16x8 b0, b1, b2, b3; tr_frag2<4 * KSB, 32>(bga + s * 32 * KSB, b0, b1); tr_frag2<4 * KSB, 32>(bua + s * 32 * KSB, b2, b3);             \
                _Pragma("unroll") for (int rt = 0; rt < 4; ++rt) { acc[rt][0] = K6MM(b0, af[rt], acc[rt][0]); acc[rt][1] = K6MM(b1, af[rt], acc[rt][1]); acc[rt][2] = K6MM(b2, af[rt], acc[rt][2]); acc[rt][3] = K6MM(b3, af[rt], acc[rt][3]); } } } while (0)
        K6_LOAD1(S0, 0); K6_LOAD1(S1, 1);
#pragma unroll 1
        for (int cc = 0; cc < 32; cc += 2) {
            K6_STEP1(S0, cc); K6_STEP1(S1, cc + 1);
            if ((cc & 15) == 14) { const int hp = cc >> 4; int tl = tid; asm volatile("" : "+v"(tl)); const int g = (tl >> 4) & 3, fr = tl & 15;
#pragma unroll
                for (int rt = 0; rt < 4; ++rt)
#pragma unroll
                    for (int ct = 0; ct < 2; ++ct) { const f32x4 ga = acc[rt][ct], ua = acc[rt][ct + 2];
                        v2u wv; wv.x = pk2(siluf_(ga[0]) * ua[0], siluf_(ga[1]) * ua[1]); wv.y = pk2(siluf_(ga[2]) * ua[2], siluf_(ga[3]) * ua[3]);
                        *(LAS v2u*)(Gimg + (64 * wr + 16 * rt + fr) * VSB + (128 * hp + 32 * wc + 16 * ct + 4 * g) * 2) = wv; }
#pragma unroll
                for (int i = 0; i < 4; ++i)
#pragma unroll
                    for (int j = 0; j < 4; ++j) acc[i][j] = (f32x4){0.f, 0.f, 0.f, 0.f}; }
        }
#undef K6_STEP1
#undef K6_LOAD1
#define K6_LOAD2(S, CC) do { const int cc_ = (CC) & 15, np_ = cc_ >> 2, kc_ = cc_ & 3; int tl = tid; asm volatile("" : "+v"(tl));                       \
            unsigned o = (unsigned)((64 * kc_ + (tl >> 6)) * D + 256 * np_ + 4 * (tl & 63));                                                             \
            if constexpr (!(ABL & 16)) { _Pragma("unroll") for (int i = 0; i < 8; ++i) S.w[i] = *(const f32x4*)(Wd + o + (unsigned)(8 * i * D)); } } while (0)
#define K6_STEP2(S, CC, KC) do { int tl = tid; asm volatile("" : "+v"(tl)); const int g = (tl >> 4) & 3, fr = tl & 15, q = (tl & 15) >> 2, p = tl & 3; \
            if constexpr (!(ABL & 8)) __syncthreads();                                                                                                       \
            if constexpr (!(ABL & 2)) _Pragma("unroll") for (int i = 0; i < 8; ++i) { v2u wd; wd.x = pk2(S.w[i].x, S.w[i].y); wd.y = pk2(S.w[i].z, S.w[i].w); *(LAS v2u*)(F.lds + K6_BG + ((tl >> 6) + 8 * i) * VSB + 8 * (tl & 63)) = wd; } \
            if constexpr (!(ABL & 8)) __syncthreads();                                                                                                       \
            K6_LOAD2(S, (CC) + 2);                                                                                                                       \
            const unsigned bda = F.ldsb + K6_BG + (unsigned)((8 * g + q) * VSB + (64 * wc + 4 * p) * 2);                                                \
            if constexpr (!(ABL & 4)) _Pragma("unroll") for (int s = 0; s < 2; ++s) { bf16x8 gf[4];                                                                                \
                _Pragma("unroll") for (int rt = 0; rt < 4; ++rt) gf[rt] = ldfrag(Gimg, 64 * wr + 16 * rt + fr, VSB, 64 * (KC) + 32 * s + 8 * g);        \
                bf16x8 b0, b1, b2, b3; tr_frag4<4 * VSB, 32>(bda + s * 32 * VSB, b0, b1, b2, b3);                                                        \
                _Pragma("unroll") for (int rt = 0; rt < 4; ++rt) { acc[rt][0] = K6MM(b0, gf[rt], acc[rt][0]); acc[rt][1] = K6MM(b1, gf[rt], acc[rt][1]); acc[rt][2] = K6MM(b2, gf[rt], acc[rt][2]); acc[rt][3] = K6MM(b3, gf[rt], acc[rt][3]); } } } while (0)
        K6_LOAD2(S0, 0); K6_LOAD2(S1, 1);
#pragma unroll 1
        for (int np = 0; np < 4; ++np) {
            K6_STEP2(S0, 4 * np, 0); K6_STEP2(S1, 4 * np + 1, 1); K6_STEP2(S0, 4 * np + 2, 2); K6_STEP2(S1, 4 * np + 3, 3);
            int tl = tid; asm volatile("" : "+v"(tl)); const int g = (tl >> 4) & 3, fr = tl & 15;
#pragma unroll
            for (int rt = 0; rt < 4; ++rt) { const int row = 64 * wr + 16 * rt + fr; const float rw = wl[row];
                if (!(ABL & 32) && r0 + row < cnt_e) { bf16* yp = YP + (size_t)(slot0 + row) * D + 256 * np + 64 * wc + 4 * g;
#pragma unroll
                    for (int ct = 0; ct < 4; ++ct) { const f32x4 o = acc[rt][ct] * rw; v2u wv; wv.x = pk2(o[0], o[1]); wv.y = pk2(o[2], o[3]); *(v2u*)(yp + 16 * ct) = wv; } } }
#pragma unroll
            for (int i = 0; i < 4; ++i)
#pragma unroll
                for (int j = 0; j < 4; ++j) acc[i][j] = (f32x4){0.f, 0.f, 0.f, 0.f};
        }
#undef K6_STEP2
#undef K6_LOAD2
        __syncthreads();
    }
}

#undef K6MM
__device__ __forceinline__ void p12_final(Frame& F) {
    unsigned char* ws = F.ws; const float* X1 = (const float*)(ws + (MK_SKIP_SHARED ? WS_X1 : WS_MIXP)); const bf16* YP = (const bf16*)(ws + WS_YP); const int* EIDX = (const int*)(ws + WS_EIDX); const int* POS = (const int*)(ws + WS_POS);
    const float* mod = (const float*)(ws + WS_MOD);
    LAS int* pref = (LAS int*)(F.lds + EX_PREF); LAS int* off = (LAS int*)(F.lds + EX_OFF);
    expert_prefix(F, pref, off);
    __syncthreads();
    const int lane = F.lane;
    const int gw = F.vcu * NWAVES + F.wave, NGW = F.G * NWAVES;
    f32x4 gn[4];
#pragma unroll
    for (int j = 0; j < 4; ++j) gn[j] = *(const f32x4*)(F.norm_final_g + 512 * (j >> 1) + 8 * lane + 4 * (j & 1));
    for (int t = gw; t < M; t += NGW) {
        const int b = t >> 13;
        f32x4 y[4];
#pragma unroll
        for (int j = 0; j < 4; ++j) y[j] = (f32x4){0.f, 0.f, 0.f, 0.f};
#if !MK_SKIP_ROUTED
        int myslot = 0;
        if (lane < 8) myslot = off[EIDX[t * 8 + lane]] + POS[t * 8 + lane];
        v4u yv[8][2];
#pragma unroll
        for (int k = 0; k < 8; ++k) { const int slot = __shfl(myslot, k); const v4u* yp = (const v4u*)(YP + (size_t)slot * D) + lane; yv[k][0] = yp[0]; yv[k][1] = yp[64]; }
#pragma unroll
        for (int k = 0; k < 8; ++k)
#pragma unroll
            for (int hh = 0; hh < 2; ++hh) { const v4u v = yv[k][hh];
                y[2 * hh] += (f32x4){bflo(v.x), bfhi(v.x), bflo(v.y), bfhi(v.y)}; y[2 * hh + 1] += (f32x4){bflo(v.z), bfhi(v.z), bflo(v.w), bfhi(v.w)}; }
#endif
        f32x4 v[4]; float ss = 0.f;
#pragma unroll
        for (int j = 0; j < 4; ++j) { const int col = 512 * (j >> 1) + 8 * lane + 4 * (j & 1);
            const f32x4 g2 = *(const f32x4*)(mod + b * NMOD + 5 * D + col); v[j] = *(const f32x4*)(X1 + (size_t)t * D + col) + g2 * y[j];
            ss += (v[j].x * v[j].x + v[j].y * v[j].y) + (v[j].z * v[j].z + v[j].w * v[j].w); }
        const float rstd = 1.0f / sqrtf(wave_sum(ss) * (1.0f / D) + EPS);
#pragma unroll
        for (int j = 0; j < 4; ++j) { const int col = 512 * (j >> 1) + 8 * lane + 4 * (j & 1); *(f32x4*)(F.out + (size_t)t * D + col) = v[j] * rstd * gn[j]; }
    }
}

struct Args { const void* in[22]; float* out; unsigned char* ws; int ph_lo, ph_hi, li, abl; };
__global__ void __launch_bounds__(NT, 2) mk_fwd(Args args) {
    extern __shared__ __attribute__((aligned(16))) unsigned char lds[];
    Frame F;
    F.lds = (LAS unsigned char*)lds; F.ldsb = (unsigned)(size_t)F.lds;
    F.MISC = (volatile LAS unsigned*)(F.lds + MISC_OFF);
    F.tid = threadIdx.x; F.lane = F.tid & 63; F.wave = __builtin_amdgcn_readfirstlane(F.tid >> 6);
    F.G = gridDim.x; { const int bx = blockIdx.x; F.vcu = (F.G % 8 == 0) ? (bx % 8) * (F.G / 8) + bx / 8 : bx; }
    F.abl = MK_ABL_RT ? args.abl : 0;
    unsigned char* ws = args.ws; F.ws = ws; F.ctl = (gu32*)(ws + WS_CTL); F.out = args.out;
    F.x = (const float*)args.in[0]; F.c = (const float*)args.in[1]; F.pos = (const int*)args.in[2]; F.w_ada = (const float*)args.in[3]; F.b_ada = (const float*)args.in[4];
    F.norm_mix_g = (const float*)args.in[5]; F.w_in = (const float*)args.in[6]; F.ret_norm_g = (const float*)args.in[7]; F.conv_w = (const float*)args.in[8];
    F.w_br_ret = (const float*)args.in[9]; F.w_br_conv = (const float*)args.in[10]; F.w_out = (const float*)args.in[11]; F.norm_ffn_g = (const float*)args.in[12];
    F.w_router = (const float*)args.in[13]; F.router_bias = (const float*)args.in[14]; F.w_eg = (const float*)args.in[15]; F.w_eu = (const float*)args.in[16]; F.w_ed = (const float*)args.in[17];
    F.w_sg = (const float*)args.in[18]; F.w_su = (const float*)args.in[19]; F.w_sd = (const float*)args.in[20]; F.norm_final_g = (const float*)args.in[21];
    for (int u = F.tid; u < (LDS_BYTES - LDSCTL_OFF) / 4; u += NT) ((LAS unsigned*)(F.lds + LDSCTL_OFF))[u] = 0u;
    __syncthreads();
    XcdBarrier bar; bar.bar = (unsigned*)(F.ctl + CW_BAR) + args.li * XCD_BAR_WORDS; bar.x = 0; bar.st = nullptr;
    if (!MK_PER_PHASE) bar = xcd_barrier_post((unsigned*)(F.ctl + CW_BAR) + args.li * XCD_BAR_WORDS, F.MISC + 8);
    const int lo = args.ph_lo, hi = args.ph_hi;
#ifndef MK_PHASE_MASK
#define MK_PHASE_MASK 0x1fff
#endif
#define IN(k) (((MK_PHASE_MASK >> (k)) & 1) && lo <= (k) && (k) < hi)
#ifndef MK_BAR_REP
#define MK_BAR_REP 1
#endif
#define SEAM(k) do { if (IN(k) && IN((k) + 1)) { for (int br_ = 0; br_ < MK_BAR_REP; ++br_) xcd_barrier(bar); } } while (0)
#ifndef MK_DOUBLE_MASK
#define MK_DOUBLE_MASK 0
#endif
#define REP(k) for (int rep_ = 0; rep_ < (((MK_DOUBLE_MASK >> (k)) & 1) ? 2 : 1); ++rep_, (((MK_DOUBLE_MASK >> (k)) & 1) && rep_ == 1 ? xcd_barrier(bar) : (void)0))
    bf16* HB = (bf16*)(ws + WS_HB); bf16* PROJ = (bf16*)(ws + WS_PROJ); const float* mod = (const float*)(ws + WS_MOD);

    if (IN(0)) { p0_prologue(F); } SEAM(0);
    if (IN(1)) { norm_mod_rows(F, F.x, F.norm_mix_g, 1 * D, 0 * D, HB); } SEAM(1);
    if (IN(2)) {
        pg8::Gemm g{HB, (const bf16*)(ws + WS_WIN), M, NIN, D}; pg8::StaticOrder S; S.init(M, NIN, F.G, (int)blockIdx.x);
        pg8::EpiBf16 E{PROJ, NIN};
        pg8::gemm_phase<pg8::EpiBf16, pg8::StaticOrder, true, true>(F.lds, g, S, E);
    } SEAM(2);
    if (IN(3)) { p3_kv_conv(F); } SEAM(3);
    if (IN(4)) { p4_scan(F); } SEAM(4);
    if (IN(5)) { p5_retention(F); } SEAM(5);
    if (IN(6)) {
        { pg8::Gemm g{(const bf16*)(ws + WS_RETG), (const bf16*)(ws + WS_WBR), M, D, D}; pg8::StaticOrder S; S.init(M, D, F.G, (int)blockIdx.x);
          pg8::EpiGateBf16 E{(bf16*)(ws + WS_MIXP), D, PROJ + OFF_MR, NIN};
          pg8::gemm_phase<pg8::EpiGateBf16, pg8::StaticOrder, true, true>(F.lds, g, S, E); }
        asm volatile("s_waitcnt vmcnt(0)" ::: "memory"); __syncthreads();
        { pg8::Gemm g{(const bf16*)(ws + WS_CONVG), (const bf16*)(ws + WS_WBC), M, D, D}; pg8::StaticOrder S; S.init(M, D, F.G, (int)blockIdx.x);
          pg8::EpiMixBf16 E{(bf16*)(ws + WS_MIX), D, (const bf16*)(ws + WS_MIXP), PROJ + OFF_MC, NIN};
          pg8::gemm_phase<pg8::EpiMixBf16, pg8::StaticOrder, true, true>(F.lds, g, S, E); }
    } SEAM(6);
    if (IN(7)) {
#if MK_SKIP_MIXER
        for (size_t i = (size_t)F.vcu * NT + F.tid; i < (size_t)M * D / 4; i += (size_t)F.G * NT) ((f32x4*)(ws + WS_X1))[i] = ((const f32x4*)F.x)[i];
#else
        pg8::Gemm g{(const bf16*)(ws + WS_MIX), (const bf16*)(ws + WS_WO), M, D, D}; pg8::StaticOrder S; S.init(M, D, F.G, (int)blockIdx.x);
        pg8::EpiResid E{(float*)(ws + WS_X1), F.x, D, mod + 2 * D, NMOD, 13};
        pg8::gemm_phase<pg8::EpiResid, pg8::StaticOrder, true, true>(F.lds, g, S, E);
#endif
    } SEAM(7);
    if (IN(8)) { norm_mod_rows(F, (const float*)(ws + WS_X1), F.norm_ffn_g, 4 * D, 3 * D, HB); } SEAM(8);
    if (IN(9)) {
        { pg8::Gemm g{HB, (const bf16*)(ws + WS_WR), M, NE, D}; pg8::StaticOrder S; S.init(M, NE, F.G, (int)blockIdx.x);
          pg8::EpiF32 E{(float*)(ws + WS_LOGITS), NE};
          pg8::gemm_phase<pg8::EpiF32, pg8::StaticOrder, true, true>(F.lds, g, S, E); }
        { pg8::Gemm g{HB, (const bf16*)(ws + WS_WSGU), M, 2 * EH, D}; pg8::StaticOrder S; S.init(M, 2 * EH, F.G, (int)((blockIdx.x + F.G / 2) % F.G));
          pg8::EpiSwiglu E{(bf16*)(ws + WS_SHG), EH};
          pg8::gemm_phase<pg8::EpiSwiglu, pg8::StaticOrder, true, true>(F.lds, g, S, E); }
    } SEAM(9);
    if (IN(10)) {
#if !MK_SKIP_SHARED
        for (int rp_ = 0; rp_ < MK_P10_GEMM_REP; ++rp_)
        { pg8::Gemm g{(const bf16*)(ws + WS_SHG), (const bf16*)(ws + WS_WSD), M, D, EH}; pg8::StaticOrder S; S.init(M, D, F.G, (int)blockIdx.x);
          pg8::EpiResid E{(float*)(ws + WS_MIXP), (const float*)(ws + WS_X1), D, mod + 5 * D, NMOD, 13};
          pg8::gemm_phase<pg8::EpiResid, pg8::StaticOrder, true, true>(F.lds, g, S, E); }
#endif
        for (int rr_ = 0; rr_ < MK_ROUTE_DRY_REP; ++rr_) route_tokens<true>(F);
        route_tokens<false>(F);
    } SEAM(10);
    if (IN(11)) {
#if !MK_SKIP_ROUTED
#if MK_EXP_V == 4
        p11_experts_v6(F);
#elif MK_EXP_V == 3
        p11_experts_v5(F);
#elif MK_EXP_V == 1
#if MK_ABL_RT
        if (F.abl) p11_experts_k64<MK_ABL_PROBE>(F); else
#endif
        p11_experts_k64<0>(F);
#else
#if MK_ABL_RT
        if (F.abl) p11_experts<MK_ABL_PROBE>(F); else
#endif
        p11_experts<0>(F);
#endif
#endif
    } SEAM(11);
    if (IN(12)) { int t_ = (int)threadIdx.x; asm volatile("" : "+v"(t_)); F.tid = t_; F.lane = t_ & 63;
        p12_final(F); }
#undef IN
#undef SEAM
}

extern "C" void kernel_launch(void* const* d_in, const int* in_sizes, int n_in, void* d_out, int out_size, void* d_ws, size_t ws_size, hipStream_t stream) {
    static int grid = 0;
    if (grid == 0) {
        if (n_in != 22 || in_sizes[0] != M * D || out_size != M * D || ws_size < WS_END) { fprintf(stderr, "kernel_launch: unexpected shapes (n_in %d, in0 %d, out %d, ws %zu, need %zu); nothing launched\n", n_in, n_in > 0 ? in_sizes[0] : -1, out_size, ws_size, (size_t)WS_END); grid = -1; return; }
        int dev = 0, cus = 0, per_cu = 0;
        if (hipGetDevice(&dev) != hipSuccess || hipDeviceGetAttribute(&cus, hipDeviceAttributeMultiprocessorCount, dev) != hipSuccess) { fprintf(stderr, "kernel_launch: device query failed\n"); grid = -1; return; }
        if (hipFuncSetAttribute((const void*)mk_fwd, hipFuncAttributeMaxDynamicSharedMemorySize, LDS_BYTES) != hipSuccess) { fprintf(stderr, "kernel_launch: hipFuncSetAttribute failed\n"); grid = -1; return; }
        if (hipOccupancyMaxActiveBlocksPerMultiprocessor(&per_cu, (const void*)mk_fwd, NT, LDS_BYTES) != hipSuccess || per_cu < 1) { fprintf(stderr, "kernel_launch: occupancy query reports %d workgroups per CU\n", per_cu); (void)hipGetLastError(); grid = -1; return; }
        grid = cus;
    }
    if (grid < 0) return;
    if (hipMemsetAsync((char*)d_ws + WS_CTL, 0, CTL_ZERO_BYTES, stream) != hipSuccess) { fprintf(stderr, "kernel_launch: hipMemsetAsync failed\n"); return; }
    Args a{};
    for (int i = 0; i < 22; ++i) a.in[i] = d_in[i];
    a.out = (float*)d_out; a.ws = (unsigned char*)d_ws;
#if MK_PER_PHASE
    for (int p = 0; p < NPHASE; ++p) { a.ph_lo = p; a.ph_hi = p + 1; hipLaunchKernelGGL(mk_fwd, dim3(grid), dim3(NT), LDS_BYTES, stream, a); }
#elif defined(MK_ABL_PROBE)
    a.ph_lo = 0; a.ph_hi = 12; a.li = 0; a.abl = 1; hipLaunchKernelGGL(mk_fwd, dim3(grid), dim3(NT), LDS_BYTES, stream, a);
    a.ph_lo = 11; a.ph_hi = NPHASE; a.li = 1; a.abl = 0; hipLaunchKernelGGL(mk_fwd, dim3(grid), dim3(NT), LDS_BYTES, stream, a);
#elif defined(MK_PROBE_LO)
    a.ph_lo = 0; a.ph_hi = MK_PROBE_HI; a.li = 0; hipLaunchKernelGGL(mk_fwd, dim3(grid), dim3(NT), LDS_BYTES, stream, a);
    a.ph_lo = MK_PROBE_LO; a.ph_hi = NPHASE; a.li = 1; hipLaunchKernelGGL(mk_fwd, dim3(grid), dim3(NT), LDS_BYTES, stream, a);
#else
    a.ph_lo = 0; a.ph_hi = NPHASE;
    hipLaunchKernelGGL(mk_fwd, dim3(grid), dim3(NT), LDS_BYTES, stream, a);
#endif
    const hipError_t le = hipPeekAtLastError();
    if (le != hipSuccess) fprintf(stderr, "kernel_launch: launch failed: %s\n", hipGetErrorName(le));
}
```

```cpp
#include <hip/hip_runtime.h>
#include <cstdio>
#include <cstdint>
namespace pg8 {
#define PG8_LAS __attribute__((address_space(3)))
typedef unsigned short bf16_t;
typedef short bf16x8 __attribute__((ext_vector_type(8)));
typedef float f32x4 __attribute__((ext_vector_type(4)));
typedef unsigned u32x4 __attribute__((ext_vector_type(4)));
constexpr int BM = 256, BK = 64, HALF = 128, HTB = HALF * BK * 2  , STAGE_BYTES = 8 * HTB, NXCD = 8, WGM = 8;

__host__ __device__ __forceinline__ int lds_byte(int r, int c) { const int st = (r >> 4) * 2 + (c >> 5), rr = r & 15, cc = c & 31, ob = rr * 64 + cc * 2; return st * 1024 + (ob ^ (((ob >> 9) & 1) << 5)); }
__host__ __device__ __forceinline__ void stage_rc(int b, int& R, int& C) { const int st = b / 1024, sb = b % 1024, swz = sb ^ (((sb >> 9) & 1) << 5); R = (st >> 1) * 16 + swz / 64; C = (st & 1) * 32 + (swz % 64) / 2; }
__host__ __device__ __forceinline__ int perm32(int rho) { const int n = rho >> 4, i = rho & 15; return 8 * (i >> 2) + 4 * n + (i & 3); }

struct Unit { int pm, pn; };
struct Gemm { const bf16_t* A; const bf16_t* Bt; int M, N, K; };

struct StaticOrder {
    int nM, nN, nwg, G, c;
    __host__ __device__ void init(int M, int N, int G_, int c_) { nM = M / BM; nN = N / BM; nwg = nM * nN; G = G_; c = c_; }
    __host__ __device__ bool next(int i, Unit& u) const {
        const long L = (long)i * G + c; if (L >= nwg) return false;
        int wgid = (int)L; { const int q = nwg / NXCD, r = nwg % NXCD, xcd = wgid % NXCD, off = wgid / NXCD; wgid = (xcd < r ? xcd * (q + 1) : r * (q + 1) + (xcd - r) * q) + off; }
        const int nig = WGM * nN, gid = wgid / nig, fm = gid * WGM, gsz = (nM - fm) < WGM ? (nM - fm) : WGM;
        u.pm = fm + ((wgid % nig) % gsz); u.pn = (wgid % nig) / gsz; return true;
    }
    __device__ __forceinline__ void a_ready(const Unit&) const {}
    __device__ __forceinline__ void done(const Unit&) const {}
};

__device__ __forceinline__ unsigned cvt_pk_bf16(float lo, float hi) { unsigned r; asm volatile("v_cvt_pk_bf16_f32 %0, %1, %2" : "=v"(r) : "v"(lo), "v"(hi)); return r; }
typedef float f32x2 __attribute__((ext_vector_type(2)));
typedef unsigned u32x2 __attribute__((ext_vector_type(2)));
__device__ __forceinline__ float bf_lo(unsigned w) { return __uint_as_float(w << 16); }
__device__ __forceinline__ float bf_hi(unsigned w) { return __uint_as_float(w & 0xffff0000u); }
__device__ __forceinline__ float sigm(float x) { return 1.0f / (1.0f + __expf(-x)); }
__device__ __forceinline__ float silu_f(float x) { return x / (1.0f + __expf(-x)); }

struct EpiBf16 {
    static constexpr bool PERM = true, AFTER_DRAIN = false;
    bf16_t* O; int ldc;
    __device__ __forceinline__ void operator()(const f32x4 (&acc)[2][2][4][2], const Unit& u, int wr, int wc, int fr, int fq) const {
        const int row0 = u.pm * BM + wr * 64 + fr; const int col0 = u.pn * BM + wc * 32 + 8 * fq;
#pragma unroll
        for (int ai = 0; ai < 2; ++ai)
#pragma unroll
            for (int m = 0; m < 4; ++m) { bf16_t* rowp = O + (size_t)(row0 + ai * HALF + m * 16) * ldc + col0;
#pragma unroll
                for (int bj = 0; bj < 2; ++bj) { const f32x4 v0 = acc[ai][bj][m][0], v1 = acc[ai][bj][m][1];
                    u32x4 w; w.x = cvt_pk_bf16(v0[0], v0[1]); w.y = cvt_pk_bf16(v0[2], v0[3]); w.z = cvt_pk_bf16(v1[0], v1[1]); w.w = cvt_pk_bf16(v1[2], v1[3]);
                    *(u32x4*)(rowp + bj * HALF) = w; } }
    }
};
struct EpiF32 {
    static constexpr bool PERM = false, AFTER_DRAIN = false;
    float* C; int ldc;
    __device__ __forceinline__ void operator()(const f32x4 (&acc)[2][2][4][2], const Unit& u, int wr, int wc, int fr, int fq) const {
        const int row0 = u.pm * BM + wr * 64 + fr, col0 = u.pn * BM + wc * 32 + 4 * fq;
#pragma unroll
        for (int ai = 0; ai < 2; ++ai)
#pragma unroll
            for (int m = 0; m < 4; ++m) { float* rowp = C + (size_t)(row0 + ai * HALF + m * 16) * ldc + col0;
#pragma unroll
                for (int bj = 0; bj < 2; ++bj)
#pragma unroll
                    for (int n = 0; n < 2; ++n) *(f32x4*)(rowp + bj * HALF + n * 16) = acc[ai][bj][m][n]; }
    }
};
struct EpiGateBf16 {
    static constexpr bool PERM = true, AFTER_DRAIN = false;
    bf16_t* O; int ldc; const bf16_t* gate; int ldg;
    __device__ __forceinline__ void operator()(const f32x4 (&acc)[2][2][4][2], const Unit& u, int wr, int wc, int fr, int fq) const {
        const int row0 = u.pm * BM + wr * 64 + fr; const int col0 = u.pn * BM + wc * 32 + 8 * fq;
#pragma unroll
        for (int ai = 0; ai < 2; ++ai)
#pragma unroll
            for (int m = 0; m < 4; ++m) { const size_t r = (size_t)(row0 + ai * HALF + m * 16); bf16_t* rowp = O + r * ldc + col0; const bf16_t* gp = gate + r * ldg + col0;
#pragma unroll
                for (int bj = 0; bj < 2; ++bj) { const f32x4 v0 = acc[ai][bj][m][0], v1 = acc[ai][bj][m][1]; const u32x4 g = *(const u32x4*)(gp + bj * HALF);
                    u32x4 w; w.x = cvt_pk_bf16(sigm(bf_lo(g.x)) * v0[0], sigm(bf_hi(g.x)) * v0[1]); w.y = cvt_pk_bf16(sigm(bf_lo(g.y)) * v0[2], sigm(bf_hi(g.y)) * v0[3]);
                    w.z = cvt_pk_bf16(sigm(bf_lo(g.z)) * v1[0], sigm(bf_hi(g.z)) * v1[1]); w.w = cvt_pk_bf16(sigm(bf_lo(g.w)) * v1[2], sigm(bf_hi(g.w)) * v1[3]);
                    *(u32x4*)(rowp + bj * HALF) = w; } }
    }
};
struct EpiMixBf16 {
    static constexpr bool PERM = true, AFTER_DRAIN = false;
    bf16_t* O; int ldc; const bf16_t* P; const bf16_t* gate; int ldg;
    __device__ __forceinline__ void operator()(const f32x4 (&acc)[2][2][4][2], const Unit& u, int wr, int wc, int fr, int fq) const {
        const int row0 = u.pm * BM + wr * 64 + fr; const int col0 = u.pn * BM + wc * 32 + 8 * fq;
#pragma unroll
        for (int ai = 0; ai < 2; ++ai)
#pragma unroll
            for (int m = 0; m < 4; ++m) { const size_t r = (size_t)(row0 + ai * HALF + m * 16); bf16_t* rowp = O + r * ldc + col0; const bf16_t* pp = P + r * ldc + col0; const bf16_t* gp = gate + r * ldg + col0;
#pragma unroll
                for (int bj = 0; bj < 2; ++bj) { const f32x4 v0 = acc[ai][bj][m][0], v1 = acc[ai][bj][m][1];
                    const u32x4 g = *(const u32x4*)(gp + bj * HALF); const u32x4 pq = *(const u32x4*)(pp + bj * HALF); const f32x4 p0 = {bf_lo(pq.x), bf_hi(pq.x), bf_lo(pq.y), bf_hi(pq.y)}, p1 = {bf_lo(pq.z), bf_hi(pq.z), bf_lo(pq.w), bf_hi(pq.w)};
                    const float o0 = p0[0] + sigm(bf_lo(g.x)) * v0[0], o1 = p0[1] + sigm(bf_hi(g.x)) * v0[1], o2 = p0[2] + sigm(bf_lo(g.y)) * v0[2], o3 = p0[3] + sigm(bf_hi(g.y)) * v0[3];
                    const float o4 = p1[0] + sigm(bf_lo(g.z)) * v1[0], o5 = p1[1] + sigm(bf_hi(g.z)) * v1[1], o6 = p1[2] + sigm(bf_lo(g.w)) * v1[2], o7 = p1[3] + sigm(bf_hi(g.w)) * v1[3];
                    u32x4 w; w.x = cvt_pk_bf16(o0, o1); w.y = cvt_pk_bf16(o2, o3); w.z = cvt_pk_bf16(o4, o5); w.w = cvt_pk_bf16(o6, o7);
                    *(u32x4*)(rowp + bj * HALF) = w; } }
    }
};
struct EpiResid {
    static constexpr bool PERM = false, AFTER_DRAIN = false;
    float* C; const float* base; int ldc; const float* gvec; int gstride; int rows_per_b_shift;
    __device__ __forceinline__ void operator()(const f32x4 (&acc)[2][2][4][2], const Unit& u, int wr, int wc, int fr, int fq) const {
        const int row0 = u.pm * BM + wr * 64 + fr, col0 = u.pn * BM + wc * 32 + 4 * fq;
        const float* gp = gvec + (size_t)((u.pm * BM) >> rows_per_b_shift) * gstride + col0;
        f32x4 gv[2][2];
#pragma unroll
        for (int bj = 0; bj < 2; ++bj)
#pragma unroll
            for (int n = 0; n < 2; ++n) gv[bj][n] = *(const f32x4*)(gp + bj * HALF + n * 16);
#pragma unroll
        for (int ai = 0; ai < 2; ++ai)
#pragma unroll
            for (int m = 0; m < 4; ++m) { const size_t off = (size_t)(row0 + ai * HALF + m * 16) * ldc + col0;
#pragma unroll
                for (int bj = 0; bj < 2; ++bj)
#pragma unroll
                    for (int n = 0; n < 2; ++n) { const f32x4 b = *(const f32x4*)(base + off + bj * HALF + n * 16);
                        *(f32x4*)(C + off + bj * HALF + n * 16) = b + gv[bj][n] * acc[ai][bj][m][n]; } }
    }
};
struct EpiSwiglu {
    static constexpr bool PERM = true, AFTER_DRAIN = false;
    bf16_t* O; int ldo;
    __device__ __forceinline__ void operator()(const f32x4 (&acc)[2][2][4][2], const Unit& u, int wr, int wc, int fr, int fq) const {
        const int row0 = u.pm * BM + wr * 64 + fr; const int col0 = u.pn * BM + wc * 32 + 8 * fq;
#pragma unroll
        for (int ai = 0; ai < 2; ++ai)
#pragma unroll
            for (int m = 0; m < 4; ++m) { bf16_t* rowp = O + (size_t)(row0 + ai * HALF + m * 16) * ldo + (col0 >> 1);
#pragma unroll
                for (int bj = 0; bj < 2; ++bj) { const f32x4 v0 = acc[ai][bj][m][0], v1 = acc[ai][bj][m][1];
                    const float g0 = silu_f(v0[0]) * v0[1], g1 = silu_f(v0[2]) * v0[3], g2 = silu_f(v1[0]) * v1[1], g3 = silu_f(v1[2]) * v1[3];
                    u32x2 w; w.x = cvt_pk_bf16(g0, g1); w.y = cvt_pk_bf16(g2, g3);
                    *(u32x2*)(rowp + bj * (HALF / 2)) = w; } }
    }
};
template <class Epi, class Sched, bool ALIGN_EPI = false, bool SP2 = false>
__device__ __forceinline__ void gemm_phase(PG8_LAS unsigned char* lds, const Gemm g, const Sched& S, const Epi& E) {
    const int tid = threadIdx.x, wid = __builtin_amdgcn_readfirstlane(tid >> 6), lane = tid & 63, wr = wid >> 2, wc = wid & 3, fr = lane & 15, fq = lane >> 4;
    const int K = g.K, nt = K / BK;
    unsigned voffA[2], voffB[2];
#pragma unroll
    for (int i = 0; i < 2; ++i) { int R, C; stage_rc(tid * 16 + i * 8192, R, C); const int Rb = Epi::PERM ? ((R & ~31) + perm32(R & 31)) : R;
        voffA[i] = (unsigned)(R * K + C) * 2u; voffB[i] = (unsigned)(Rb * K + C) * 2u; }
    const size_t kstep = (size_t)(BK * 2);
    const size_t hstep = (size_t)HALF * K * 2;
    const size_t tstep = 2 * hstep;
    const unsigned ldsw = (unsigned)wid * 1024u;
    const int aoff = lds_byte(wr * 64 + fr, fq * 8), boff = lds_byte(wc * 32 + fr, fq * 8);
#define PG8_SA(b, h) (((b) * 2 + (h)) * HTB)
#define PG8_SB(b, h) ((4 + (b) * 2 + (h)) * HTB)
#define PG8_STAGE(bufoff, gbase, voff) do { _Pragma("unroll") for (int _i = 0; _i < 2; ++_i) \
        __builtin_amdgcn_global_load_lds((const unsigned*)((const char*)(gbase) + (voff)[_i]), (PG8_LAS unsigned*)(lds + (bufoff) + ldsw + _i * 8192), 16, 0, 0); } while (0)
#define PG8_LDA(dst, b, h) do { _Pragma("unroll") for (int m = 0; m < 4; ++m) _Pragma("unroll") for (int k = 0; k < 2; ++k) dst[m][k] = *(const PG8_LAS bf16x8*)(lds + PG8_SA(b, h) + aoff + m * 2048 + k * 1024); } while (0)
#define PG8_LDB(dst, b, h) do { _Pragma("unroll") for (int n = 0; n < 2; ++n) _Pragma("unroll") for (int k = 0; k < 2; ++k) dst[n][k] = *(const PG8_LAS bf16x8*)(lds + PG8_SB(b, h) + boff + n * 2048 + k * 1024); } while (0)
#define PG8_MMA(ai, bj, At, Bt) do { __builtin_amdgcn_s_setprio(1); _Pragma("unroll") for (int m = 0; m < 4; ++m) _Pragma("unroll") for (int n = 0; n < 2; ++n) _Pragma("unroll") for (int k = 0; k < 2; ++k) \
        acc[ai][bj][m][n] = __builtin_amdgcn_mfma_f32_16x16x32_bf16(Bt[n][k], At[m][k], acc[ai][bj][m][n], 0, 0, 0); __builtin_amdgcn_s_setprio(0); } while (0)
#define PG8_WAIT_V(n) asm volatile("s_waitcnt vmcnt(" #n ")" ::: "memory")
#define PG8_WAIT_L(n) asm volatile("s_waitcnt lgkmcnt(" #n ")" ::: "memory")
#define PG8_BAR __builtin_amdgcn_s_barrier()
#define PG8_SCHED __builtin_amdgcn_sched_barrier(0)
    Unit cur, nxt; int ui = 0;
    if (!S.next(0, cur)) return;
    f32x4 acc[2][2][4][2];
#pragma unroll
    for (int a = 0; a < 2; ++a)
#pragma unroll
        for (int b = 0; b < 2; ++b)
#pragma unroll
            for (int m = 0; m < 4; ++m)
#pragma unroll
                for (int n = 0; n < 2; ++n) acc[a][b][m][n] = (f32x4){0.f, 0.f, 0.f, 0.f};
    bf16x8 At[4][2], B0[2][2], B1[2][2];
    const char* cA = (const char*)g.A + (size_t)cur.pm * tstep; const char* cB = (const char*)g.Bt + (size_t)cur.pn * tstep;
    S.a_ready(cur);
    if constexpr (SP2) {
        PG8_STAGE(PG8_SB(0, 0), cB, voffB); PG8_STAGE(PG8_SB(0, 1), cB + hstep, voffB); PG8_STAGE(PG8_SA(0, 0), cA, voffA); PG8_STAGE(PG8_SA(0, 1), cA + hstep, voffA);
        if (wr == 1) PG8_BAR;
        PG8_WAIT_V(2); PG8_BAR;
        PG8_STAGE(PG8_SB(1, 0), cB + kstep, voffB); PG8_STAGE(PG8_SA(1, 0), cA + kstep, voffA); PG8_STAGE(PG8_SB(1, 1), cB + hstep + kstep, voffB);
        PG8_WAIT_V(6); PG8_BAR;
    } else {
        PG8_STAGE(PG8_SB(0, 0), cB, voffB); PG8_STAGE(PG8_SA(0, 0), cA, voffA); PG8_STAGE(PG8_SB(0, 1), cB + hstep, voffB); PG8_STAGE(PG8_SA(0, 1), cA + hstep, voffA);
        if (wr == 1) PG8_BAR;
        PG8_WAIT_V(4); PG8_BAR;
        PG8_STAGE(PG8_SB(1, 0), cB + kstep, voffB); PG8_STAGE(PG8_SA(1, 0), cA + kstep, voffA); PG8_STAGE(PG8_SB(1, 1), cB + hstep + kstep, voffB);
        PG8_WAIT_V(6); PG8_BAR;
    }
    for (;;) {
        const bool has_next = S.next(ui + 1, nxt);
        const char* nA = has_next ? (const char*)g.A + (size_t)nxt.pm * tstep : cA; const char* nB = has_next ? (const char*)g.Bt + (size_t)nxt.pn * tstep : cB;
        for (int t = 0; t < nt; t += 2) {
            const bool last = (t == nt - 2);
            const char* a1 = cA + (size_t)(t + 1) * kstep;
            const char* a2 = last ? nA : cA + (size_t)(t + 2) * kstep; const char* b2 = last ? nB : cB + (size_t)(t + 2) * kstep;
            const char* a3 = a2 + kstep; const char* b3 = b2 + kstep;
            if (last && has_next) S.a_ready(nxt);
            if constexpr (SP2) {
            PG8_LDB(B0, 0, 0); PG8_LDB(B1, 0, 1); PG8_SCHED; PG8_LDA(At, 0, 0); PG8_STAGE(PG8_SA(1, 1), a1 + hstep, voffA);
            PG8_WAIT_V(8); PG8_WAIT_L(0); PG8_BAR; PG8_MMA(0, 0, At, B0); PG8_MMA(0, 1, At, B1); PG8_BAR; PG8_SCHED;
            PG8_LDA(At, 0, 1); PG8_STAGE(PG8_SB(0, 0), b2, voffB); PG8_STAGE(PG8_SB(0, 1), b2 + hstep, voffB); PG8_STAGE(PG8_SA(0, 0), a2, voffA);
            PG8_WAIT_V(8); PG8_WAIT_L(0); PG8_BAR; PG8_MMA(1, 0, At, B0); PG8_MMA(1, 1, At, B1); PG8_BAR; PG8_SCHED;
            PG8_LDB(B0, 1, 0); PG8_LDB(B1, 1, 1); PG8_SCHED; PG8_LDA(At, 1, 0); PG8_STAGE(PG8_SA(0, 1), a2 + hstep, voffA);
            PG8_WAIT_V(8); PG8_WAIT_L(0); PG8_BAR; PG8_MMA(0, 0, At, B0); PG8_MMA(0, 1, At, B1); PG8_BAR; PG8_SCHED;
            PG8_LDA(At, 1, 1); PG8_STAGE(PG8_SB(1, 0), b3, voffB); PG8_STAGE(PG8_SB(1, 1), b3 + hstep, voffB); PG8_STAGE(PG8_SA(1, 0), a3, voffA);
            PG8_WAIT_V(8); PG8_WAIT_L(0); PG8_BAR; PG8_MMA(1, 0, At, B0); PG8_MMA(1, 1, At, B1); PG8_BAR; PG8_SCHED;
            } else {
            PG8_LDB(B0, 0, 0); PG8_SCHED; PG8_LDA(At, 0, 0); PG8_STAGE(PG8_SA(1, 1), a1 + hstep, voffA);
            PG8_WAIT_L(8); PG8_BAR; PG8_WAIT_L(0); PG8_MMA(0, 0, At, B0); PG8_BAR; PG8_SCHED;
            PG8_LDB(B1, 0, 1); PG8_STAGE(PG8_SB(0, 0), b2, voffB);
            PG8_BAR; PG8_WAIT_L(0); PG8_MMA(0, 1, At, B1); PG8_BAR;
            PG8_LDA(At, 0, 1); PG8_STAGE(PG8_SA(0, 0), a2, voffA);
            PG8_BAR; PG8_WAIT_L(0); PG8_MMA(1, 0, At, B0); PG8_BAR; PG8_SCHED;
            PG8_STAGE(PG8_SB(0, 1), b2 + hstep, voffB);
            PG8_WAIT_V(6); PG8_BAR; PG8_MMA(1, 1, At, B1); PG8_BAR;
            PG8_LDB(B0, 1, 0); PG8_SCHED; PG8_LDA(At, 1, 0); PG8_STAGE(PG8_SA(0, 1), a2 + hstep, voffA);
            PG8_WAIT_L(8); PG8_BAR; PG8_WAIT_L(0); PG8_MMA(0, 0, At, B0); PG8_BAR; PG8_SCHED;
            PG8_LDB(B1, 1, 1); PG8_STAGE(PG8_SB(1, 0), b3, voffB);
            PG8_BAR; PG8_WAIT_L(0); PG8_MMA(0, 1, At, B1); PG8_BAR;
            PG8_LDA(At, 1, 1); PG8_STAGE(PG8_SA(1, 0), a3, voffA);
            PG8_BAR; PG8_WAIT_L(0); PG8_MMA(1, 0, At, B0); PG8_BAR; PG8_SCHED;
            PG8_STAGE(PG8_SB(1, 1), b3 + hstep, voffB);
            PG8_WAIT_V(6); PG8_BAR; PG8_MMA(1, 1, At, B1); PG8_BAR;
            }
        }
        if constexpr (ALIGN_EPI) { if (wr == 0) PG8_BAR; }
        if constexpr (!Epi::AFTER_DRAIN) { E(acc, cur, wr, wc, fr, fq); S.done(cur); }
        if (!has_next) break;
#pragma unroll
        for (int a = 0; a < 2; ++a)
#pragma unroll
            for (int b = 0; b < 2; ++b)
#pragma unroll
                for (int m = 0; m < 4; ++m)
#pragma unroll
                    for (int n = 0; n < 2; ++n) acc[a][b][m][n] = (f32x4){0.f, 0.f, 0.f, 0.f};
        cur = nxt; cA = nA; cB = nB; ++ui;
        if constexpr (ALIGN_EPI) { if (wr == 1) PG8_BAR; }
    }
    PG8_WAIT_V(0);
    if constexpr (!ALIGN_EPI) { if (wr == 0) PG8_BAR; }
    PG8_BAR;
    if constexpr (Epi::AFTER_DRAIN) { E.fused(acc, cur, wr, wc, fr, fq, lds, wid, lane); S.done(cur); }
#undef PG8_SA
#undef PG8_SB
#undef PG8_STAGE
#undef PG8_LDA
#undef PG8_LDB
#undef PG8_MMA
#undef PG8_WAIT_V
#undef PG8_WAIT_L
#undef PG8_BAR
#undef PG8_SCHED
}
}

constexpr int NWAVES = 8, NT = 512;
#ifndef MK_PER_PHASE
#define MK_PER_PHASE 0
#endif
#ifndef MK_EXP_V
#define MK_EXP_V 4
#endif
#ifndef MK_TIMER_PHASE
#define MK_TIMER_PHASE -1
#endif
#ifndef MK_ABL_RT
#define MK_ABL_RT 0
#endif
#ifndef MK_P10_GEMM_REP
#define MK_P10_GEMM_REP 1
#endif
#ifndef MK_GSYNC
#define MK_GSYNC 0
#endif
#ifndef MK_GSYNC_EVERY
#define MK_GSYNC_EVERY 16
#endif
#ifndef MK_GSTAG
#define MK_GSTAG 0
#endif
#ifndef MK_PFD
#define MK_PFD 0
#endif
#ifndef MK_ROUTE_DRY_REP
#define MK_ROUTE_DRY_REP 0
#endif
#ifndef MK_LATE_ISSUE
#define MK_LATE_ISSUE 0
#endif
#ifndef MK_SPREAD
#define MK_SPREAD 2
#endif
#ifndef MK_SKIP_MIXER
#define MK_SKIP_MIXER 0
#endif
#ifndef MK_SKIP_SHARED
#define MK_SKIP_SHARED 0
#endif
#ifndef MK_SKIP_ROUTED
#define MK_SKIP_ROUTED 0
#endif
constexpr int NPHASE = 13;
constexpr int BATCH = 2, SEQ = 8192, D = 1024, M = BATCH * SEQ, NIN = 8192, NMOD = 6144;
constexpr int OFF_Q = 0, OFF_K = 512, OFF_V = 1024, OFF_GR = 2048, OFF_U = 3072, OFF_GC = 4096, OFF_GB = 5120, OFF_MR = 6144, OFF_MC = 7168;
constexpr int NE = 256, TOPK = 8, EH = 256, CAP = 16384, NCH = 64, CH = 128, NH = 4, DK = 128, DV = 256;
constexpr float EPS = 1e-6f;

constexpr size_t MiB = (size_t)1 << 20;
constexpr size_t WS_CTL = 0, CTL_ZERO_BYTES = 1 * MiB;
constexpr size_t WS_MOD = 1 * MiB;
constexpr size_t WS_ROPE = 2 * MiB;
constexpr size_t WS_WR = 10 * MiB;
constexpr size_t WS_WSGU = 11 * MiB;
constexpr size_t WS_WSD = 12 * MiB;
constexpr size_t WS_WBR = 13 * MiB, WS_WBC = 15 * MiB, WS_WO = 17 * MiB;
constexpr size_t WS_WIN = 20 * MiB;
constexpr size_t WS_HB = 36 * MiB;
constexpr size_t WS_PROJ = 68 * MiB;
constexpr size_t WS_KV = 324 * MiB;
constexpr size_t WS_SP = 388 * MiB;
constexpr size_t WS_RETG = 420 * MiB;
constexpr size_t WS_CONVG = 452 * MiB;
constexpr size_t WS_MIXP = 484 * MiB;
constexpr size_t WS_MIX = 548 * MiB;
constexpr size_t WS_X1 = 580 * MiB;
constexpr size_t WS_LOGITS = 644 * MiB;
constexpr size_t WS_SHG = 660 * MiB;
constexpr size_t WS_EIDX = 668 * MiB, WS_POS = 669 * MiB;
constexpr size_t WS_LTOK = 670 * MiB, WS_LW = 686 * MiB;
constexpr size_t WS_YP = 702 * MiB;
constexpr size_t WS_END = 958 * MiB;
constexpr int CW_TMO = 0, CW_CODE = 1, CW_BAR = 4096, CW_CNT = 16384, CW_GS = 131072;

constexpr int LDSCTL_OFF = 143360, MISC_OFF = LDSCTL_OFF + 320, LDS_BYTES = 147456;

#define GAS __attribute__((address_space(1)))
#define LAS __attribute__((address_space(3)))
typedef unsigned short bf16;
typedef unsigned v4u __attribute__((ext_vector_type(4)));
typedef unsigned v2u __attribute__((ext_vector_type(2)));
typedef float f32x4 __attribute__((ext_vector_type(4)));
typedef float f32x2 __attribute__((ext_vector_type(2)));
typedef short bf16x8 __attribute__((ext_vector_type(8)));
typedef short s16x4 __attribute__((ext_vector_type(4)));
typedef GAS unsigned gu32;
#define RLX_AGENT __ATOMIC_RELAXED, __HIP_MEMORY_SCOPE_AGENT
__device__ __forceinline__ unsigned f2bf(float f) { unsigned u = __builtin_bit_cast(unsigned, f); return (u + 0x7fffu + ((u >> 16) & 1u)) >> 16; }
__device__ __forceinline__ unsigned pk2(float lo, float hi) { unsigned r; asm volatile("v_cvt_pk_bf16_f32 %0, %1, %2" : "=v"(r) : "v"(lo), "v"(hi)); return r; }
__device__ __forceinline__ float bflo(unsigned w) { return __uint_as_float(w << 16); }
__device__ __forceinline__ float bfhi(unsigned w) { return __uint_as_float(w & 0xffff0000u); }
__device__ __forceinline__ float sigmoidf_(float x) { return 1.0f / (1.0f + __expf(-x)); }
__device__ __forceinline__ float siluf_(float x) { return x / (1.0f + __expf(-x)); }

#define XB_TMO      128
#define XB_XCNT(j)  (256  + 64 * (j))
#define XB_XSUB(j)  (1280 + 64 * (j))
#define XB_XGEN(j)  (2304 + 64 * (j))
#define XB_TOP      3328
#define XB_TOPGEN   3392
#define XCD_BAR_WORDS 3456
#define XB_SPIN_CAP (1u << 18)

__device__ __forceinline__ unsigned xb_ld(unsigned* p)              { return __hip_atomic_load(p, __ATOMIC_RELAXED, __HIP_MEMORY_SCOPE_AGENT); }
__device__ __forceinline__ unsigned xb_add(unsigned* p, unsigned v) { return __hip_atomic_fetch_add(p, v, __ATOMIC_RELAXED, __HIP_MEMORY_SCOPE_AGENT); }
__device__ __forceinline__ unsigned xb_xcc_id() { return (unsigned)__builtin_amdgcn_s_getreg((3 << 11) | 20) & 0xFu; }
#define XB_SPIN(cond, bar) do { unsigned _sp = 0; while (cond) { __builtin_amdgcn_s_sleep(1); \
    if ((++_sp & 255u) == 0u) { if (xb_ld(&(bar)[XB_TMO])) break; if (_sp > XB_SPIN_CAP) { atomicAdd(&(bar)[XB_TMO], 1u); break; } } } } while (0)

struct XcdBarrier {
    unsigned* bar; unsigned x;
    volatile LAS unsigned* st;
};

__device__ __forceinline__ XcdBarrier xcd_barrier_post(unsigned* bar, volatile LAS unsigned* st) {
    XcdBarrier b; b.bar = bar; b.x = xb_xcc_id(); b.st = st;
    if (threadIdx.x == 0) (void)xb_add(&bar[XB_XCNT(b.x)], 1u);
    return b;
}
__device__ __forceinline__ void xcd_barrier_complete(unsigned* bar, unsigned x, unsigned& nloc, unsigned& nx) {
    const unsigned G = gridDim.x * gridDim.y * gridDim.z;
    unsigned sum, cnt, mine, sp = 0u;
    for (;;) {
        sum = 0u; cnt = 0u; mine = 0u;
#pragma unroll
        for (unsigned j = 0; j < 16; ++j) { const unsigned c = xb_ld(&bar[XB_XCNT(j)]); sum += c; cnt += (c > 0u) ? 1u : 0u; mine = (j == x) ? c : mine; }
        if (sum == G) break;
        __builtin_amdgcn_s_sleep(1);
        if ((++sp & 255u) == 0u) { if (xb_ld(&bar[XB_TMO])) break; if (sp > XB_SPIN_CAP) { atomicAdd(&bar[XB_TMO], 1u); break; } }
    }
    nloc = mine > 0u ? mine : 1u; nx = cnt > 0u ? cnt : 1u;
}

__device__ __forceinline__ void xcd_barrier(const XcdBarrier& b) {
    asm volatile("s_waitcnt vmcnt(0)" ::: "memory");
    __syncthreads();
    if (threadIdx.x == 0) {
        unsigned* bar = b.bar;
        __builtin_amdgcn_s_waitcnt(0);
        unsigned nloc = b.st[0], nx = b.st[1];
        if (nloc == 0u) { xcd_barrier_complete(bar, b.x, nloc, nx); b.st[0] = nloc; b.st[1] = nx; }
        const unsigned old = xb_add(&bar[XB_XSUB(b.x)], 1u);
        const unsigned gen = old / nloc;
        if (old + 1u == (gen + 1u) * nloc) {
            __builtin_amdgcn_fence(__ATOMIC_RELEASE, "agent");
            asm volatile("s_waitcnt vmcnt(0)" ::: "memory");
            const unsigned og = xb_add(&bar[XB_TOP], 1u);
            const unsigned tg = og / nx;
            if (og + 1u == (tg + 1u) * nx) xb_add(&bar[XB_TOPGEN], 1u);
            else XB_SPIN(xb_ld(&bar[XB_TOPGEN]) == tg, bar);
            __builtin_amdgcn_fence(__ATOMIC_ACQUIRE, "agent");
            xb_add(&bar[XB_XGEN(b.x)], 1u);
            asm volatile("s_waitcnt vmcnt(0)" ::: "memory");
        } else {
            XB_SPIN(xb_ld(&bar[XB_XGEN(b.x)]) == gen, bar);
            __builtin_amdgcn_fence(__ATOMIC_ACQUIRE, "agent");
            asm volatile("s_waitcnt vmcnt(0)" ::: "memory");
        }
    }
    __syncthreads();
}

struct Frame {
    LAS unsigned char* lds; unsigned ldsb;
    volatile LAS unsigned* MISC; gu32* ctl;
    int tid, lane, wave, vcu, G, abl;
    const float *x, *c; const int* pos; const float *w_ada, *b_ada, *norm_mix_g, *w_in, *ret_norm_g, *conv_w, *w_br_ret, *w_br_conv, *w_out, *norm_ffn_g, *w_router, *router_bias,
        *w_eg, *w_eu, *w_ed, *w_sg, *w_su, *w_sd, *norm_final_g;
    float* out; unsigned char* ws;
};
__device__ __forceinline__ float wave_sum(float v) {
#pragma unroll
    for (int o = 1; o < 64; o <<= 1) v += __shfl_xor(v, o);
    return v;
}

__device__ __forceinline__ void p0_mod_task(Frame& F, int j) {
    const int cq = F.tid & 15, kq = F.tid >> 4;
    f32x4 a0 = {0.f, 0.f, 0.f, 0.f}, a1 = {0.f, 0.f, 0.f, 0.f};
    const float* W = F.w_ada + 64 * j + 4 * cq;
#pragma unroll 8
    for (int i = 0; i < 32; ++i) { const int k = kq + 32 * i; const float c0 = F.c[k], c1 = F.c[1024 + k];
        const float s0 = c0 / (1.0f + expf(-c0)), s1 = c1 / (1.0f + expf(-c1));
        const f32x4 w = *(const f32x4*)(W + (size_t)k * NMOD); a0 += s0 * w; a1 += s1 * w; }
    LAS f32x4* red = (LAS f32x4*)F.lds;
    red[(kq * 2 + 0) * 16 + cq] = a0; red[(kq * 2 + 1) * 16 + cq] = a1;
    __syncthreads();
    if (F.tid < 32) { const int b = F.tid >> 4, c2 = F.tid & 15; f32x4 s = *(const f32x4*)(F.b_ada + 64 * j + 4 * c2);
        for (int k2 = 0; k2 < 32; ++k2) s += red[(k2 * 2 + b) * 16 + c2];
        *(f32x4*)((float*)(F.ws + WS_MOD) + b * NMOD + 64 * j + 4 * c2) = s; }
    __syncthreads();
}
__device__ __forceinline__ void p0_transpose_item(const float* W, int K, int N, bf16* WT, int row_off, int row_mul, LAS float* scr, int item, int lane) {
    const int nblk = N / 32, kb = item / nblk, nb = item % nblk, k0 = 64 * kb, n0 = 32 * nb;
#pragma unroll 8
    for (int i = 0; i < 32; ++i) { const int kk = 2 * i + (lane >> 5); scr[kk * 33 + (lane & 31)] = W[(size_t)(k0 + kk) * N + n0 + (lane & 31)]; }
    asm volatile("s_waitcnt lgkmcnt(0)" ::: "memory");
    const int c = lane & 7;
#pragma unroll
    for (int j = 0; j < 4; ++j) { const int n = (lane >> 3) + 8 * j; const LAS float* s = scr + (8 * c) * 33 + n;
        v4u o; o.x = pk2(s[0 * 33], s[1 * 33]); o.y = pk2(s[2 * 33], s[3 * 33]); o.z = pk2(s[4 * 33], s[5 * 33]); o.w = pk2(s[6 * 33], s[7 * 33]);
        *(v4u*)(WT + (size_t)(row_off + row_mul * (n0 + n)) * K + k0 + 8 * c) = o; }
    asm volatile("s_waitcnt lgkmcnt(0)" ::: "memory");
}
__device__ __forceinline__ void p0_prologue(Frame& F) {
    if ((int)blockIdx.x < NMOD / 64) p0_mod_task(F, (int)blockIdx.x);
    LAS float* scr = (LAS float*)(F.lds + F.wave * 16384);
    const int gw = F.vcu * NWAVES + F.wave, NGW = F.G * NWAVES;
    constexpr int I_IN = (D / 64) * (NIN / 32), I_SQ = (D / 64) * (D / 32), I_R = (D / 64) * (256 / 32), I_SD = (256 / 64) * (D / 32);
    constexpr int NITEMS = I_IN + 3 * I_SQ + 3 * I_R + I_SD;
    unsigned char* ws = F.ws;
    for (int it = gw; it < NITEMS; it += NGW) {
        int r = it;
        if (r < I_IN) { p0_transpose_item(F.w_in, D, NIN, (bf16*)(ws + WS_WIN), 0, 1, scr, r, F.lane); continue; } r -= I_IN;
        if (r < I_SQ) { p0_transpose_item(F.w_br_ret, D, D, (bf16*)(ws + WS_WBR), 0, 1, scr, r, F.lane); continue; } r -= I_SQ;
        if (r < I_SQ) { p0_transpose_item(F.w_br_conv, D, D, (bf16*)(ws + WS_WBC), 0, 1, scr, r, F.lane); continue; } r -= I_SQ;
        if (r < I_SQ) { p0_transpose_item(F.w_out, D, D, (bf16*)(ws + WS_WO), 0, 1, scr, r, F.lane); continue; } r -= I_SQ;
        if (r < I_R) { p0_transpose_item(F.w_router, D, NE, (bf16*)(ws + WS_WR), 0, 1, scr, r, F.lane); continue; } r -= I_R;
        if (r < I_R) { p0_transpose_item(F.w_sg, D, EH, (bf16*)(ws + WS_WSGU), 0, 2, scr, r, F.lane); continue; } r -= I_R;
        if (r < I_R) { p0_transpose_item(F.w_su, D, EH, (bf16*)(ws + WS_WSGU), 1, 2, scr, r, F.lane); continue; } r -= I_R;
        p0_transpose_item(F.w_sd, EH, D, (bf16*)(ws + WS_WSD), 0, 1, scr, r, F.lane);
    }
    f32x2* rope = (f32x2*)(ws + WS_ROPE);
    for (int idx = F.vcu * NT + F.tid; idx < M * 64; idx += F.G * NT) { const int t = idx >> 6, i = idx & 63;
        const float invf = powf(10000.0f, -(float)i * (1.0f / 64.0f)); const float ang = (float)F.pos[t] * invf;
        const double ad = (double)ang; const double rr = ad - 6.283185307179586 * rint(ad * 0.15915494309189535); const float rf = (float)rr;
        rope[idx] = (f32x2){cosf(rf), sinf(rf)}; }
}

__device__ __forceinline__ void norm_mod_rows(Frame& F, const float* X, const float* gain, int sc_off, int sh_off, bf16* O) {
    const int gw = F.vcu * NWAVES + F.wave, NGW = F.G * NWAVES;
    const float* mod = (const float*)(F.ws + WS_MOD);
    f32x4 g[4];
#pragma unroll
    for (int j = 0; j < 4; ++j) g[j] = *(const f32x4*)(gain + 4 * F.lane + 256 * j);
    for (int m = gw; m < M; m += NGW) {
        const int b = m >> 13; const f32x4* xr = (const f32x4*)(X + (size_t)m * D) + F.lane;
        f32x4 v[4]; float ss = 0.f;
#pragma unroll
        for (int j = 0; j < 4; ++j) { v[j] = xr[64 * j]; ss += (v[j].x * v[j].x + v[j].y * v[j].y) + (v[j].z * v[j].z + v[j].w * v[j].w); }
        const float rstd = 1.0f / sqrtf(wave_sum(ss) * (1.0f / D) + EPS);
        v2u* o8 = (v2u*)(O + (size_t)m * D) + F.lane;
#pragma unroll
        for (int j = 0; j < 4; ++j) { const f32x4 sc = *(const f32x4*)(mod + b * NMOD + sc_off + 4 * F.lane + 256 * j), sh = *(const f32x4*)(mod + b * NMOD + sh_off + 4 * F.lane + 256 * j);
            const f32x4 h = (v[j] * rstd * g[j]) * (1.0f + sc) + sh; v2u w; w.x = pk2(h.x, h.y); w.y = pk2(h.z, h.w); o8[64 * j] = w; }
    }
}

constexpr int KS = 136, KSB = KS * 2;
constexpr int VS = 264, VSB = VS * 2;
__device__ __forceinline__ float log_gamma(int h) { return log1pf(-exp2f(-5.0f - (float)h)); }
__device__ __forceinline__ bf16x8 ldfrag(const LAS unsigned char* img, int row, int rsb, int k) { return *(const LAS bf16x8*)(img + row * rsb + k * 2); }
template <int RS4> __device__ __forceinline__ bf16x8 tr_frag(unsigned addr) {
    s16x4 lo, hi;
    asm volatile("ds_read_b64_tr_b16 %0, %2\n\tds_read_b64_tr_b16 %1, %2 offset:%3\n\ts_waitcnt lgkmcnt(0)" : "=&v"(lo), "=&v"(hi) : "v"(addr), "i"(RS4) : "memory");
    return __builtin_shufflevector(lo, hi, 0, 1, 2, 3, 4, 5, 6, 7);
}
template <int RS4, int STEP> __device__ __forceinline__ void tr_frag4(unsigned addr, bf16x8& f0, bf16x8& f1, bf16x8& f2, bf16x8& f3) {
    s16x4 l0, h0, l1, h1, l2, h2, l3, h3;
    asm volatile("ds_read_b64_tr_b16 %0, %8\n\tds_read_b64_tr_b16 %1, %8 offset:%9\n\t"
                 "ds_read_b64_tr_b16 %2, %8 offset:%10\n\tds_read_b64_tr_b16 %3, %8 offset:%11\n\t"
                 "ds_read_b64_tr_b16 %4, %8 offset:%12\n\tds_read_b64_tr_b16 %5, %8 offset:%13\n\t"
                 "ds_read_b64_tr_b16 %6, %8 offset:%14\n\tds_read_b64_tr_b16 %7, %8 offset:%15\n\ts_waitcnt lgkmcnt(0)"
                 : "=&v"(l0), "=&v"(h0), "=&v"(l1), "=&v"(h1), "=&v"(l2), "=&v"(h2), "=&v"(l3), "=&v"(h3)
                 : "v"(addr), "i"(RS4), "i"(STEP), "i"(STEP + RS4), "i"(2 * STEP), "i"(2 * STEP + RS4), "i"(3 * STEP), "i"(3 * STEP + RS4) : "memory");
    f0 = __builtin_shufflevector(l0, h0, 0, 1, 2, 3, 4, 5, 6, 7); f1 = __builtin_shufflevector(l1, h1, 0, 1, 2, 3, 4, 5, 6, 7);
    f2 = __builtin_shufflevector(l2, h2, 0, 1, 2, 3, 4, 5, 6, 7); f3 = __builtin_shufflevector(l3, h3, 0, 1, 2, 3, 4, 5, 6, 7);
}
#define MFMA16(a, b, c) __builtin_amdgcn_mfma_f32_16x16x32_bf16((a), (b), (c), 0, 0, 0)

template <bool DECAY> __device__ __forceinline__ void stage_rope(Frame& F, LAS unsigned char* img, const bf16* src, const f32x2* rope, float s_const, float lg) {
#pragma unroll
    for (int i = 0; i < 4; ++i) { const int task = F.tid + NT * i, c = task >> 4, g = task & 15;
        const v2u lo = *(const v2u*)(src + (size_t)c * NIN + 4 * g), hi = *(const v2u*)(src + (size_t)c * NIN + 64 + 4 * g);
        const f32x4 r01 = *(const f32x4*)(rope + c * 64 + 4 * g), r23 = *(const f32x4*)(rope + c * 64 + 4 * g + 2);
        const float sc = DECAY ? s_const * __expf(lg * (float)(127 - c)) : s_const;
        const float x1[4] = {bflo(lo.x), bfhi(lo.x), bflo(lo.y), bfhi(lo.y)}, x2[4] = {bflo(hi.x), bfhi(hi.x), bflo(hi.y), bfhi(hi.y)};
        const float cs[4] = {r01.x, r01.z, r23.x, r23.z}, sn[4] = {r01.y, r01.w, r23.y, r23.w};
        float y1[4], y2[4];
#pragma unroll
        for (int j = 0; j < 4; ++j) { y1[j] = (x1[j] * cs[j] - x2[j] * sn[j]) * sc; y2[j] = (x2[j] * cs[j] + x1[j] * sn[j]) * sc; }
        v2u w1, w2; w1.x = pk2(y1[0], y1[1]); w1.y = pk2(y1[2], y1[3]); w2.x = pk2(y2[0], y2[1]); w2.y = pk2(y2[2], y2[3]);
        *(LAS v2u*)(img + c * KSB + 8 * g) = w1; *(LAS v2u*)(img + c * KSB + 128 + 8 * g) = w2; }
}
__device__ __forceinline__ void stage_v(Frame& F, LAS unsigned char* img, const bf16* src) {
#pragma unroll
    for (int i = 0; i < 8; ++i) { const int task = F.tid + NT * i, c = task >> 5, g = task & 31;
        *(LAS v4u*)(img + c * VSB + 16 * g) = *(const v4u*)(src + (size_t)c * NIN + 8 * g); }
}

__device__ __forceinline__ void p3_kv_conv(Frame& F) {
    unsigned char* ws = F.ws; const bf16* PROJ = (const bf16*)(ws + WS_PROJ); const f32x2* ROPE = (const f32x2*)(ws + WS_ROPE); bf16* KV = (bf16*)(ws + WS_KV);
    LAS unsigned char* Kimg = F.lds; LAS unsigned char* Vimg = F.lds + 34816;
    const int w = F.wave, lane = F.lane, g = lane >> 4, q = (lane & 15) >> 2, p = lane & 3;
    for (int it = (int)blockIdx.x; it < BATCH * NH * NCH; it += F.G) {
        const int n = it & 63, h = (it >> 6) & 3, b = it >> 8; const int t0 = b * SEQ + n * CH; const float lg = log_gamma(h);
        stage_rope<true>(F, Kimg, PROJ + (size_t)t0 * NIN + OFF_K + h * DK, ROPE + (size_t)t0 * 64, 1.0f, lg);
        stage_v(F, Vimg, PROJ + (size_t)t0 * NIN + OFF_V + h * DV);
        __syncthreads();
        f32x4 acc[16];
#pragma unroll
        for (int i = 0; i < 16; ++i) acc[i] = (f32x4){0.f, 0.f, 0.f, 0.f};
        const unsigned ka = F.ldsb + (unsigned)((8 * g + q) * KSB + (16 * w + 4 * p) * 2);
        const unsigned va = F.ldsb + 34816u + (unsigned)((8 * g + q) * VSB + (4 * p) * 2);
#pragma unroll
        for (int ks = 0; ks < 4; ++ks) {
            const bf16x8 a = tr_frag<4 * KSB>(ka + ks * 32 * KSB);
#pragma unroll
            for (int nt = 0; nt < 16; nt += 4) { bf16x8 b0, b1, b2, b3; tr_frag4<4 * VSB, 32>(va + ks * 32 * VSB + nt * 32, b0, b1, b2, b3);
                acc[nt] = MFMA16(a, b0, acc[nt]); acc[nt + 1] = MFMA16(a, b1, acc[nt + 1]); acc[nt + 2] = MFMA16(a, b2, acc[nt + 2]); acc[nt + 3] = MFMA16(a, b3, acc[nt + 3]); }
        }
        bf16* kvp = KV + (size_t)it * (DV * DK) + (size_t)(lane & 15) * DK + 16 * w + 4 * g;
#pragma unroll
        for (int nt = 0; nt < 16; ++nt) { v2u wv; wv.x = pk2(acc[nt][0], acc[nt][1]); wv.y = pk2(acc[nt][2], acc[nt][3]); *(v2u*)(kvp + (size_t)(16 * nt) * DK) = wv; }
        __syncthreads();
    }
    bf16* CONVG = (bf16*)(ws + WS_CONVG);
    const int gw = F.vcu * NWAVES + F.wave, NGW = F.G * NWAVES;
    for (int m = gw; m < M; m += NGW) { const int s = m & (SEQ - 1);
#pragma unroll
        for (int j = 0; j < 4; ++j) { const int ch = 4 * lane + 256 * j; const bf16* rp = PROJ + (size_t)m * NIN + ch;
            const f32x4 w0 = *(const f32x4*)(F.conv_w + ch), w1 = *(const f32x4*)(F.conv_w + D + ch), w2 = *(const f32x4*)(F.conv_w + 2 * D + ch);
            const v2u u0 = *(const v2u*)(rp + OFF_U), c0 = *(const v2u*)(rp + OFF_GC), gb = *(const v2u*)(rp + OFF_GB);
            v2u u1 = {0u, 0u}, c1 = {0u, 0u}, u2 = {0u, 0u}, c2 = {0u, 0u};
            if (s >= 1) { u1 = *(const v2u*)(rp - NIN + OFF_U); c1 = *(const v2u*)(rp - NIN + OFF_GC); }
            if (s >= 2) { u2 = *(const v2u*)(rp - 2 * NIN + OFF_U); c2 = *(const v2u*)(rp - 2 * NIN + OFF_GC); }
            f32x4 cu0 = {bflo(u0.x) * bflo(c0.x), bfhi(u0.x) * bfhi(c0.x), bflo(u0.y) * bflo(c0.y), bfhi(u0.y) * bfhi(c0.y)};
            f32x4 cu1 = {bflo(u1.x) * bflo(c1.x), bfhi(u1.x) * bfhi(c1.x), bflo(u1.y) * bflo(c1.y), bfhi(u1.y) * bfhi(c1.y)};
            f32x4 cu2 = {bflo(u2.x) * bflo(c2.x), bfhi(u2.x) * bfhi(c2.x), bflo(u2.y) * bflo(c2.y), bfhi(u2.y) * bfhi(c2.y)};
            const f32x4 gbf = {bflo(gb.x), bfhi(gb.x), bflo(gb.y), bfhi(gb.y)};
            const f32x4 o = gbf * (w0 * cu2 + w1 * cu1 + w2 * cu0);
            v2u wv; wv.x = pk2(o.x, o.y); wv.y = pk2(o.z, o.w); *(v2u*)(CONVG + (size_t)m * D + ch) = wv; }
    }
}

__device__ __forceinline__ void p4_scan(Frame& F) {
    const unsigned* KV = (const unsigned*)(F.ws + WS_KV); unsigned* SP = (unsigned*)(F.ws + WS_SP);
    for (int gid = F.vcu * NT + F.tid; gid < BATCH * NH * (DV * DK / 2); gid += F.G * NT) {
        const int bh = gid >> 14, e2 = gid & 16383, h = bh & 3; const float dec = __expf(log_gamma(h) * 128.0f);
        f32x2 S = {0.f, 0.f};
        const unsigned* kp = KV + (size_t)bh * NCH * 16384 + e2; unsigned* sp = SP + (size_t)bh * NCH * 16384 + e2;
#pragma unroll 8
        for (int n = 0; n < NCH; ++n) { const unsigned kw = kp[(size_t)n * 16384]; const f32x2 kv = {bflo(kw), bfhi(kw)}; sp[(size_t)n * 16384] = pk2(S.x, S.y); S = S * dec + kv; }
    }
}

__device__ __forceinline__ void p5_retention(Frame& F) {
    unsigned char* ws = F.ws; const bf16* PROJ = (const bf16*)(ws + WS_PROJ); const f32x2* ROPE = (const f32x2*)(ws + WS_ROPE); const bf16* SP = (const bf16*)(ws + WS_SP);
    bf16* RETG = (bf16*)(ws + WS_RETG);
    LAS unsigned char* Qimg = F.lds; LAS unsigned char* Kimg = F.lds + 34816; LAS unsigned char* Bimg = F.lds + 69632;
    const int w = F.wave, lane = F.lane, g = lane >> 4, q = (lane & 15) >> 2, p = lane & 3, fr = lane & 15;
    for (int it = (int)blockIdx.x; it < BATCH * NH * NCH; it += F.G) {
        const int n = it & 63, h = (it >> 6) & 3, b = it >> 8; const int t0 = b * SEQ + n * CH; const float lg = log_gamma(h);
        stage_rope<false>(F, Qimg, PROJ + (size_t)t0 * NIN + OFF_Q + h * DK, ROPE + (size_t)t0 * 64, 0.08838834764831845f, 0.f);
        stage_rope<false>(F, Kimg, PROJ + (size_t)t0 * NIN + OFF_K + h * DK, ROPE + (size_t)t0 * 64, 1.0f, 0.f);
        { const bf16* sp = SP + (size_t)it * (DV * DK);
#pragma unroll
          for (int i = 0; i < 8; ++i) { const int task = F.tid + NT * i, r = task >> 4, c16 = task & 15; *(LAS v4u*)(Bimg + r * KSB + 16 * c16) = *(const v4u*)(sp + r * DK + 8 * c16); } }
        __syncthreads();
        f32x4 acc[16];
#pragma unroll
        for (int i = 0; i < 16; ++i) acc[i] = (f32x4){0.f, 0.f, 0.f, 0.f};
        f32x4 sc[8];
#pragma unroll
        for (int i = 0; i < 8; ++i) sc[i] = (f32x4){0.f, 0.f, 0.f, 0.f};
#pragma unroll 1
        for (int ks = 0; ks < 4; ++ks) {
            const bf16x8 qf = ldfrag(Qimg, 16 * w + fr, KSB, 32 * ks + 8 * g);
#pragma unroll
            for (int nt = 0; nt < 16; ++nt) { const bf16x8 sf = ldfrag(Bimg, 16 * nt + fr, KSB, 32 * ks + 8 * g); acc[nt] = MFMA16(sf, qf, acc[nt]); }
#pragma unroll
            for (int jt = 0; jt < 8; ++jt) { const bf16x8 kf = ldfrag(Kimg, 16 * jt + fr, KSB, 32 * ks + 8 * g); sc[jt] = MFMA16(kf, qf, sc[jt]); }
        }
        const int irow = 16 * w + fr;
        { const float cd = __expf(lg * (float)(irow + 1));
#pragma unroll
          for (int nt = 0; nt < 16; ++nt) acc[nt] = acc[nt] * cd; }
        __syncthreads();
#pragma unroll
        for (int jt = 0; jt < 8; ++jt) { float pv[4];
#pragma unroll
            for (int r = 0; r < 4; ++r) { const int j = 16 * jt + 4 * g + r; pv[r] = (irow >= j) ? sc[jt][r] * __expf(lg * (float)(irow - j)) : 0.f; }
            v2u wv; wv.x = pk2(pv[0], pv[1]); wv.y = pk2(pv[2], pv[3]); *(LAS v2u*)(Kimg + irow * KSB + (16 * jt + 4 * g) * 2) = wv; }
        stage_v(F, Bimg, PROJ + (size_t)t0 * NIN + OFF_V + h * DV);
        __syncthreads();
        const unsigned va = F.ldsb + 69632u + (unsigned)((8 * g + q) * VSB + (4 * p) * 2);
#pragma unroll 1
        for (int ks = 0; ks < 4; ++ks) {
            const bf16x8 pf = ldfrag(Kimg, 16 * w + fr, KSB, 32 * ks + 8 * g);
#pragma unroll
            for (int nt = 0; nt < 16; nt += 4) { bf16x8 v0, v1, v2, v3; tr_frag4<4 * VSB, 32>(va + ks * 32 * VSB + nt * 32, v0, v1, v2, v3);
                acc[nt] = MFMA16(v0, pf, acc[nt]); acc[nt + 1] = MFMA16(v1, pf, acc[nt + 1]); acc[nt + 2] = MFMA16(v2, pf, acc[nt + 2]); acc[nt + 3] = MFMA16(v3, pf, acc[nt + 3]); }
        }
        float ss = 0.f;
#pragma unroll
        for (int nt = 0; nt < 16; ++nt) ss += (acc[nt][0] * acc[nt][0] + acc[nt][1] * acc[nt][1]) + (acc[nt][2] * acc[nt][2] + acc[nt][3] * acc[nt][3]);
        ss += __shfl_xor(ss, 16); ss += __shfl_xor(ss, 32);
        const float rstd = 1.0f / sqrtf(ss * (1.0f / DV) + EPS);
        const size_t trow = (size_t)(t0 + irow);
#pragma unroll
        for (int nt = 0; nt < 16; ++nt) { const int dv = 16 * nt + 4 * g; const f32x4 gn = *(const f32x4*)(F.ret_norm_g + h * DV + dv);
            const v2u gr = *(const v2u*)(PROJ + trow * NIN + OFF_GR + h * DV + dv);
            const f32x4 o = acc[nt] * rstd * gn * (f32x4){siluf_(bflo(gr.x)), siluf_(bfhi(gr.x)), siluf_(bflo(gr.y)), siluf_(bfhi(gr.y))};
            v2u wv; wv.x = pk2(o[0], o[1]); wv.y = pk2(o[2], o[3]); *(v2u*)(RETG + trow * D + h * DV + dv) = wv; }
        __syncthreads();
    }
}

__device__ __forceinline__ unsigned f32_key(float x) { const unsigned u = __float_as_uint(x); return (u & 0x80000000u) ? ~u : (u | 0x80000000u); }
template <bool DRY> __device__ __forceinline__ void route_tokens(Frame& F) {
    unsigned char* ws = F.ws; const float* LOGITS = (const float*)(ws + WS_LOGITS);
    int* EIDX = (int*)(ws + WS_EIDX); int* POS = (int*)(ws + WS_POS); int* LTOK = (int*)(ws + WS_LTOK); float* LW = (float*)(ws + WS_LW);
    unsigned* cnt = (unsigned*)(F.ctl + CW_CNT);
    const int gw = F.vcu * NWAVES + F.wave, NGW = F.G * NWAVES, lane = F.lane;
    const f32x4 bias = *(const f32x4*)(F.router_bias + 4 * lane);
    for (int t0 = 2 * gw; t0 < M; t0 += 2 * NGW) {
        float sc[2][4]; unsigned key[2][4];
#pragma unroll
        for (int u = 0; u < 2; ++u) {
            const f32x4 lgv = *(const f32x4*)(LOGITS + (size_t)(t0 + u) * NE + 4 * lane);
            sc[u][0] = 1.0f / (1.0f + __expf(-lgv.x)); sc[u][1] = 1.0f / (1.0f + __expf(-lgv.y)); sc[u][2] = 1.0f / (1.0f + __expf(-lgv.z)); sc[u][3] = 1.0f / (1.0f + __expf(-lgv.w));
            const float c0 = sc[u][0] + bias.x, c1 = sc[u][1] + bias.y, c2 = sc[u][2] + bias.z, c3 = sc[u][3] + bias.w;
            const float a = fmaxf(c0, c1), bq = fminf(c0, c1), cc = fmaxf(c2, c3), dd = fminf(c2, c3);
            float m1 = fmaxf(a, cc), m2 = fmaxf(fminf(a, cc), fmaxf(bq, dd));
#pragma unroll
            for (int o = 1; o < 8; o <<= 1) { const float o1 = __shfl_xor(m1, o), o2 = __shfl_xor(m2, o); const float n1 = fmaxf(m1, o1), n2 = fmaxf(fminf(m1, o1), fmaxf(m2, o2)); m1 = n1; m2 = n2; }
            const float gs = m1 + m2; const int myg = lane >> 3; int rank = 0;
#pragma unroll
            for (int g2 = 0; g2 < 8; ++g2) { const float sg = __uint_as_float((unsigned)__builtin_amdgcn_readlane((int)__float_as_uint(gs), g2 * 8)); rank += (sg > gs || (sg == gs && g2 < myg)) ? 1 : 0; }
            const bool gsel = rank < 4;
            key[u][0] = gsel ? f32_key(c0) : 0u; key[u][1] = gsel ? f32_key(c1) : 0u; key[u][2] = gsel ? f32_key(c2) : 0u; key[u][3] = gsel ? f32_key(c3) : 0u;
        }
        unsigned th0 = 0u, th1 = 0u;
#pragma unroll 4
        for (int bit = 31; bit >= 0; --bit) {
            const unsigned ca = th0 | (1u << bit), cb = th1 | (1u << bit);
            const int na = __popcll(__ballot(key[0][0] >= ca)) + __popcll(__ballot(key[0][1] >= ca)) + __popcll(__ballot(key[0][2] >= ca)) + __popcll(__ballot(key[0][3] >= ca));
            const int nb = __popcll(__ballot(key[1][0] >= cb)) + __popcll(__ballot(key[1][1] >= cb)) + __popcll(__ballot(key[1][2] >= cb)) + __popcll(__ballot(key[1][3] >= cb));
            th0 = na >= 8 ? ca : th0; th1 = nb >= 8 ? cb : th1;
        }
        unsigned pa[2][4]; int ra[2][4]; float inva[2];
#pragma unroll
        for (int u = 0; u < 2; ++u) { const unsigned th = u ? th1 : th0;
            const bool s0 = key[u][0] >= th, s1 = key[u][1] >= th, s2 = key[u][2] >= th, s3 = key[u][3] >= th;
            const unsigned long long b0 = __ballot(s0), b1 = __ballot(s1), b2 = __ballot(s2), b3 = __ballot(s3);
            const unsigned long long lt = (1ull << lane) - 1ull;
            const int base = __popcll(b0 & lt) + __popcll(b1 & lt) + __popcll(b2 & lt) + __popcll(b3 & lt);
            const int r0 = base, r1 = r0 + (s0 ? 1 : 0), r2 = r1 + (s1 ? 1 : 0), r3 = r2 + (s2 ? 1 : 0);
            const float part = (s0 ? sc[u][0] : 0.f) + (s1 ? sc[u][1] : 0.f) + (s2 ? sc[u][2] : 0.f) + (s3 ? sc[u][3] : 0.f);
            const float inv = 2.5f / wave_sum(part);
            const bool a0 = s0 && r0 < 8, a1 = s1 && r1 < 8, a2 = s2 && r2 < 8, a3 = s3 && r3 < 8; const int e0 = 4 * lane;
            unsigned p0 = 0u, p1 = 0u, p2 = 0u, p3 = 0u;
            if (DRY) { if (a0) p0 = __hip_atomic_load(cnt + 64 * e0, RLX_AGENT); if (a1) p1 = __hip_atomic_load(cnt + 64 * (e0 + 1), RLX_AGENT); if (a2) p2 = __hip_atomic_load(cnt + 64 * (e0 + 2), RLX_AGENT); if (a3) p3 = __hip_atomic_load(cnt + 64 * (e0 + 3), RLX_AGENT); } else {
            if (a0) p0 = __hip_atomic_fetch_add(cnt + 64 * e0, 1u, RLX_AGENT);
            if (a1) p1 = __hip_atomic_fetch_add(cnt + 64 * (e0 + 1), 1u, RLX_AGENT);
            if (a2) p2 = __hip_atomic_fetch_add(cnt + 64 * (e0 + 2), 1u, RLX_AGENT);
            if (a3) p3 = __hip_atomic_fetch_add(cnt + 64 * (e0 + 3), 1u, RLX_AGENT); }
            pa[u][0] = p0; pa[u][1] = p1; pa[u][2] = p2; pa[u][3] = p3; ra[u][0] = a0 ? r0 : -1; ra[u][1] = a1 ? r1 : -1; ra[u][2] = a2 ? r2 : -1; ra[u][3] = a3 ? r3 : -1; inva[u] = inv;
        }
#pragma unroll
        for (int u = 0; u < 2; ++u) { const int t = t0 + u;
#pragma unroll
            for (int j = 0; j < 4; ++j) if (ra[u][j] >= 0) { const int e = 4 * lane + j; const unsigned ps = DRY ? (unsigned)(CAP - 1 - (t & 1023)) : pa[u][j]; if (DRY && pa[u][j] == 0xffffffffu) continue;
                LTOK[(size_t)e * CAP + ps] = t; LW[(size_t)e * CAP + ps] = sc[u][j] * inva[u]; EIDX[t * 8 + ra[u][j]] = e; POS[t * 8 + ra[u][j]] = (int)ps; }
        }
    }
}

__device__ __forceinline__ void expert_prefix(Frame& F, LAS int* pref, LAS int* off) {
    if (F.wave == 0) { const unsigned* cnt = (const unsigned*)(F.ctl + CW_CNT); const int lane = F.lane;
        int c[4], nb[4]; int tc = 0, tb = 0;
#pragma unroll
        for (int j = 0; j < 4; ++j) { c[j] = (int)__hip_atomic_load(cnt + 64 * (4 * lane + j), RLX_AGENT); nb[j] = (c[j] + 127) >> 7; tc += c[j]; tb += nb[j]; }
        int xc = tc, xb = tb;
#pragma unroll
        for (int o = 1; o < 64; o <<= 1) { const int vc = __shfl_up(xc, o), vb = __shfl_up(xb, o); if (lane >= o) { xc += vc; xb += vb; } }
        int ec = xc - tc, eb = xb - tb;
#pragma unroll
        for (int j = 0; j < 4; ++j) { off[4 * lane + j] = ec; pref[4 * lane + j] = eb; ec += c[j]; eb += nb[j]; }
        if (lane == 63) { off[256] = ec; pref[256] = eb; } }
}

constexpr int EX_PREF = 0, EX_OFF = 1040, EX_TOK = 2176, EX_W = 2688, EX_BUF = 3200, EX_BUFSZ = 27648, EX_BOFF = 10240, EX_G = EX_BUF + 2 * EX_BUFSZ;
constexpr int ASB = 80, EXD = 4, EXNC = 96;
static_assert(EX_G + 128 * VSB <= LDSCTL_OFF, "expert LDS map");
template <int RS4, int STEP> __device__ __forceinline__ void tr_frag2(unsigned addr, bf16x8& f0, bf16x8& f1) {
    s16x4 l0, h0, l1, h1;
    asm volatile("ds_read_b64_tr_b16 %0, %4\n\tds_read_b64_tr_b16 %1, %4 offset:%5\n\tds_read_b64_tr_b16 %2, %4 offset:%6\n\tds_read_b64_tr_b16 %3, %4 offset:%7\n\ts_waitcnt lgkmcnt(0)"
                 : "=&v"(l0), "=&v"(h0), "=&v"(l1), "=&v"(h1) : "v"(addr), "i"(RS4), "i"(STEP), "i"(STEP + RS4) : "memory");
    f0 = __builtin_shufflevector(l0, h0, 0, 1, 2, 3, 4, 5, 6, 7); f1 = __builtin_shufflevector(l1, h1, 0, 1, 2, 3, 4, 5, 6, 7);
}
struct ExSet { f32x4 w[4]; v4u a; };
constexpr int PF_OFF = 140288;
__device__ __forceinline__ void pf_dma(const void* gsrc, unsigned lds_dst) {
    unsigned keep;
    asm volatile("s_mov_b32 %0, m0\n\ts_mov_b32 m0, %2\n\ts_nop 0\n\tglobal_load_lds_dword %1, off\n\ts_mov_b32 m0, %0" : "=&s"(keep) : "v"(gsrc), "s"(lds_dst) : "memory");
}
template <int ABL> __device__ __forceinline__ void p11_experts(Frame& F) {
    unsigned char* ws = F.ws; const bf16* H2 = (const bf16*)(ws + WS_HB); const int* LTOK = (const int*)(ws + WS_LTOK); const float* LW = (const float*)(ws + WS_LW); bf16* YP = (bf16*)(ws + WS_YP);
    LAS int* pref = (LAS int*)(F.lds + EX_PREF); LAS int* off = (LAS int*)(F.lds + EX_OFF); LAS int* tokl = (LAS int*)(F.lds + EX_TOK); LAS float* wl = (LAS float*)(F.lds + EX_W);
    LAS unsigned char* Gimg = F.lds + EX_G;
    const int tid = F.tid, w = F.wave, wr = w >> 2, wc = w & 3;
    const unsigned pfl = F.ldsb + PF_OFF + (unsigned)w * 256u;
    expert_prefix(F, pref, off);
    __syncthreads();
    const int nitems = pref[256];
    for (int it = F.vcu; it < nitems; it += F.G) {
        int e = 0;
#pragma unroll
        for (int s = 128; s >= 1; s >>= 1) if (pref[e + s] <= it) e += s;
        e = __builtin_amdgcn_readfirstlane(e);
        const int rb = __builtin_amdgcn_readfirstlane(it - pref[e]), cnt_e = __builtin_amdgcn_readfirstlane(off[e + 1] - off[e]), r0 = rb * 128, slot0 = __builtin_amdgcn_readfirstlane(off[e]) + r0;
        if (tid < 128) { const int idx = r0 + tid; const bool ok = idx < cnt_e; tokl[tid] = LTOK[(size_t)e * CAP + (ok ? idx : r0)]; wl[tid] = ok ? LW[(size_t)e * CAP + idx] : 0.f; }
        __syncthreads();
        const float* Wg = F.w_eg + (size_t)e * D * EH; const float* Wu = F.w_eu + (size_t)e * D * EH; const float* Wd = F.w_ed + (size_t)e * EH * D;
        const bf16* asrc = H2 + (size_t)tokl[tid >> 2] * D + (tid & 3) * 8;
        int gs_lo, gs_n; { const int xs = (it / F.G) * F.G + (F.vcu & ~31); int lo = pref[e], hi = pref[e + 1]; lo = lo > xs ? lo : xs; hi = hi < xs + 32 ? hi : xs + 32; hi = hi < nitems ? hi : nitems;
            gs_lo = __builtin_amdgcn_readfirstlane(lo); gs_n = __builtin_amdgcn_readfirstlane(hi - lo); }
        unsigned gs_k = 0u;
#define EX_GSYNC() do { if (MK_GSYNC && gs_n > 1) { ++gs_k; if (tid == 0) { unsigned* cw = (unsigned*)(F.ctl + CW_GS) + 64 * gs_lo; __hip_atomic_fetch_add(cw, 1u, RLX_AGENT);               \
                const unsigned long long t0_ = __builtin_amdgcn_s_memrealtime(); const unsigned want = (unsigned)gs_n * gs_k;                                                                 \
                while (__hip_atomic_load(cw, RLX_AGENT) < want) { if (__builtin_amdgcn_s_memrealtime() - t0_ > 20000ull) break; __builtin_amdgcn_s_sleep(2); } }                            \
            __syncthreads(); } } while (0)
        EX_GSYNC();
        if (MK_GSTAG > 0 && gs_n > 1) { const unsigned long long t0_ = __builtin_amdgcn_s_memrealtime(); const unsigned long long d_ = (unsigned long long)(MK_GSTAG * (it - gs_lo)); while (__builtin_amdgcn_s_memrealtime() - t0_ < d_) __builtin_amdgcn_s_sleep(1); }
        f32x4 acc[4][4];
#define EX_ZERO() do { _Pragma("unroll") for (int i = 0; i < 4; ++i) _Pragma("unroll") for (int j = 0; j < 4; ++j) acc[i][j] = (f32x4){0.f, 0.f, 0.f, 0.f}; } while (0)
        EX_ZERO();
        ExSet S0, S1, S2, S3;
        if (ABL & 16) { _Pragma("unroll") for (int i = 0; i < 4; ++i) { S0.w[i] = S1.w[i] = S2.w[i] = S3.w[i] = (f32x4){1.f, 1.f, 1.f, 1.f}; } S0.a = S1.a = S2.a = S3.a = (v4u){0u, 0u, 0u, 0u}; }
#define EX_L1(S, CC) do { if (ABL & 16) break; const int cc_ = (CC) & 63, hp_ = cc_ >> 5, kc_ = cc_ & 31; int tl = tid; asm volatile("" : "+v"(tl));                         \
            unsigned o = (unsigned)((32 * kc_ + (tl >> 5)) * EH + 128 * hp_ + 4 * (tl & 31));                                                            \
            S.w[0] = *(const f32x4*)(Wg + o); S.w[1] = *(const f32x4*)(Wg + o + 16 * EH); S.w[2] = *(const f32x4*)(Wu + o); S.w[3] = *(const f32x4*)(Wu + o + 16 * EH); \
            S.a = *(const v4u*)(asrc + 32 * kc_); } while (0)
#define EX_PF1(CC) do { if (MK_PFD > 0) { const int cc_ = (CC) & 63, hp_ = cc_ >> 5, kc_ = cc_ & 31; int tl = tid; asm volatile("" : "+v"(tl)); const int ln_ = tl & 63;   \
            if (w < 4) { const float* wm_ = (w & 2) ? Wu : Wg; pf_dma(wm_ + (size_t)(32 * kc_ + (w & 1) * 16 + (ln_ >> 2)) * EH + 128 * hp_ + 32 * (ln_ & 3), pfl); }              \
            else if (w < 6) { pf_dma(H2 + (size_t)tokl[(w - 4) * 64 + ln_] * D + 32 * kc_, pfl); } } } while (0)
#define EX_W1(S, BUF) do { if (ABL & 2) { asm volatile("" :: "v"(S.w[0]), "v"(S.w[1]), "v"(S.w[2]), "v"(S.w[3]), "v"(S.a)); break; } int tl = tid; asm volatile("" : "+v"(tl)); LAS unsigned char* b_ = (BUF) + EX_BOFF + (tl >> 5) * KSB + 8 * (tl & 31); v2u p_[4];  \
            _Pragma("unroll") for (int i = 0; i < 4; ++i) { p_[i].x = pk2(S.w[i].x, S.w[i].y); p_[i].y = pk2(S.w[i].z, S.w[i].w); }                        \
            *(LAS v2u*)b_ = p_[0]; *(LAS v2u*)(b_ + 16 * KSB) = p_[1]; *(LAS v2u*)(b_ + 32 * KSB) = p_[2]; *(LAS v2u*)(b_ + 48 * KSB) = p_[3];             \
            *(LAS v4u*)((BUF) + (tl >> 2) * ASB + (tl & 3) * 16) = S.a; } while (0)
#define EX_C1(C) do { if (ABL & 1) break; int tl = tid; asm volatile("" : "+v"(tl)); const int g = (tl >> 4) & 3, fr = tl & 15, q = (tl & 15) >> 2, p = tl & 3;              \
            LAS unsigned char* buf = F.lds + EX_BUF + ((C) & 1) * EX_BUFSZ; const unsigned ta = F.ldsb + EX_BUF + (unsigned)(((C) & 1) * EX_BUFSZ + EX_BOFF + (8 * g + q) * KSB + (32 * wc + 4 * p) * 2); \
            bf16x8 af[4]; _Pragma("unroll") for (int rt = 0; rt < 4; ++rt) af[rt] = ldfrag(buf, 64 * wr + 16 * rt + fr, ASB, 8 * g);                     \
            bf16x8 b0, b1, b2, b3; tr_frag2<4 * KSB, 32>(ta, b0, b1); tr_frag2<4 * KSB, 32>(ta + 32 * KSB, b2, b3);                                       \
            _Pragma("unroll") for (int rt = 0; rt < 4; ++rt) { acc[rt][0] = MFMA16(b0, af[rt], acc[rt][0]); acc[rt][1] = MFMA16(b1, af[rt], acc[rt][1]); acc[rt][2] = MFMA16(b2, af[rt], acc[rt][2]); acc[rt][3] = MFMA16(b3, af[rt], acc[rt][3]); } } while (0)
#define EX_C1S(SL, C) do { int tl = tid; asm volatile("" : "+v"(tl)); const int g = (tl >> 4) & 3, fr = tl & 15, q = (tl & 15) >> 2, p = tl & 3;      \
            const int cc_ = ((C) + 4) & 63, hp_ = cc_ >> 5, kc_ = cc_ & 31; const unsigned o = (unsigned)((32 * kc_ + (tl >> 5)) * EH + 128 * hp_ + 4 * (tl & 31));        \
            LAS unsigned char* buf = F.lds + EX_BUF + ((C) & 1) * EX_BUFSZ; const unsigned ta = F.ldsb + EX_BUF + (unsigned)(((C) & 1) * EX_BUFSZ + EX_BOFF + (8 * g + q) * KSB + (32 * wc + 4 * p) * 2); \
            bf16x8 af[4]; _Pragma("unroll") for (int rt = 0; rt < 4; ++rt) af[rt] = ldfrag(buf, 64 * wr + 16 * rt + fr, ASB, 8 * g);                     \
            bf16x8 b0, b1, b2, b3; tr_frag2<4 * KSB, 32>(ta, b0, b1); tr_frag2<4 * KSB, 32>(ta + 32 * KSB, b2, b3);                                       \
            __builtin_amdgcn_sched_barrier(0); SL.w[0] = *(const f32x4*)(Wg + o); __builtin_amdgcn_sched_barrier(0);                                       \
            acc[0][0] = MFMA16(b0, af[0], acc[0][0]); acc[0][1] = MFMA16(b1, af[0], acc[0][1]); acc[0][2] = MFMA16(b2, af[0], acc[0][2]); acc[0][3] = MFMA16(b3, af[0], acc[0][3]); \
            __builtin_amdgcn_sched_barrier(0); SL.w[1] = *(const f32x4*)(Wg + o + 16 * EH); __builtin_amdgcn_sched_barrier(0);                             \
            acc[1][0] = MFMA16(b0, af[1], acc[1][0]); acc[1][1] = MFMA16(b1, af[1], acc[1][1]); acc[1][2] = MFMA16(b2, af[1], acc[1][2]); acc[1][3] = MFMA16(b3, af[1], acc[1][3]); \
            __builtin_amdgcn_sched_barrier(0); SL.w[2] = *(const f32x4*)(Wu + o); __builtin_amdgcn_sched_barrier(0);                                       \
            acc[2][0] = MFMA16(b0, af[2], acc[2][0]); acc[2][1] = MFMA16(b1, af[2], acc[2][1]); acc[2][2] = MFMA16(b2, af[2], acc[2][2]); acc[2][3] = MFMA16(b3, af[2], acc[2][3]); \
            __builtin_amdgcn_sched_barrier(0); SL.w[3] = *(const f32x4*)(Wu + o + 16 * EH); SL.a = *(const v4u*)(asrc + 32 * kc_); __builtin_amdgcn_sched_barrier(0);   \
            acc[3][0] = MFMA16(b0, af[3], acc[3][0]); acc[3][1] = MFMA16(b1, af[3], acc[3][1]); acc[3][2] = MFMA16(b2, af[3], acc[3][2]); acc[3][3] = MFMA16(b3, af[3], acc[3][3]); } while (0)
#define EX_STEP1(SL, SW, C) do { if (MK_SPREAD) { EX_C1S(SL, C); EX_W1(SW, F.lds + EX_BUF + (((C) + 1) & 1) * EX_BUFSZ); __syncthreads(); break; } if (!MK_LATE_ISSUE) { EX_L1(SL, (C) + 4); } EX_C1(C); EX_W1(SW, F.lds + EX_BUF + (((C) + 1) & 1) * EX_BUFSZ); if (MK_LATE_ISSUE) { EX_L1(SL, (C) + 4); } __syncthreads(); } while (0)
        EX_L1(S0, 0); EX_L1(S1, 1); EX_L1(S2, 2); EX_L1(S3, 3);
        EX_W1(S0, F.lds + EX_BUF);
        __syncthreads();
#pragma unroll 1
        for (int c4 = 0; c4 < 64; c4 += 4) {
            if (MK_GSYNC_EVERY > 0 && (c4 & (MK_GSYNC_EVERY - 1)) == 0 && c4) EX_GSYNC();
            EX_STEP1(S0, S1, c4); EX_STEP1(S1, S2, c4 + 1); EX_STEP1(S2, S3, c4 + 2); EX_STEP1(S3, S0, c4 + 3);
            if ((c4 & 31) == 28) { const int hp = c4 >> 5; int tl = tid; asm volatile("" : "+v"(tl)); const int g = (tl >> 4) & 3, fr = tl & 15;
#pragma unroll
                for (int rt = 0; rt < 4; ++rt)
#pragma unroll
                    for (int ct = 0; ct < 2; ++ct) { const f32x4 ga = acc[rt][ct], ua = acc[rt][ct + 2];
                        v2u wv; wv.x = pk2(siluf_(ga[0]) * ua[0], siluf_(ga[1]) * ua[1]); wv.y = pk2(siluf_(ga[2]) * ua[2], siluf_(ga[3]) * ua[3]);
                        *(LAS v2u*)(Gimg + (64 * wr + 16 * rt + fr) * VSB + (128 * hp + 32 * wc + 16 * ct + 4 * g) * 2) = wv; }
                EX_ZERO(); }
        }
#define EX_L2(S, CC) do { if (ABL & 16) break; const int cc_ = (CC) & 31, np_ = cc_ >> 3, kc_ = cc_ & 7; int tl = tid; asm volatile("" : "+v"(tl));                           \
            unsigned o = (unsigned)((32 * kc_ + (tl >> 6)) * D + 256 * np_ + 4 * (tl & 63));                                                              \
            _Pragma("unroll") for (int i = 0; i < 4; ++i) S.w[i] = *(const f32x4*)(Wd + o + (unsigned)(8 * i * D)); } while (0)
#define EX_PF2(CC) do { if (MK_PFD > 0) { const int cc_ = (CC) & 31, np_ = cc_ >> 3, kc_ = cc_ & 7; int tl = tid; asm volatile("" : "+v"(tl)); const int ln_ = tl & 63;    \
            if (w < 4) pf_dma(Wd + (size_t)(32 * kc_ + w * 8 + (ln_ >> 3)) * D + 256 * np_ + 32 * (ln_ & 7), pfl); } } while (0)
#define EX_W2(S, BUF) do { if (ABL & 2) { asm volatile("" :: "v"(S.w[0]), "v"(S.w[1]), "v"(S.w[2]), "v"(S.w[3])); break; } int tl = tid; asm volatile("" : "+v"(tl)); LAS unsigned char* b_ = (BUF) + EX_BOFF + (tl >> 6) * VSB + 8 * (tl & 63);          \
            _Pragma("unroll") for (int i = 0; i < 4; ++i) { v2u p_; p_.x = pk2(S.w[i].x, S.w[i].y); p_.y = pk2(S.w[i].z, S.w[i].w); *(LAS v2u*)(b_ + (8 * i) * VSB) = p_; } } while (0)
#define EX_C2(C) do { if (ABL & 1) break; int tl = tid; asm volatile("" : "+v"(tl)); const int g = (tl >> 4) & 3, fr = tl & 15, q = (tl & 15) >> 2, p = tl & 3;              \
            const unsigned ta = F.ldsb + EX_BUF + (unsigned)(((C) & 1) * EX_BUFSZ + EX_BOFF + (8 * g + q) * VSB + (64 * wc + 4 * p) * 2);                \
            bf16x8 gf[4]; _Pragma("unroll") for (int rt = 0; rt < 4; ++rt) gf[rt] = ldfrag(Gimg, 64 * wr + 16 * rt + fr, VSB, 32 * ((C) & 7) + 8 * g);   \
            bf16x8 b0, b1, b2, b3; tr_frag4<4 * VSB, 32>(ta, b0, b1, b2, b3);                                                                             \
            _Pragma("unroll") for (int rt = 0; rt < 4; ++rt) { acc[rt][0] = MFMA16(b0, gf[rt], acc[rt][0]); acc[rt][1] = MFMA16(b1, gf[rt], acc[rt][1]); acc[rt][2] = MFMA16(b2, gf[rt], acc[rt][2]); acc[rt][3] = MFMA16(b3, gf[rt], acc[rt][3]); } } while (0)
#define EX_STEP2(SL, SW, C) do { if (!MK_LATE_ISSUE) { EX_L2(SL, (C) + 4); } EX_C2(C); EX_W2(SW, F.lds + EX_BUF + (((C) + 1) & 1) * EX_BUFSZ); if (MK_LATE_ISSUE) { EX_L2(SL, (C) + 4); } __syncthreads(); } while (0)
        EX_L2(S0, 0); EX_L2(S1, 1); EX_L2(S2, 2); EX_L2(S3, 3);
        EX_W2(S0, F.lds + EX_BUF);
        __syncthreads();
#pragma unroll 1
        for (int np = 0; np < 4; ++np) {
            if (MK_GSYNC_EVERY > 0) EX_GSYNC();
#pragma unroll 1
            for (int h4 = 0; h4 < 8; h4 += 4) { const int c4 = 8 * np + h4;
                EX_STEP2(S0, S1, c4); EX_STEP2(S1, S2, c4 + 1); EX_STEP2(S2, S3, c4 + 2); EX_STEP2(S3, S0, c4 + 3); }
            int tl = tid; asm volatile("" : "+v"(tl)); const int g = (tl >> 4) & 3, fr = tl & 15;
#pragma unroll
            for (int rt = 0; rt < 4; ++rt) { const int row = 64 * wr + 16 * rt + fr; const float rw = wl[row];
                if (!(ABL & 32) && r0 + row < cnt_e) { bf16* yp = YP + (size_t)(slot0 + row) * D + 256 * np + 64 * wc + 4 * g;
#pragma unroll
                    for (int ct = 0; ct < 4; ++ct) { const f32x4 o = acc[rt][ct] * rw; v2u wv; wv.x = pk2(o[0], o[1]); wv.y = pk2(o[2], o[3]); *(v2u*)(yp + 16 * ct) = wv; } } }
            EX_ZERO();
        }
#undef EX_L1
#undef EX_C1S
#undef EX_PF1
#undef EX_PF2
#undef EX_W1
#undef EX_C1
#undef EX_STEP1
#undef EX_L2
#undef EX_W2
#undef EX_C2
#undef EX_STEP2
#undef EX_ZERO
#undef EX_GSYNC
        __syncthreads();
    }
    asm volatile("s_waitcnt vmcnt(0)" ::: "memory");
}

constexpr int E5_TOK = 2176, E5_W = 3200, E5_BUF = 4224, E5_BUFSZ = 37888, E5_BOFF = 20480;
static_assert(E5_BUF + 2 * E5_BUFSZ <= LDSCTL_OFF, "expert v5 LDS map");
struct E5Set { f32x4 w[4]; v4u a0, a1; };
__device__ __forceinline__ void expert_prefix256(Frame& F, LAS int* pref, LAS int* off) {
    if (F.wave == 0) { const unsigned* cnt = (const unsigned*)(F.ctl + CW_CNT); const int lane = F.lane;
        int c[4], nb[4]; int tc = 0, tb = 0;
#pragma unroll
        for (int j = 0; j < 4; ++j) { c[j] = (int)__hip_atomic_load(cnt + 64 * (4 * lane + j), RLX_AGENT); nb[j] = (c[j] + 255) >> 8; tc += c[j]; tb += nb[j]; }
        int xc = tc, xb = tb;
#pragma unroll
        for (int o = 1; o < 64; o <<= 1) { const int vc = __shfl_up(xc, o), vb = __shfl_up(xb, o); if (lane >= o) { xc += vc; xb += vb; } }
        int ec = xc - tc, eb = xb - tb;
#pragma unroll
        for (int j = 0; j < 4; ++j) { off[4 * lane + j] = ec; pref[4 * lane + j] = eb; ec += c[j]; eb += nb[j]; }
        if (lane == 63) { off[256] = ec; pref[256] = eb; } }
}
__device__ __forceinline__ void p11_experts_v5(Frame& F) {
    unsigned char* ws = F.ws; const bf16* H2 = (const bf16*)(ws + WS_HB); const int* LTOK = (const int*)(ws + WS_LTOK); const float* LW = (const float*)(ws + WS_LW); bf16* YP = (bf16*)(ws + WS_YP);
    bf16* Gs = (bf16*)(ws + WS_RETG) + (size_t)blockIdx.x * 65536;
    LAS int* pref = (LAS int*)(F.lds + EX_PREF); LAS int* off = (LAS int*)(F.lds + EX_OFF); LAS int* tokl = (LAS int*)(F.lds + E5_TOK); LAS float* wl = (LAS float*)(F.lds + E5_W);
    const int tid = F.tid, w = F.wave, wr = w >> 2, wc = w & 3;
    expert_prefix256(F, pref, off);
    __syncthreads();
    const int nitems = pref[256];
    for (int it = F.vcu; it < nitems; it += F.G) {
        int e = 0;
#pragma unroll
        for (int s = 128; s >= 1; s >>= 1) if (pref[e + s] <= it) e += s;
        e = __builtin_amdgcn_readfirstlane(e);
        const int rb = __builtin_amdgcn_readfirstlane(it - pref[e]), cnt_e = __builtin_amdgcn_readfirstlane(off[e + 1] - off[e]), r0 = rb * 256, slot0 = __builtin_amdgcn_readfirstlane(off[e]) + r0;
        if (tid < 256) { const int idx = r0 + tid; const bool ok = idx < cnt_e; tokl[tid] = LTOK[(size_t)e * CAP + (ok ? idx : r0)]; wl[tid] = ok ? LW[(size_t)e * CAP + idx] : 0.f; }
        __syncthreads();
        const float* Wg = F.w_eg + (size_t)e * D * EH; const float* Wu = F.w_eu + (size_t)e * D * EH; const float* Wd = F.w_ed + (size_t)e * EH * D;
        const bf16* asrc = H2 + (size_t)tokl[tid >> 1] * D + (tid & 1) * 16;
        const bf16* gsrc = Gs + (size_t)(tid >> 1) * 256 + (tid & 1) * 16;
        f32x4 acc[2][4][4];
#define E5_ZERO() do { _Pragma("unroll") for (int s_ = 0; s_ < 2; ++s_) _Pragma("unroll") for (int i = 0; i < 4; ++i) _Pragma("unroll") for (int j = 0; j < 4; ++j) acc[s_][i][j] = (f32x4){0.f, 0.f, 0.f, 0.f}; } while (0)
        E5_ZERO();
        E5Set S0, S1;
#define E5_WA(S, BUF, TL) do { *(LAS v4u*)((BUF) + ((TL) >> 1) * ASB + ((TL) & 1) * 32) = S.a0; *(LAS v4u*)((BUF) + ((TL) >> 1) * ASB + ((TL) & 1) * 32 + 16) = S.a1; } while (0)
#define E5_MMA(BUF, B0, B1, B2, B3, FR, G_) do { _Pragma("unroll") for (int s_ = 0; s_ < 2; ++s_) _Pragma("unroll") for (int rt = 0; rt < 4; ++rt) {                       \
            const bf16x8 af = ldfrag((BUF), 128 * s_ + 64 * wr + 16 * rt + (FR), ASB, 8 * (G_));                                                                          \
            acc[s_][rt][0] = MFMA16(B0, af, acc[s_][rt][0]); acc[s_][rt][1] = MFMA16(B1, af, acc[s_][rt][1]); acc[s_][rt][2] = MFMA16(B2, af, acc[s_][rt][2]); acc[s_][rt][3] = MFMA16(B3, af, acc[s_][rt][3]); } } while (0)
#define E5_L1(S, CC) do { const int cc_ = (CC) & 63, hp_ = cc_ >> 5, kc_ = cc_ & 31; int tl = tid; asm volatile("" : "+v"(tl));                         \
            unsigned o = (unsigned)((32 * kc_ + (tl >> 5)) * EH + 128 * hp_ + 4 * (tl & 31));                                                            \
            S.w[0] = *(const f32x4*)(Wg + o); S.w[1] = *(const f32x4*)(Wg + o + 16 * EH); S.w[2] = *(const f32x4*)(Wu + o); S.w[3] = *(const f32x4*)(Wu + o + 16 * EH); \
            S.a0 = *(const v4u*)(asrc + 32 * kc_); S.a1 = *(const v4u*)(asrc + 32 * kc_ + 8); } while (0)
#define E5_W1(S, BUF) do { int tl = tid; asm volatile("" : "+v"(tl)); LAS unsigned char* b_ = (BUF) + E5_BOFF + (tl >> 5) * KSB + 8 * (tl & 31); v2u p_[4];  \
            _Pragma("unroll") for (int i = 0; i < 4; ++i) { p_[i].x = pk2(S.w[i].x, S.w[i].y); p_[i].y = pk2(S.w[i].z, S.w[i].w); }                        \
            *(LAS v2u*)b_ = p_[0]; *(LAS v2u*)(b_ + 16 * KSB) = p_[1]; *(LAS v2u*)(b_ + 32 * KSB) = p_[2]; *(LAS v2u*)(b_ + 48 * KSB) = p_[3];             \
            E5_WA(S, BUF, tl); } while (0)
#define E5_C1(BUFI) do { int tl = tid; asm volatile("" : "+v"(tl)); const int g = (tl >> 4) & 3, fr = tl & 15, q = (tl & 15) >> 2, p = tl & 3;          \
            LAS unsigned char* buf = F.lds + E5_BUF + (BUFI) * E5_BUFSZ; const unsigned ta = F.ldsb + E5_BUF + (unsigned)((BUFI) * E5_BUFSZ + E5_BOFF + (8 * g + q) * KSB + (32 * wc + 4 * p) * 2); \
            bf16x8 b0, b1, b2, b3; tr_frag2<4 * KSB, 32>(ta, b0, b1); tr_frag2<4 * KSB, 32>(ta + 32 * KSB, b2, b3);                                       \
            E5_MMA(buf, b0, b1, b2, b3, fr, g); } while (0)
        E5Set S2;
#define E5_GW(HP) do { int tl = tid; asm volatile("" : "+v"(tl)); const int g = (tl >> 4) & 3, fr = tl & 15;     \
            _Pragma("unroll") for (int s_ = 0; s_ < 2; ++s_) _Pragma("unroll") for (int rt = 0; rt < 4; ++rt) _Pragma("unroll") for (int ct = 0; ct < 2; ++ct) { const f32x4 ga = acc[s_][rt][ct], ua = acc[s_][rt][ct + 2]; \
                v2u wv; wv.x = pk2(siluf_(ga[0]) * ua[0], siluf_(ga[1]) * ua[1]); wv.y = pk2(siluf_(ga[2]) * ua[2], siluf_(ga[3]) * ua[3]);                   \
                *(v2u*)(Gs + (size_t)(128 * s_ + 64 * wr + 16 * rt + fr) * 256 + 128 * (HP) + 32 * wc + 16 * ct + 4 * g) = wv; }                              \
            E5_ZERO(); } while (0)
#define E5_STEP1(SL, SW, CC) do { const int bi_ = (CC) & 1; E5_L1(SL, (CC) + 3); E5_C1(bi_); E5_W1(SW, F.lds + E5_BUF + (1 - bi_) * E5_BUFSZ); __syncthreads(); } while (0)
        E5_L1(S0, 0); E5_L1(S1, 1); E5_L1(S2, 2);
        E5_W1(S0, F.lds + E5_BUF);
        __syncthreads();
#pragma unroll 1
        for (int c3 = 0; c3 < 63; c3 += 3) {
            E5_STEP1(S0, S1, c3); E5_STEP1(S1, S2, c3 + 1);
            if (c3 == 30) E5_GW(0);
            E5_STEP1(S2, S0, c3 + 2);
        }
        E5_STEP1(S0, S1, 63);
        E5_GW(1);
#undef E5_STEP1
#undef E5_GW
        asm volatile("s_waitcnt vmcnt(0)" ::: "memory");
        __syncthreads();
#define E5_L2(S, CC) do { const int cc_ = (CC) & 31, np_ = cc_ >> 3, kc_ = cc_ & 7; int tl = tid; asm volatile("" : "+v"(tl));                           \
            unsigned o = (unsigned)((32 * kc_ + (tl >> 6)) * D + 256 * np_ + 4 * (tl & 63));                                                              \
            _Pragma("unroll") for (int i = 0; i < 4; ++i) S.w[i] = *(const f32x4*)(Wd + o + (unsigned)(8 * i * D));                                       \
            S.a0 = *(const v4u*)(gsrc + 32 * kc_); S.a1 = *(const v4u*)(gsrc + 32 * kc_ + 8); } while (0)
#define E5_W2(S, BUF) do { int tl = tid; asm volatile("" : "+v"(tl)); LAS unsigned char* b_ = (BUF) + E5_BOFF + (tl >> 6) * VSB + 8 * (tl & 63);          \
            _Pragma("unroll") for (int i = 0; i < 4; ++i) { v2u p_; p_.x = pk2(S.w[i].x, S.w[i].y); p_.y = pk2(S.w[i].z, S.w[i].w); *(LAS v2u*)(b_ + (8 * i) * VSB) = p_; } \
            E5_WA(S, BUF, tl); } while (0)
#define E5_C2(BUFI) do { int tl = tid; asm volatile("" : "+v"(tl)); const int g = (tl >> 4) & 3, fr = tl & 15, q = (tl & 15) >> 2, p = tl & 3;          \
            LAS unsigned char* buf = F.lds + E5_BUF + (BUFI) * E5_BUFSZ; const unsigned ta = F.ldsb + E5_BUF + (unsigned)((BUFI) * E5_BUFSZ + E5_BOFF + (8 * g + q) * VSB + (64 * wc + 4 * p) * 2); \
            bf16x8 b0, b1, b2, b3; tr_frag4<4 * VSB, 32>(ta, b0, b1, b2, b3);                                                                             \
            E5_MMA(buf, b0, b1, b2, b3, fr, g); } while (0)
        E5_L2(S0, 0); E5_L2(S1, 1);
        E5_W2(S0, F.lds + E5_BUF);
        __syncthreads();
#pragma unroll 1
        for (int np = 0; np < 4; ++np) {
#pragma unroll 1
            for (int h2 = 0; h2 < 8; h2 += 2) { const int c2 = 8 * np + h2;
                E5_L2(S0, c2 + 2); E5_C2(0); E5_W2(S1, F.lds + E5_BUF + E5_BUFSZ); __syncthreads();
                E5_L2(S1, c2 + 3); E5_C2(1); E5_W2(S0, F.lds + E5_BUF); __syncthreads(); }
            int tl = tid; asm volatile("" : "+v"(tl)); const int g = (tl >> 4) & 3, fr = tl & 15;
#pragma unroll
            for (int s_ = 0; s_ < 2; ++s_)
#pragma unroll
                for (int rt = 0; rt < 4; ++rt) { const int row = 128 * s_ + 64 * wr + 16 * rt + fr; const float rw = wl[row];
                    if (r0 + row < cnt_e) { bf16* yp = YP + (size_t)(slot0 + row) * D + 256 * np + 64 * wc + 4 * g;
#pragma unroll
                        for (int ct = 0; ct < 4; ++ct) { const f32x4 o = acc[s_][rt][ct] * rw; v2u wv; wv.x = pk2(o[0], o[1]); wv.y = pk2(o[2], o[3]); *(v2u*)(yp + 16 * ct) = wv; } } }
            E5_ZERO();
        }
#undef E5_L1
#undef E5_W1
#undef E5_C1
#undef E5_L2
#undef E5_W2
#undef E5_C2
#undef E5_MMA
#undef E5_WA
#undef E5_ZERO
        asm volatile("s_waitcnt vmcnt(0)" ::: "memory");
        __syncthreads();
    }
}

constexpr int E6_TOK = 2176, E6_W = 3200, E6_AR = 4224, E6_ASL = 16384, E6_BI = E6_AR + 4 * E6_ASL, E6_BSZ = 17408;
static_assert(E6_BI + 2 * E6_BSZ <= PF_OFF, "expert v6 LDS map");
__device__ __forceinline__ void dma16(const void* gsrc, unsigned lds_dst) {
    unsigned keep;
    asm volatile("s_mov_b32 %0, m0\n\ts_mov_b32 m0, %2\n\ts_nop 0\n\tglobal_load_lds_dwordx4 %1, off\n\ts_mov_b32 m0, %0" : "=&s"(keep) : "v"(gsrc), "s"(lds_dst) : "memory");
}
struct E6Set { f32x4 w[4]; };
__device__ __forceinline__ void p11_experts_v6(Frame& F) {
    unsigned char* ws = F.ws; const bf16* H2 = (const bf16*)(ws + WS_HB); const int* LTOK = (const int*)(ws + WS_LTOK); const float* LW = (const float*)(ws + WS_LW); bf16* YP = (bf16*)(ws + WS_YP);
    bf16* Gs = (bf16*)(ws + WS_RETG) + (size_t)blockIdx.x * 65536;
    LAS int* pref = (LAS int*)(F.lds + EX_PREF); LAS int* off = (LAS int*)(F.lds + EX_OFF); LAS int* tokl = (LAS int*)(F.lds + E6_TOK); LAS float* wl = (LAS float*)(F.lds + E6_W);
    const int tid = F.tid, w = F.wave, wr = w >> 2, wc = w & 3;
    expert_prefix256(F, pref, off);
    __syncthreads();
    const int nitems = pref[256];
    for (int it = F.vcu; it < nitems; it += F.G) {
        int e = 0;
#pragma unroll
        for (int s = 128; s >= 1; s >>= 1) if (pref[e + s] <= it) e += s;
        e = __builtin_amdgcn_readfirstlane(e);
        const int rb = __builtin_amdgcn_readfirstlane(it - pref[e]), cnt_e = __builtin_amdgcn_readfirstlane(off[e + 1] - off[e]), r0 = rb * 256, slot0 = __builtin_amdgcn_readfirstlane(off[e]) + r0;
        if (tid < 256) { const int idx = r0 + tid; const bool ok = idx < cnt_e; tokl[tid] = LTOK[(size_t)e * CAP + (ok ? idx : r0)]; wl[tid] = ok ? LW[(size_t)e * CAP + idx] : 0.f; }
        __syncthreads();
        const float* Wg = F.w_eg + (size_t)e * D * EH; const float* Wu = F.w_eu + (size_t)e * D * EH; const float* Wd = F.w_ed + (size_t)e * EH * D;
        int tli = tid; asm volatile("" : "+v"(tli));
        const int ln = tli & 63, arow0 = 32 * w + (ln >> 2), aseg = ((ln & 3) ^ ((ln >> 4) & 3)) * 8;
        const bf16* ap0 = H2 + (size_t)tokl[arow0] * D + aseg; const bf16* ap1 = H2 + (size_t)tokl[arow0 + 16] * D + aseg;
        f32x4 acc[2][4][4];
#define E6_ZERO() do { _Pragma("unroll") for (int s_ = 0; s_ < 2; ++s_) _Pragma("unroll") for (int i = 0; i < 4; ++i) _Pragma("unroll") for (int j = 0; j < 4; ++j) acc[s_][i][j] = (f32x4){0.f, 0.f, 0.f, 0.f}; } while (0)
        E6_ZERO();
        E6Set S0, S1, S2;
#define E6_ADMA(KOFF, CC) do { const unsigned sl_ = F.ldsb + E6_AR + (unsigned)(((CC) & 3) * E6_ASL + 2048 * w); const bf16* a0_ = ap0; const bf16* a1_ = ap1; asm volatile("" : "+v"(a0_), "+v"(a1_)); dma16(a0_ + (KOFF), sl_); dma16(a1_ + (KOFF), sl_ + 1024u); } while (0)
#define E6_MMA(C, B0, B1, B2, B3) do { int tl = tid; asm volatile("" : "+v"(tl)); const int g = (tl >> 4) & 3, fr = tl & 15, q = (tl & 15) >> 2;                              \
            const LAS unsigned char* ab_ = F.lds + E6_AR + ((C) & 3) * E6_ASL + (64 * wr + fr) * 64 + ((g ^ q) << 4);                                                      \
            _Pragma("unroll") for (int s_ = 0; s_ < 2; ++s_) { if (s_) __builtin_amdgcn_sched_barrier(0); _Pragma("unroll") for (int rt = 0; rt < 4; ++rt) {                \
                const bf16x8 af = *(const LAS bf16x8*)(ab_ + (128 * s_ + 16 * rt) * 64);                                                                                  \
                acc[s_][rt][0] = MFMA16(B0, af, acc[s_][rt][0]); acc[s_][rt][1] = MFMA16(B1, af, acc[s_][rt][1]); acc[s_][rt][2] = MFMA16(B2, af, acc[s_][rt][2]); acc[s_][rt][3] = MFMA16(B3, af, acc[s_][rt][3]); } } } while (0)
#define E6_L1(S, CC) do { const int cc_ = (CC) & 63, hp_ = cc_ >> 5, kc_ = cc_ & 31; int tl = tid; asm volatile("" : "+v"(tl));                         \
            E6_ADMA(32 * kc_, CC);                                                                                                                       \
            unsigned o = (unsigned)((32 * kc_ + (tl >> 5)) * EH + 128 * hp_ + 4 * (tl & 31));                                                            \
            S.w[0] = *(const f32x4*)(Wg + o); S.w[1] = *(const f32x4*)(Wg + o + 16 * EH); S.w[2] = *(const f32x4*)(Wu + o); S.w[3] = *(const f32x4*)(Wu + o + 16 * EH); } while (0)
#define E6_W1(S, CC) do { int tl = tid; asm volatile("" : "+v"(tl)); LAS unsigned char* b_ = F.lds + E6_BI + ((CC) & 1) * E6_BSZ + (tl >> 5) * KSB + 8 * (tl & 31); v2u p_[4];  \
            _Pragma("unroll") for (int i = 0; i < 4; ++i) { p_[i].x = pk2(S.w[i].x, S.w[i].y); p_[i].y = pk2(S.w[i].z, S.w[i].w); }                        \
            *(LAS v2u*)b_ = p_[0]; *(LAS v2u*)(b_ + 16 * KSB) = p_[1]; *(LAS v2u*)(b_ + 32 * KSB) = p_[2]; *(LAS v2u*)(b_ + 48 * KSB) = p_[3]; } while (0)
#define E6_C1(C) do { int tl = tid; asm volatile("" : "+v"(tl)); const int g = (tl >> 4) & 3, q = (tl & 15) >> 2, p = tl & 3;                            \
            const unsigned ta = F.ldsb + E6_BI + (unsigned)(((C) & 1) * E6_BSZ + (8 * g + q) * KSB + (32 * wc + 4 * p) * 2);                             \
            bf16x8 b0, b1, b2, b3; tr_frag2<4 * KSB, 32>(ta, b0, b1); tr_frag2<4 * KSB, 32>(ta + 32 * KSB, b2, b3);                                       \
            E6_MMA(C, b0, b1, b2, b3); } while (0)
#define E6_GW(HP) do { int tl = tid; asm volatile("" : "+v"(tl)); const int g = (tl >> 4) & 3, fr = tl & 15;     \
            _Pragma("unroll") for (int s_ = 0; s_ < 2; ++s_) _Pragma("unroll") for (int rt = 0; rt < 4; ++rt) _Pragma("unroll") for (int ct = 0; ct < 2; ++ct) { const f32x4 ga = acc[s_][rt][ct], ua = acc[s_][rt][ct + 2]; \
                v2u wv; wv.x = pk2(siluf_(ga[0]) * ua[0], siluf_(ga[1]) * ua[1]); wv.y = pk2(siluf_(ga[2]) * ua[2], siluf_(ga[3]) * ua[3]);                   \
                *(v2u*)(Gs + (size_t)(128 * s_ + 64 * wr + 16 * rt + fr) * 256 + 128 * (HP) + 32 * wc + 16 * ct + 4 * g) = wv; }                              \
            E6_ZERO(); } while (0)
#define E6_C1S(SL, C) do { int tl = tid; asm volatile("" : "+v"(tl)); const int g = (tl >> 4) & 3, fr = tl & 15, q = (tl & 15) >> 2, p = tl & 3;      \
            const int cc_ = ((C) + 3) & 63, hp_ = cc_ >> 5, kc_ = cc_ & 31; const unsigned o = (unsigned)((32 * kc_ + (tl >> 5)) * EH + 128 * hp_ + 4 * (tl & 31));        \
            E6_ADMA(32 * kc_, (C) + 3);                                                                                                                   \
            const unsigned ta = F.ldsb + E6_BI + (unsigned)(((C) & 1) * E6_BSZ + (8 * g + q) * KSB + (32 * wc + 4 * p) * 2);                             \
            bf16x8 b0, b1, b2, b3; tr_frag2<4 * KSB, 32>(ta, b0, b1); tr_frag2<4 * KSB, 32>(ta + 32 * KSB, b2, b3);                                       \
            const LAS unsigned char* ab_ = F.lds + E6_AR + ((C) & 3) * E6_ASL + (64 * wr + fr) * 64 + ((g ^ q) << 4);                                     \
            _Pragma("unroll") for (int s_ = 0; s_ < 2; ++s_) _Pragma("unroll") for (int rt = 0; rt < 4; ++rt) {                                           \
                const bf16x8 af = *(const LAS bf16x8*)(ab_ + (128 * s_ + 16 * rt) * 64);                                                                 \
                acc[s_][rt][0] = MFMA16(b0, af, acc[s_][rt][0]); acc[s_][rt][1] = MFMA16(b1, af, acc[s_][rt][1]); acc[s_][rt][2] = MFMA16(b2, af, acc[s_][rt][2]); acc[s_][rt][3] = MFMA16(b3, af, acc[s_][rt][3]); \
                if ((rt & 1) == 1) { const int li_ = 2 * s_ + (rt >> 1); __builtin_amdgcn_sched_barrier(0);                                                \
                    if (li_ == 0) SL.w[0] = *(const f32x4*)(Wg + o); else if (li_ == 1) SL.w[1] = *(const f32x4*)(Wg + o + 16 * EH);                      \
                    else if (li_ == 2) SL.w[2] = *(const f32x4*)(Wu + o); else SL.w[3] = *(const f32x4*)(Wu + o + 16 * EH);                               \
                    __builtin_amdgcn_sched_barrier(0); } } } while (0)
#define E6_STEP1(SL, SW, C) do { if (MK_SPREAD) { E6_C1S(SL, C); E6_W1(SW, (C) + 1); if (((C) & 31) == 31) E6_GW((C) >> 5); __syncthreads(); break; } if (!MK_LATE_ISSUE) { E6_L1(SL, (C) + 3); } E6_C1(C); E6_W1(SW, (C) + 1); if (((C) & 31) == 31) E6_GW((C) >> 5); if (MK_LATE_ISSUE) { E6_L1(SL, (C) + 3); } __syncthreads(); } while (0)
        E6_L1(S0, 0); E6_L1(S1, 1);
        E6_W1(S0, 0);
        E6_L1(S2, 2);
        __syncthreads();
#pragma unroll 1
        for (int c3 = 0; c3 < 63; c3 += 3) { E6_STEP1(S0, S1, c3); E6_STEP1(S1, S2, c3 + 1); E6_STEP1(S2, S0, c3 + 2); }
        E6_STEP1(S0, S1, 63);
        asm volatile("s_waitcnt vmcnt(0)" ::: "memory");
        __syncthreads();
        { int tl = tid; asm volatile("" : "+v"(tl)); const int l2_ = tl & 63, ar_ = 32 * w + (l2_ >> 2), as_ = ((l2_ & 3) ^ ((l2_ >> 4) & 3)) * 8; ap0 = Gs + (size_t)ar_ * 256 + as_; ap1 = Gs + (size_t)(ar_ + 16) * 256 + as_; }
#define E6_L2(S, CC) do { const int cc_ = (CC) & 31, np_ = cc_ >> 3, kc_ = cc_ & 7; int tl = tid; asm volatile("" : "+v"(tl));                           \
            E6_ADMA(32 * kc_, CC);                                                                                                                       \
            unsigned o = (unsigned)((32 * kc_ + (tl >> 6)) * D + 256 * np_ + 4 * (tl & 63));                                                              \
            _Pragma("unroll") for (int i = 0; i < 4; ++i) S.w[i] = *(const f32x4*)(Wd + o + (unsigned)(8 * i * D)); } while (0)
#define E6_W2(S, CC) do { int tl = tid; asm volatile("" : "+v"(tl)); LAS unsigned char* b_ = F.lds + E6_BI + ((CC) & 1) * E6_BSZ + (tl >> 6) * VSB + 8 * (tl & 63);  \
            _Pragma("unroll") for (int i = 0; i < 4; ++i) { v2u p_; p_.x = pk2(S.w[i].x, S.w[i].y); p_.y = pk2(S.w[i].z, S.w[i].w); *(LAS v2u*)(b_ + (8 * i) * VSB) = p_; } } while (0)
#define E6_C2(C) do { int tl = tid; asm volatile("" : "+v"(tl)); const int g = (tl >> 4) & 3, q = (tl & 15) >> 2, p = tl & 3;                            \
            const unsigned ta = F.ldsb + E6_BI + (unsigned)(((C) & 1) * E6_BSZ + (8 * g + q) * VSB + (64 * wc + 4 * p) * 2);                             \
            bf16x8 b0, b1, b2, b3; tr_frag4<4 * VSB, 32>(ta, b0, b1, b2, b3);                                                                             \
            E6_MMA(C, b0, b1, b2, b3); } while (0)
#define E6_YP(NP) do { int tl = tid; asm volatile("" : "+v"(tl)); const int g = (tl >> 4) & 3, fr = tl & 15;                                            \
            _Pragma("unroll") for (int s_ = 0; s_ < 2; ++s_) _Pragma("unroll") for (int rt = 0; rt < 4; ++rt) { const int row = 128 * s_ + 64 * wr + 16 * rt + fr; const float rw = wl[row]; \
                if (r0 + row < cnt_e) { bf16* yp = YP + (size_t)(slot0 + row) * D + 256 * (NP) + 64 * wc + 4 * g;                                         \
                    _Pragma("unroll") for (int ct = 0; ct < 4; ++ct) { const f32x4 o = acc[s_][rt][ct] * rw; v2u wv; wv.x = pk2(o[0], o[1]); wv.y = pk2(o[2], o[3]); *(v2u*)(yp + 16 * ct) = wv; } } } \
            E6_ZERO(); } while (0)
#define E6_C2S(SL, C) do { int tl = tid; asm volatile("" : "+v"(tl)); const int g = (tl >> 4) & 3, fr = tl & 15, q = (tl & 15) >> 2, p = tl & 3;      \
            const int cc_ = ((C) + 3) & 31, np_ = cc_ >> 3, kc_ = cc_ & 7; const unsigned o = (unsigned)((32 * kc_ + (tl >> 6)) * D + 256 * np_ + 4 * (tl & 63));           \
            E6_ADMA(32 * kc_, (C) + 3);                                                                                                                   \
            const unsigned ta = F.ldsb + E6_BI + (unsigned)(((C) & 1) * E6_BSZ + (8 * g + q) * VSB + (64 * wc + 4 * p) * 2);                             \
            bf16x8 b0, b1, b2, b3; tr_frag4<4 * VSB, 32>(ta, b0, b1, b2, b3);                                                                             \
            const LAS unsigned char* ab_ = F.lds + E6_AR + ((C) & 3) * E6_ASL + (64 * wr + fr) * 64 + ((g ^ q) << 4);                                     \
            _Pragma("unroll") for (int s_ = 0; s_ < 2; ++s_) _Pragma("unroll") for (int rt = 0; rt < 4; ++rt) {                                           \
                const bf16x8 af = *(const LAS bf16x8*)(ab_ + (128 * s_ + 16 * rt) * 64);                                                                 \
                acc[s_][rt][0] = MFMA16(b0, af, acc[s_][rt][0]); acc[s_][rt][1] = MFMA16(b1, af, acc[s_][rt][1]); acc[s_][rt][2] = MFMA16(b2, af, acc[s_][rt][2]); acc[s_][rt][3] = MFMA16(b3, af, acc[s_][rt][3]); \
                if ((rt & 1) == 1) { const int li_ = 2 * s_ + (rt >> 1); __builtin_amdgcn_sched_barrier(0); SL.w[li_] = *(const f32x4*)(Wd + o + (unsigned)(8 * li_ * D)); __builtin_amdgcn_sched_barrier(0); } } } while (0)
#define E6_STEP2(SL, SW, C) do { if (MK_SPREAD > 1) { E6_C2S(SL, C); E6_W2(SW, (C) + 1); if (((C) & 7) == 7) E6_YP((C) >> 3); __syncthreads(); break; } if (!MK_LATE_ISSUE) { E6_L2(SL, (C) + 3); } E6_C2(C); E6_W2(SW, (C) + 1); if (((C) & 7) == 7) E6_YP((C) >> 3); if (MK_LATE_ISSUE) { E6_L2(SL, (C) + 3); } __syncthreads(); } while (0)
        E6_L2(S0, 0); E6_L2(S1, 1);
        E6_W2(S0, 0);
        E6_L2(S2, 2);
        __syncthreads();
#pragma unroll 1
        for (int c3 = 0; c3 < 30; c3 += 3) { E6_STEP2(S0, S1, c3); E6_STEP2(S1, S2, c3 + 1); E6_STEP2(S2, S0, c3 + 2); }
        E6_STEP2(S0, S1, 30); E6_STEP2(S1, S2, 31);
#undef E6_L1
#undef E6_C1S
#undef E6_W1
#undef E6_C1
#undef E6_GW
#undef E6_STEP1
#undef E6_L2
#undef E6_C2S
#undef E6_W2
#undef E6_C2
#undef E6_YP
#undef E6_STEP2
#undef E6_MMA
#undef E6_ADMA
#undef E6_ZERO
        asm volatile("s_waitcnt vmcnt(0)" ::: "memory");
        __syncthreads();
    }
}

constexpr int E7_BUF = 3200, E7_BUFSZ = 53248, E7_BOFF = 18432, E7_ASB = 144;
static_assert(E7_BUF + 2 * E7_BUFSZ <= PF_OFF, "expert v7 LDS map");
struct E7Set { f32x4 w[8]; v4u a0, a1; };
struct E7Frag { bf16x8 a[4]; s16x4 l[4], h[4]; };
template <int STAGE> __device__ __forceinline__ void e7_stage(Frame& F, const float* Wg, const float* Wu, const float* Wd, const bf16* arow, bf16* Gs, bf16* YP, LAS float* wl, int r0, int cnt_e, int slot0) {
    const int tid = F.tid, w = F.wave, wr = w >> 2, wc = w & 3;
    constexpr int NC = STAGE == 0 ? 32 : 16;
    f32x4 acc[4][4];
#define E7_ZERO() do { _Pragma("unroll") for (int i = 0; i < 4; ++i) _Pragma("unroll") for (int j = 0; j < 4; ++j) acc[i][j] = (f32x4){0.f, 0.f, 0.f, 0.f}; } while (0)
    E7_ZERO();
    E7Set S0, S1;
#define E7_LD(S, CC) do { int tl = tid; asm volatile("" : "+v"(tl)); const int cc_ = (CC) & (NC - 1);                                                           \
        if (STAGE == 0) { const int hp_ = cc_ >> 4, kc_ = cc_ & 15; unsigned o = (unsigned)((64 * kc_ + (tl >> 5)) * EH + 128 * hp_ + 4 * (tl & 31));            \
            _Pragma("unroll") for (int i = 0; i < 4; ++i) { S.w[i] = *(const f32x4*)(Wg + o + (unsigned)(16 * i * EH)); S.w[4 + i] = *(const f32x4*)(Wu + o + (unsigned)(16 * i * EH)); } \
            S.a0 = *(const v4u*)(arow + 64 * kc_); S.a1 = *(const v4u*)(arow + 64 * kc_ + 8);                                                                      \
        } else { const int np_ = cc_ >> 2, kc_ = cc_ & 3; unsigned o = (unsigned)((64 * kc_ + (tl >> 6)) * D + 256 * np_ + 4 * (tl & 63));                         \
            _Pragma("unroll") for (int i = 0; i < 8; ++i) S.w[i] = *(const f32x4*)(Wd + o + (unsigned)(8 * i * D));                                                  \
            S.a0 = *(const v4u*)(arow + 64 * kc_); S.a1 = *(const v4u*)(arow + 64 * kc_ + 8); } } while (0)
#define E7_WR(S, BI) do { int tl = tid; asm volatile("" : "+v"(tl)); LAS unsigned char* buf_ = F.lds + E7_BUF + (BI) * E7_BUFSZ;                                  \
        if (STAGE == 0) { LAS unsigned char* b_ = buf_ + E7_BOFF + (tl >> 5) * KSB + 8 * (tl & 31);                                                                \
            _Pragma("unroll") for (int i = 0; i < 4; ++i) { v2u pg, pu; pg.x = pk2(S.w[i].x, S.w[i].y); pg.y = pk2(S.w[i].z, S.w[i].w); pu.x = pk2(S.w[4 + i].x, S.w[4 + i].y); pu.y = pk2(S.w[4 + i].z, S.w[4 + i].w); \
                *(LAS v2u*)(b_ + (16 * i) * KSB) = pg; *(LAS v2u*)(b_ + (64 + 16 * i) * KSB) = pu; }                                                                \
        } else { LAS unsigned char* b_ = buf_ + E7_BOFF + (tl >> 6) * VSB + 8 * (tl & 63);                                                                          \
            _Pragma("unroll") for (int i = 0; i < 8; ++i) { v2u p_; p_.x = pk2(S.w[i].x, S.w[i].y); p_.y = pk2(S.w[i].z, S.w[i].w); *(LAS v2u*)(b_ + (8 * i) * VSB) = p_; } } \
        *(LAS v4u*)(buf_ + (tl >> 2) * E7_ASB + (tl & 3) * 32) = S.a0; *(LAS v4u*)(buf_ + (tl >> 2) * E7_ASB + (tl & 3) * 32 + 16) = S.a1; } while (0)
    int tlc = tid; asm volatile("" : "+v"(tlc)); const int g = (tlc >> 4) & 3, fr = tlc & 15, q = (tlc & 15) >> 2, p = tlc & 3;
    const unsigned aoff = F.ldsb + E7_BUF + (unsigned)((64 * wr + fr) * E7_ASB + 16 * g);
    const unsigned boff = F.ldsb + E7_BUF + (unsigned)(E7_BOFF + (STAGE == 0 ? (8 * g + q) * KSB + (32 * wc + 4 * p) * 2 : (8 * g + q) * VSB + (64 * wc + 4 * p) * 2));
    constexpr int RS = STAGE == 0 ? KSB : VSB;
#define E7_ISSUE(FS, BI, HS) do { const unsigned aa_ = aoff + (unsigned)((BI) * E7_BUFSZ + 64 * (HS)), bb_ = boff + (unsigned)((BI) * E7_BUFSZ + 32 * (HS) * RS);       \
        asm volatile("ds_read_b128 %0, %4\n\tds_read_b128 %1, %4 offset:%5\n\tds_read_b128 %2, %4 offset:%6\n\tds_read_b128 %3, %4 offset:%7"                         \
            : "=&v"(FS.a[0]), "=&v"(FS.a[1]), "=&v"(FS.a[2]), "=&v"(FS.a[3]) : "v"(aa_), "i"(16 * E7_ASB), "i"(32 * E7_ASB), "i"(48 * E7_ASB) : "memory");            \
        asm volatile("ds_read_b64_tr_b16 %0, %8\n\tds_read_b64_tr_b16 %1, %8 offset:%9\n\tds_read_b64_tr_b16 %2, %8 offset:%10\n\tds_read_b64_tr_b16 %3, %8 offset:%11\n\t" \
                     "ds_read_b64_tr_b16 %4, %8 offset:%12\n\tds_read_b64_tr_b16 %5, %8 offset:%13\n\tds_read_b64_tr_b16 %6, %8 offset:%14\n\tds_read_b64_tr_b16 %7, %8 offset:%15" \
            : "=&v"(FS.l[0]), "=&v"(FS.h[0]), "=&v"(FS.l[1]), "=&v"(FS.h[1]), "=&v"(FS.l[2]), "=&v"(FS.h[2]), "=&v"(FS.l[3]), "=&v"(FS.h[3])                              \
            : "v"(bb_), "i"(4 * RS), "i"(32), "i"(32 + 4 * RS), "i"(STAGE == 0 ? 64 * KSB : 64), "i"(STAGE == 0 ? 64 * KSB + 4 * KSB : 64 + 4 * VSB),                     \
              "i"(STAGE == 0 ? 64 * KSB + 32 : 96), "i"(STAGE == 0 ? 64 * KSB + 32 + 4 * KSB : 96 + 4 * VSB) : "memory"); } while (0)
#define E7_WAIT(FS) do { asm volatile("s_waitcnt lgkmcnt(0)" : "+v"(FS.a[0]), "+v"(FS.a[1]), "+v"(FS.a[2]), "+v"(FS.a[3]), "+v"(FS.l[0]), "+v"(FS.h[0]), "+v"(FS.l[1]), "+v"(FS.h[1]), "+v"(FS.l[2]), "+v"(FS.h[2]), "+v"(FS.l[3]), "+v"(FS.h[3]) :: "memory"); } while (0)
#define E7_MMA(FS) do { _Pragma("unroll") for (int ct = 0; ct < 4; ++ct) { const bf16x8 bb = __builtin_shufflevector(FS.l[ct], FS.h[ct], 0, 1, 2, 3, 4, 5, 6, 7);     \
            _Pragma("unroll") for (int rt = 0; rt < 4; ++rt) acc[rt][ct] = MFMA16(bb, FS.a[rt], acc[rt][ct]); } } while (0)
#define E7_COMPUTE(BI) do { E7Frag Fa, Fb; E7_ISSUE(Fa, BI, 0); E7_WAIT(Fa); E7_ISSUE(Fb, BI, 1); __builtin_amdgcn_sched_barrier(0); E7_MMA(Fa); __builtin_amdgcn_sched_barrier(0); E7_WAIT(Fb); E7_MMA(Fb); } while (0)
#define E7_EPI(C) do { if (STAGE == 0) { if (((C) & 15) == 15) { const int hp = (C) >> 4;     \
                _Pragma("unroll") for (int rt = 0; rt < 4; ++rt) _Pragma("unroll") for (int ct = 0; ct < 2; ++ct) { const f32x4 ga = acc[rt][ct], ua = acc[rt][ct + 2];               \
                    v2u wv; wv.x = pk2(siluf_(ga[0]) * ua[0], siluf_(ga[1]) * ua[1]); wv.y = pk2(siluf_(ga[2]) * ua[2], siluf_(ga[3]) * ua[3]);                                  \
                    *(v2u*)(Gs + (size_t)(64 * wr + 16 * rt + fr) * 256 + 128 * hp + 32 * wc + 16 * ct + 4 * g) = wv; }                                                          \
                E7_ZERO(); }                                                                                                                                                      \
        } else if (((C) & 3) == 3) { const int np = (C) >> 2;                                                                                                                     \
            _Pragma("unroll") for (int rt = 0; rt < 4; ++rt) { const int row = 64 * wr + 16 * rt + fr; const float rw = wl[row];                                                  \
                if (r0 + row < cnt_e) { bf16* yp = YP + (size_t)(slot0 + row) * D + 256 * np + 64 * wc + 4 * g;                                                                  \
                    _Pragma("unroll") for (int ct = 0; ct < 4; ++ct) { const f32x4 o = acc[rt][ct] * rw; v2u wv; wv.x = pk2(o[0], o[1]); wv.y = pk2(o[2], o[3]); *(v2u*)(yp + 16 * ct) = wv; } } } \
            E7_ZERO(); } } while (0)
    E7_LD(S0, 0); E7_LD(S1, 1);
    E7_WR(S0, 0);
    __syncthreads();
#pragma unroll 1
    for (int c2 = 0; c2 < NC; c2 += 2) {
        E7_LD(S0, c2 + 2); E7_COMPUTE(0); E7_WR(S1, 1); E7_EPI(c2); __syncthreads();
        E7_LD(S1, c2 + 3); E7_COMPUTE(1); E7_WR(S0, 0); E7_EPI(c2 + 1); __syncthreads();
    }
#undef E7_ZERO
#undef E7_LD
#undef E7_WR
#undef E7_ISSUE
#undef E7_WAIT
#undef E7_MMA
#undef E7_COMPUTE
#undef E7_EPI
}
__device__ __forceinline__ void p11_experts_v7(Frame& F) {
    unsigned char* ws = F.ws; const bf16* H2 = (const bf16*)(ws + WS_HB); const int* LTOK = (const int*)(ws + WS_LTOK); const float* LW = (const float*)(ws + WS_LW); bf16* YP = (bf16*)(ws + WS_YP);
    bf16* Gs = (bf16*)(ws + WS_RETG) + (size_t)blockIdx.x * 32768;
    LAS int* pref = (LAS int*)(F.lds + EX_PREF); LAS int* off = (LAS int*)(F.lds + EX_OFF); LAS int* tokl = (LAS int*)(F.lds + EX_TOK); LAS float* wl = (LAS float*)(F.lds + EX_W);
    const int tid = F.tid;
    expert_prefix(F, pref, off);
    __syncthreads();
    const int nitems = pref[256];
    for (int it = F.vcu; it < nitems; it += F.G) {
        int e = 0;
#pragma unroll
        for (int s = 128; s >= 1; s >>= 1) if (pref[e + s] <= it) e += s;
        e = __builtin_amdgcn_readfirstlane(e);
        const int rb = __builtin_amdgcn_readfirstlane(it - pref[e]), cnt_e = __builtin_amdgcn_readfirstlane(off[e + 1] - off[e]), r0 = rb * 128, slot0 = __builtin_amdgcn_readfirstlane(off[e]) + r0;
        if (tid < 128) { const int idx = r0 + tid; const bool ok = idx < cnt_e; tokl[tid] = LTOK[(size_t)e * CAP + (ok ? idx : r0)]; wl[tid] = ok ? LW[(size_t)e * CAP + idx] : 0.f; }
        __syncthreads();
        const float* Wg = F.w_eg + (size_t)e * D * EH; const float* Wu = F.w_eu + (size_t)e * D * EH; const float* Wd = F.w_ed + (size_t)e * EH * D;
        int tli = tid; asm volatile("" : "+v"(tli));
        e7_stage<0>(F, Wg, Wu, Wd, H2 + (size_t)tokl[tli >> 2] * D + (tli & 3) * 16, Gs, YP, wl, r0, cnt_e, slot0);
        asm volatile("s_waitcnt vmcnt(0)" ::: "memory");
        __syncthreads();
        e7_stage<1>(F, Wg, Wu, Wd, Gs + (size_t)(tli >> 2) * 256 + (tli & 3) * 16, Gs, YP, wl, r0, cnt_e, slot0);
        asm volatile("s_waitcnt vmcnt(0)" ::: "memory");
        __syncthreads();
    }
}

constexpr int K6_A = 3200, K6_BG = 21632, K6_BU = 39040, K6_G = 56448;
constexpr int ASB6 = 144;
#define K6MM(a, b, c) ((ABL & 1) ? k6_keep((a), (b), (c)) : MFMA16((a), (b), (c)))
__device__ __forceinline__ f32x4 k6_keep(bf16x8 a, bf16x8 b, f32x4 c) { asm volatile("" :: "v"(a), "v"(b)); return c; }
struct K6Set { f32x4 w[8]; v4u a0, a1; };
template <int ABL> __device__ __forceinline__ void p11_experts_k64(Frame& F) {
    unsigned char* ws = F.ws; const bf16* H2 = (const bf16*)(ws + WS_HB); const int* LTOK = (const int*)(ws + WS_LTOK); const float* LW = (const float*)(ws + WS_LW); bf16* YP = (bf16*)(ws + WS_YP);
    LAS int* pref = (LAS int*)(F.lds + EX_PREF); LAS int* off = (LAS int*)(F.lds + EX_OFF); LAS int* tokl = (LAS int*)(F.lds + EX_TOK); LAS float* wl = (LAS float*)(F.lds + EX_W);
    LAS unsigned char* Aimg = F.lds + K6_A; LAS unsigned char* Gimg = F.lds + K6_G;
    const int tid = F.tid, w = F.wave, wr = w >> 2, wc = w & 3;
    expert_prefix(F, pref, off);
    __syncthreads();
    const int nitems = pref[256];
    for (int it = F.vcu; it < nitems; it += F.G) {
        int e = 0;
#pragma unroll
        for (int s = 128; s >= 1; s >>= 1) if (pref[e + s] <= it) e += s;
        e = __builtin_amdgcn_readfirstlane(e);
        const int rb = __builtin_amdgcn_readfirstlane(it - pref[e]), cnt_e = __builtin_amdgcn_readfirstlane(off[e + 1] - off[e]), r0 = rb * 128, slot0 = __builtin_amdgcn_readfirstlane(off[e]) + r0;
        if (tid < 128) { const int idx = r0 + tid; const bool ok = idx < cnt_e; tokl[tid] = LTOK[(size_t)e * CAP + (ok ? idx : r0)]; wl[tid] = ok ? LW[(size_t)e * CAP + idx] : 0.f; }
        __syncthreads();
        const int ew = e;
        const float* Wg = F.w_eg + (size_t)ew * D * EH; const float* Wu = F.w_eu + (size_t)ew * D * EH; const float* Wd = F.w_ed + (size_t)ew * EH * D;
        const bf16* asrc = H2 + (size_t)tokl[tid >> 2] * D + (tid & 3) * 16;
        f32x4 acc[4][4];
#pragma unroll
        for (int i = 0; i < 4; ++i)
#pragma unroll
            for (int j = 0; j < 4; ++j) acc[i][j] = (f32x4){0.f, 0.f, 0.f, 0.f};
        K6Set S0, S1;
        if constexpr (ABL & 16) {
#pragma unroll
            for (int i = 0; i < 8; ++i) { S0.w[i] = (f32x4){1.f, 1.f, 1.f, 1.f}; S1.w[i] = (f32x4){1.f, 1.f, 1.f, 1.f}; } S0.a0 = S0.a1 = S1.a0 = S1.a1 = (v4u){0u, 0u, 0u, 0u}; }
#define K6_LOAD1(S, CC) do { const int cc_ = (CC) & 31, hp_ = cc_ >> 4, kc_ = cc_ & 15; int tl = tid; asm volatile("" : "+v"(tl));                      \
            unsigned o = (unsigned)((64 * kc_ + (tl >> 5)) * EH + 128 * hp_ + 4 * (tl & 31));                                                            \
            if constexpr (!(ABL & 16)) { _Pragma("unroll") for (int i = 0; i < 4; ++i) { S.w[i] = *(const f32x4*)(Wg + o + (unsigned)(16 * i * EH)); S.w[4 + i] = *(const f32x4*)(Wu + o + (unsigned)(16 * i * EH)); } \
            S.a0 = *(const v4u*)(asrc + 64 * kc_); S.a1 = *(const v4u*)(asrc + 64 * kc_ + 8); } } while (0)
#define K6_STEP1(S, CC) do { int tl = tid; asm volatile("" : "+v"(tl)); const int g = (tl >> 4) & 3, fr = tl & 15, q = (tl & 15) >> 2, p = tl & 3;    \
            if constexpr (!(ABL & 8)) __syncthreads();                                                                                                       \
            if constexpr (!(ABL & 2)) { *(LAS v4u*)(Aimg + (tl >> 2) * ASB6 + (tl & 3) * 32) = S.a0; *(LAS v4u*)(Aimg + (tl >> 2) * ASB6 + (tl & 3) * 32 + 16) = S.a1; }            \
            if constexpr (!(ABL & 2)) _Pragma("unroll") for (int i = 0; i < 4; ++i) { v2u wg, wu; wg.x = pk2(S.w[i].x, S.w[i].y); wg.y = pk2(S.w[i].z, S.w[i].w); wu.x = pk2(S.w[4 + i].x, S.w[4 + i].y); wu.y = pk2(S.w[4 + i].z, S.w[4 + i].w); \
                *(LAS v2u*)(F.lds + K6_BG + ((tl >> 5) + 16 * i) * KSB + 8 * (tl & 31)) = wg; *(LAS v2u*)(F.lds + K6_BU + ((tl >> 5) + 16 * i) * KSB + 8 * (tl & 31)) = wu; } \
            if constexpr (!(ABL & 8)) __syncthreads();                                                                                                       \
            K6_LOAD1(S, (CC) + 2);                                                                                                                       \
            const unsigned bga = F.ldsb + K6_BG + (unsigned)((8 * g + q) * KSB + (32 * wc + 4 * p) * 2), bua = bga + (K6_BU - K6_BG);                   \
            if constexpr (!(ABL & 4)) _Pragma("unroll") for (int s = 0; s < 2; ++s) { bf16x8 af[4];                                                                                \
                _Pragma("unroll") for (int rt = 0; rt < 4; ++rt) af[rt] = ldfrag(Aimg, 64 * wr + 16 * rt + fr, ASB6, 32 * s + 8 * g);                    \
                bf16x8 b0, b1, b2, b3; tr_frag2<4 * KSB, 32>(bga + s * 32 * KSB, b0, b1); tr_frag2<4 * KSB, 32>(bua + s * 32 * KSB, b2, b3);             \
                _Pragma("unroll") for (int rt = 0; rt < 4; ++rt) { acc[rt][0] = K6MM(b0, af[rt], acc[rt][0]); acc[rt][1] = K6MM(b1, af[rt], acc[rt][1]); acc[rt][2] = K6MM(b2, af[rt], acc[rt][2]); acc[rt][3] = K6MM(b3, af[rt], acc[rt][3]); } } } while (0)
        K6_LOAD1(S0, 0); K6_LOAD1(S1, 1);
#pragma unroll 1
        for (int cc = 0; cc < 32; cc += 2) {
            K6_STEP1(S0, cc); K6_STEP1(S1, cc + 1);
            if ((cc & 15) == 14) { const int hp = cc >> 4; int tl = tid; asm volatile("" : "+v"(tl)); const int g = (tl >> 4) & 3, fr = tl & 15;
#pragma unroll
                for (int rt = 0; rt < 4; ++rt)
#pragma unroll
                    for (int ct = 0; ct < 2; ++ct) { const f32x4 ga = acc[rt][ct], ua = acc[rt][ct + 2];
                        v2u wv; wv.x = pk2(siluf_(ga[0]) * ua[0], siluf_(ga[1]) * ua[1]); wv.y = pk2(siluf_(ga[2]) * ua[2], siluf_(ga[3]) * ua[3]);
                        *(LAS v2u*)(Gimg + (64 * wr + 16 * rt + fr) * VSB + (128 * hp + 32 * wc + 16 * ct + 4 * g) * 2) = wv; }
#pragma unroll
                for (int i = 0; i < 4; ++i)
#pragma unroll
                    for (int j = 0; j < 4; ++j) acc[i][j] = (f32x4){0.f, 0.f, 0.f, 0.f}; }
        }
#undef K6_STEP1
#undef K6_LOAD1
#define K6_LOAD2(S, CC) do { const int cc_ = (CC) & 15, np_ = cc_ >> 2, kc_ = cc_ & 3; int tl = tid; asm volatile("" : "+v"(tl));                       \
            unsigned o = (unsigned)((64 * kc_ + (tl >> 6)) * D + 256 * np_ + 4 * (tl & 63));                                                             \
            if constexpr (!(ABL & 16)) { _Pragma("unroll") for (int i = 0; i < 8; ++i) S.w[i] = *(const f32x4*)(Wd + o + (unsigned)(8 * i * D)); } } while (0)
#define K6_STEP2(S, CC, KC) do { int tl = tid; asm volatile("" : "+v"(tl)); const int g = (tl >> 4) & 3, fr = tl & 15, q = (tl & 15) >> 2, p = tl & 3; \
            if constexpr (!(ABL & 8)) __syncthreads();                                                                                                       \
            if constexpr (!(ABL & 2)) _Pragma("unroll") for (int i = 0; i < 8; ++i) { v2u wd; wd.x = pk2(S.w[i].x, S.w[i].y); wd.y = pk2(S.w[i].z, S.w[i].w); *(LAS v2u*)(F.lds + K6_BG + ((tl >> 6) + 8 * i) * VSB + 8 * (tl & 63)) = wd; } \
            if constexpr (!(ABL & 8)) __syncthreads();                                                                                                       \
            K6_LOAD2(S, (CC) + 2);                                                                                                                       \
            const unsigned bda = F.ldsb + K6_BG + (unsigned)((8 * g + q) * VSB + (64 * wc + 4 * p) * 2);                                                \
            if constexpr (!(ABL & 4)) _Pragma("unroll") for (int s = 0; s < 2; ++s) { bf16x8 gf[4];                                                                                \
                _Pragma("unroll") for (int rt = 0; rt < 4; ++rt) gf[rt] = ldfrag(Gimg, 64 * wr + 16 * rt + fr, VSB, 64 * (KC) + 32 * s + 8 * g);        \
                bf16x8 b0, b1, b2, b3; tr_frag4<4 * VSB, 32>(bda + s * 32 * VSB, b0, b1, b2, b3);                                                        \
                _Pragma("unroll") for (int rt = 0; rt < 4; ++rt) { acc[rt][0] = K6MM(b0, gf[rt], acc[rt][0]); acc[rt][1] = K6MM(b1, gf[rt], acc[rt][1]); acc[rt][2] = K6MM(b2, gf[rt], acc[rt][2]); acc[rt][3] = K6MM(b3, gf[rt], acc[rt][3]); } } } while (0)
        K6_LOAD2(S0, 0); K6_LOAD2(S1, 1);
#pragma unroll 1
        for (int np = 0; np < 4; ++np) {
            K6_STEP2(S0, 4 * np, 0); K6_STEP2(S1, 4 * np + 1, 1); K6_STEP2(S0, 4 * np + 2, 2); K6_STEP2(S1, 4 * np + 3, 3);
            int tl = tid; asm volatile("" : "+v"(tl)); const int g = (tl >> 4) & 3, fr = tl & 15;
#pragma unroll
            for (int rt = 0; rt < 4; ++rt) { const int row = 64 * wr + 16 * rt + fr; const float rw = wl[row];
                if (!(ABL & 32) && r0 + row < cnt_e) { bf16* yp = YP + (size_t)(slot0 + row) * D + 256 * np + 64 * wc + 4 * g;
#pragma unroll
                    for (int ct = 0; ct < 4; ++ct) { const f32x4 o = acc[rt][ct] * rw; v2u wv; wv.x = pk2(o[0], o[1]); wv.y = pk2(o[2], o[3]); *(v2u*)(yp + 16 * ct) = wv; } } }
#pragma unroll
            for (int i = 0; i < 4; ++i)
#pragma unroll
                for (int j = 0; j < 4; ++j) acc[i][j] = (f32x4){0.f, 0.f, 0.f, 0.f};
        }
#undef K6_STEP2
#undef K6_LOAD2
        __syncthreads();
    }
}

#undef K6MM
__device__ __forceinline__ void p12_final(Frame& F) {
    unsigned char* ws = F.ws; const float* X1 = (const float*)(ws + (MK_SKIP_SHARED ? WS_X1 : WS_MIXP)); const bf16* YP = (const bf16*)(ws + WS_YP); const int* EIDX = (const int*)(ws + WS_EIDX); const int* POS = (const int*)(ws + WS_POS);
    const float* mod = (const float*)(ws + WS_MOD);
    LAS int* pref = (LAS int*)(F.lds + EX_PREF); LAS int* off = (LAS int*)(F.lds + EX_OFF);
    expert_prefix(F, pref, off);
    __syncthreads();
    const int lane = F.lane;
    const int gw = F.vcu * NWAVES + F.wave, NGW = F.G * NWAVES;
    f32x4 gn[4];
#pragma unroll
    for (int j = 0; j < 4; ++j) gn[j] = *(const f32x4*)(F.norm_final_g + 512 * (j >> 1) + 8 * lane + 4 * (j & 1));
    for (int t = gw; t < M; t += NGW) {
        const int b = t >> 13;
        f32x4 y[4];
#pragma unroll
        for (int j = 0; j < 4; ++j) y[j] = (f32x4){0.f, 0.f, 0.f, 0.f};
#if !MK_SKIP_ROUTED
        int myslot = 0;
        if (lane < 8) myslot = off[EIDX[t * 8 + lane]] + POS[t * 8 + lane];
        v4u yv[8][2];
#pragma unroll
        for (int k = 0; k < 8; ++k) { const int slot = __shfl(myslot, k); const v4u* yp = (const v4u*)(YP + (size_t)slot * D) + lane; yv[k][0] = yp[0]; yv[k][1] = yp[64]; }
#pragma unroll
        for (int k = 0; k < 8; ++k)
#pragma unroll
            for (int hh = 0; hh < 2; ++hh) { const v4u v = yv[k][hh];
                y[2 * hh] += (f32x4){bflo(v.x), bfhi(v.x), bflo(v.y), bfhi(v.y)}; y[2 * hh + 1] += (f32x4){bflo(v.z), bfhi(v.z), bflo(v.w), bfhi(v.w)}; }
#endif
        f32x4 v[4]; float ss = 0.f;
#pragma unroll
        for (int j = 0; j < 4; ++j) { const int col = 512 * (j >> 1) + 8 * lane + 4 * (j & 1);
            const f32x4 g2 = *(const f32x4*)(mod + b * NMOD + 5 * D + col); v[j] = *(const f32x4*)(X1 + (size_t)t * D + col) + g2 * y[j];
            ss += (v[j].x * v[j].x + v[j].y * v[j].y) + (v[j].z * v[j].z + v[j].w * v[j].w); }
        const float rstd = 1.0f / sqrtf(wave_sum(ss) * (1.0f / D) + EPS);
#pragma unroll
        for (int j = 0; j < 4; ++j) { const int col = 512 * (j >> 1) + 8 * lane + 4 * (j & 1); *(f32x4*)(F.out + (size_t)t * D + col) = v[j] * rstd * gn[j]; }
    }
}

struct Args { const void* in[22]; float* out; unsigned char* ws; int ph_lo, ph_hi, li, abl; };
__global__ void __launch_bounds__(NT, 2) mk_fwd(Args args) {
    extern __shared__ __attribute__((aligned(16))) unsigned char lds[];
    Frame F;
    F.lds = (LAS unsigned char*)lds; F.ldsb = (unsigned)(size_t)F.lds;
    F.MISC = (volatile LAS unsigned*)(F.lds + MISC_OFF);
    F.tid = threadIdx.x; F.lane = F.tid & 63; F.wave = __builtin_amdgcn_readfirstlane(F.tid >> 6);
    F.G = gridDim.x; { const int bx = blockIdx.x; F.vcu = (F.G % 8 == 0) ? (bx % 8) * (F.G / 8) + bx / 8 : bx; }
    F.abl = MK_ABL_RT ? args.abl : 0;
    unsigned char* ws = args.ws; F.ws = ws; F.ctl = (gu32*)(ws + WS_CTL); F.out = args.out;
    F.x = (const float*)args.in[0]; F.c = (const float*)args.in[1]; F.pos = (const int*)args.in[2]; F.w_ada = (const float*)args.in[3]; F.b_ada = (const float*)args.in[4];
    F.norm_mix_g = (const float*)args.in[5]; F.w_in = (const float*)args.in[6]; F.ret_norm_g = (const float*)args.in[7]; F.conv_w = (const float*)args.in[8];
    F.w_br_ret = (const float*)args.in[9]; F.w_br_conv = (const float*)args.in[10]; F.w_out = (const float*)args.in[11]; F.norm_ffn_g = (const float*)args.in[12];
    F.w_router = (const float*)args.in[13]; F.router_bias = (const float*)args.in[14]; F.w_eg = (const float*)args.in[15]; F.w_eu = (const float*)args.in[16]; F.w_ed = (const float*)args.in[17];
    F.w_sg = (const float*)args.in[18]; F.w_su = (const float*)args.in[19]; F.w_sd = (const float*)args.in[20]; F.norm_final_g = (const float*)args.in[21];
    for (int u = F.tid; u < (LDS_BYTES - LDSCTL_OFF) / 4; u += NT) ((LAS unsigned*)(F.lds + LDSCTL_OFF))[u] = 0u;
    __syncthreads();
    XcdBarrier bar; bar.bar = (unsigned*)(F.ctl + CW_BAR) + args.li * XCD_BAR_WORDS; bar.x = 0; bar.st = nullptr;
    if (!MK_PER_PHASE) bar = xcd_barrier_post((unsigned*)(F.ctl + CW_BAR) + args.li * XCD_BAR_WORDS, F.MISC + 8);
    const int lo = args.ph_lo, hi = args.ph_hi;
#ifndef MK_PHASE_MASK
#define MK_PHASE_MASK 0x1fff
#endif
#define IN(k) (((MK_PHASE_MASK >> (k)) & 1) && lo <= (k) && (k) < hi)
#ifndef MK_BAR_REP
#define MK_BAR_REP 1
#endif
#define SEAM(k) do { if (IN(k) && IN((k) + 1)) { for (int br_ = 0; br_ < MK_BAR_REP; ++br_) xcd_barrier(bar); } } while (0)
#ifndef MK_DOUBLE_MASK
#define MK_DOUBLE_MASK 0
#endif
#define REP(k) for (int rep_ = 0; rep_ < (((MK_DOUBLE_MASK >> (k)) & 1) ? 2 : 1); ++rep_, (((MK_DOUBLE_MASK >> (k)) & 1) && rep_ == 1 ? xcd_barrier(bar) : (void)0))
    bf16* HB = (bf16*)(ws + WS_HB); bf16* PROJ = (bf16*)(ws + WS_PROJ); const float* mod = (const float*)(ws + WS_MOD);

    if (IN(0)) { p0_prologue(F); } SEAM(0);
    if (IN(1)) { norm_mod_rows(F, F.x, F.norm_mix_g, 1 * D, 0 * D, HB); } SEAM(1);
    if (IN(2)) {
        pg8::Gemm g{HB, (const bf16*)(ws + WS_WIN), M, NIN, D}; pg8::StaticOrder S; S.init(M, NIN, F.G, (int)blockIdx.x);
        pg8::EpiBf16 E{PROJ, NIN};
        pg8::gemm_phase<pg8::EpiBf16, pg8::StaticOrder, true, true>(F.lds, g, S, E);
    } SEAM(2);
    if (IN(3)) { p3_kv_conv(F); } SEAM(3);
    if (IN(4)) { p4_scan(F); } SEAM(4);
    if (IN(5)) { p5_retention(F); } SEAM(5);
    if (IN(6)) {
        { pg8::Gemm g{(const bf16*)(ws + WS_RETG), (const bf16*)(ws + WS_WBR), M, D, D}; pg8::StaticOrder S; S.init(M, D, F.G, (int)blockIdx.x);
          pg8::EpiGateBf16 E{(bf16*)(ws + WS_MIXP), D, PROJ + OFF_MR, NIN};
          pg8::gemm_phase<pg8::EpiGateBf16, pg8::StaticOrder, true, true>(F.lds, g, S, E); }
        asm volatile("s_waitcnt vmcnt(0)" ::: "memory"); __syncthreads();
        { pg8::Gemm g{(const bf16*)(ws + WS_CONVG), (const bf16*)(ws + WS_WBC), M, D, D}; pg8::StaticOrder S; S.init(M, D, F.G, (int)blockIdx.x);
          pg8::EpiMixBf16 E{(bf16*)(ws + WS_MIX), D, (const bf16*)(ws + WS_MIXP), PROJ + OFF_MC, NIN};
          pg8::gemm_phase<pg8::EpiMixBf16, pg8::StaticOrder, true, true>(F.lds, g, S, E); }
    } SEAM(6);
    if (IN(7)) {
#if MK_SKIP_MIXER
        for (size_t i = (size_t)F.vcu * NT + F.tid; i < (size_t)M * D / 4; i += (size_t)F.G * NT) ((f32x4*)(ws + WS_X1))[i] = ((const f32x4*)F.x)[i];
#else
        pg8::Gemm g{(const bf16*)(ws + WS_MIX), (const bf16*)(ws + WS_WO), M, D, D}; pg8::StaticOrder S; S.init(M, D, F.G, (int)blockIdx.x);
        pg8::EpiResid E{(float*)(ws + WS_X1), F.x, D, mod + 2 * D, NMOD, 13};
        pg8::gemm_phase<pg8::EpiResid, pg8::StaticOrder, true, true>(F.lds, g, S, E);
#endif
    } SEAM(7);
    if (IN(8)) { norm_mod_rows(F, (const float*)(ws + WS_X1), F.norm_ffn_g, 4 * D, 3 * D, HB); } SEAM(8);
    if (IN(9)) {
        { pg8::Gemm g{HB, (const bf16*)(ws + WS_WR), M, NE, D}; pg8::StaticOrder S; S.init(M, NE, F.G, (int)blockIdx.x);
          pg8::EpiF32 E{(float*)(ws + WS_LOGITS), NE};
          pg8::gemm_phase<pg8::EpiF32, pg8::StaticOrder, true, true>(F.lds, g, S, E); }
        { pg8::Gemm g{HB, (const bf16*)(ws + WS_WSGU), M, 2 * EH, D}; pg8::StaticOrder S; S.init(M, 2 * EH, F.G, (int)((blockIdx.x + F.G / 2) % F.G));
          pg8::EpiSwiglu E{(bf16*)(ws + WS_SHG), EH};
          pg8::gemm_phase<pg8::EpiSwiglu, pg8::StaticOrder, true, true>(F.lds, g, S, E); }
    } SEAM(9);
    if (IN(10)) {
#if !MK_SKIP_SHARED
        for (int rp_ = 0; rp_ < MK_P10_GEMM_REP; ++rp_)
        { pg8::Gemm g{(const bf16*)(ws + WS_SHG), (const bf16*)(ws + WS_WSD), M, D, EH}; pg8::StaticOrder S; S.init(M, D, F.G, (int)blockIdx.x);
          pg8::EpiResid E{(float*)(ws + WS_MIXP), (const float*)(ws + WS_X1), D, mod + 5 * D, NMOD, 13};
          pg8::gemm_phase<pg8::EpiResid, pg8::StaticOrder, true, true>(F.lds, g, S, E); }
#endif
        for (int rr_ = 0; rr_ < MK_ROUTE_DRY_REP; ++rr_) route_tokens<true>(F);
        route_tokens<false>(F);
    } SEAM(10);
    if (IN(11)) {
#if !MK_SKIP_ROUTED
#if MK_EXP_V == 4
        p11_experts_v6(F);
#elif MK_EXP_V == 3
        p11_experts_v5(F);
#elif MK_EXP_V == 1
#if MK_ABL_RT
        if (F.abl) p11_experts_k64<MK_ABL_PROBE>(F); else
#endif
        p11_experts_k64<0>(F);
#else
#if MK_ABL_RT
        if (F.abl) p11_experts<MK_ABL_PROBE>(F); else
#endif
        p11_experts<0>(F);
#endif
#endif
    } SEAM(11);
    if (IN(12)) { int t_ = (int)threadIdx.x; asm volatile("" : "+v"(t_)); F.tid = t_; F.lane = t_ & 63;
        p12_final(F); }
#undef IN
#undef SEAM
}

extern "C" void kernel_launch(void* const* d_in, const int* in_sizes, int n_in, void* d_out, int out_size, void* d_ws, size_t ws_size, hipStream_t stream) {
    static int grid = 0;
    if (grid == 0) {
        if (n_in != 22 || in_sizes[0] != M * D || out_size != M * D || ws_size < WS_END) { fprintf(stderr, "kernel_launch: unexpected shapes (n_in %d, in0 %d, out %d, ws %zu, need %zu); nothing launched\n", n_in, n_in > 0 ? in_sizes[0] : -1, out_size, ws_size, (size_t)WS_END); grid = -1; return; }
        int dev = 0, cus = 0, per_cu = 0;
        if (hipGetDevice(&dev) != hipSuccess || hipDeviceGetAttribute(&cus, hipDeviceAttributeMultiprocessorCount, dev) != hipSuccess) { fprintf(stderr, "kernel_launch: device query failed\n"); grid = -1; return; }
        if (hipFuncSetAttribute((const void*)mk_fwd, hipFuncAttributeMaxDynamicSharedMemorySize, LDS_BYTES) != hipSuccess) { fprintf(stderr, "kernel_launch: hipFuncSetAttribute failed\n"); grid = -1; return; }
        if (hipOccupancyMaxActiveBlocksPerMultiprocessor(&per_cu, (const void*)mk_fwd, NT, LDS_BYTES) != hipSuccess || per_cu < 1) { fprintf(stderr, "kernel_launch: occupancy query reports %d workgroups per CU\n", per_cu); (void)hipGetLastError(); grid = -1; return; }
        grid = cus;
    }
    if (grid < 0) return;
    if (hipMemsetAsync((char*)d_ws + WS_CTL, 0, CTL_ZERO_BYTES, stream) != hipSuccess) { fprintf(stderr, "kernel_launch: hipMemsetAsync failed\n"); return; }
    Args a{};
    for (int i = 0; i < 22; ++i) a.in[i] = d_in[i];
    a.out = (float*)d_out; a.ws = (unsigned char*)d_ws;
#if MK_PER_PHASE
    for (int p = 0; p < NPHASE; ++p) { a.ph_lo = p; a.ph_hi = p + 1; hipLaunchKernelGGL(mk_fwd, dim3(grid), dim3(NT), LDS_BYTES, stream, a); }
#elif defined(MK_ABL_PROBE)
    a.ph_lo = 0; a.ph_hi = 12; a.li = 0; a.abl = 1; hipLaunchKernelGGL(mk_fwd, dim3(grid), dim3(NT), LDS_BYTES, stream, a);
    a.ph_lo = 11; a.ph_hi = NPHASE; a.li = 1; a.abl = 0; hipLaunchKernelGGL(mk_fwd, dim3(grid), dim3(NT), LDS_BYTES, stream, a);
#elif defined(MK_PROBE_LO)
    a.ph_lo = 0; a.ph_hi = MK_PROBE_HI; a.li = 0; hipLaunchKernelGGL(mk_fwd, dim3(grid), dim3(NT), LDS_BYTES, stream, a);
    a.ph_lo = MK_PROBE_LO; a.ph_hi = NPHASE; a.li = 1; hipLaunchKernelGGL(mk_fwd, dim3(grid), dim3(NT), LDS_BYTES, stream, a);
#else
    a.ph_lo = 0; a.ph_hi = NPHASE;
    hipLaunchKernelGGL(mk_fwd, dim3(grid), dim3(NT), LDS_BYTES, stream, a);
#endif
    const hipError_t le = hipPeekAtLastError();
    if (le != hipSuccess) fprintf(stderr, "kernel_launch: launch failed: %s\n", hipGetErrorName(le));
}
```

```cpp
#include <hip/hip_runtime.h>
#include <cstdio>
#include <cstdint>
namespace pg8 {
#define PG8_LAS __attribute__((address_space(3)))
typedef unsigned short bf16_t;
typedef short bf16x8 __attribute__((ext_vector_type(8)));
typedef float f32x4 __attribute__((ext_vector_type(4)));
typedef unsigned u32x4 __attribute__((ext_vector_type(4)));
constexpr int BM = 256, BK = 64, HALF = 128, HTB = HALF * BK * 2  , STAGE_BYTES = 8 * HTB, NXCD = 8, WGM = 8;

__host__ __device__ __forceinline__ int lds_byte(int r, int c) { const int st = (r >> 4) * 2 + (c >> 5), rr = r & 15, cc = c & 31, ob = rr * 64 + cc * 2; return st * 1024 + (ob ^ (((ob >> 9) & 1) << 5)); }
__host__ __device__ __forceinline__ void stage_rc(int b, int& R, int& C) { const int st = b / 1024, sb = b % 1024, swz = sb ^ (((sb >> 9) & 1) << 5); R = (st >> 1) * 16 + swz / 64; C = (st & 1) * 32 + (swz % 64) / 2; }
__host__ __device__ __forceinline__ int perm32(int rho) { const int n = rho >> 4, i = rho & 15; return 8 * (i >> 2) + 4 * n + (i & 3); }

struct Unit { int pm, pn; };
struct Gemm { const bf16_t* A; const bf16_t* Bt; int M, N, K; };

struct StaticOrder {
    int nM, nN, nwg, G, c;
    __host__ __device__ void init(int M, int N, int G_, int c_) { nM = M / BM; nN = N / BM; nwg = nM * nN; G = G_; c = c_; }
    __host__ __device__ bool next(int i, Unit& u) const {
        const long L = (long)i * G + c; if (L >= nwg) return false;
        int wgid = (int)L; { const int q = nwg / NXCD, r = nwg % NXCD, xcd = wgid % NXCD, off = wgid / NXCD; wgid = (xcd < r ? xcd * (q + 1) : r * (q + 1) + (xcd - r) * q) + off; }
        const int nig = WGM * nN, gid = wgid / nig, fm = gid * WGM, gsz = (nM - fm) < WGM ? (nM - fm) : WGM;
        u.pm = fm + ((wgid % nig) % gsz); u.pn = (wgid % nig) / gsz; return true;
    }
    __device__ __forceinline__ void a_ready(const Unit&) const {}
    __device__ __forceinline__ void done(const Unit&) const {}
};

__device__ __forceinline__ unsigned cvt_pk_bf16(float lo, float hi) { unsigned r; asm volatile("v_cvt_pk_bf16_f32 %0, %1, %2" : "=v"(r) : "v"(lo), "v"(hi)); return r; }
typedef float f32x2 __attribute__((ext_vector_type(2)));
typedef unsigned u32x2 __attribute__((ext_vector_type(2)));
__device__ __forceinline__ float bf_lo(unsigned w) { return __uint_as_float(w << 16); }
__device__ __forceinline__ float bf_hi(unsigned w) { return __uint_as_float(w & 0xffff0000u); }
__device__ __forceinline__ float sigm(float x) { return 1.0f / (1.0f + __expf(-x)); }
__device__ __forceinline__ float silu_f(float x) { return x / (1.0f + __expf(-x)); }

struct EpiBf16 {
    static constexpr bool PERM = true, AFTER_DRAIN = false;
    bf16_t* O; int ldc;
    __device__ __forceinline__ void operator()(const f32x4 (&acc)[2][2][4][2], const Unit& u, int wr, int wc, int fr, int fq) const {
        const int row0 = u.pm * BM + wr * 64 + fr; const int col0 = u.pn * BM + wc * 32 + 8 * fq;
#pragma unroll
        for (int ai = 0; ai < 2; ++ai)
#pragma unroll
            for (int m = 0; m < 4; ++m) { bf16_t* rowp = O + (size_t)(row0 + ai * HALF + m * 16) * ldc + col0;
#pragma unroll
                for (int bj = 0; bj < 2; ++bj) { const f32x4 v0 = acc[ai][bj][m][0], v1 = acc[ai][bj][m][1];
                    u32x4 w; w.x = cvt_pk_bf16(v0[0], v0[1]); w.y = cvt_pk_bf16(v0[2], v0[3]); w.z = cvt_pk_bf16(v1[0], v1[1]); w.w = cvt_pk_bf16(v1[2], v1[3]);
                    *(u32x4*)(rowp + bj * HALF) = w; } }
    }
};
struct EpiF32 {
    static constexpr bool PERM = false, AFTER_DRAIN = false;
    float* C; int ldc;
    __device__ __forceinline__ void operator()(const f32x4 (&acc)[2][2][4][2], const Unit& u, int wr, int wc, int fr, int fq) const {
        const int row0 = u.pm * BM + wr * 64 + fr, col0 = u.pn * BM + wc * 32 + 4 * fq;
#pragma unroll
        for (int ai = 0; ai < 2; ++ai)
#pragma unroll
            for (int m = 0; m < 4; ++m) { float* rowp = C + (size_t)(row0 + ai * HALF + m * 16) * ldc + col0;
#pragma unroll
                for (int bj = 0; bj < 2; ++bj)
#pragma unroll
                    for (int n = 0; n < 2; ++n) *(f32x4*)(rowp + bj * HALF + n * 16) = acc[ai][bj][m][n]; }
    }
};
struct EpiGateBf16 {
    static constexpr bool PERM = true, AFTER_DRAIN = false;
    bf16_t* O; int ldc; const bf16_t* gate; int ldg;
    __device__ __forceinline__ void operator()(const f32x4 (&acc)[2][2][4][2], const Unit& u, int wr, int wc, int fr, int fq) const {
        const int row0 = u.pm * BM + wr * 64 + fr; const int col0 = u.pn * BM + wc * 32 + 8 * fq;
#pragma unroll
        for (int ai = 0; ai < 2; ++ai)
#pragma unroll
            for (int m = 0; m < 4; ++m) { const size_t r = (size_t)(row0 + ai * HALF + m * 16); bf16_t* rowp = O + r * ldc + col0; const bf16_t* gp = gate + r * ldg + col0;
#pragma unroll
                for (int bj = 0; bj < 2; ++bj) { const f32x4 v0 = acc[ai][bj][m][0], v1 = acc[ai][bj][m][1]; const u32x4 g = *(const u32x4*)(gp + bj * HALF);
                    u32x4 w; w.x = cvt_pk_bf16(sigm(bf_lo(g.x)) * v0[0], sigm(bf_hi(g.x)) * v0[1]); w.y = cvt_pk_bf16(sigm(bf_lo(g.y)) * v0[2], sigm(bf_hi(g.y)) * v0[3]);
                    w.z = cvt_pk_bf16(sigm(bf_lo(g.z)) * v1[0], sigm(bf_hi(g.z)) * v1[1]); w.w = cvt_pk_bf16(sigm(bf_lo(g.w)) * v1[2], sigm(bf_hi(g.w)) * v1[3]);
                    *(u32x4*)(rowp + bj * HALF) = w; } }
    }
};
struct EpiMixBf16 {
    static constexpr bool PERM = true, AFTER_DRAIN = false;
    bf16_t* O; int ldc; const bf16_t* P; const bf16_t* gate; int ldg;
    __device__ __forceinline__ void operator()(const f32x4 (&acc)[2][2][4][2], const Unit& u, int wr, int wc, int fr, int fq) const {
        const int row0 = u.pm * BM + wr * 64 + fr; const int col0 = u.pn * BM + wc * 32 + 8 * fq;
#pragma unroll
        for (int ai = 0; ai < 2; ++ai)
#pragma unroll
            for (int m = 0; m < 4; ++m) { const size_t r = (size_t)(row0 + ai * HALF + m * 16); bf16_t* rowp = O + r * ldc + col0; const bf16_t* pp = P + r * ldc + col0; const bf16_t* gp = gate + r * ldg + col0;
#pragma unroll
                for (int bj = 0; bj < 2; ++bj) { const f32x4 v0 = acc[ai][bj][m][0], v1 = acc[ai][bj][m][1];
                    const u32x4 g = *(const u32x4*)(gp + bj * HALF); const u32x4 pq = *(const u32x4*)(pp + bj * HALF); const f32x4 p0 = {bf_lo(pq.x), bf_hi(pq.x), bf_lo(pq.y), bf_hi(pq.y)}, p1 = {bf_lo(pq.z), bf_hi(pq.z), bf_lo(pq.w), bf_hi(pq.w)};
                    const float o0 = p0[0] + sigm(bf_lo(g.x)) * v0[0], o1 = p0[1] + sigm(bf_hi(g.x)) * v0[1], o2 = p0[2] + sigm(bf_lo(g.y)) * v0[2], o3 = p0[3] + sigm(bf_hi(g.y)) * v0[3];
                    const float o4 = p1[0] + sigm(bf_lo(g.z)) * v1[0], o5 = p1[1] + sigm(bf_hi(g.z)) * v1[1], o6 = p1[2] + sigm(bf_lo(g.w)) * v1[2], o7 = p1[3] + sigm(bf_hi(g.w)) * v1[3];
                    u32x4 w; w.x = cvt_pk_bf16(o0, o1); w.y = cvt_pk_bf16(o2, o3); w.z = cvt_pk_bf16(o4, o5); w.w = cvt_pk_bf16(o6, o7);
                    *(u32x4*)(rowp + bj * HALF) = w; } }
    }
};
struct EpiResid {
    static constexpr bool PERM = false, AFTER_DRAIN = false;
    float* C; const float* base; int ldc; const float* gvec; int gstride; int rows_per_b_shift;
    __device__ __forceinline__ void operator()(const f32x4 (&acc)[2][2][4][2], const Unit& u, int wr, int wc, int fr, int fq) const {
        const int row0 = u.pm * BM + wr * 64 + fr, col0 = u.pn * BM + wc * 32 + 4 * fq;
        const float* gp = gvec + (size_t)((u.pm * BM) >> rows_per_b_shift) * gstride + col0;
        f32x4 gv[2][2];
#pragma unroll
        for (int bj = 0; bj < 2; ++bj)
#pragma unroll
            for (int n = 0; n < 2; ++n) gv[bj][n] = *(const f32x4*)(gp + bj * HALF + n * 16);
#pragma unroll
        for (int ai = 0; ai < 2; ++ai)
#pragma unroll
            for (int m = 0; m < 4; ++m) { const size_t off = (size_t)(row0 + ai * HALF + m * 16) * ldc + col0;
#pragma unroll
                for (int bj = 0; bj < 2; ++bj)
#pragma unroll
                    for (int n = 0; n < 2; ++n) { const f32x4 b = *(const f32x4*)(base + off + bj * HALF + n * 16);
                        *(f32x4*)(C + off + bj * HALF + n * 16) = b + gv[bj][n] * acc[ai][bj][m][n]; } }
    }
};
struct EpiSwiglu {
    static constexpr bool PERM = true, AFTER_DRAIN = false;
    bf16_t* O; int ldo;
    __device__ __forceinline__ void operator()(const f32x4 (&acc)[2][2][4][2], const Unit& u, int wr, int wc, int fr, int fq) const {
        const int row0 = u.pm * BM + wr * 64 + fr; const int col0 = u.pn * BM + wc * 32 + 8 * fq;
#pragma unroll
        for (int ai = 0; ai < 2; ++ai)
#pragma unroll
            for (int m = 0; m < 4; ++m) { bf16_t* rowp = O + (size_t)(row0 + ai * HALF + m * 16) * ldo + (col0 >> 1);
#pragma unroll
                for (int bj = 0; bj < 2; ++bj) { const f32x4 v0 = acc[ai][bj][m][0], v1 = acc[ai][bj][m][1];
                    const float g0 = silu_f(v0[0]) * v0[1], g1 = silu_f(v0[2]) * v0[3], g2 = silu_f(v1[0]) * v1[1], g3 = silu_f(v1[2]) * v1[3];
                    u32x2 w; w.x = cvt_pk_bf16(g0, g1); w.y = cvt_pk_bf16(g2, g3);
                    *(u32x2*)(rowp + bj * (HALF / 2)) = w; } }
    }
};
template <class Epi, class Sched, bool ALIGN_EPI = false, bool SP2 = false>
__device__ __forceinline__ void gemm_phase(PG8_LAS unsigned char* lds, const Gemm g, const Sched& S, const Epi& E) {
    const int tid = threadIdx.x, wid = __builtin_amdgcn_readfirstlane(tid >> 6), lane = tid & 63, wr = wid >> 2, wc = wid & 3, fr = lane & 15, fq = lane >> 4;
    const int K = g.K, nt = K / BK;
    unsigned voffA[2], voffB[2];
#pragma unroll
    for (int i = 0; i < 2; ++i) { int R, C; stage_rc(tid * 16 + i * 8192, R, C); const int Rb = Epi::PERM ? ((R & ~31) + perm32(R & 31)) : R;
        voffA[i] = (unsigned)(R * K + C) * 2u; voffB[i] = (unsigned)(Rb * K + C) * 2u; }
    const size_t kstep = (size_t)(BK * 2);
    const size_t hstep = (size_t)HALF * K * 2;
    const size_t tstep = 2 * hstep;
    const unsigned ldsw = (unsigned)wid * 1024u;
    const int aoff = lds_byte(wr * 64 + fr, fq * 8), boff = lds_byte(wc * 32 + fr, fq * 8);
#define PG8_SA(b, h) (((b) * 2 + (h)) * HTB)
#define PG8_SB(b, h) ((4 + (b) * 2 + (h)) * HTB)
#define PG8_STAGE(bufoff, gbase, voff) do { _Pragma("unroll") for (int _i = 0; _i < 2; ++_i) \
        __builtin_amdgcn_global_load_lds((const unsigned*)((const char*)(gbase) + (voff)[_i]), (PG8_LAS unsigned*)(lds + (bufoff) + ldsw + _i * 8192), 16, 0, 0); } while (0)
#define PG8_LDA(dst, b, h) do { _Pragma("unroll") for (int m = 0; m < 4; ++m) _Pragma("unroll") for (int k = 0; k < 2; ++k) dst[m][k] = *(const PG8_LAS bf16x8*)(lds + PG8_SA(b, h) + aoff + m * 2048 + k * 1024); } while (0)
#define PG8_LDB(dst, b, h) do { _Pragma("unroll") for (int n = 0; n < 2; ++n) _Pragma("unroll") for (int k = 0; k < 2; ++k) dst[n][k] = *(const PG8_LAS bf16x8*)(lds + PG8_SB(b, h) + boff + n * 2048 + k * 1024); } while (0)
#define PG8_MMA(ai, bj, At, Bt) do { __builtin_amdgcn_s_setprio(1); _Pragma("unroll") for (int m = 0; m < 4; ++m) _Pragma("unroll") for (int n = 0; n < 2; ++n) _Pragma("unroll") for (int k = 0; k < 2; ++k) \
        acc[ai][bj][m][n] = __builtin_amdgcn_mfma_f32_16x16x32_bf16(Bt[n][k], At[m][k], acc[ai][bj][m][n], 0, 0, 0); __builtin_amdgcn_s_setprio(0); } while (0)
#define PG8_WAIT_V(n) asm volatile("s_waitcnt vmcnt(" #n ")" ::: "memory")
#define PG8_WAIT_L(n) asm volatile("s_waitcnt lgkmcnt(" #n ")" ::: "memory")
#define PG8_BAR __builtin_amdgcn_s_barrier()
#define PG8_SCHED __builtin_amdgcn_sched_barrier(0)
    Unit cur, nxt; int ui = 0;
    if (!S.next(0, cur)) return;
    f32x4 acc[2][2][4][2];
#pragma unroll
    for (int a = 0; a < 2; ++a)
#pragma unroll
        for (int b = 0; b < 2; ++b)
#pragma unroll
            for (int m = 0; m < 4; ++m)
#pragma unroll
                for (int n = 0; n < 2; ++n) acc[a][b][m][n] = (f32x4){0.f, 0.f, 0.f, 0.f};
    bf16x8 At[4][2], B0[2][2], B1[2][2];
    const char* cA = (const char*)g.A + (size_t)cur.pm * tstep; const char* cB = (const char*)g.Bt + (size_t)cur.pn * tstep;
    S.a_ready(cur);
    if constexpr (SP2) {
        PG8_STAGE(PG8_SB(0, 0), cB, voffB); PG8_STAGE(PG8_SB(0, 1), cB + hstep, voffB); PG8_STAGE(PG8_SA(0, 0), cA, voffA); PG8_STAGE(PG8_SA(0, 1), cA + hstep, voffA);
        if (wr == 1) PG8_BAR;
        PG8_WAIT_V(2); PG8_BAR;
        PG8_STAGE(PG8_SB(1, 0), cB + kstep, voffB); PG8_STAGE(PG8_SA(1, 0), cA + kstep, voffA); PG8_STAGE(PG8_SB(1, 1), cB + hstep + kstep, voffB);
        PG8_WAIT_V(6); PG8_BAR;
    } else {
        PG8_STAGE(PG8_SB(0, 0), cB, voffB); PG8_STAGE(PG8_SA(0, 0), cA, voffA); PG8_STAGE(PG8_SB(0, 1), cB + hstep, voffB); PG8_STAGE(PG8_SA(0, 1), cA + hstep, voffA);
        if (wr == 1) PG8_BAR;
        PG8_WAIT_V(4); PG8_BAR;
        PG8_STAGE(PG8_SB(1, 0), cB + kstep, voffB); PG8_STAGE(PG8_SA(1, 0), cA + kstep, voffA); PG8_STAGE(PG8_SB(1, 1), cB + hstep + kstep, voffB);
        PG8_WAIT_V(6); PG8_BAR;
    }
    for (;;) {
        const bool has_next = S.next(ui + 1, nxt);
        const char* nA = has_next ? (const char*)g.A + (size_t)nxt.pm * tstep : cA; const char* nB = has_next ? (const char*)g.Bt + (size_t)nxt.pn * tstep : cB;
        for (int t = 0; t < nt; t += 2) {
            const bool last = (t == nt - 2);
            const char* a1 = cA + (size_t)(t + 1) * kstep;
            const char* a2 = last ? nA : cA + (size_t)(t + 2) * kstep; const char* b2 = last ? nB : cB + (size_t)(t + 2) * kstep;
            const char* a3 = a2 + kstep; const char* b3 = b2 + kstep;
            if (last && has_next) S.a_ready(nxt);
            if constexpr (SP2) {
            PG8_LDB(B0, 0, 0); PG8_LDB(B1, 0, 1); PG8_SCHED; PG8_LDA(At, 0, 0); PG8_STAGE(PG8_SA(1, 1), a1 + hstep, voffA);
            PG8_WAIT_V(8); PG8_WAIT_L(0); PG8_BAR; PG8_MMA(0, 0, At, B0); PG8_MMA(0, 1, At, B1); PG8_BAR; PG8_SCHED;
            PG8_LDA(At, 0, 1); PG8_STAGE(PG8_SB(0, 0), b2, voffB); PG8_STAGE(PG8_SB(0, 1), b2 + hstep, voffB); PG8_STAGE(PG8_SA(0, 0), a2, voffA);
            PG8_WAIT_V(8); PG8_WAIT_L(0); PG8_BAR; PG8_MMA(1, 0, At, B0); PG8_MMA(1, 1, At, B1); PG8_BAR; PG8_SCHED;
            PG8_LDB(B0, 1, 0); PG8_LDB(B1, 1, 1); PG8_SCHED; PG8_LDA(At, 1, 0); PG8_STAGE(PG8_SA(0, 1), a2 + hstep, voffA);
            PG8_WAIT_V(8); PG8_WAIT_L(0); PG8_BAR; PG8_MMA(0, 0, At, B0); PG8_MMA(0, 1, At, B1); PG8_BAR; PG8_SCHED;
            PG8_LDA(At, 1, 1); PG8_STAGE(PG8_SB(1, 0), b3, voffB); PG8_STAGE(PG8_SB(1, 1), b3 + hstep, voffB); PG8_STAGE(PG8_SA(1, 0), a3, voffA);
            PG8_WAIT_V(8); PG8_WAIT_L(0); PG8_BAR; PG8_MMA(1, 0, At, B0); PG8_MMA(1, 1, At, B1); PG8_BAR; PG8_SCHED;
            } else {
            PG8_LDB(B0, 0, 0); PG8_SCHED; PG8_LDA(At, 0, 0); PG8_STAGE(PG8_SA(1, 1), a1 + hstep, voffA);
            PG8_WAIT_L(8); PG8_BAR; PG8_WAIT_L(0); PG8_MMA(0, 0, At, B0); PG8_BAR; PG8_SCHED;
            PG8_LDB(B1, 0, 1); PG8_STAGE(PG8_SB(0, 0), b2, voffB);
            PG8_BAR; PG8_WAIT_L(0); PG8_MMA(0, 1, At, B1); PG8_BAR;
            PG8_LDA(At, 0, 1); PG8_STAGE(PG8_SA(0, 0), a2, voffA);
            PG8_BAR; PG8_WAIT_L(0); PG8_MMA(1, 0, At, B0); PG8_BAR; PG8_SCHED;
            PG8_STAGE(PG8_SB(0, 1), b2 + hstep, voffB);
            PG8_WAIT_V(6); PG8_BAR; PG8_MMA(1, 1, At, B1); PG8_BAR;
            PG8_LDB(B0, 1, 0); PG8_SCHED; PG8_LDA(At, 1, 0); PG8_STAGE(PG8_SA(0, 1), a2 + hstep, voffA);
            PG8_WAIT_L(8); PG8_BAR; PG8_WAIT_L(0); PG8_MMA(0, 0, At, B0); PG8_BAR; PG8_SCHED;
            PG8_LDB(B1, 1, 1); PG8_STAGE(PG8_SB(1, 0), b3, voffB);
            PG8_BAR; PG8_WAIT_L(0); PG8_MMA(0, 1, At, B1); PG8_BAR;
            PG8_LDA(At, 1, 1); PG8_STAGE(PG8_SA(1, 0), a3, voffA);
            PG8_BAR; PG8_WAIT_L(0); PG8_MMA(1, 0, At, B0); PG8_BAR; PG8_SCHED;
            PG8_STAGE(PG8_SB(1, 1), b3 + hstep, voffB);
            PG8_WAIT_V(6); PG8_BAR; PG8_MMA(1, 1, At, B1); PG8_BAR;
            }
        }
        if constexpr (ALIGN_EPI) { if (wr == 0) PG8_BAR; }
        if constexpr (!Epi::AFTER_DRAIN) { E(acc, cur, wr, wc, fr, fq); S.done(cur); }
        if (!has_next) break;
#pragma unroll
        for (int a = 0; a < 2; ++a)
#pragma unroll
            for (int b = 0; b < 2; ++b)
#pragma unroll
                for (int m = 0; m < 4; ++m)
#pragma unroll
                    for (int n = 0; n < 2; ++n) acc[a][b][m][n] = (f32x4){0.f, 0.f, 0.f, 0.f};
        cur = nxt; cA = nA; cB = nB; ++ui;
        if constexpr (ALIGN_EPI) { if (wr == 1) PG8_BAR; }
    }
    PG8_WAIT_V(0);
    if constexpr (!ALIGN_EPI) { if (wr == 0) PG8_BAR; }
    PG8_BAR;
    if constexpr (Epi::AFTER_DRAIN) { E.fused(acc, cur, wr, wc, fr, fq, lds, wid, lane); S.done(cur); }
#undef PG8_SA
#undef PG8_SB
#undef PG8_STAGE
#undef PG8_LDA
#undef PG8_LDB
#undef PG8_MMA
#undef PG8_WAIT_V
#undef PG8_WAIT_L
#undef PG8_BAR
#undef PG8_SCHED
}
}

constexpr int NWAVES = 8, NT = 512;
#ifndef MK_PER_PHASE
#define MK_PER_PHASE 0
#endif
#ifndef MK_EXP_V
#define MK_EXP_V 4
#endif
#ifndef MK_TIMER_PHASE
#define MK_TIMER_PHASE -1
#endif
#ifndef MK_ABL_RT
#define MK_ABL_RT 0
#endif
#ifndef MK_P10_GEMM_REP
#define MK_P10_GEMM_REP 1
#endif
#ifndef MK_GSYNC
#define MK_GSYNC 0
#endif
#ifndef MK_GSYNC_EVERY
#define MK_GSYNC_EVERY 16
#endif
#ifndef MK_GSTAG
#define MK_GSTAG 0
#endif
#ifndef MK_PFD
#define MK_PFD 0
#endif
#ifndef MK_ROUTE_DRY_REP
#define MK_ROUTE_DRY_REP 0
#endif
#ifndef MK_LATE_ISSUE
#define MK_LATE_ISSUE 0
#endif
#ifndef MK_SPREAD
#define MK_SPREAD 2
#endif
#ifndef MK_SHARED_IN_P11
#define MK_SHARED_IN_P11 1
#endif
#ifndef MK_SKIP_MIXER
#define MK_SKIP_MIXER 0
#endif
#ifndef MK_SKIP_SHARED
#define MK_SKIP_SHARED 0
#endif
#ifndef MK_SKIP_ROUTED
#define MK_SKIP_ROUTED 0
#endif
constexpr int NPHASE = 13;
constexpr int BATCH = 2, SEQ = 8192, D = 1024, M = BATCH * SEQ, NIN = 8192, NMOD = 6144;
constexpr int OFF_Q = 0, OFF_K = 512, OFF_V = 1024, OFF_GR = 2048, OFF_U = 3072, OFF_GC = 4096, OFF_GB = 5120, OFF_MR = 6144, OFF_MC = 7168;
constexpr int NE = 256, TOPK = 8, EH = 256, CAP = 16384, NCH = 64, CH = 128, NH = 4, DK = 128, DV = 256;
constexpr float EPS = 1e-6f;

constexpr size_t MiB = (size_t)1 << 20;
constexpr size_t WS_CTL = 0, CTL_ZERO_BYTES = 1 * MiB;
constexpr size_t WS_MOD = 1 * MiB;
constexpr size_t WS_ROPE = 2 * MiB;
constexpr size_t WS_WR = 10 * MiB;
constexpr size_t WS_WSGU = 11 * MiB;
constexpr size_t WS_WSD = 12 * MiB;
constexpr size_t WS_WBR = 13 * MiB, WS_WBC = 15 * MiB, WS_WO = 17 * MiB;
constexpr size_t WS_WIN = 20 * MiB;
constexpr size_t WS_HB = 36 * MiB;
constexpr size_t WS_PROJ = 68 * MiB;
constexpr size_t WS_KV = 324 * MiB;
constexpr size_t WS_SP = 388 * MiB;
constexpr size_t WS_RETG = 420 * MiB;
constexpr size_t WS_CONVG = 452 * MiB;
constexpr size_t WS_MIXP = 484 * MiB;
constexpr size_t WS_MIX = 548 * MiB;
constexpr size_t WS_X1 = 580 * MiB;
constexpr size_t WS_LOGITS = 644 * MiB;
constexpr size_t WS_SHG = 660 * MiB;
constexpr size_t WS_EIDX = 668 * MiB, WS_POS = 669 * MiB;
constexpr size_t WS_LTOK = 670 * MiB, WS_LW = 686 * MiB;
constexpr size_t WS_YP = 702 * MiB;
constexpr size_t WS_END = 958 * MiB;
constexpr int CW_TMO = 0, CW_CODE = 1, CW_BAR = 4096, CW_CNT = 16384, CW_GS = 131072;

constexpr int LDSCTL_OFF = 143360, MISC_OFF = LDSCTL_OFF + 320, LDS_BYTES = 147456;

#define GAS __attribute__((address_space(1)))
#define LAS __attribute__((address_space(3)))
typedef unsigned short bf16;
typedef unsigned v4u __attribute__((ext_vector_type(4)));
typedef unsigned v2u __attribute__((ext_vector_type(2)));
typedef float f32x4 __attribute__((ext_vector_type(4)));
typedef float f32x2 __attribute__((ext_vector_type(2)));
typedef short bf16x8 __attribute__((ext_vector_type(8)));
typedef short s16x4 __attribute__((ext_vector_type(4)));
typedef GAS unsigned gu32;
#define RLX_AGENT __ATOMIC_RELAXED, __HIP_MEMORY_SCOPE_AGENT
__device__ __forceinline__ unsigned f2bf(float f) { unsigned u = __builtin_bit_cast(unsigned, f); return (u + 0x7fffu + ((u >> 16) & 1u)) >> 16; }
__device__ __forceinline__ unsigned pk2(float lo, float hi) { unsigned r; asm volatile("v_cvt_pk_bf16_f32 %0, %1, %2" : "=v"(r) : "v"(lo), "v"(hi)); return r; }
__device__ __forceinline__ float bflo(unsigned w) { return __uint_as_float(w << 16); }
__device__ __forceinline__ float bfhi(unsigned w) { return __uint_as_float(w & 0xffff0000u); }
__device__ __forceinline__ float sigmoidf_(float x) { return 1.0f / (1.0f + __expf(-x)); }
__device__ __forceinline__ float siluf_(float x) { return x / (1.0f + __expf(-x)); }

#define XB_TMO      128
#define XB_XCNT(j)  (256  + 64 * (j))
#define XB_XSUB(j)  (1280 + 64 * (j))
#define XB_XGEN(j)  (2304 + 64 * (j))
#define XB_TOP      3328
#define XB_TOPGEN   3392
#define XCD_BAR_WORDS 3456
#define XB_SPIN_CAP (1u << 18)

__device__ __forceinline__ unsigned xb_ld(unsigned* p)              { return __hip_atomic_load(p, __ATOMIC_RELAXED, __HIP_MEMORY_SCOPE_AGENT); }
__device__ __forceinline__ unsigned xb_add(unsigned* p, unsigned v) { return __hip_atomic_fetch_add(p, v, __ATOMIC_RELAXED, __HIP_MEMORY_SCOPE_AGENT); }
__device__ __forceinline__ unsigned xb_xcc_id() { return (unsigned)__builtin_amdgcn_s_getreg((3 << 11) | 20) & 0xFu; }
#define XB_SPIN(cond, bar) do { unsigned _sp = 0; while (cond) { __builtin_amdgcn_s_sleep(1); \
    if ((++_sp & 255u) == 0u) { if (xb_ld(&(bar)[XB_TMO])) break; if (_sp > XB_SPIN_CAP) { atomicAdd(&(bar)[XB_TMO], 1u); break; } } } } while (0)

struct XcdBarrier {
    unsigned* bar; unsigned x;
    volatile LAS unsigned* st;
};

__device__ __forceinline__ XcdBarrier xcd_barrier_post(unsigned* bar, volatile LAS unsigned* st) {
    XcdBarrier b; b.bar = bar; b.x = xb_xcc_id(); b.st = st;
    if (threadIdx.x == 0) (void)xb_add(&bar[XB_XCNT(b.x)], 1u);
    return b;
}
__device__ __forceinline__ void xcd_barrier_complete(unsigned* bar, unsigned x, unsigned& nloc, unsigned& nx) {
    const unsigned G = gridDim.x * gridDim.y * gridDim.z;
    unsigned sum, cnt, mine, sp = 0u;
    for (;;) {
        sum = 0u; cnt = 0u; mine = 0u;
#pragma unroll
        for (unsigned j = 0; j < 16; ++j) { const unsigned c = xb_ld(&bar[XB_XCNT(j)]); sum += c; cnt += (c > 0u) ? 1u : 0u; mine = (j == x) ? c : mine; }
        if (sum == G) break;
        __builtin_amdgcn_s_sleep(1);
        if ((++sp & 255u) == 0u) { if (xb_ld(&bar[XB_TMO])) break; if (sp > XB_SPIN_CAP) { atomicAdd(&bar[XB_TMO], 1u); break; } }
    }
    nloc = mine > 0u ? mine : 1u; nx = cnt > 0u ? cnt : 1u;
}

__device__ __forceinline__ void xcd_barrier(const XcdBarrier& b) {
    asm volatile("s_waitcnt vmcnt(0)" ::: "memory");
    __syncthreads();
    if (threadIdx.x == 0) {
        unsigned* bar = b.bar;
        __builtin_amdgcn_s_waitcnt(0);
        unsigned nloc = b.st[0], nx = b.st[1];
        if (nloc == 0u) { xcd_barrier_complete(bar, b.x, nloc, nx); b.st[0] = nloc; b.st[1] = nx; }
        const unsigned old = xb_add(&bar[XB_XSUB(b.x)], 1u);
        const unsigned gen = old / nloc;
        if (old + 1u == (gen + 1u) * nloc) {
            __builtin_amdgcn_fence(__ATOMIC_RELEASE, "agent");
            asm volatile("s_waitcnt vmcnt(0)" ::: "memory");
            const unsigned og = xb_add(&bar[XB_TOP], 1u);
            const unsigned tg = og / nx;
            if (og + 1u == (tg + 1u) * nx) xb_add(&bar[XB_TOPGEN], 1u);
            else XB_SPIN(xb_ld(&bar[XB_TOPGEN]) == tg, bar);
            __builtin_amdgcn_fence(__ATOMIC_ACQUIRE, "agent");
            xb_add(&bar[XB_XGEN(b.x)], 1u);
            asm volatile("s_waitcnt vmcnt(0)" ::: "memory");
        } else {
            XB_SPIN(xb_ld(&bar[XB_XGEN(b.x)]) == gen, bar);
            __builtin_amdgcn_fence(__ATOMIC_ACQUIRE, "agent");
            asm volatile("s_waitcnt vmcnt(0)" ::: "memory");
        }
    }
    __syncthreads();
}

struct Frame {
    LAS unsigned char* lds; unsigned ldsb;
    volatile LAS unsigned* MISC; gu32* ctl;
    int tid, lane, wave, vcu, G, abl;
    const float *x, *c; const int* pos; const float *w_ada, *b_ada, *norm_mix_g, *w_in, *ret_norm_g, *conv_w, *w_br_ret, *w_br_conv, *w_out, *norm_ffn_g, *w_router, *router_bias,
        *w_eg, *w_eu, *w_ed, *w_sg, *w_su, *w_sd, *norm_final_g;
    float* out; unsigned char* ws;
};
__device__ __forceinline__ float wave_sum(float v) {
#pragma unroll
    for (int o = 1; o < 64; o <<= 1) v += __shfl_xor(v, o);
    return v;
}

__device__ __forceinline__ void p0_mod_task(Frame& F, int j) {
    const int cq = F.tid & 15, kq = F.tid >> 4;
    f32x4 a0 = {0.f, 0.f, 0.f, 0.f}, a1 = {0.f, 0.f, 0.f, 0.f};
    const float* W = F.w_ada + 64 * j + 4 * cq;
#pragma unroll 8
    for (int i = 0; i < 32; ++i) { const int k = kq + 32 * i; const float c0 = F.c[k], c1 = F.c[1024 + k];
        const float s0 = c0 / (1.0f + expf(-c0)), s1 = c1 / (1.0f + expf(-c1));
        const f32x4 w = *(const f32x4*)(W + (size_t)k * NMOD); a0 += s0 * w; a1 += s1 * w; }
    LAS f32x4* red = (LAS f32x4*)F.lds;
    red[(kq * 2 + 0) * 16 + cq] = a0; red[(kq * 2 + 1) * 16 + cq] = a1;
    __syncthreads();
    if (F.tid < 32) { const int b = F.tid >> 4, c2 = F.tid & 15; f32x4 s = *(const f32x4*)(F.b_ada + 64 * j + 4 * c2);
        for (int k2 = 0; k2 < 32; ++k2) s += red[(k2 * 2 + b) * 16 + c2];
        *(f32x4*)((float*)(F.ws + WS_MOD) + b * NMOD + 64 * j + 4 * c2) = s; }
    __syncthreads();
}
__device__ __forceinline__ void p0_transpose_item(const float* W, int K, int N, bf16* WT, int row_off, int row_mul, LAS float* scr, int item, int lane) {
    const int nblk = N / 32, kb = item / nblk, nb = item % nblk, k0 = 64 * kb, n0 = 32 * nb;
#pragma unroll 8
    for (int i = 0; i < 32; ++i) { const int kk = 2 * i + (lane >> 5); scr[kk * 33 + (lane & 31)] = W[(size_t)(k0 + kk) * N + n0 + (lane & 31)]; }
    asm volatile("s_waitcnt lgkmcnt(0)" ::: "memory");
    const int c = lane & 7;
#pragma unroll
    for (int j = 0; j < 4; ++j) { const int n = (lane >> 3) + 8 * j; const LAS float* s = scr + (8 * c) * 33 + n;
        v4u o; o.x = pk2(s[0 * 33], s[1 * 33]); o.y = pk2(s[2 * 33], s[3 * 33]); o.z = pk2(s[4 * 33], s[5 * 33]); o.w = pk2(s[6 * 33], s[7 * 33]);
        *(v4u*)(WT + (size_t)(row_off + row_mul * (n0 + n)) * K + k0 + 8 * c) = o; }
    asm volatile("s_waitcnt lgkmcnt(0)" ::: "memory");
}
__device__ __forceinline__ void p0_prologue(Frame& F) {
    if ((int)blockIdx.x < NMOD / 64) p0_mod_task(F, (int)blockIdx.x);
    LAS float* scr = (LAS float*)(F.lds + F.wave * 16384);
    const int gw = F.vcu * NWAVES + F.wave, NGW = F.G * NWAVES;
    constexpr int I_IN = (D / 64) * (NIN / 32), I_SQ = (D / 64) * (D / 32), I_R = (D / 64) * (256 / 32), I_SD = (256 / 64) * (D / 32);
    constexpr int NITEMS = I_IN + 3 * I_SQ + 3 * I_R + I_SD;
    unsigned char* ws = F.ws;
    for (int it = gw; it < NITEMS; it += NGW) {
        int r = it;
        if (r < I_IN) { p0_transpose_item(F.w_in, D, NIN, (bf16*)(ws + WS_WIN), 0, 1, scr, r, F.lane); continue; } r -= I_IN;
        if (r < I_SQ) { p0_transpose_item(F.w_br_ret, D, D, (bf16*)(ws + WS_WBR), 0, 1, scr, r, F.lane); continue; } r -= I_SQ;
        if (r < I_SQ) { p0_transpose_item(F.w_br_conv, D, D, (bf16*)(ws + WS_WBC), 0, 1, scr, r, F.lane); continue; } r -= I_SQ;
        if (r < I_SQ) { p0_transpose_item(F.w_out, D, D, (bf16*)(ws + WS_WO), 0, 1, scr, r, F.lane); continue; } r -= I_SQ;
        if (r < I_R) { p0_transpose_item(F.w_router, D, NE, (bf16*)(ws + WS_WR), 0, 1, scr, r, F.lane); continue; } r -= I_R;
        if (r < I_R) { p0_transpose_item(F.w_sg, D, EH, (bf16*)(ws + WS_WSGU), 0, 2, scr, r, F.lane); continue; } r -= I_R;
        if (r < I_R) { p0_transpose_item(F.w_su, D, EH, (bf16*)(ws + WS_WSGU), 1, 2, scr, r, F.lane); continue; } r -= I_R;
        p0_transpose_item(F.w_sd, EH, D, (bf16*)(ws + WS_WSD), 0, 1, scr, r, F.lane);
    }
    f32x2* rope = (f32x2*)(ws + WS_ROPE);
    for (int idx = F.vcu * NT + F.tid; idx < M * 64; idx += F.G * NT) { const int t = idx >> 6, i = idx & 63;
        const float invf = powf(10000.0f, -(float)i * (1.0f / 64.0f)); const float ang = (float)F.pos[t] * invf;
        const double ad = (double)ang; const double rr = ad - 6.283185307179586 * rint(ad * 0.15915494309189535); const float rf = (float)rr;
        rope[idx] = (f32x2){cosf(rf), sinf(rf)}; }
}

__device__ __forceinline__ void norm_mod_rows(Frame& F, const float* X, const float* gain, int sc_off, int sh_off, bf16* O) {
    const int gw = F.vcu * NWAVES + F.wave, NGW = F.G * NWAVES;
    const float* mod = (const float*)(F.ws + WS_MOD);
    f32x4 g[4];
#pragma unroll
    for (int j = 0; j < 4; ++j) g[j] = *(const f32x4*)(gain + 4 * F.lane + 256 * j);
    for (int m = gw; m < M; m += NGW) {
        const int b = m >> 13; const f32x4* xr = (const f32x4*)(X + (size_t)m * D) + F.lane;
        f32x4 v[4]; float ss = 0.f;
#pragma unroll
        for (int j = 0; j < 4; ++j) { v[j] = xr[64 * j]; ss += (v[j].x * v[j].x + v[j].y * v[j].y) + (v[j].z * v[j].z + v[j].w * v[j].w); }
        const float rstd = 1.0f / sqrtf(wave_sum(ss) * (1.0f / D) + EPS);
        v2u* o8 = (v2u*)(O + (size_t)m * D) + F.lane;
#pragma unroll
        for (int j = 0; j < 4; ++j) { const f32x4 sc = *(const f32x4*)(mod + b * NMOD + sc_off + 4 * F.lane + 256 * j), sh = *(const f32x4*)(mod + b * NMOD + sh_off + 4 * F.lane + 256 * j);
            const f32x4 h = (v[j] * rstd * g[j]) * (1.0f + sc) + sh; v2u w; w.x = pk2(h.x, h.y); w.y = pk2(h.z, h.w); o8[64 * j] = w; }
    }
}

constexpr int KS = 136, KSB = KS * 2;
constexpr int VS = 264, VSB = VS * 2;
__device__ __forceinline__ float log_gamma(int h) { return log1pf(-exp2f(-5.0f - (float)h)); }
__device__ __forceinline__ bf16x8 ldfrag(const LAS unsigned char* img, int row, int rsb, int k) { return *(const LAS bf16x8*)(img + row * rsb + k * 2); }
template <int RS4> __device__ __forceinline__ bf16x8 tr_frag(unsigned addr) {
    s16x4 lo, hi;
    asm volatile("ds_read_b64_tr_b16 %0, %2\n\tds_read_b64_tr_b16 %1, %2 offset:%3\n\ts_waitcnt lgkmcnt(0)" : "=&v"(lo), "=&v"(hi) : "v"(addr), "i"(RS4) : "memory");
    return __builtin_shufflevector(lo, hi, 0, 1, 2, 3, 4, 5, 6, 7);
}
template <int RS4, int STEP> __device__ __forceinline__ void tr_frag4(unsigned addr, bf16x8& f0, bf16x8& f1, bf16x8& f2, bf16x8& f3) {
    s16x4 l0, h0, l1, h1, l2, h2, l3, h3;
    asm volatile("ds_read_b64_tr_b16 %0, %8\n\tds_read_b64_tr_b16 %1, %8 offset:%9\n\t"
                 "ds_read_b64_tr_b16 %2, %8 offset:%10\n\tds_read_b64_tr_b16 %3, %8 offset:%11\n\t"
                 "ds_read_b64_tr_b16 %4, %8 offset:%12\n\tds_read_b64_tr_b16 %5, %8 offset:%13\n\t"
                 "ds_read_b64_tr_b16 %6, %8 offset:%14\n\tds_read_b64_tr_b16 %7, %8 offset:%15\n\ts_waitcnt lgkmcnt(0)"
                 : "=&v"(l0), "=&v"(h0), "=&v"(l1), "=&v"(h1), "=&v"(l2), "=&v"(h2), "=&v"(l3), "=&v"(h3)
                 : "v"(addr), "i"(RS4), "i"(STEP), "i"(STEP + RS4), "i"(2 * STEP), "i"(2 * STEP + RS4), "i"(3 * STEP), "i"(3 * STEP + RS4) : "memory");
    f0 = __builtin_shufflevector(l0, h0, 0, 1, 2, 3, 4, 5, 6, 7); f1 = __builtin_shufflevector(l1, h1, 0, 1, 2, 3, 4, 5, 6, 7);
    f2 = __builtin_shufflevector(l2, h2, 0, 1, 2, 3, 4, 5, 6, 7); f3 = __builtin_shufflevector(l3, h3, 0, 1, 2, 3, 4, 5, 6, 7);
}
#define MFMA16(a, b, c) __builtin_amdgcn_mfma_f32_16x16x32_bf16((a), (b), (c), 0, 0, 0)

template <bool DECAY> __device__ __forceinline__ void stage_rope(Frame& F, LAS unsigned char* img, const bf16* src, const f32x2* rope, float s_const, float lg) {
#pragma unroll
    for (int i = 0; i < 4; ++i) { const int task = F.tid + NT * i, c = task >> 4, g = task & 15;
        const v2u lo = *(const v2u*)(src + (size_t)c * NIN + 4 * g), hi = *(const v2u*)(src + (size_t)c * NIN + 64 + 4 * g);
        const f32x4 r01 = *(const f32x4*)(rope + c * 64 + 4 * g), r23 = *(const f32x4*)(rope + c * 64 + 4 * g + 2);
        const float sc = DECAY ? s_const * __expf(lg * (float)(127 - c)) : s_const;
        const float x1[4] = {bflo(lo.x), bfhi(lo.x), bflo(lo.y), bfhi(lo.y)}, x2[4] = {bflo(hi.x), bfhi(hi.x), bflo(hi.y), bfhi(hi.y)};
        const float cs[4] = {r01.x, r01.z, r23.x, r23.z}, sn[4] = {r01.y, r01.w, r23.y, r23.w};
        float y1[4], y2[4];
#pragma unroll
        for (int j = 0; j < 4; ++j) { y1[j] = (x1[j] * cs[j] - x2[j] * sn[j]) * sc; y2[j] = (x2[j] * cs[j] + x1[j] * sn[j]) * sc; }
        v2u w1, w2; w1.x = pk2(y1[0], y1[1]); w1.y = pk2(y1[2], y1[3]); w2.x = pk2(y2[0], y2[1]); w2.y = pk2(y2[2], y2[3]);
        *(LAS v2u*)(img + c * KSB + 8 * g) = w1; *(LAS v2u*)(img + c * KSB + 128 + 8 * g) = w2; }
}
__device__ __forceinline__ void stage_v(Frame& F, LAS unsigned char* img, const bf16* src) {
#pragma unroll
    for (int i = 0; i < 8; ++i) { const int task = F.tid + NT * i, c = task >> 5, g = task & 31;
        *(LAS v4u*)(img + c * VSB + 16 * g) = *(const v4u*)(src + (size_t)c * NIN + 8 * g); }
}

__device__ __forceinline__ void p3_kv_conv(Frame& F) {
    unsigned char* ws = F.ws; const bf16* PROJ = (const bf16*)(ws + WS_PROJ); const f32x2* ROPE = (const f32x2*)(ws + WS_ROPE); bf16* KV = (bf16*)(ws + WS_KV);
    LAS unsigned char* Kimg = F.lds; LAS unsigned char* Vimg = F.lds + 34816;
    const int w = F.wave, lane = F.lane, g = lane >> 4, q = (lane & 15) >> 2, p = lane & 3;
    for (int it = (int)blockIdx.x; it < BATCH * NH * NCH; it += F.G) {
        const int n = it & 63, h = (it >> 6) & 3, b = it >> 8; const int t0 = b * SEQ + n * CH; const float lg = log_gamma(h);
        stage_rope<true>(F, Kimg, PROJ + (size_t)t0 * NIN + OFF_K + h * DK, ROPE + (size_t)t0 * 64, 1.0f, lg);
        stage_v(F, Vimg, PROJ + (size_t)t0 * NIN + OFF_V + h * DV);
        __syncthreads();
        f32x4 acc[16];
#pragma unroll
        for (int i = 0; i < 16; ++i) acc[i] = (f32x4){0.f, 0.f, 0.f, 0.f};
        const unsigned ka = F.ldsb + (unsigned)((8 * g + q) * KSB + (16 * w + 4 * p) * 2);
        const unsigned va = F.ldsb + 34816u + (unsigned)((8 * g + q) * VSB + (4 * p) * 2);
#pragma unroll
        for (int ks = 0; ks < 4; ++ks) {
            const bf16x8 a = tr_frag<4 * KSB>(ka + ks * 32 * KSB);
#pragma unroll
            for (int nt = 0; nt < 16; nt += 4) { bf16x8 b0, b1, b2, b3; tr_frag4<4 * VSB, 32>(va + ks * 32 * VSB + nt * 32, b0, b1, b2, b3);
                acc[nt] = MFMA16(a, b0, acc[nt]); acc[nt + 1] = MFMA16(a, b1, acc[nt + 1]); acc[nt + 2] = MFMA16(a, b2, acc[nt + 2]); acc[nt + 3] = MFMA16(a, b3, acc[nt + 3]); }
        }
        bf16* kvp = KV + (size_t)it * (DV * DK) + (size_t)(lane & 15) * DK + 16 * w + 4 * g;
#pragma unroll
        for (int nt = 0; nt < 16; ++nt) { v2u wv; wv.x = pk2(acc[nt][0], acc[nt][1]); wv.y = pk2(acc[nt][2], acc[nt][3]); *(v2u*)(kvp + (size_t)(16 * nt) * DK) = wv; }
        __syncthreads();
    }
    bf16* CONVG = (bf16*)(ws + WS_CONVG);
    const int gw = F.vcu * NWAVES + F.wave, NGW = F.G * NWAVES;
    for (int m = gw; m < M; m += NGW) { const int s = m & (SEQ - 1);
#pragma unroll
        for (int j = 0; j < 4; ++j) { const int ch = 4 * lane + 256 * j; const bf16* rp = PROJ + (size_t)m * NIN + ch;
            const f32x4 w0 = *(const f32x4*)(F.conv_w + ch), w1 = *(const f32x4*)(F.conv_w + D + ch), w2 = *(const f32x4*)(F.conv_w + 2 * D + ch);
            const v2u u0 = *(const v2u*)(rp + OFF_U), c0 = *(const v2u*)(rp + OFF_GC), gb = *(const v2u*)(rp + OFF_GB);
            v2u u1 = {0u, 0u}, c1 = {0u, 0u}, u2 = {0u, 0u}, c2 = {0u, 0u};
            if (s >= 1) { u1 = *(const v2u*)(rp - NIN + OFF_U); c1 = *(const v2u*)(rp - NIN + OFF_GC); }
            if (s >= 2) { u2 = *(const v2u*)(rp - 2 * NIN + OFF_U); c2 = *(const v2u*)(rp - 2 * NIN + OFF_GC); }
            f32x4 cu0 = {bflo(u0.x) * bflo(c0.x), bfhi(u0.x) * bfhi(c0.x), bflo(u0.y) * bflo(c0.y), bfhi(u0.y) * bfhi(c0.y)};
            f32x4 cu1 = {bflo(u1.x) * bflo(c1.x), bfhi(u1.x) * bfhi(c1.x), bflo(u1.y) * bflo(c1.y), bfhi(u1.y) * bfhi(c1.y)};
            f32x4 cu2 = {bflo(u2.x) * bflo(c2.x), bfhi(u2.x) * bfhi(c2.x), bflo(u2.y) * bflo(c2.y), bfhi(u2.y) * bfhi(c2.y)};
            const f32x4 gbf = {bflo(gb.x), bfhi(gb.x), bflo(gb.y), bfhi(gb.y)};
            const f32x4 o = gbf * (w0 * cu2 + w1 * cu1 + w2 * cu0);
            v2u wv; wv.x = pk2(o.x, o.y); wv.y = pk2(o.z, o.w); *(v2u*)(CONVG + (size_t)m * D + ch) = wv; }
    }
}

__device__ __forceinline__ void p4_scan(Frame& F) {
    const unsigned* KV = (const unsigned*)(F.ws + WS_KV); unsigned* SP = (unsigned*)(F.ws + WS_SP);
    for (int gid = F.vcu * NT + F.tid; gid < BATCH * NH * (DV * DK / 2); gid += F.G * NT) {
        const int bh = gid >> 14, e2 = gid & 16383, h = bh & 3; const float dec = __expf(log_gamma(h) * 128.0f);
        f32x2 S = {0.f, 0.f};
        const unsigned* kp = KV + (size_t)bh * NCH * 16384 + e2; unsigned* sp = SP + (size_t)bh * NCH * 16384 + e2;
#pragma unroll 8
        for (int n = 0; n < NCH; ++n) { const unsigned kw = kp[(size_t)n * 16384]; const f32x2 kv = {bflo(kw), bfhi(kw)}; sp[(size_t)n * 16384] = pk2(S.x, S.y); S = S * dec + kv; }
    }
}

__device__ __forceinline__ void p5_retention(Frame& F) {
    unsigned char* ws = F.ws; const bf16* PROJ = (const bf16*)(ws + WS_PROJ); const f32x2* ROPE = (const f32x2*)(ws + WS_ROPE); const bf16* SP = (const bf16*)(ws + WS_SP);
    bf16* RETG = (bf16*)(ws + WS_RETG);
    LAS unsigned char* Qimg = F.lds; LAS unsigned char* Kimg = F.lds + 34816; LAS unsigned char* Bimg = F.lds + 69632;
    const int w = F.wave, lane = F.lane, g = lane >> 4, q = (lane & 15) >> 2, p = lane & 3, fr = lane & 15;
    for (int it = (int)blockIdx.x; it < BATCH * NH * NCH; it += F.G) {
        const int n = it & 63, h = (it >> 6) & 3, b = it >> 8; const int t0 = b * SEQ + n * CH; const float lg = log_gamma(h);
        stage_rope<false>(F, Qimg, PROJ + (size_t)t0 * NIN + OFF_Q + h * DK, ROPE + (size_t)t0 * 64, 0.08838834764831845f, 0.f);
        stage_rope<false>(F, Kimg, PROJ + (size_t)t0 * NIN + OFF_K + h * DK, ROPE + (size_t)t0 * 64, 1.0f, 0.f);
        { const bf16* sp = SP + (size_t)it * (DV * DK);
#pragma unroll
          for (int i = 0; i < 8; ++i) { const int task = F.tid + NT * i, r = task >> 4, c16 = task & 15; *(LAS v4u*)(Bimg + r * KSB + 16 * c16) = *(const v4u*)(sp + r * DK + 8 * c16); } }
        __syncthreads();
        f32x4 acc[16];
#pragma unroll
        for (int i = 0; i < 16; ++i) acc[i] = (f32x4){0.f, 0.f, 0.f, 0.f};
        f32x4 sc[8];
#pragma unroll
        for (int i = 0; i < 8; ++i) sc[i] = (f32x4){0.f, 0.f, 0.f, 0.f};
#pragma unroll 1
        for (int ks = 0; ks < 4; ++ks) {
            const bf16x8 qf = ldfrag(Qimg, 16 * w + fr, KSB, 32 * ks + 8 * g);
#pragma unroll
            for (int nt = 0; nt < 16; ++nt) { const bf16x8 sf = ldfrag(Bimg, 16 * nt + fr, KSB, 32 * ks + 8 * g); acc[nt] = MFMA16(sf, qf, acc[nt]); }
#pragma unroll
            for (int jt = 0; jt < 8; ++jt) { const bf16x8 kf = ldfrag(Kimg, 16 * jt + fr, KSB, 32 * ks + 8 * g); sc[jt] = MFMA16(kf, qf, sc[jt]); }
        }
        const int irow = 16 * w + fr;
        { const float cd = __expf(lg * (float)(irow + 1));
#pragma unroll
          for (int nt = 0; nt < 16; ++nt) acc[nt] = acc[nt] * cd; }
        __syncthreads();
#pragma unroll
        for (int jt = 0; jt < 8; ++jt) { float pv[4];
#pragma unroll
            for (int r = 0; r < 4; ++r) { const int j = 16 * jt + 4 * g + r; pv[r] = (irow >= j) ? sc[jt][r] * __expf(lg * (float)(irow - j)) : 0.f; }
            v2u wv; wv.x = pk2(pv[0], pv[1]); wv.y = pk2(pv[2], pv[3]); *(LAS v2u*)(Kimg + irow * KSB + (16 * jt + 4 * g) * 2) = wv; }
        stage_v(F, Bimg, PROJ + (size_t)t0 * NIN + OFF_V + h * DV);
        __syncthreads();
        const unsigned va = F.ldsb + 69632u + (unsigned)((8 * g + q) * VSB + (4 * p) * 2);
#pragma unroll 1
        for (int ks = 0; ks < 4; ++ks) {
            const bf16x8 pf = ldfrag(Kimg, 16 * w + fr, KSB, 32 * ks + 8 * g);
#pragma unroll
            for (int nt = 0; nt < 16; nt += 4) { bf16x8 v0, v1, v2, v3; tr_frag4<4 * VSB, 32>(va + ks * 32 * VSB + nt * 32, v0, v1, v2, v3);
                acc[nt] = MFMA16(v0, pf, acc[nt]); acc[nt + 1] = MFMA16(v1, pf, acc[nt + 1]); acc[nt + 2] = MFMA16(v2, pf, acc[nt + 2]); acc[nt + 3] = MFMA16(v3, pf, acc[nt + 3]); }
        }
        float ss = 0.f;
#pragma unroll
        for (int nt = 0; nt < 16; ++nt) ss += (acc[nt][0] * acc[nt][0] + acc[nt][1] * acc[nt][1]) + (acc[nt][2] * acc[nt][2] + acc[nt][3] * acc[nt][3]);
        ss += __shfl_xor(ss, 16); ss += __shfl_xor(ss, 32);
        const float rstd = 1.0f / sqrtf(ss * (1.0f / DV) + EPS);
        const size_t trow = (size_t)(t0 + irow);
#pragma unroll
        for (int nt = 0; nt < 16; ++nt) { const int dv = 16 * nt + 4 * g; const f32x4 gn = *(const f32x4*)(F.ret_norm_g + h * DV + dv);
            const v2u gr = *(const v2u*)(PROJ + trow * NIN + OFF_GR + h * DV + dv);
            const f32x4 o = acc[nt] * rstd * gn * (f32x4){siluf_(bflo(gr.x)), siluf_(bfhi(gr.x)), siluf_(bflo(gr.y)), siluf_(bfhi(gr.y))};
            v2u wv; wv.x = pk2(o[0], o[1]); wv.y = pk2(o[2], o[3]); *(v2u*)(RETG + trow * D + h * DV + dv) = wv; }
        __syncthreads();
    }
}

__device__ __forceinline__ unsigned f32_key(float x) { const unsigned u = __float_as_uint(x); return (u & 0x80000000u) ? ~u : (u | 0x80000000u); }
template <bool DRY> __device__ __forceinline__ void route_tokens(Frame& F) {
    unsigned char* ws = F.ws; const float* LOGITS = (const float*)(ws + WS_LOGITS);
    int* EIDX = (int*)(ws + WS_EIDX); int* POS = (int*)(ws + WS_POS); int* LTOK = (int*)(ws + WS_LTOK); float* LW = (float*)(ws + WS_LW);
    unsigned* cnt = (unsigned*)(F.ctl + CW_CNT);
    const int gw = F.vcu * NWAVES + F.wave, NGW = F.G * NWAVES, lane = F.lane;
    const f32x4 bias = *(const f32x4*)(F.router_bias + 4 * lane);
    for (int t0 = 2 * gw; t0 < M; t0 += 2 * NGW) {
        float sc[2][4]; unsigned key[2][4];
#pragma unroll
        for (int u = 0; u < 2; ++u) {
            const f32x4 lgv = *(const f32x4*)(LOGITS + (size_t)(t0 + u) * NE + 4 * lane);
            sc[u][0] = 1.0f / (1.0f + __expf(-lgv.x)); sc[u][1] = 1.0f / (1.0f + __expf(-lgv.y)); sc[u][2] = 1.0f / (1.0f + __expf(-lgv.z)); sc[u][3] = 1.0f / (1.0f + __expf(-lgv.w));
            const float c0 = sc[u][0] + bias.x, c1 = sc[u][1] + bias.y, c2 = sc[u][2] + bias.z, c3 = sc[u][3] + bias.w;
            const float a = fmaxf(c0, c1), bq = fminf(c0, c1), cc = fmaxf(c2, c3), dd = fminf(c2, c3);
            float m1 = fmaxf(a, cc), m2 = fmaxf(fminf(a, cc), fmaxf(bq, dd));
#pragma unroll
            for (int o = 1; o < 8; o <<= 1) { const float o1 = __shfl_xor(m1, o), o2 = __shfl_xor(m2, o); const float n1 = fmaxf(m1, o1), n2 = fmaxf(fminf(m1, o1), fmaxf(m2, o2)); m1 = n1; m2 = n2; }
            const float gs = m1 + m2; const int myg = lane >> 3; int rank = 0;
#pragma unroll
            for (int g2 = 0; g2 < 8; ++g2) { const float sg = __uint_as_float((unsigned)__builtin_amdgcn_readlane((int)__float_as_uint(gs), g2 * 8)); rank += (sg > gs || (sg == gs && g2 < myg)) ? 1 : 0; }
            const bool gsel = rank < 4;
            key[u][0] = gsel ? f32_key(c0) : 0u; key[u][1] = gsel ? f32_key(c1) : 0u; key[u][2] = gsel ? f32_key(c2) : 0u; key[u][3] = gsel ? f32_key(c3) : 0u;
        }
        unsigned th0 = 0u, th1 = 0u;
#pragma unroll 4
        for (int bit = 31; bit >= 0; --bit) {
            const unsigned ca = th0 | (1u << bit), cb = th1 | (1u << bit);
            const int na = __popcll(__ballot(key[0][0] >= ca)) + __popcll(__ballot(key[0][1] >= ca)) + __popcll(__ballot(key[0][2] >= ca)) + __popcll(__ballot(key[0][3] >= ca));
            const int nb = __popcll(__ballot(key[1][0] >= cb)) + __popcll(__ballot(key[1][1] >= cb)) + __popcll(__ballot(key[1][2] >= cb)) + __popcll(__ballot(key[1][3] >= cb));
            th0 = na >= 8 ? ca : th0; th1 = nb >= 8 ? cb : th1;
        }
        unsigned pa[2][4]; int ra[2][4]; float inva[2];
#pragma unroll
        for (int u = 0; u < 2; ++u) { const unsigned th = u ? th1 : th0;
            const bool s0 = key[u][0] >= th, s1 = key[u][1] >= th, s2 = key[u][2] >= th, s3 = key[u][3] >= th;
            const unsigned long long b0 = __ballot(s0), b1 = __ballot(s1), b2 = __ballot(s2), b3 = __ballot(s3);
            const unsigned long long lt = (1ull << lane) - 1ull;
            const int base = __popcll(b0 & lt) + __popcll(b1 & lt) + __popcll(b2 & lt) + __popcll(b3 & lt);
            const int r0 = base, r1 = r0 + (s0 ? 1 : 0), r2 = r1 + (s1 ? 1 : 0), r3 = r2 + (s2 ? 1 : 0);
            const float part = (s0 ? sc[u][0] : 0.f) + (s1 ? sc[u][1] : 0.f) + (s2 ? sc[u][2] : 0.f) + (s3 ? sc[u][3] : 0.f);
            const float inv = 2.5f / wave_sum(part);
            const bool a0 = s0 && r0 < 8, a1 = s1 && r1 < 8, a2 = s2 && r2 < 8, a3 = s3 && r3 < 8; const int e0 = 4 * lane;
            unsigned p0 = 0u, p1 = 0u, p2 = 0u, p3 = 0u;
            if (DRY) { if (a0) p0 = __hip_atomic_load(cnt + 64 * e0, RLX_AGENT); if (a1) p1 = __hip_atomic_load(cnt + 64 * (e0 + 1), RLX_AGENT); if (a2) p2 = __hip_atomic_load(cnt + 64 * (e0 + 2), RLX_AGENT); if (a3) p3 = __hip_atomic_load(cnt + 64 * (e0 + 3), RLX_AGENT); } else {
            if (a0) p0 = __hip_atomic_fetch_add(cnt + 64 * e0, 1u, RLX_AGENT);
            if (a1) p1 = __hip_atomic_fetch_add(cnt + 64 * (e0 + 1), 1u, RLX_AGENT);
            if (a2) p2 = __hip_atomic_fetch_add(cnt + 64 * (e0 + 2), 1u, RLX_AGENT);
            if (a3) p3 = __hip_atomic_fetch_add(cnt + 64 * (e0 + 3), 1u, RLX_AGENT); }
            pa[u][0] = p0; pa[u][1] = p1; pa[u][2] = p2; pa[u][3] = p3; ra[u][0] = a0 ? r0 : -1; ra[u][1] = a1 ? r1 : -1; ra[u][2] = a2 ? r2 : -1; ra[u][3] = a3 ? r3 : -1; inva[u] = inv;
        }
#pragma unroll
        for (int u = 0; u < 2; ++u) { const int t = t0 + u;
#pragma unroll
            for (int j = 0; j < 4; ++j) if (ra[u][j] >= 0) { const int e = 4 * lane + j; const unsigned ps = DRY ? (unsigned)(CAP - 1 - (t & 1023)) : pa[u][j]; if (DRY && pa[u][j] == 0xffffffffu) continue;
                LTOK[(size_t)e * CAP + ps] = t; LW[(size_t)e * CAP + ps] = sc[u][j] * inva[u]; EIDX[t * 8 + ra[u][j]] = e; POS[t * 8 + ra[u][j]] = (int)ps; }
        }
    }
}

__device__ __forceinline__ void expert_prefix(Frame& F, LAS int* pref, LAS int* off) {
    if (F.wave == 0) { const unsigned* cnt = (const unsigned*)(F.ctl + CW_CNT); const int lane = F.lane;
        int c[4], nb[4]; int tc = 0, tb = 0;
#pragma unroll
        for (int j = 0; j < 4; ++j) { c[j] = (int)__hip_atomic_load(cnt + 64 * (4 * lane + j), RLX_AGENT); nb[j] = (c[j] + 127) >> 7; tc += c[j]; tb += nb[j]; }
        int xc = tc, xb = tb;
#pragma unroll
        for (int o = 1; o < 64; o <<= 1) { const int vc = __shfl_up(xc, o), vb = __shfl_up(xb, o); if (lane >= o) { xc += vc; xb += vb; } }
        int ec = xc - tc, eb = xb - tb;
#pragma unroll
        for (int j = 0; j < 4; ++j) { off[4 * lane + j] = ec; pref[4 * lane + j] = eb; ec += c[j]; eb += nb[j]; }
        if (lane == 63) { off[256] = ec; pref[256] = eb; } }
}

constexpr int EX_PREF = 0, EX_OFF = 1040, EX_TOK = 2176, EX_W = 2688, EX_BUF = 3200, EX_BUFSZ = 27648, EX_BOFF = 10240, EX_G = EX_BUF + 2 * EX_BUFSZ;
constexpr int ASB = 80, EXD = 4, EXNC = 96;
static_assert(EX_G + 128 * VSB <= LDSCTL_OFF, "expert LDS map");
template <int RS4, int STEP> __device__ __forceinline__ void tr_frag2(unsigned addr, bf16x8& f0, bf16x8& f1) {
    s16x4 l0, h0, l1, h1;
    asm volatile("ds_read_b64_tr_b16 %0, %4\n\tds_read_b64_tr_b16 %1, %4 offset:%5\n\tds_read_b64_tr_b16 %2, %4 offset:%6\n\tds_read_b64_tr_b16 %3, %4 offset:%7\n\ts_waitcnt lgkmcnt(0)"
                 : "=&v"(l0), "=&v"(h0), "=&v"(l1), "=&v"(h1) : "v"(addr), "i"(RS4), "i"(STEP), "i"(STEP + RS4) : "memory");
    f0 = __builtin_shufflevector(l0, h0, 0, 1, 2, 3, 4, 5, 6, 7); f1 = __builtin_shufflevector(l1, h1, 0, 1, 2, 3, 4, 5, 6, 7);
}
struct ExSet { f32x4 w[4]; v4u a; };
constexpr int PF_OFF = 140288;
__device__ __forceinline__ void pf_dma(const void* gsrc, unsigned lds_dst) {
    unsigned keep;
    asm volatile("s_mov_b32 %0, m0\n\ts_mov_b32 m0, %2\n\ts_nop 0\n\tglobal_load_lds_dword %1, off\n\ts_mov_b32 m0, %0" : "=&s"(keep) : "v"(gsrc), "s"(lds_dst) : "memory");
}
template <int ABL> __device__ __forceinline__ void p11_experts(Frame& F) {
    unsigned char* ws = F.ws; const bf16* H2 = (const bf16*)(ws + WS_HB); const int* LTOK = (const int*)(ws + WS_LTOK); const float* LW = (const float*)(ws + WS_LW); bf16* YP = (bf16*)(ws + WS_YP);
    LAS int* pref = (LAS int*)(F.lds + EX_PREF); LAS int* off = (LAS int*)(F.lds + EX_OFF); LAS int* tokl = (LAS int*)(F.lds + EX_TOK); LAS float* wl = (LAS float*)(F.lds + EX_W);
    LAS unsigned char* Gimg = F.lds + EX_G;
    const int tid = F.tid, w = F.wave, wr = w >> 2, wc = w & 3;
    const unsigned pfl = F.ldsb + PF_OFF + (unsigned)w * 256u;
    expert_prefix(F, pref, off);
    __syncthreads();
    const int nitems = pref[256];
    for (int it = F.vcu; it < nitems; it += F.G) {
        int e = 0;
#pragma unroll
        for (int s = 128; s >= 1; s >>= 1) if (pref[e + s] <= it) e += s;
        e = __builtin_amdgcn_readfirstlane(e);
        const int rb = __builtin_amdgcn_readfirstlane(it - pref[e]), cnt_e = __builtin_amdgcn_readfirstlane(off[e + 1] - off[e]), r0 = rb * 128, slot0 = __builtin_amdgcn_readfirstlane(off[e]) + r0;
        if (tid < 128) { const int idx = r0 + tid; const bool ok = idx < cnt_e; tokl[tid] = LTOK[(size_t)e * CAP + (ok ? idx : r0)]; wl[tid] = ok ? LW[(size_t)e * CAP + idx] : 0.f; }
        __syncthreads();
        const float* Wg = F.w_eg + (size_t)e * D * EH; const float* Wu = F.w_eu + (size_t)e * D * EH; const float* Wd = F.w_ed + (size_t)e * EH * D;
        const bf16* asrc = H2 + (size_t)tokl[tid >> 2] * D + (tid & 3) * 8;
        int gs_lo, gs_n; { const int xs = (it / F.G) * F.G + (F.vcu & ~31); int lo = pref[e], hi = pref[e + 1]; lo = lo > xs ? lo : xs; hi = hi < xs + 32 ? hi : xs + 32; hi = hi < nitems ? hi : nitems;
            gs_lo = __builtin_amdgcn_readfirstlane(lo); gs_n = __builtin_amdgcn_readfirstlane(hi - lo); }
        unsigned gs_k = 0u;
#define EX_GSYNC() do { if (MK_GSYNC && gs_n > 1) { ++gs_k; if (tid == 0) { unsigned* cw = (unsigned*)(F.ctl + CW_GS) + 64 * gs_lo; __hip_atomic_fetch_add(cw, 1u, RLX_AGENT);               \
                const unsigned long long t0_ = __builtin_amdgcn_s_memrealtime(); const unsigned want = (unsigned)gs_n * gs_k;                                                                 \
                while (__hip_atomic_load(cw, RLX_AGENT) < want) { if (__builtin_amdgcn_s_memrealtime() - t0_ > 20000ull) break; __builtin_amdgcn_s_sleep(2); } }                            \
            __syncthreads(); } } while (0)
        EX_GSYNC();
        if (MK_GSTAG > 0 && gs_n > 1) { const unsigned long long t0_ = __builtin_amdgcn_s_memrealtime(); const unsigned long long d_ = (unsigned long long)(MK_GSTAG * (it - gs_lo)); while (__builtin_amdgcn_s_memrealtime() - t0_ < d_) __builtin_amdgcn_s_sleep(1); }
        f32x4 acc[4][4];
#define EX_ZERO() do { _Pragma("unroll") for (int i = 0; i < 4; ++i) _Pragma("unroll") for (int j = 0; j < 4; ++j) acc[i][j] = (f32x4){0.f, 0.f, 0.f, 0.f}; } while (0)
        EX_ZERO();
        ExSet S0, S1, S2, S3;
        if (ABL & 16) { _Pragma("unroll") for (int i = 0; i < 4; ++i) { S0.w[i] = S1.w[i] = S2.w[i] = S3.w[i] = (f32x4){1.f, 1.f, 1.f, 1.f}; } S0.a = S1.a = S2.a = S3.a = (v4u){0u, 0u, 0u, 0u}; }
#define EX_L1(S, CC) do { if (ABL & 16) break; const int cc_ = (CC) & 63, hp_ = cc_ >> 5, kc_ = cc_ & 31; int tl = tid; asm volatile("" : "+v"(tl));                         \
            unsigned o = (unsigned)((32 * kc_ + (tl >> 5)) * EH + 128 * hp_ + 4 * (tl & 31));                                                            \
            S.w[0] = *(const f32x4*)(Wg + o); S.w[1] = *(const f32x4*)(Wg + o + 16 * EH); S.w[2] = *(const f32x4*)(Wu + o); S.w[3] = *(const f32x4*)(Wu + o + 16 * EH); \
            S.a = *(const v4u*)(asrc + 32 * kc_); } while (0)
#define EX_PF1(CC) do { if (MK_PFD > 0) { const int cc_ = (CC) & 63, hp_ = cc_ >> 5, kc_ = cc_ & 31; int tl = tid; asm volatile("" : "+v"(tl)); const int ln_ = tl & 63;   \
            if (w < 4) { const float* wm_ = (w & 2) ? Wu : Wg; pf_dma(wm_ + (size_t)(32 * kc_ + (w & 1) * 16 + (ln_ >> 2)) * EH + 128 * hp_ + 32 * (ln_ & 3), pfl); }              \
            else if (w < 6) { pf_dma(H2 + (size_t)tokl[(w - 4) * 64 + ln_] * D + 32 * kc_, pfl); } } } while (0)
#define EX_W1(S, BUF) do { if (ABL & 2) { asm volatile("" :: "v"(S.w[0]), "v"(S.w[1]), "v"(S.w[2]), "v"(S.w[3]), "v"(S.a)); break; } int tl = tid; asm volatile("" : "+v"(tl)); LAS unsigned char* b_ = (BUF) + EX_BOFF + (tl >> 5) * KSB + 8 * (tl & 31); v2u p_[4];  \
            _Pragma("unroll") for (int i = 0; i < 4; ++i) { p_[i].x = pk2(S.w[i].x, S.w[i].y); p_[i].y = pk2(S.w[i].z, S.w[i].w); }                        \
            *(LAS v2u*)b_ = p_[0]; *(LAS v2u*)(b_ + 16 * KSB) = p_[1]; *(LAS v2u*)(b_ + 32 * KSB) = p_[2]; *(LAS v2u*)(b_ + 48 * KSB) = p_[3];             \
            *(LAS v4u*)((BUF) + (tl >> 2) * ASB + (tl & 3) * 16) = S.a; } while (0)
#define EX_C1(C) do { if (ABL & 1) break; int tl = tid; asm volatile("" : "+v"(tl)); const int g = (tl >> 4) & 3, fr = tl & 15, q = (tl & 15) >> 2, p = tl & 3;              \
            LAS unsigned char* buf = F.lds + EX_BUF + ((C) & 1) * EX_BUFSZ; const unsigned ta = F.ldsb + EX_BUF + (unsigned)(((C) & 1) * EX_BUFSZ + EX_BOFF + (8 * g + q) * KSB + (32 * wc + 4 * p) * 2); \
            bf16x8 af[4]; _Pragma("unroll") for (int rt = 0; rt < 4; ++rt) af[rt] = ldfrag(buf, 64 * wr + 16 * rt + fr, ASB, 8 * g);                     \
            bf16x8 b0, b1, b2, b3; tr_frag2<4 * KSB, 32>(ta, b0, b1); tr_frag2<4 * KSB, 32>(ta + 32 * KSB, b2, b3);                                       \
            _Pragma("unroll") for (int rt = 0; rt < 4; ++rt) { acc[rt][0] = MFMA16(b0, af[rt], acc[rt][0]); acc[rt][1] = MFMA16(b1, af[rt], acc[rt][1]); acc[rt][2] = MFMA16(b2, af[rt], acc[rt][2]); acc[rt][3] = MFMA16(b3, af[rt], acc[rt][3]); } } while (0)
#define EX_C1S(SL, C) do { int tl = tid; asm volatile("" : "+v"(tl)); const int g = (tl >> 4) & 3, fr = tl & 15, q = (tl & 15) >> 2, p = tl & 3;      \
            const int cc_ = ((C) + 4) & 63, hp_ = cc_ >> 5, kc_ = cc_ & 31; const unsigned o = (unsigned)((32 * kc_ + (tl >> 5)) * EH + 128 * hp_ + 4 * (tl & 31));        \
            LAS unsigned char* buf = F.lds + EX_BUF + ((C) & 1) * EX_BUFSZ; const unsigned ta = F.ldsb + EX_BUF + (unsigned)(((C) & 1) * EX_BUFSZ + EX_BOFF + (8 * g + q) * KSB + (32 * wc + 4 * p) * 2); \
            bf16x8 af[4]; _Pragma("unroll") for (int rt = 0; rt < 4; ++rt) af[rt] = ldfrag(buf, 64 * wr + 16 * rt + fr, ASB, 8 * g);                     \
            bf16x8 b0, b1, b2, b3; tr_frag2<4 * KSB, 32>(ta, b0, b1); tr_frag2<4 * KSB, 32>(ta + 32 * KSB, b2, b3);                                       \
            __builtin_amdgcn_sched_barrier(0); SL.w[0] = *(const f32x4*)(Wg + o); __builtin_amdgcn_sched_barrier(0);                                       \
            acc[0][0] = MFMA16(b0, af[0], acc[0][0]); acc[0][1] = MFMA16(b1, af[0], acc[0][1]); acc[0][2] = MFMA16(b2, af[0], acc[0][2]); acc[0][3] = MFMA16(b3, af[0], acc[0][3]); \
            __builtin_amdgcn_sched_barrier(0); SL.w[1] = *(const f32x4*)(Wg + o + 16 * EH); __builtin_amdgcn_sched_barrier(0);                             \
            acc[1][0] = MFMA16(b0, af[1], acc[1][0]); acc[1][1] = MFMA16(b1, af[1], acc[1][1]); acc[1][2] = MFMA16(b2, af[1], acc[1][2]); acc[1][3] = MFMA16(b3, af[1], acc[1][3]); \
            __builtin_amdgcn_sched_barrier(0); SL.w[2] = *(const f32x4*)(Wu + o); __builtin_amdgcn_sched_barrier(0);                                       \
            acc[2][0] = MFMA16(b0, af[2], acc[2][0]); acc[2][1] = MFMA16(b1, af[2], acc[2][1]); acc[2][2] = MFMA16(b2, af[2], acc[2][2]); acc[2][3] = MFMA16(b3, af[2], acc[2][3]); \
            __builtin_amdgcn_sched_barrier(0); SL.w[3] = *(const f32x4*)(Wu + o + 16 * EH); SL.a = *(const v4u*)(asrc + 32 * kc_); __builtin_amdgcn_sched_barrier(0);   \
            acc[3][0] = MFMA16(b0, af[3], acc[3][0]); acc[3][1] = MFMA16(b1, af[3], acc[3][1]); acc[3][2] = MFMA16(b2, af[3], acc[3][2]); acc[3][3] = MFMA16(b3, af[3], acc[3][3]); } while (0)
#define EX_STEP1(SL, SW, C) do { if (MK_SPREAD) { EX_C1S(SL, C); EX_W1(SW, F.lds + EX_BUF + (((C) + 1) & 1) * EX_BUFSZ); __syncthreads(); break; } if (!MK_LATE_ISSUE) { EX_L1(SL, (C) + 4); } EX_C1(C); EX_W1(SW, F.lds + EX_BUF + (((C) + 1) & 1) * EX_BUFSZ); if (MK_LATE_ISSUE) { EX_L1(SL, (C) + 4); } __syncthreads(); } while (0)
        EX_L1(S0, 0); EX_L1(S1, 1); EX_L1(S2, 2); EX_L1(S3, 3);
        EX_W1(S0, F.lds + EX_BUF);
        __syncthreads();
#pragma unroll 1
        for (int c4 = 0; c4 < 64; c4 += 4) {
            if (MK_GSYNC_EVERY > 0 && (c4 & (MK_GSYNC_EVERY - 1)) == 0 && c4) EX_GSYNC();
            EX_STEP1(S0, S1, c4); EX_STEP1(S1, S2, c4 + 1); EX_STEP1(S2, S3, c4 + 2); EX_STEP1(S3, S0, c4 + 3);
            if ((c4 & 31) == 28) { const int hp = c4 >> 5; int tl = tid; asm volatile("" : "+v"(tl)); const int g = (tl >> 4) & 3, fr = tl & 15;
#pragma unroll
                for (int rt = 0; rt < 4; ++rt)
#pragma unroll
                    for (int ct = 0; ct < 2; ++ct) { const f32x4 ga = acc[rt][ct], ua = acc[rt][ct + 2];
                        v2u wv; wv.x = pk2(siluf_(ga[0]) * ua[0], siluf_(ga[1]) * ua[1]); wv.y = pk2(siluf_(ga[2]) * ua[2], siluf_(ga[3]) * ua[3]);
                        *(LAS v2u*)(Gimg + (64 * wr + 16 * rt + fr) * VSB + (128 * hp + 32 * wc + 16 * ct + 4 * g) * 2) = wv; }
                EX_ZERO(); }
        }
#define EX_L2(S, CC) do { if (ABL & 16) break; const int cc_ = (CC) & 31, np_ = cc_ >> 3, kc_ = cc_ & 7; int tl = tid; asm volatile("" : "+v"(tl));                           \
            unsigned o = (unsigned)((32 * kc_ + (tl >> 6)) * D + 256 * np_ + 4 * (tl & 63));                                                              \
            _Pragma("unroll") for (int i = 0; i < 4; ++i) S.w[i] = *(const f32x4*)(Wd + o + (unsigned)(8 * i * D)); } while (0)
#define EX_PF2(CC) do { if (MK_PFD > 0) { const int cc_ = (CC) & 31, np_ = cc_ >> 3, kc_ = cc_ & 7; int tl = tid; asm volatile("" : "+v"(tl)); const int ln_ = tl & 63;    \
            if (w < 4) pf_dma(Wd + (size_t)(32 * kc_ + w * 8 + (ln_ >> 3)) * D + 256 * np_ + 32 * (ln_ & 7), pfl); } } while (0)
#define EX_W2(S, BUF) do { if (ABL & 2) { asm volatile("" :: "v"(S.w[0]), "v"(S.w[1]), "v"(S.w[2]), "v"(S.w[3])); break; } int tl = tid; asm volatile("" : "+v"(tl)); LAS unsigned char* b_ = (BUF) + EX_BOFF + (tl >> 6) * VSB + 8 * (tl & 63);          \
            _Pragma("unroll") for (int i = 0; i < 4; ++i) { v2u p_; p_.x = pk2(S.w[i].x, S.w[i].y); p_.y = pk2(S.w[i].z, S.w[i].w); *(LAS v2u*)(b_ + (8 * i) * VSB) = p_; } } while (0)
#define EX_C2(C) do { if (ABL & 1) break; int tl = tid; asm volatile("" : "+v"(tl)); const int g = (tl >> 4) & 3, fr = tl & 15, q = (tl & 15) >> 2, p = tl & 3;              \
            const unsigned ta = F.ldsb + EX_BUF + (unsigned)(((C) & 1) * EX_BUFSZ + EX_BOFF + (8 * g + q) * VSB + (64 * wc + 4 * p) * 2);                \
            bf16x8 gf[4]; _Pragma("unroll") for (int rt = 0; rt < 4; ++rt) gf[rt] = ldfrag(Gimg, 64 * wr + 16 * rt + fr, VSB, 32 * ((C) & 7) + 8 * g);   \
            bf16x8 b0, b1, b2, b3; tr_frag4<4 * VSB, 32>(ta, b0, b1, b2, b3);                                                                             \
            _Pragma("unroll") for (int rt = 0; rt < 4; ++rt) { acc[rt][0] = MFMA16(b0, gf[rt], acc[rt][0]); acc[rt][1] = MFMA16(b1, gf[rt], acc[rt][1]); acc[rt][2] = MFMA16(b2, gf[rt], acc[rt][2]); acc[rt][3] = MFMA16(b3, gf[rt], acc[rt][3]); } } while (0)
#define EX_STEP2(SL, SW, C) do { if (!MK_LATE_ISSUE) { EX_L2(SL, (C) + 4); } EX_C2(C); EX_W2(SW, F.lds + EX_BUF + (((C) + 1) & 1) * EX_BUFSZ); if (MK_LATE_ISSUE) { EX_L2(SL, (C) + 4); } __syncthreads(); } while (0)
        EX_L2(S0, 0); EX_L2(S1, 1); EX_L2(S2, 2); EX_L2(S3, 3);
        EX_W2(S0, F.lds + EX_BUF);
        __syncthreads();
#pragma unroll 1
        for (int np = 0; np < 4; ++np) {
            if (MK_GSYNC_EVERY > 0) EX_GSYNC();
#pragma unroll 1
            for (int h4 = 0; h4 < 8; h4 += 4) { const int c4 = 8 * np + h4;
                EX_STEP2(S0, S1, c4); EX_STEP2(S1, S2, c4 + 1); EX_STEP2(S2, S3, c4 + 2); EX_STEP2(S3, S0, c4 + 3); }
            int tl = tid; asm volatile("" : "+v"(tl)); const int g = (tl >> 4) & 3, fr = tl & 15;
#pragma unroll
            for (int rt = 0; rt < 4; ++rt) { const int row = 64 * wr + 16 * rt + fr; const float rw = wl[row];
                if (!(ABL & 32) && r0 + row < cnt_e) { bf16* yp = YP + (size_t)(slot0 + row) * D + 256 * np + 64 * wc + 4 * g;
#pragma unroll
                    for (int ct = 0; ct < 4; ++ct) { const f32x4 o = acc[rt][ct] * rw; v2u wv; wv.x = pk2(o[0], o[1]); wv.y = pk2(o[2], o[3]); *(v2u*)(yp + 16 * ct) = wv; } } }
            EX_ZERO();
        }
#undef EX_L1
#undef EX_C1S
#undef EX_PF1
#undef EX_PF2
#undef EX_W1
#undef EX_C1
#undef EX_STEP1
#undef EX_L2
#undef EX_W2
#undef EX_C2
#undef EX_STEP2
#undef EX_ZERO
#undef EX_GSYNC
        __syncthreads();
    }
    asm volatile("s_waitcnt vmcnt(0)" ::: "memory");
}

constexpr int E5_TOK = 2176, E5_W = 3200, E5_BUF = 4224, E5_BUFSZ = 37888, E5_BOFF = 20480;
static_assert(E5_BUF + 2 * E5_BUFSZ <= LDSCTL_OFF, "expert v5 LDS map");
struct E5Set { f32x4 w[4]; v4u a0, a1; };
__device__ __forceinline__ void expert_prefix256(Frame& F, LAS int* pref, LAS int* off) {
    if (F.wave == 0) { const unsigned* cnt = (const unsigned*)(F.ctl + CW_CNT); const int lane = F.lane;
        int c[4], nb[4]; int tc = 0, tb = 0;
#pragma unroll
        for (int j = 0; j < 4; ++j) { c[j] = (int)__hip_atomic_load(cnt + 64 * (4 * lane + j), RLX_AGENT); nb[j] = (c[j] + 255) >> 8; tc += c[j]; tb += nb[j]; }
        int xc = tc, xb = tb;
#pragma unroll
        for (int o = 1; o < 64; o <<= 1) { const int vc = __shfl_up(xc, o), vb = __shfl_up(xb, o); if (lane >= o) { xc += vc; xb += vb; } }
        int ec = xc - tc, eb = xb - tb;
#pragma unroll
        for (int j = 0; j < 4; ++j) { off[4 * lane + j] = ec; pref[4 * lane + j] = eb; ec += c[j]; eb += nb[j]; }
        if (lane == 63) { off[256] = ec; pref[256] = eb; } }
}
__device__ __forceinline__ void p11_experts_v5(Frame& F) {
    unsigned char* ws = F.ws; const bf16* H2 = (const bf16*)(ws + WS_HB); const int* LTOK = (const int*)(ws + WS_LTOK); const float* LW = (const float*)(ws + WS_LW); bf16* YP = (bf16*)(ws + WS_YP);
    bf16* Gs = (bf16*)(ws + WS_RETG) + (size_t)blockIdx.x * 65536;
    LAS int* pref = (LAS int*)(F.lds + EX_PREF); LAS int* off = (LAS int*)(F.lds + EX_OFF); LAS int* tokl = (LAS int*)(F.lds + E5_TOK); LAS float* wl = (LAS float*)(F.lds + E5_W);
    const int tid = F.tid, w = F.wave, wr = w >> 2, wc = w & 3;
    expert_prefix256(F, pref, off);
    __syncthreads();
    const int nitems = pref[256];
    for (int it = F.vcu; it < nitems; it += F.G) {
        int e = 0;
#pragma unroll
        for (int s = 128; s >= 1; s >>= 1) if (pref[e + s] <= it) e += s;
        e = __builtin_amdgcn_readfirstlane(e);
        const int rb = __builtin_amdgcn_readfirstlane(it - pref[e]), cnt_e = __builtin_amdgcn_readfirstlane(off[e + 1] - off[e]), r0 = rb * 256, slot0 = __builtin_amdgcn_readfirstlane(off[e]) + r0;
        if (tid < 256) { const int idx = r0 + tid; const bool ok = idx < cnt_e; tokl[tid] = LTOK[(size_t)e * CAP + (ok ? idx : r0)]; wl[tid] = ok ? LW[(size_t)e * CAP + idx] : 0.f; }
        __syncthreads();
        const float* Wg = F.w_eg + (size_t)e * D * EH; const float* Wu = F.w_eu + (size_t)e * D * EH; const float* Wd = F.w_ed + (size_t)e * EH * D;
        const bf16* asrc = H2 + (size_t)tokl[tid >> 1] * D + (tid & 1) * 16;
        const bf16* gsrc = Gs + (size_t)(tid >> 1) * 256 + (tid & 1) * 16;
        f32x4 acc[2][4][4];
#define E5_ZERO() do { _Pragma("unroll") for (int s_ = 0; s_ < 2; ++s_) _Pragma("unroll") for (int i = 0; i < 4; ++i) _Pragma("unroll") for (int j = 0; j < 4; ++j) acc[s_][i][j] = (f32x4){0.f, 0.f, 0.f, 0.f}; } while (0)
        E5_ZERO();
        E5Set S0, S1;
#define E5_WA(S, BUF, TL) do { *(LAS v4u*)((BUF) + ((TL) >> 1) * ASB + ((TL) & 1) * 32) = S.a0; *(LAS v4u*)((BUF) + ((TL) >> 1) * ASB + ((TL) & 1) * 32 + 16) = S.a1; } while (0)
#define E5_MMA(BUF, B0, B1, B2, B3, FR, G_) do { _Pragma("unroll") for (int s_ = 0; s_ < 2; ++s_) _Pragma("unroll") for (int rt = 0; rt < 4; ++rt) {                       \
            const bf16x8 af = ldfrag((BUF), 128 * s_ + 64 * wr + 16 * rt + (FR), ASB, 8 * (G_));                                                                          \
            acc[s_][rt][0] = MFMA16(B0, af, acc[s_][rt][0]); acc[s_][rt][1] = MFMA16(B1, af, acc[s_][rt][1]); acc[s_][rt][2] = MFMA16(B2, af, acc[s_][rt][2]); acc[s_][rt][3] = MFMA16(B3, af, acc[s_][rt][3]); } } while (0)
#define E5_L1(S, CC) do { const int cc_ = (CC) & 63, hp_ = cc_ >> 5, kc_ = cc_ & 31; int tl = tid; asm volatile("" : "+v"(tl));                         \
            unsigned o = (unsigned)((32 * kc_ + (tl >> 5)) * EH + 128 * hp_ + 4 * (tl & 31));                                                            \
            S.w[0] = *(const f32x4*)(Wg + o); S.w[1] = *(const f32x4*)(Wg + o + 16 * EH); S.w[2] = *(const f32x4*)(Wu + o); S.w[3] = *(const f32x4*)(Wu + o + 16 * EH); \
            S.a0 = *(const v4u*)(asrc + 32 * kc_); S.a1 = *(const v4u*)(asrc + 32 * kc_ + 8); } while (0)
#define E5_W1(S, BUF) do { int tl = tid; asm volatile("" : "+v"(tl)); LAS unsigned char* b_ = (BUF) + E5_BOFF + (tl >> 5) * KSB + 8 * (tl & 31); v2u p_[4];  \
            _Pragma("unroll") for (int i = 0; i < 4; ++i) { p_[i].x = pk2(S.w[i].x, S.w[i].y); p_[i].y = pk2(S.w[i].z, S.w[i].w); }                        \
            *(LAS v2u*)b_ = p_[0]; *(LAS v2u*)(b_ + 16 * KSB) = p_[1]; *(LAS v2u*)(b_ + 32 * KSB) = p_[2]; *(LAS v2u*)(b_ + 48 * KSB) = p_[3];             \
            E5_WA(S, BUF, tl); } while (0)
#define E5_C1(BUFI) do { int tl = tid; asm volatile("" : "+v"(tl)); const int g = (tl >> 4) & 3, fr = tl & 15, q = (tl & 15) >> 2, p = tl & 3;          \
            LAS unsigned char* buf = F.lds + E5_BUF + (BUFI) * E5_BUFSZ; const unsigned ta = F.ldsb + E5_BUF + (unsigned)((BUFI) * E5_BUFSZ + E5_BOFF + (8 * g + q) * KSB + (32 * wc + 4 * p) * 2); \
            bf16x8 b0, b1, b2, b3; tr_frag2<4 * KSB, 32>(ta, b0, b1); tr_frag2<4 * KSB, 32>(ta + 32 * KSB, b2, b3);                                       \
            E5_MMA(buf, b0, b1, b2, b3, fr, g); } while (0)
        E5Set S2;
#define E5_GW(HP) do { int tl = tid; asm volatile("" : "+v"(tl)); const int g = (tl >> 4) & 3, fr = tl & 15;     \
            _Pragma("unroll") for (int s_ = 0; s_ < 2; ++s_) _Pragma("unroll") for (int rt = 0; rt < 4; ++rt) _Pragma("unroll") for (int ct = 0; ct < 2; ++ct) { const f32x4 ga = acc[s_][rt][ct], ua = acc[s_][rt][ct + 2]; \
                v2u wv; wv.x = pk2(siluf_(ga[0]) * ua[0], siluf_(ga[1]) * ua[1]); wv.y = pk2(siluf_(ga[2]) * ua[2], siluf_(ga[3]) * ua[3]);                   \
                *(v2u*)(Gs + (size_t)(128 * s_ + 64 * wr + 16 * rt + fr) * 256 + 128 * (HP) + 32 * wc + 16 * ct + 4 * g) = wv; }                              \
            E5_ZERO(); } while (0)
#define E5_STEP1(SL, SW, CC) do { const int bi_ = (CC) & 1; E5_L1(SL, (CC) + 3); E5_C1(bi_); E5_W1(SW, F.lds + E5_BUF + (1 - bi_) * E5_BUFSZ); __syncthreads(); } while (0)
        E5_L1(S0, 0); E5_L1(S1, 1); E5_L1(S2, 2);
        E5_W1(S0, F.lds + E5_BUF);
        __syncthreads();
#pragma unroll 1
        for (int c3 = 0; c3 < 63; c3 += 3) {
            E5_STEP1(S0, S1, c3); E5_STEP1(S1, S2, c3 + 1);
            if (c3 == 30) E5_GW(0);
            E5_STEP1(S2, S0, c3 + 2);
        }
        E5_STEP1(S0, S1, 63);
        E5_GW(1);
#undef E5_STEP1
#undef E5_GW
        asm volatile("s_waitcnt vmcnt(0)" ::: "memory");
        __syncthreads();
#define E5_L2(S, CC) do { const int cc_ = (CC) & 31, np_ = cc_ >> 3, kc_ = cc_ & 7; int tl = tid; asm volatile("" : "+v"(tl));                           \
            unsigned o = (unsigned)((32 * kc_ + (tl >> 6)) * D + 256 * np_ + 4 * (tl & 63));                                                              \
            _Pragma("unroll") for (int i = 0; i < 4; ++i) S.w[i] = *(const f32x4*)(Wd + o + (unsigned)(8 * i * D));                                       \
            S.a0 = *(const v4u*)(gsrc + 32 * kc_); S.a1 = *(const v4u*)(gsrc + 32 * kc_ + 8); } while (0)
#define E5_W2(S, BUF) do { int tl = tid; asm volatile("" : "+v"(tl)); LAS unsigned char* b_ = (BUF) + E5_BOFF + (tl >> 6) * VSB + 8 * (tl & 63);          \
            _Pragma("unroll") for (int i = 0; i < 4; ++i) { v2u p_; p_.x = pk2(S.w[i].x, S.w[i].y); p_.y = pk2(S.w[i].z, S.w[i].w); *(LAS v2u*)(b_ + (8 * i) * VSB) = p_; } \
            E5_WA(S, BUF, tl); } while (0)
#define E5_C2(BUFI) do { int tl = tid; asm volatile("" : "+v"(tl)); const int g = (tl >> 4) & 3, fr = tl & 15, q = (tl & 15) >> 2, p = tl & 3;          \
            LAS unsigned char* buf = F.lds + E5_BUF + (BUFI) * E5_BUFSZ; const unsigned ta = F.ldsb + E5_BUF + (unsigned)((BUFI) * E5_BUFSZ + E5_BOFF + (8 * g + q) * VSB + (64 * wc + 4 * p) * 2); \
            bf16x8 b0, b1, b2, b3; tr_frag4<4 * VSB, 32>(ta, b0, b1, b2, b3);                                                                             \
            E5_MMA(buf, b0, b1, b2, b3, fr, g); } while (0)
        E5_L2(S0, 0); E5_L2(S1, 1);
        E5_W2(S0, F.lds + E5_BUF);
        __syncthreads();
#pragma unroll 1
        for (int np = 0; np < 4; ++np) {
#pragma unroll 1
            for (int h2 = 0; h2 < 8; h2 += 2) { const int c2 = 8 * np + h2;
                E5_L2(S0, c2 + 2); E5_C2(0); E5_W2(S1, F.lds + E5_BUF + E5_BUFSZ); __syncthreads();
                E5_L2(S1, c2 + 3); E5_C2(1); E5_W2(S0, F.lds + E5_BUF); __syncthreads(); }
            int tl = tid; asm volatile("" : "+v"(tl)); const int g = (tl >> 4) & 3, fr = tl & 15;
#pragma unroll
            for (int s_ = 0; s_ < 2; ++s_)
#pragma unroll
                for (int rt = 0; rt < 4; ++rt) { const int row = 128 * s_ + 64 * wr + 16 * rt + fr; const float rw = wl[row];
                    if (r0 + row < cnt_e) { bf16* yp = YP + (size_t)(slot0 + row) * D + 256 * np + 64 * wc + 4 * g;
#pragma unroll
                        for (int ct = 0; ct < 4; ++ct) { const f32x4 o = acc[s_][rt][ct] * rw; v2u wv; wv.x = pk2(o[0], o[1]); wv.y = pk2(o[2], o[3]); *(v2u*)(yp + 16 * ct) = wv; } } }
            E5_ZERO();
        }
#undef E5_L1
#undef E5_W1
#undef E5_C1
#undef E5_L2
#undef E5_W2
#undef E5_C2
#undef E5_MMA
#undef E5_WA
#undef E5_ZERO
        asm volatile("s_waitcnt vmcnt(0)" ::: "memory");
        __syncthreads();
    }
}

constexpr int E6_TOK = 2176, E6_W = 3200, E6_AR = 4224, E6_ASL = 16384, E6_BI = E6_AR + 4 * E6_ASL, E6_BSZ = 17408;
static_assert(E6_BI + 2 * E6_BSZ <= PF_OFF, "expert v6 LDS map");
__device__ __forceinline__ void dma16(const void* gsrc, unsigned lds_dst) {
    unsigned keep;
    asm volatile("s_mov_b32 %0, m0\n\ts_mov_b32 m0, %2\n\ts_nop 0\n\tglobal_load_lds_dwordx4 %1, off\n\ts_mov_b32 m0, %0" : "=&s"(keep) : "v"(gsrc), "s"(lds_dst) : "memory");
}
struct E6Set { f32x4 w[4]; };
__device__ __forceinline__ void p11_experts_v6(Frame& F) {
    unsigned char* ws = F.ws; const bf16* H2 = (const bf16*)(ws + WS_HB); const int* LTOK = (const int*)(ws + WS_LTOK); const float* LW = (const float*)(ws + WS_LW); bf16* YP = (bf16*)(ws + WS_YP);
    bf16* Gs = (bf16*)(ws + WS_RETG) + (size_t)blockIdx.x * 65536;
    LAS int* pref = (LAS int*)(F.lds + EX_PREF); LAS int* off = (LAS int*)(F.lds + EX_OFF); LAS int* tokl = (LAS int*)(F.lds + E6_TOK); LAS float* wl = (LAS float*)(F.lds + E6_W);
    const int tid = F.tid, w = F.wave, wr = w >> 2, wc = w & 3;
    expert_prefix256(F, pref, off);
    __syncthreads();
    const int nitems = pref[256];
    for (int it = F.vcu; it < nitems; it += F.G) {
        int e = 0;
#pragma unroll
        for (int s = 128; s >= 1; s >>= 1) if (pref[e + s] <= it) e += s;
        e = __builtin_amdgcn_readfirstlane(e);
        const int rb = __builtin_amdgcn_readfirstlane(it - pref[e]), cnt_e = __builtin_amdgcn_readfirstlane(off[e + 1] - off[e]), r0 = rb * 256, slot0 = __builtin_amdgcn_readfirstlane(off[e]) + r0;
        if (tid < 256) { const int idx = r0 + tid; const bool ok = idx < cnt_e; tokl[tid] = LTOK[(size_t)e * CAP + (ok ? idx : r0)]; wl[tid] = ok ? LW[(size_t)e * CAP + idx] : 0.f; }
        __syncthreads();
        const float* Wg = F.w_eg + (size_t)e * D * EH; const float* Wu = F.w_eu + (size_t)e * D * EH; const float* Wd = F.w_ed + (size_t)e * EH * D;
        int tli = tid; asm volatile("" : "+v"(tli));
        const int ln = tli & 63, arow0 = 32 * w + (ln >> 2), aseg = ((ln & 3) ^ ((ln >> 4) & 3)) * 8;
        const bf16* ap0 = H2 + (size_t)tokl[arow0] * D + aseg; const bf16* ap1 = H2 + (size_t)tokl[arow0 + 16] * D + aseg;
        f32x4 acc[2][4][4];
#define E6_ZERO() do { _Pragma("unroll") for (int s_ = 0; s_ < 2; ++s_) _Pragma("unroll") for (int i = 0; i < 4; ++i) _Pragma("unroll") for (int j = 0; j < 4; ++j) acc[s_][i][j] = (f32x4){0.f, 0.f, 0.f, 0.f}; } while (0)
        E6_ZERO();
        E6Set S0, S1, S2;
#define E6_ADMA(KOFF, CC) do { const unsigned sl_ = F.ldsb + E6_AR + (unsigned)(((CC) & 3) * E6_ASL + 2048 * w); const bf16* a0_ = ap0; const bf16* a1_ = ap1; asm volatile("" : "+v"(a0_), "+v"(a1_)); dma16(a0_ + (KOFF), sl_); dma16(a1_ + (KOFF), sl_ + 1024u); } while (0)
#define E6_MMA(C, B0, B1, B2, B3) do { int tl = tid; asm volatile("" : "+v"(tl)); const int g = (tl >> 4) & 3, fr = tl & 15, q = (tl & 15) >> 2;                              \
            const LAS unsigned char* ab_ = F.lds + E6_AR + ((C) & 3) * E6_ASL + (64 * wr + fr) * 64 + ((g ^ q) << 4);                                                      \
            _Pragma("unroll") for (int s_ = 0; s_ < 2; ++s_) { if (s_) __builtin_amdgcn_sched_barrier(0); _Pragma("unroll") for (int rt = 0; rt < 4; ++rt) {                \
                const bf16x8 af = *(const LAS bf16x8*)(ab_ + (128 * s_ + 16 * rt) * 64);                                                                                  \
                acc[s_][rt][0] = MFMA16(B0, af, acc[s_][rt][0]); acc[s_][rt][1] = MFMA16(B1, af, acc[s_][rt][1]); acc[s_][rt][2] = MFMA16(B2, af, acc[s_][rt][2]); acc[s_][rt][3] = MFMA16(B3, af, acc[s_][rt][3]); } } } while (0)
#define E6_L1(S, CC) do { const int cc_ = (CC) & 63, hp_ = cc_ >> 5, kc_ = cc_ & 31; int tl = tid; asm volatile("" : "+v"(tl));                         \
            E6_ADMA(32 * kc_, CC);                                                                                                                       \
            unsigned o = (unsigned)((32 * kc_ + (tl >> 5)) * EH + 128 * hp_ + 4 * (tl & 31));                                                            \
            S.w[0] = *(const f32x4*)(Wg + o); S.w[1] = *(const f32x4*)(Wg + o + 16 * EH); S.w[2] = *(const f32x4*)(Wu + o); S.w[3] = *(const f32x4*)(Wu + o + 16 * EH); } while (0)
#define E6_W1(S, CC) do { int tl = tid; asm volatile("" : "+v"(tl)); LAS unsigned char* b_ = F.lds + E6_BI + ((CC) & 1) * E6_BSZ + (tl >> 5) * KSB + 8 * (tl & 31); v2u p_[4];  \
            _Pragma("unroll") for (int i = 0; i < 4; ++i) { p_[i].x = pk2(S.w[i].x, S.w[i].y); p_[i].y = pk2(S.w[i].z, S.w[i].w); }                        \
            *(LAS v2u*)b_ = p_[0]; *(LAS v2u*)(b_ + 16 * KSB) = p_[1]; *(LAS v2u*)(b_ + 32 * KSB) = p_[2]; *(LAS v2u*)(b_ + 48 * KSB) = p_[3]; } while (0)
#define E6_C1(C) do { int tl = tid; asm volatile("" : "+v"(tl)); const int g = (tl >> 4) & 3, q = (tl & 15) >> 2, p = tl & 3;                            \
            const unsigned ta = F.ldsb + E6_BI + (unsigned)(((C) & 1) * E6_BSZ + (8 * g + q) * KSB + (32 * wc + 4 * p) * 2);                             \
            bf16x8 b0, b1, b2, b3; tr_frag2<4 * KSB, 32>(ta, b0, b1); tr_frag2<4 * KSB, 32>(ta + 32 * KSB, b2, b3);                                       \
            E6_MMA(C, b0, b1, b2, b3); } while (0)
#define E6_GW(HP) do { int tl = tid; asm volatile("" : "+v"(tl)); const int g = (tl >> 4) & 3, fr = tl & 15;     \
            _Pragma("unroll") for (int s_ = 0; s_ < 2; ++s_) _Pragma("unroll") for (int rt = 0; rt < 4; ++rt) _Pragma("unroll") for (int ct = 0; ct < 2; ++ct) { const f32x4 ga = acc[s_][rt][ct], ua = acc[s_][rt][ct + 2]; \
                v2u wv; wv.x = pk2(siluf_(ga[0]) * ua[0], siluf_(ga[1]) * ua[1]); wv.y = pk2(siluf_(ga[2]) * ua[2], siluf_(ga[3]) * ua[3]);                   \
                *(v2u*)(Gs + (size_t)(128 * s_ + 64 * wr + 16 * rt + fr) * 256 + 128 * (HP) + 32 * wc + 16 * ct + 4 * g) = wv; }                              \
            E6_ZERO(); } while (0)
#define E6_C1S(SL, C) do { int tl = tid; asm volatile("" : "+v"(tl)); const int g = (tl >> 4) & 3, fr = tl & 15, q = (tl & 15) >> 2, p = tl & 3;      \
            const int cc_ = ((C) + 3) & 63, hp_ = cc_ >> 5, kc_ = cc_ & 31; const unsigned o = (unsigned)((32 * kc_ + (tl >> 5)) * EH + 128 * hp_ + 4 * (tl & 31));        \
            E6_ADMA(32 * kc_, (C) + 3);                                                                                                                   \
            const unsigned ta = F.ldsb + E6_BI + (unsigned)(((C) & 1) * E6_BSZ + (8 * g + q) * KSB + (32 * wc + 4 * p) * 2);                             \
            bf16x8 b0, b1, b2, b3; tr_frag2<4 * KSB, 32>(ta, b0, b1); tr_frag2<4 * KSB, 32>(ta + 32 * KSB, b2, b3);                                       \
            const LAS unsigned char* ab_ = F.lds + E6_AR + ((C) & 3) * E6_ASL + (64 * wr + fr) * 64 + ((g ^ q) << 4);                                     \
            _Pragma("unroll") for (int s_ = 0; s_ < 2; ++s_) _Pragma("unroll") for (int rt = 0; rt < 4; ++rt) {                                           \
                const bf16x8 af = *(const LAS bf16x8*)(ab_ + (128 * s_ + 16 * rt) * 64);                                                                 \
                acc[s_][rt][0] = MFMA16(b0, af, acc[s_][rt][0]); acc[s_][rt][1] = MFMA16(b1, af, acc[s_][rt][1]); acc[s_][rt][2] = MFMA16(b2, af, acc[s_][rt][2]); acc[s_][rt][3] = MFMA16(b3, af, acc[s_][rt][3]); \
                if ((rt & 1) == 1) { const int li_ = 2 * s_ + (rt >> 1); __builtin_amdgcn_sched_barrier(0);                                                \
                    if (li_ == 0) SL.w[0] = *(const f32x4*)(Wg + o); else if (li_ == 1) SL.w[1] = *(const f32x4*)(Wg + o + 16 * EH);                      \
                    else if (li_ == 2) SL.w[2] = *(const f32x4*)(Wu + o); else SL.w[3] = *(const f32x4*)(Wu + o + 16 * EH);                               \
                    __builtin_amdgcn_sched_barrier(0); } } } while (0)
#define E6_STEP1(SL, SW, C) do { if (MK_SPREAD) { E6_C1S(SL, C); E6_W1(SW, (C) + 1); if (((C) & 31) == 31) E6_GW((C) >> 5); __syncthreads(); break; } if (!MK_LATE_ISSUE) { E6_L1(SL, (C) + 3); } E6_C1(C); E6_W1(SW, (C) + 1); if (((C) & 31) == 31) E6_GW((C) >> 5); if (MK_LATE_ISSUE) { E6_L1(SL, (C) + 3); } __syncthreads(); } while (0)
        E6_L1(S0, 0); E6_L1(S1, 1);
        E6_W1(S0, 0);
        E6_L1(S2, 2);
        __syncthreads();
#pragma unroll 1
        for (int c3 = 0; c3 < 63; c3 += 3) { E6_STEP1(S0, S1, c3); E6_STEP1(S1, S2, c3 + 1); E6_STEP1(S2, S0, c3 + 2); }
        E6_STEP1(S0, S1, 63);
        asm volatile("s_waitcnt vmcnt(0)" ::: "memory");
        __syncthreads();
        { int tl = tid; asm volatile("" : "+v"(tl)); const int l2_ = tl & 63, ar_ = 32 * w + (l2_ >> 2), as_ = ((l2_ & 3) ^ ((l2_ >> 4) & 3)) * 8; ap0 = Gs + (size_t)ar_ * 256 + as_; ap1 = Gs + (size_t)(ar_ + 16) * 256 + as_; }
#define E6_L2(S, CC) do { const int cc_ = (CC) & 31, np_ = cc_ >> 3, kc_ = cc_ & 7; int tl = tid; asm volatile("" : "+v"(tl));                           \
            E6_ADMA(32 * kc_, CC);                                                                                                                       \
            unsigned o = (unsigned)((32 * kc_ + (tl >> 6)) * D + 256 * np_ + 4 * (tl & 63));                                                              \
            _Pragma("unroll") for (int i = 0; i < 4; ++i) S.w[i] = *(const f32x4*)(Wd + o + (unsigned)(8 * i * D)); } while (0)
#define E6_W2(S, CC) do { int tl = tid; asm volatile("" : "+v"(tl)); LAS unsigned char* b_ = F.lds + E6_BI + ((CC) & 1) * E6_BSZ + (tl >> 6) * VSB + 8 * (tl & 63);  \
            _Pragma("unroll") for (int i = 0; i < 4; ++i) { v2u p_; p_.x = pk2(S.w[i].x, S.w[i].y); p_.y = pk2(S.w[i].z, S.w[i].w); *(LAS v2u*)(b_ + (8 * i) * VSB) = p_; } } while (0)
#define E6_C2(C) do { int tl = tid; asm volatile("" : "+v"(tl)); const int g = (tl >> 4) & 3, q = (tl & 15) >> 2, p = tl & 3;                            \
            const unsigned ta = F.ldsb + E6_BI + (unsigned)(((C) & 1) * E6_BSZ + (8 * g + q) * VSB + (64 * wc + 4 * p) * 2);                             \
            bf16x8 b0, b1, b2, b3; tr_frag4<4 * VSB, 32>(ta, b0, b1, b2, b3);                                                                             \
            E6_MMA(C, b0, b1, b2, b3); } while (0)
#define E6_YP(NP) do { int tl = tid; asm volatile("" : "+v"(tl)); const int g = (tl >> 4) & 3, fr = tl & 15;                                            \
            _Pragma("unroll") for (int s_ = 0; s_ < 2; ++s_) _Pragma("unroll") for (int rt = 0; rt < 4; ++rt) { const int row = 128 * s_ + 64 * wr + 16 * rt + fr; const float rw = wl[row]; \
                if (r0 + row < cnt_e) { bf16* yp = YP + (size_t)(slot0 + row) * D + 256 * (NP) + 64 * wc + 4 * g;                                         \
                    _Pragma("unroll") for (int ct = 0; ct < 4; ++ct) { const f32x4 o = acc[s_][rt][ct] * rw; v2u wv; wv.x = pk2(o[0], o[1]); wv.y = pk2(o[2], o[3]); *(v2u*)(yp + 16 * ct) = wv; } } } \
            E6_ZERO(); } while (0)
#define E6_C2S(SL, C) do { int tl = tid; asm volatile("" : "+v"(tl)); const int g = (tl >> 4) & 3, fr = tl & 15, q = (tl & 15) >> 2, p = tl & 3;      \
            const int cc_ = ((C) + 3) & 31, np_ = cc_ >> 3, kc_ = cc_ & 7; const unsigned o = (unsigned)((32 * kc_ + (tl >> 6)) * D + 256 * np_ + 4 * (tl & 63));           \
            E6_ADMA(32 * kc_, (C) + 3);                                                                                                                   \
            const unsigned ta = F.ldsb + E6_BI + (unsigned)(((C) & 1) * E6_BSZ + (8 * g + q) * VSB + (64 * wc + 4 * p) * 2);                             \
            bf16x8 b0, b1, b2, b3; tr_frag4<4 * VSB, 32>(ta, b0, b1, b2, b3);                                                                             \
            const LAS unsigned char* ab_ = F.lds + E6_AR + ((C) & 3) * E6_ASL + (64 * wr + fr) * 64 + ((g ^ q) << 4);                                     \
            _Pragma("unroll") for (int s_ = 0; s_ < 2; ++s_) _Pragma("unroll") for (int rt = 0; rt < 4; ++rt) {                                           \
                const bf16x8 af = *(const LAS bf16x8*)(ab_ + (128 * s_ + 16 * rt) * 64);                                                                 \
                acc[s_][rt][0] = MFMA16(b0, af, acc[s_][rt][0]); acc[s_][rt][1] = MFMA16(b1, af, acc[s_][rt][1]); acc[s_][rt][2] = MFMA16(b2, af, acc[s_][rt][2]); acc[s_][rt][3] = MFMA16(b3, af, acc[s_][rt][3]); \
                if ((rt & 1) == 1) { const int li_ = 2 * s_ + (rt >> 1); __builtin_amdgcn_sched_barrier(0); SL.w[li_] = *(const f32x4*)(Wd + o + (unsigned)(8 * li_ * D)); __builtin_amdgcn_sched_barrier(0); } } } while (0)
#define E6_STEP2(SL, SW, C) do { if (MK_SPREAD > 1) { E6_C2S(SL, C); E6_W2(SW, (C) + 1); if (((C) & 7) == 7) E6_YP((C) >> 3); __syncthreads(); break; } if (!MK_LATE_ISSUE) { E6_L2(SL, (C) + 3); } E6_C2(C); E6_W2(SW, (C) + 1); if (((C) & 7) == 7) E6_YP((C) >> 3); if (MK_LATE_ISSUE) { E6_L2(SL, (C) + 3); } __syncthreads(); } while (0)
        E6_L2(S0, 0); E6_L2(S1, 1);
        E6_W2(S0, 0);
        E6_L2(S2, 2);
        __syncthreads();
#pragma unroll 1
        for (int c3 = 0; c3 < 30; c3 += 3) { E6_STEP2(S0, S1, c3); E6_STEP2(S1, S2, c3 + 1); E6_STEP2(S2, S0, c3 + 2); }
        E6_STEP2(S0, S1, 30); E6_STEP2(S1, S2, 31);
#undef E6_L1
#undef E6_C1S
#undef E6_W1
#undef E6_C1
#undef E6_GW
#undef E6_STEP1
#undef E6_L2
#undef E6_C2S
#undef E6_W2
#undef E6_C2
#undef E6_YP
#undef E6_STEP2
#undef E6_MMA
#undef E6_ADMA
#undef E6_ZERO
        asm volatile("s_waitcnt vmcnt(0)" ::: "memory");
        __syncthreads();
    }
}

constexpr int E7_BUF = 3200, E7_BUFSZ = 53248, E7_BOFF = 18432, E7_ASB = 144;
static_assert(E7_BUF + 2 * E7_BUFSZ <= PF_OFF, "expert v7 LDS map");
struct E7Set { f32x4 w[8]; v4u a0, a1; };
struct E7Frag { bf16x8 a[4]; s16x4 l[4], h[4]; };
template <int STAGE> __device__ __forceinline__ void e7_stage(Frame& F, const float* Wg, const float* Wu, const float* Wd, const bf16* arow, bf16* Gs, bf16* YP, LAS float* wl, int r0, int cnt_e, int slot0) {
    const int tid = F.tid, w = F.wave, wr = w >> 2, wc = w & 3;
    constexpr int NC = STAGE == 0 ? 32 : 16;
    f32x4 acc[4][4];
#define E7_ZERO() do { _Pragma("unroll") for (int i = 0; i < 4; ++i) _Pragma("unroll") for (int j = 0; j < 4; ++j) acc[i][j] = (f32x4){0.f, 0.f, 0.f, 0.f}; } while (0)
    E7_ZERO();
    E7Set S0, S1;
#define E7_LD(S, CC) do { int tl = tid; asm volatile("" : "+v"(tl)); const int cc_ = (CC) & (NC - 1);                                                           \
        if (STAGE == 0) { const int hp_ = cc_ >> 4, kc_ = cc_ & 15; unsigned o = (unsigned)((64 * kc_ + (tl >> 5)) * EH + 128 * hp_ + 4 * (tl & 31));            \
            _Pragma("unroll") for (int i = 0; i < 4; ++i) { S.w[i] = *(const f32x4*)(Wg + o + (unsigned)(16 * i * EH)); S.w[4 + i] = *(const f32x4*)(Wu + o + (unsigned)(16 * i * EH)); } \
            S.a0 = *(const v4u*)(arow + 64 * kc_); S.a1 = *(const v4u*)(arow + 64 * kc_ + 8);                                                                      \
        } else { const int np_ = cc_ >> 2, kc_ = cc_ & 3; unsigned o = (unsigned)((64 * kc_ + (tl >> 6)) * D + 256 * np_ + 4 * (tl & 63));                         \
            _Pragma("unroll") for (int i = 0; i < 8; ++i) S.w[i] = *(const f32x4*)(Wd + o + (unsigned)(8 * i * D));                                                  \
            S.a0 = *(const v4u*)(arow + 64 * kc_); S.a1 = *(const v4u*)(arow + 64 * kc_ + 8); } } while (0)
#define E7_WR(S, BI) do { int tl = tid; asm volatile("" : "+v"(tl)); LAS unsigned char* buf_ = F.lds + E7_BUF + (BI) * E7_BUFSZ;                                  \
        if (STAGE == 0) { LAS unsigned char* b_ = buf_ + E7_BOFF + (tl >> 5) * KSB + 8 * (tl & 31);                                                                \
            _Pragma("unroll") for (int i = 0; i < 4; ++i) { v2u pg, pu; pg.x = pk2(S.w[i].x, S.w[i].y); pg.y = pk2(S.w[i].z, S.w[i].w); pu.x = pk2(S.w[4 + i].x, S.w[4 + i].y); pu.y = pk2(S.w[4 + i].z, S.w[4 + i].w); \
                *(LAS v2u*)(b_ + (16 * i) * KSB) = pg; *(LAS v2u*)(b_ + (64 + 16 * i) * KSB) = pu; }                                                                \
        } else { LAS unsigned char* b_ = buf_ + E7_BOFF + (tl >> 6) * VSB + 8 * (tl & 63);                                                                          \
            _Pragma("unroll") for (int i = 0; i < 8; ++i) { v2u p_; p_.x = pk2(S.w[i].x, S.w[i].y); p_.y = pk2(S.w[i].z, S.w[i].w); *(LAS v2u*)(b_ + (8 * i) * VSB) = p_; } } \
        *(LAS v4u*)(buf_ + (tl >> 2) * E7_ASB + (tl & 3) * 32) = S.a0; *(LAS v4u*)(buf_ + (tl >> 2) * E7_ASB + (tl & 3) * 32 + 16) = S.a1; } while (0)
    int tlc = tid; asm volatile("" : "+v"(tlc)); const int g = (tlc >> 4) & 3, fr = tlc & 15, q = (tlc & 15) >> 2, p = tlc & 3;
    const unsigned aoff = F.ldsb + E7_BUF + (unsigned)((64 * wr + fr) * E7_ASB + 16 * g);
    const unsigned boff = F.ldsb + E7_BUF + (unsigned)(E7_BOFF + (STAGE == 0 ? (8 * g + q) * KSB + (32 * wc + 4 * p) * 2 : (8 * g + q) * VSB + (64 * wc + 4 * p) * 2));
    constexpr int RS = STAGE == 0 ? KSB : VSB;
#define E7_ISSUE(FS, BI, HS) do { const unsigned aa_ = aoff + (unsigned)((BI) * E7_BUFSZ + 64 * (HS)), bb_ = boff + (unsigned)((BI) * E7_BUFSZ + 32 * (HS) * RS);       \
        asm volatile("ds_read_b128 %0, %4\n\tds_read_b128 %1, %4 offset:%5\n\tds_read_b128 %2, %4 offset:%6\n\tds_read_b128 %3, %4 offset:%7"                         \
            : "=&v"(FS.a[0]), "=&v"(FS.a[1]), "=&v"(FS.a[2]), "=&v"(FS.a[3]) : "v"(aa_), "i"(16 * E7_ASB), "i"(32 * E7_ASB), "i"(48 * E7_ASB) : "memory");            \
        asm volatile("ds_read_b64_tr_b16 %0, %8\n\tds_read_b64_tr_b16 %1, %8 offset:%9\n\tds_read_b64_tr_b16 %2, %8 offset:%10\n\tds_read_b64_tr_b16 %3, %8 offset:%11\n\t" \
                     "ds_read_b64_tr_b16 %4, %8 offset:%12\n\tds_read_b64_tr_b16 %5, %8 offset:%13\n\tds_read_b64_tr_b16 %6, %8 offset:%14\n\tds_read_b64_tr_b16 %7, %8 offset:%15" \
            : "=&v"(FS.l[0]), "=&v"(FS.h[0]), "=&v"(FS.l[1]), "=&v"(FS.h[1]), "=&v"(FS.l[2]), "=&v"(FS.h[2]), "=&v"(FS.l[3]), "=&v"(FS.h[3])                              \
            : "v"(bb_), "i"(4 * RS), "i"(32), "i"(32 + 4 * RS), "i"(STAGE == 0 ? 64 * KSB : 64), "i"(STAGE == 0 ? 64 * KSB + 4 * KSB : 64 + 4 * VSB),                     \
              "i"(STAGE == 0 ? 64 * KSB + 32 : 96), "i"(STAGE == 0 ? 64 * KSB + 32 + 4 * KSB : 96 + 4 * VSB) : "memory"); } while (0)
#define E7_WAIT(FS) do { asm volatile("s_waitcnt lgkmcnt(0)" : "+v"(FS.a[0]), "+v"(FS.a[1]), "+v"(FS.a[2]), "+v"(FS.a[3]), "+v"(FS.l[0]), "+v"(FS.h[0]), "+v"(FS.l[1]), "+v"(FS.h[1]), "+v"(FS.l[2]), "+v"(FS.h[2]), "+v"(FS.l[3]), "+v"(FS.h[3]) :: "memory"); } while (0)
#define E7_MMA(FS) do { _Pragma("unroll") for (int ct = 0; ct < 4; ++ct) { const bf16x8 bb = __builtin_shufflevector(FS.l[ct], FS.h[ct], 0, 1, 2, 3, 4, 5, 6, 7);     \
            _Pragma("unroll") for (int rt = 0; rt < 4; ++rt) acc[rt][ct] = MFMA16(bb, FS.a[rt], acc[rt][ct]); } } while (0)
#define E7_COMPUTE(BI) do { E7Frag Fa, Fb; E7_ISSUE(Fa, BI, 0); E7_WAIT(Fa); E7_ISSUE(Fb, BI, 1); __builtin_amdgcn_sched_barrier(0); E7_MMA(Fa); __builtin_amdgcn_sched_barrier(0); E7_WAIT(Fb); E7_MMA(Fb); } while (0)
#define E7_EPI(C) do { if (STAGE == 0) { if (((C) & 15) == 15) { const int hp = (C) >> 4;     \
                _Pragma("unroll") for (int rt = 0; rt < 4; ++rt) _Pragma("unroll") for (int ct = 0; ct < 2; ++ct) { const f32x4 ga = acc[rt][ct], ua = acc[rt][ct + 2];               \
                    v2u wv; wv.x = pk2(siluf_(ga[0]) * ua[0], siluf_(ga[1]) * ua[1]); wv.y = pk2(siluf_(ga[2]) * ua[2], siluf_(ga[3]) * ua[3]);                                  \
                    *(v2u*)(Gs + (size_t)(64 * wr + 16 * rt + fr) * 256 + 128 * hp + 32 * wc + 16 * ct + 4 * g) = wv; }                                                          \
                E7_ZERO(); }                                                                                                                                                      \
        } else if (((C) & 3) == 3) { const int np = (C) >> 2;                                                                                                                     \
            _Pragma("unroll") for (int rt = 0; rt < 4; ++rt) { const int row = 64 * wr + 16 * rt + fr; const float rw = wl[row];                                                  \
                if (r0 + row < cnt_e) { bf16* yp = YP + (size_t)(slot0 + row) * D + 256 * np + 64 * wc + 4 * g;                                                                  \
                    _Pragma("unroll") for (int ct = 0; ct < 4; ++ct) { const f32x4 o = acc[rt][ct] * rw; v2u wv; wv.x = pk2(o[0], o[1]); wv.y = pk2(o[2], o[3]); *(v2u*)(yp + 16 * ct) = wv; } } } \
            E7_ZERO(); } } while (0)
    E7_LD(S0, 0); E7_LD(S1, 1);
    E7_WR(S0, 0);
    __syncthreads();
#pragma unroll 1
    for (int c2 = 0; c2 < NC; c2 += 2) {
        E7_LD(S0, c2 + 2); E7_COMPUTE(0); E7_WR(S1, 1); E7_EPI(c2); __syncthreads();
        E7_LD(S1, c2 + 3); E7_COMPUTE(1); E7_WR(S0, 0); E7_EPI(c2 + 1); __syncthreads();
    }
#undef E7_ZERO
#undef E7_LD
#undef E7_WR
#undef E7_ISSUE
#undef E7_WAIT
#undef E7_MMA
#undef E7_COMPUTE
#undef E7_EPI
}
__device__ __forceinline__ void p11_experts_v7(Frame& F) {
    unsigned char* ws = F.ws; const bf16* H2 = (const bf16*)(ws + WS_HB); const int* LTOK = (const int*)(ws + WS_LTOK); const float* LW = (const float*)(ws + WS_LW); bf16* YP = (bf16*)(ws + WS_YP);
    bf16* Gs = (bf16*)(ws + WS_RETG) + (size_t)blockIdx.x * 32768;
    LAS int* pref = (LAS int*)(F.lds + EX_PREF); LAS int* off = (LAS int*)(F.lds + EX_OFF); LAS int* tokl = (LAS int*)(F.lds + EX_TOK); LAS float* wl = (LAS float*)(F.lds + EX_W);
    const int tid = F.tid;
    expert_prefix(F, pref, off);
    __syncthreads();
    const int nitems = pref[256];
    for (int it = F.vcu; it < nitems; it += F.G) {
        int e = 0;
#pragma unroll
        for (int s = 128; s >= 1; s >>= 1) if (pref[e + s] <= it) e += s;
        e = __builtin_amdgcn_readfirstlane(e);
        const int rb = __builtin_amdgcn_readfirstlane(it - pref[e]), cnt_e = __builtin_amdgcn_readfirstlane(off[e + 1] - off[e]), r0 = rb * 128, slot0 = __builtin_amdgcn_readfirstlane(off[e]) + r0;
        if (tid < 128) { const int idx = r0 + tid; const bool ok = idx < cnt_e; tokl[tid] = LTOK[(size_t)e * CAP + (ok ? idx : r0)]; wl[tid] = ok ? LW[(size_t)e * CAP + idx] : 0.f; }
        __syncthreads();
        const float* Wg = F.w_eg + (size_t)e * D * EH; const float* Wu = F.w_eu + (size_t)e * D * EH; const float* Wd = F.w_ed + (size_t)e * EH * D;
        int tli = tid; asm volatile("" : "+v"(tli));
        e7_stage<0>(F, Wg, Wu, Wd, H2 + (size_t)tokl[tli >> 2] * D + (tli & 3) * 16, Gs, YP, wl, r0, cnt_e, slot0);
        asm volatile("s_waitcnt vmcnt(0)" ::: "memory");
        __syncthreads();
        e7_stage<1>(F, Wg, Wu, Wd, Gs + (size_t)(tli >> 2) * 256 + (tli & 3) * 16, Gs, YP, wl, r0, cnt_e, slot0);
        asm volatile("s_waitcnt vmcnt(0)" ::: "memory");
        __syncthreads();
    }
}

constexpr int K6_A = 3200, K6_BG = 21632, K6_BU = 39040, K6_G = 56448;
constexpr int ASB6 = 144;
#define K6MM(a, b, c) ((ABL & 1) ? k6_keep((a), (b), (c)) : MFMA16((a), (b), (c)))
__device__ __forceinline__ f32x4 k6_keep(bf16x8 a, bf16x8 b, f32x4 c) { asm volatile("" :: "v"(a), "v"(b)); return c; }
struct K6Set { f32x4 w[8]; v4u a0, a1; };
template <int ABL> __device__ __forceinline__ void p11_experts_k64(Frame& F) {
    unsigned char* ws = F.ws; const bf16* H2 = (const bf16*)(ws + WS_HB); const int* LTOK = (const int*)(ws + WS_LTOK); const float* LW = (const float*)(ws + WS_LW); bf16* YP = (bf16*)(ws + WS_YP);
    LAS int* pref = (LAS int*)(F.lds + EX_PREF); LAS int* off = (LAS int*)(F.lds + EX_OFF); LAS int* tokl = (LAS int*)(F.lds + EX_TOK); LAS float* wl = (LAS float*)(F.lds + EX_W);
    LAS unsigned char* Aimg = F.lds + K6_A; LAS unsigned char* Gimg = F.lds + K6_G;
    const int tid = F.tid, w = F.wave, wr = w >> 2, wc = w & 3;
    expert_prefix(F, pref, off);
    __syncthreads();
    const int nitems = pref[256];
    for (int it = F.vcu; it < nitems; it += F.G) {
        int e = 0;
#pragma unroll
        for (int s = 128; s >= 1; s >>= 1) if (pref[e + s] <= it) e += s;
        e = __builtin_amdgcn_readfirstlane(e);
        const int rb = __builtin_amdgcn_readfirstlane(it - pref[e]), cnt_e = __builtin_amdgcn_readfirstlane(off[e + 1] - off[e]), r0 = rb * 128, slot0 = __builtin_amdgcn_readfirstlane(off[e]) + r0;
        if (tid < 128) { const int idx = r0 + tid; const bool ok = idx < cnt_e; tokl[tid] = LTOK[(size_t)e * CAP + (ok ? idx : r0)]; wl[tid] = ok ? LW[(size_t)e * CAP + idx] : 0.f; }
        __syncthreads();
        const int ew = e;
        const float* Wg = F.w_eg + (size_t)ew * D * EH; const float* Wu = F.w_eu + (size_t)ew * D * EH; const float* Wd = F.w_ed + (size_t)ew * EH * D;
        const bf16* asrc = H2 + (size_t)tokl[tid >> 2] * D + (tid & 3) * 16;
        f32x4 acc[4][4];
#pragma unroll
        for (int i = 0; i < 4; ++i)
#pragma unroll
            for (int j = 0; j < 4; ++j) acc[i][j] = (f32x4){0.f, 0.f, 0.f, 0.f};
        K6Set S0, S1;
        if constexpr (ABL & 16) {
#pragma unroll
            for (int i = 0; i < 8; ++i) { S0.w[i] = (f32x4){1.f, 1.f, 1.f, 1.f}; S1.w[i] = (f32x4){1.f, 1.f, 1.f, 1.f}; } S0.a0 = S0.a1 = S1.a0 = S1.a1 = (v4u){0u, 0u, 0u, 0u}; }
#define K6_LOAD1(S, CC) do { const int cc_ = (CC) & 31, hp_ = cc_ >> 4, kc_ = cc_ & 15; int tl = tid; asm volatile("" : "+v"(tl));                      \
            unsigned o = (unsigned)((64 * kc_ + (tl >> 5)) * EH + 128 * hp_ + 4 * (tl & 31));                                                            \
            if constexpr (!(ABL & 16)) { _Pragma("unroll") for (int i = 0; i < 4; ++i) { S.w[i] = *(const f32x4*)(Wg + o + (unsigned)(16 * i * EH)); S.w[4 + i] = *(const f32x4*)(Wu + o + (unsigned)(16 * i * EH)); } \
            S.a0 = *(const v4u*)(asrc + 64 * kc_); S.a1 = *(const v4u*)(asrc + 64 * kc_ + 8); } } while (0)
#define K6_STEP1(S, CC) do { int tl = tid; asm volatile("" : "+v"(tl)); const int g = (tl >> 4) & 3, fr = tl & 15, q = (tl & 15) >> 2, p = tl & 3;    \
            if constexpr (!(ABL & 8)) __syncthreads();                                                                                                       \
            if constexpr (!(ABL & 2)) { *(LAS v4u*)(Aimg + (tl >> 2) * ASB6 + (tl & 3) * 32) = S.a0; *(LAS v4u*)(Aimg + (tl >> 2) * ASB6 + (tl & 3) * 32 + 16) = S.a1; }            \
            if constexpr (!(ABL & 2)) _Pragma("unroll") for (int i = 0; i < 4; ++i) { v2u wg, wu; wg.x = pk2(S.w[i].x, S.w[i].y); wg.y = pk2(S.w[i].z, S.w[i].w); wu.x = pk2(S.w[4 + i].x, S.w[4 + i].y); wu.y = pk2(S.w[4 + i].z, S.w[4 + i].w); \
                *(LAS v2u*)(F.lds + K6_BG + ((tl >> 5) + 16 * i) * KSB + 8 * (tl & 31)) = wg; *(LAS v2u*)(F.lds + K6_BU + ((tl >> 5) + 16 * i) * KSB + 8 * (tl & 31)) = wu; } \
            if constexpr (!(ABL & 8)) __syncthreads();                                                                                                       \
            K6_LOAD1(S, (CC) + 2);                                                                                                                       \
            const unsigned bga = F.ldsb + K6_BG + (unsigned)((8 * g + q) * KSB + (32 * wc + 4 * p) * 2), bua = bga + (K6_BU - K6_BG);                   \
            if constexpr (!(ABL & 4)) _Pragma("unroll") for (int s = 0; s < 2; ++s) { bf16x8 af[4];                                                                                \
                _Pragma("unroll") for (int rt = 0; rt < 4; ++rt) af[rt] = ldfrag(Aimg, 64 * wr + 16 * rt + fr, ASB6, 32 * s + 8 * g);                    \
                bf16x8 b0, b1, b2, b3; tr_frag2<4 * KSB, 32>(bga + s * 32 * KSB, b0, b1); tr_frag2<4 * KSB, 32>(bua + s * 32 * KSB, b2, b3);             \
                _Pragma("unroll") for (int rt = 0; rt < 4; ++rt) { acc[rt][0] = K6MM(b0, af[rt], acc[rt][0]); acc[rt][1] = K6MM(b1, af[rt], acc[rt][1]); acc[rt][2] = K6MM(b2, af[rt], acc[rt][2]); acc[rt][3] = K6MM(b3, af[rt], acc[rt][3]); } } } while (0)
        K6_LOAD1(S0, 0); K6_LOAD1(S1, 1);
#pragma unroll 1
        for (int cc = 0; cc < 32; cc += 2) {
            K6_STEP1(S0, cc); K6_STEP1(S1, cc + 1);
            if ((cc & 15) == 14) { const int hp = cc >> 4; int tl = tid; asm volatile("" : "+v"(tl)); const int g = (tl >> 4) & 3, fr = tl & 15;
#pragma unroll
                for (int rt = 0; rt < 4; ++rt)
#pragma unroll
                    for (int ct = 0; ct < 2; ++ct) { const f32x4 ga = acc[rt][ct], ua = acc[rt][ct + 2];
                        v2u wv; wv.x = pk2(siluf_(ga[0]) * ua[0], siluf_(ga[1]) * ua[1]); wv.y = pk2(siluf_(ga[2]) * ua[2], siluf_(ga[3]) * ua[3]);
                        *(LAS v2u*)(Gimg + (64 * wr + 16 * rt + fr) * VSB + (128 * hp + 32 * wc + 16 * ct + 4 * g) * 2) = wv; }
#pragma unroll
                for (int i = 0; i < 4; ++i)
#pragma unroll
                    for (int j = 0; j < 4; ++j) acc[i][j] = (f32x4){0.f, 0.f, 0.f, 0.f}; }
        }
#undef K6_STEP1
#undef K6_LOAD1
#define K6_LOAD2(S, CC) do { const int cc_ = (CC) & 15, np_ = cc_ >> 2, kc_ = cc_ & 3; int tl = tid; asm volatile("" : "+v"(tl));                       \
            unsigned o = (unsigned)((64 * kc_ + (tl >> 6)) * D + 256 * np_ + 4 * (tl & 63));                                                             \
            if constexpr (!(ABL & 16)) { _Pragma("unroll") for (int i = 0; i < 8; ++i) S.w[i] = *(const f32x4*)(Wd + o + (unsigned)(8 * i * D)); } } while (0)
#define K6_STEP2(S, CC, KC) do { int tl = tid; asm volatile("" : "+v"(tl)); const int g = (tl >> 4) & 3, fr = tl & 15, q = (tl & 15) >> 2, p = tl & 3; \
            if constexpr (!(ABL & 8)) __syncthreads();                                                                                                       \
            if constexpr (!(ABL & 2)) _Pragma("unroll") for (int i = 0; i < 8; ++i) { v2u wd; wd.x = pk2(S.w[i].x, S.w[i].y); wd.y = pk2(S.w[i].z, S.w[i].w); *(LAS v2u*)(F.lds + K6_BG + ((tl >> 6) + 8 * i) * VSB + 8 * (tl & 63)) = wd; } \
            if constexpr (!(ABL & 8)) __syncthreads();                                                                                                       \
            K6_LOAD2(S, (CC) + 2);                                                                                                                       \
            const unsigned bda = F.ldsb + K6_BG + (unsigned)((8 * g + q) * VSB + (64 * wc + 4 * p) * 2);                                                \
            if constexpr (!(ABL & 4)) _Pragma("unroll") for (int s = 0; s < 2; ++s) { bf16x8 gf[4];                                                                                \
                _Pragma("unroll") for (int rt = 0; rt < 4; ++rt) gf[rt] = ldfrag(Gimg, 64 * wr + 16 * rt + fr, VSB, 64 * (KC) + 32 * s + 8 * g);        \
                bf16x8 b0, b1, b2, b3; tr_frag4<4 * VSB, 32>(bda + s * 32 * VSB, b0, b1, b2, b3);                                                        \
                _Pragma("unroll") for (int rt = 0; rt < 4; ++rt) { acc[rt][0] = K6MM(b0, gf[rt], acc[rt][0]); acc[rt][1] = K6MM(b1, gf[rt], acc[rt][1]); acc[rt][2] = K6MM(b2, gf[rt], acc[rt][2]); acc[rt][3] = K6MM(b3, gf[rt], acc[rt][3]); } } } while (0)
        K6_LOAD2(S0, 0); K6_LOAD2(S1, 1);
#pragma unroll 1
        for (int np = 0; np < 4; ++np) {
            K6_STEP2(S0, 4 * np, 0); K6_STEP2(S1, 4 * np + 1, 1); K6_STEP2(S0, 4 * np + 2, 2); K6_STEP2(S1, 4 * np + 3, 3);
            int tl = tid; asm volatile("" : "+v"(tl)); const int g = (tl >> 4) & 3, fr = tl & 15;
#pragma unroll
            for (int rt = 0; rt < 4; ++rt) { const int row = 64 * wr + 16 * rt + fr; const float rw = wl[row];
                if (!(ABL & 32) && r0 + row < cnt_e) { bf16* yp = YP + (size_t)(slot0 + row) * D + 256 * np + 64 * wc + 4 * g;
#pragma unroll
                    for (int ct = 0; ct < 4; ++ct) { const f32x4 o = acc[rt][ct] * rw; v2u wv; wv.x = pk2(o[0], o[1]); wv.y = pk2(o[2], o[3]); *(v2u*)(yp + 16 * ct) = wv; } } }
#pragma unroll
            for (int i = 0; i < 4; ++i)
#pragma unroll
                for (int j = 0; j < 4; ++j) acc[i][j] = (f32x4){0.f, 0.f, 0.f, 0.f};
        }
#undef K6_STEP2
#undef K6_LOAD2
        __syncthreads();
    }
}

#undef K6MM
__device__ __forceinline__ void p12_final(Frame& F) {
    unsigned char* ws = F.ws; const float* X1 = (const float*)(ws + (MK_SKIP_SHARED ? WS_X1 : WS_MIXP)); const bf16* YP = (const bf16*)(ws + WS_YP); const int* EIDX = (const int*)(ws + WS_EIDX); const int* POS = (const int*)(ws + WS_POS);
    const float* mod = (const float*)(ws + WS_MOD);
    LAS int* pref = (LAS int*)(F.lds + EX_PREF); LAS int* off = (LAS int*)(F.lds + EX_OFF);
    expert_prefix(F, pref, off);
    __syncthreads();
    const int lane = F.lane;
    const int gw = F.vcu * NWAVES + F.wave, NGW = F.G * NWAVES;
    f32x4 gn[4];
#pragma unroll
    for (int j = 0; j < 4; ++j) gn[j] = *(const f32x4*)(F.norm_final_g + 512 * (j >> 1) + 8 * lane + 4 * (j & 1));
    for (int t = gw; t < M; t += NGW) {
        const int b = t >> 13;
        f32x4 y[4];
#pragma unroll
        for (int j = 0; j < 4; ++j) y[j] = (f32x4){0.f, 0.f, 0.f, 0.f};
#if !MK_SKIP_ROUTED
        int myslot = 0;
        if (lane < 8) myslot = off[EIDX[t * 8 + lane]] + POS[t * 8 + lane];
        v4u yv[8][2];
#pragma unroll
        for (int k = 0; k < 8; ++k) { const int slot = __shfl(myslot, k); const v4u* yp = (const v4u*)(YP + (size_t)slot * D) + lane; yv[k][0] = yp[0]; yv[k][1] = yp[64]; }
#pragma unroll
        for (int k = 0; k < 8; ++k)
#pragma unroll
            for (int hh = 0; hh < 2; ++hh) { const v4u v = yv[k][hh];
                y[2 * hh] += (f32x4){bflo(v.x), bfhi(v.x), bflo(v.y), bfhi(v.y)}; y[2 * hh + 1] += (f32x4){bflo(v.z), bfhi(v.z), bflo(v.w), bfhi(v.w)}; }
#endif
        f32x4 v[4]; float ss = 0.f;
#pragma unroll
        for (int j = 0; j < 4; ++j) { const int col = 512 * (j >> 1) + 8 * lane + 4 * (j & 1);
            const f32x4 g2 = *(const f32x4*)(mod + b * NMOD + 5 * D + col); v[j] = *(const f32x4*)(X1 + (size_t)t * D + col) + g2 * y[j];
            ss += (v[j].x * v[j].x + v[j].y * v[j].y) + (v[j].z * v[j].z + v[j].w * v[j].w); }
        const float rstd = 1.0f / sqrtf(wave_sum(ss) * (1.0f / D) + EPS);
#pragma unroll
        for (int j = 0; j < 4; ++j) { const int col = 512 * (j >> 1) + 8 * lane + 4 * (j & 1); *(f32x4*)(F.out + (size_t)t * D + col) = v[j] * rstd * gn[j]; }
    }
}

struct Args { const void* in[22]; float* out; unsigned char* ws; int ph_lo, ph_hi, li, abl; };
__global__ void __launch_bounds__(NT, 2) mk_fwd(Args args) {
    extern __shared__ __attribute__((aligned(16))) unsigned char lds[];
    Frame F;
    F.lds = (LAS unsigned char*)lds; F.ldsb = (unsigned)(size_t)F.lds;
    F.MISC = (volatile LAS unsigned*)(F.lds + MISC_OFF);
    F.tid = threadIdx.x; F.lane = F.tid & 63; F.wave = __builtin_amdgcn_readfirstlane(F.tid >> 6);
    F.G = gridDim.x; { const int bx = blockIdx.x; F.vcu = (F.G % 8 == 0) ? (bx % 8) * (F.G / 8) + bx / 8 : bx; }
    F.abl = MK_ABL_RT ? args.abl : 0;
    unsigned char* ws = args.ws; F.ws = ws; F.ctl = (gu32*)(ws + WS_CTL); F.out = args.out;
    F.x = (const float*)args.in[0]; F.c = (const float*)args.in[1]; F.pos = (const int*)args.in[2]; F.w_ada = (const float*)args.in[3]; F.b_ada = (const float*)args.in[4];
    F.norm_mix_g = (const float*)args.in[5]; F.w_in = (const float*)args.in[6]; F.ret_norm_g = (const float*)args.in[7]; F.conv_w = (const float*)args.in[8];
    F.w_br_ret = (const float*)args.in[9]; F.w_br_conv = (const float*)args.in[10]; F.w_out = (const float*)args.in[11]; F.norm_ffn_g = (const float*)args.in[12];
    F.w_router = (const float*)args.in[13]; F.router_bias = (const float*)args.in[14]; F.w_eg = (const float*)args.in[15]; F.w_eu = (const float*)args.in[16]; F.w_ed = (const float*)args.in[17];
    F.w_sg = (const float*)args.in[18]; F.w_su = (const float*)args.in[19]; F.w_sd = (const float*)args.in[20]; F.norm_final_g = (const float*)args.in[21];
    for (int u = F.tid; u < (LDS_BYTES - LDSCTL_OFF) / 4; u += NT) ((LAS unsigned*)(F.lds + LDSCTL_OFF))[u] = 0u;
    __syncthreads();
    XcdBarrier bar; bar.bar = (unsigned*)(F.ctl + CW_BAR) + args.li * XCD_BAR_WORDS; bar.x = 0; bar.st = nullptr;
    if (!MK_PER_PHASE) bar = xcd_barrier_post((unsigned*)(F.ctl + CW_BAR) + args.li * XCD_BAR_WORDS, F.MISC + 8);
    const int lo = args.ph_lo, hi = args.ph_hi;
#ifndef MK_PHASE_MASK
#define MK_PHASE_MASK 0x1fff
#endif
#define IN(k) (((MK_PHASE_MASK >> (k)) & 1) && lo <= (k) && (k) < hi)
#ifndef MK_BAR_REP
#define MK_BAR_REP 1
#endif
#define SEAM(k) do { if (IN(k) && IN((k) + 1)) { for (int br_ = 0; br_ < MK_BAR_REP; ++br_) xcd_barrier(bar); } } while (0)
#ifndef MK_DOUBLE_MASK
#define MK_DOUBLE_MASK 0
#endif
#define REP(k) for (int rep_ = 0; rep_ < (((MK_DOUBLE_MASK >> (k)) & 1) ? 2 : 1); ++rep_, (((MK_DOUBLE_MASK >> (k)) & 1) && rep_ == 1 ? xcd_barrier(bar) : (void)0))
    bf16* HB = (bf16*)(ws + WS_HB); bf16* PROJ = (bf16*)(ws + WS_PROJ); const float* mod = (const float*)(ws + WS_MOD);

    if (IN(0)) { p0_prologue(F); } SEAM(0);
    if (IN(1)) { norm_mod_rows(F, F.x, F.norm_mix_g, 1 * D, 0 * D, HB); } SEAM(1);
    if (IN(2)) {
        pg8::Gemm g{HB, (const bf16*)(ws + WS_WIN), M, NIN, D}; pg8::StaticOrder S; S.init(M, NIN, F.G, (int)blockIdx.x);
        pg8::EpiBf16 E{PROJ, NIN};
        pg8::gemm_phase<pg8::EpiBf16, pg8::StaticOrder, true, true>(F.lds, g, S, E);
    } SEAM(2);
    if (IN(3)) { p3_kv_conv(F); } SEAM(3);
    if (IN(4)) { p4_scan(F); } SEAM(4);
    if (IN(5)) { p5_retention(F); } SEAM(5);
    if (IN(6)) {
        { pg8::Gemm g{(const bf16*)(ws + WS_RETG), (const bf16*)(ws + WS_WBR), M, D, D}; pg8::StaticOrder S; S.init(M, D, F.G, (int)blockIdx.x);
          pg8::EpiGateBf16 E{(bf16*)(ws + WS_MIXP), D, PROJ + OFF_MR, NIN};
          pg8::gemm_phase<pg8::EpiGateBf16, pg8::StaticOrder, true, true>(F.lds, g, S, E); }
        asm volatile("s_waitcnt vmcnt(0)" ::: "memory"); __syncthreads();
        { pg8::Gemm g{(const bf16*)(ws + WS_CONVG), (const bf16*)(ws + WS_WBC), M, D, D}; pg8::StaticOrder S; S.init(M, D, F.G, (int)blockIdx.x);
          pg8::EpiMixBf16 E{(bf16*)(ws + WS_MIX), D, (const bf16*)(ws + WS_MIXP), PROJ + OFF_MC, NIN};
          pg8::gemm_phase<pg8::EpiMixBf16, pg8::StaticOrder, true, true>(F.lds, g, S, E); }
    } SEAM(6);
    if (IN(7)) {
#if MK_SKIP_MIXER
        for (size_t i = (size_t)F.vcu * NT + F.tid; i < (size_t)M * D / 4; i += (size_t)F.G * NT) ((f32x4*)(ws + WS_X1))[i] = ((const f32x4*)F.x)[i];
#else
        pg8::Gemm g{(const bf16*)(ws + WS_MIX), (const bf16*)(ws + WS_WO), M, D, D}; pg8::StaticOrder S; S.init(M, D, F.G, (int)blockIdx.x);
        pg8::EpiResid E{(float*)(ws + WS_X1), F.x, D, mod + 2 * D, NMOD, 13};
        pg8::gemm_phase<pg8::EpiResid, pg8::StaticOrder, true, true>(F.lds, g, S, E);
#endif
    } SEAM(7);
    if (IN(8)) { norm_mod_rows(F, (const float*)(ws + WS_X1), F.norm_ffn_g, 4 * D, 3 * D, HB); } SEAM(8);
    if (IN(9)) {
        { pg8::Gemm g{HB, (const bf16*)(ws + WS_WR), M, NE, D}; pg8::StaticOrder S; S.init(M, NE, F.G, (int)blockIdx.x);
          pg8::EpiF32 E{(float*)(ws + WS_LOGITS), NE};
          pg8::gemm_phase<pg8::EpiF32, pg8::StaticOrder, true, true>(F.lds, g, S, E); }
        { pg8::Gemm g{HB, (const bf16*)(ws + WS_WSGU), M, 2 * EH, D}; pg8::StaticOrder S; S.init(M, 2 * EH, F.G, (int)((blockIdx.x + F.G / 2) % F.G));
          pg8::EpiSwiglu E{(bf16*)(ws + WS_SHG), EH};
          pg8::gemm_phase<pg8::EpiSwiglu, pg8::StaticOrder, true, true>(F.lds, g, S, E); }
    } SEAM(9);
    if (IN(10)) {
#if !MK_SKIP_SHARED && !(MK_EXP_V == 4 && MK_SHARED_IN_P11)
        for (int rp_ = 0; rp_ < MK_P10_GEMM_REP; ++rp_)
        { pg8::Gemm g{(const bf16*)(ws + WS_SHG), (const bf16*)(ws + WS_WSD), M, D, EH}; pg8::StaticOrder S; S.init(M, D, F.G, (int)blockIdx.x);
          pg8::EpiResid E{(float*)(ws + WS_MIXP), (const float*)(ws + WS_X1), D, mod + 5 * D, NMOD, 13};
          pg8::gemm_phase<pg8::EpiResid, pg8::StaticOrder, true, true>(F.lds, g, S, E); }
#endif
        for (int rr_ = 0; rr_ < MK_ROUTE_DRY_REP; ++rr_) route_tokens<true>(F);
        route_tokens<false>(F);
    } SEAM(10);
    if (IN(11)) {
#if !MK_SKIP_ROUTED
#if MK_EXP_V == 4
        p11_experts_v6(F);
#if !MK_SKIP_SHARED && MK_SHARED_IN_P11
        {
            const int nit = ((LAS int*)(F.lds + EX_PREF))[256]; const int R = (nit + F.G - 1) / F.G, n_idle = R * F.G - nit;
            const int rank = n_idle == 0 ? F.vcu : F.vcu - (nit - (R - 1) * F.G), nG = n_idle == 0 ? F.G : n_idle;
            __syncthreads();
            if (rank >= 0) { pg8::Gemm g{(const bf16*)(ws + WS_SHG), (const bf16*)(ws + WS_WSD), M, D, EH}; pg8::StaticOrder S; S.init(M, D, nG, rank);
                pg8::EpiResid E{(float*)(ws + WS_MIXP), (const float*)(ws + WS_X1), D, mod + 5 * D, NMOD, 13};
                pg8::gemm_phase<pg8::EpiResid, pg8::StaticOrder, true, true>(F.lds, g, S, E); }
        }
#endif
#elif MK_EXP_V == 3
        p11_experts_v5(F);
#elif MK_EXP_V == 1
#if MK_ABL_RT
        if (F.abl) p11_experts_k64<MK_ABL_PROBE>(F); else
#endif
        p11_experts_k64<0>(F);
#else
#if MK_ABL_RT
        if (F.abl) p11_experts<MK_ABL_PROBE>(F); else
#endif
        p11_experts<0>(F);
#endif
#endif
    } SEAM(11);
    if (IN(12)) { int t_ = (int)threadIdx.x; asm volatile("" : "+v"(t_)); F.tid = t_; F.lane = t_ & 63;
        p12_final(F); }
#undef IN
#undef SEAM
}

extern "C" void kernel_launch(void* const* d_in, const int* in_sizes, int n_in, void* d_out, int out_size, void* d_ws, size_t ws_size, hipStream_t stream) {
    static int grid = 0;
    if (grid == 0) {
        if (n_in != 22 || in_sizes[0] != M * D || out_size != M * D || ws_size < WS_END) { fprintf(stderr, "kernel_launch: unexpected shapes (n_in %d, in0 %d, out %d, ws %zu, need %zu); nothing launched\n", n_in, n_in > 0 ? in_sizes[0] : -1, out_size, ws_size, (size_t)WS_END); grid = -1; return; }
        int dev = 0, cus = 0, per_cu = 0;
        if (hipGetDevice(&dev) != hipSuccess || hipDeviceGetAttribute(&cus, hipDeviceAttributeMultiprocessorCount, dev) != hipSuccess) { fprintf(stderr, "kernel_launch: device query failed\n"); grid = -1; return; }
        if (hipFuncSetAttribute((const void*)mk_fwd, hipFuncAttributeMaxDynamicSharedMemorySize, LDS_BYTES) != hipSuccess) { fprintf(stderr, "kernel_launch: hipFuncSetAttribute failed\n"); grid = -1; return; }
        if (hipOccupancyMaxActiveBlocksPerMultiprocessor(&per_cu, (const void*)mk_fwd, NT, LDS_BYTES) != hipSuccess || per_cu < 1) { fprintf(stderr, "kernel_launch: occupancy query reports %d workgroups per CU\n", per_cu); (void)hipGetLastError(); grid = -1; return; }
        grid = cus;
    }
    if (grid < 0) return;
    if (hipMemsetAsync((char*)d_ws + WS_CTL, 0, CTL_ZERO_BYTES, stream) != hipSuccess) { fprintf(stderr, "kernel_launch: hipMemsetAsync failed\n"); return; }
    Args a{};
    for (int i = 0; i < 22; ++i) a.in[i] = d_in[i];
    a.out = (float*)d_out; a.ws = (unsigned char*)d_ws;
#if MK_PER_PHASE
    for (int p = 0; p < NPHASE; ++p) { a.ph_lo = p; a.ph_hi = p + 1; hipLaunchKernelGGL(mk_fwd, dim3(grid), dim3(NT), LDS_BYTES, stream, a); }
#elif defined(MK_ABL_PROBE)
    a.ph_lo = 0; a.ph_hi = 12; a.li = 0; a.abl = 1; hipLaunchKernelGGL(mk_fwd, dim3(grid), dim3(NT), LDS_BYTES, stream, a);
    a.ph_lo = 11; a.ph_hi = NPHASE; a.li = 1; a.abl = 0; hipLaunchKernelGGL(mk_fwd, dim3(grid), dim3(NT), LDS_BYTES, stream, a);
#elif defined(MK_PROBE_LO)
    a.ph_lo = 0; a.ph_hi = MK_PROBE_HI; a.li = 0; hipLaunchKernelGGL(mk_fwd, dim3(grid), dim3(NT), LDS_BYTES, stream, a);
    a.ph_lo = MK_PROBE_LO; a.ph_hi = NPHASE; a.li = 1; hipLaunchKernelGGL(mk_fwd, dim3(grid), dim3(NT), LDS_BYTES, stream, a);
#else
    a.ph_lo = 0; a.ph_hi = NPHASE;
    hipLaunchKernelGGL(mk_fwd, dim3(grid), dim3(NT), LDS_BYTES, stream, a);
#endif
    const hipError_t le = hipPeekAtLastError();
    if (le != hipSuccess) fprintf(stderr, "kernel_launch: launch failed: %s\n", hipGetErrorName(le));
}
```
